# Optimizing an MI355X kernel written in HIP

```python
import jax, jax.numpy as jnp
from jax import lax
import numpy as np

D_MODEL = 4096
BATCH = 4
SEQ = 2048
DEPTH = 1

NORM_EPS = 1e-6
N_MOD = 6
MIX_WIDTH = D_MODEL
GLA_WIDTH = MIX_WIDTH // 2
GLA_DV = 128
GLA_HEADS = GLA_WIDTH // GLA_DV
GLA_DK = GLA_DV // 2
GLA_KEY_WIDTH = GLA_HEADS * GLA_DK
GLA_GATE_RANK = 16
GLA_GATE_TEMP = 16.0
GLA_CHUNK = 64
SWA_HEAD_DIM = 64
SWA_Q_HEADS = (MIX_WIDTH - GLA_WIDTH) // SWA_HEAD_DIM
SWA_KV_HEADS = SWA_Q_HEADS // 8
SWA_Q_WIDTH = SWA_Q_HEADS * SWA_HEAD_DIM
SWA_KV_WIDTH = SWA_KV_HEADS * SWA_HEAD_DIM
SWA_WINDOW = 128
SWA_BLOCK = 128
ROPE_THETA = 10000.0
IN_SIZES = (GLA_KEY_WIDTH, GLA_KEY_WIDTH, GLA_WIDTH, GLA_WIDTH, GLA_GATE_RANK,
            SWA_Q_WIDTH, SWA_KV_WIDTH, SWA_KV_WIDTH)
IN_WIDTH = sum(IN_SIZES)
IN_OFFSETS = tuple(sum(IN_SIZES[:i + 1]) for i in range(len(IN_SIZES) - 1))
PEER_HEADS = 8
PEER_N_KEYS = 128
PEER_N_EXPERTS = PEER_N_KEYS * PEER_N_KEYS
PEER_QUERY_DIM = 256
PEER_HALF_DIM = PEER_QUERY_DIM // 2
PEER_TOPK = 16
PEER_TOKEN_BLOCK = 64

kernel_name = 'hymba_gla_swa_peer_adaln'


def _rms(x, gain=None):
    xf = x.astype(jnp.float32)
    y = xf * lax.rsqrt(jnp.mean(xf * xf, axis=-1, keepdims=True) + NORM_EPS)
    if gain is not None:
        y = y * gain.astype(jnp.float32)
    return y.astype(x.dtype)


def _modulate(x, shift, scale):
    return _rms(x) * (1 + scale) + shift


def _rope(x, pos):
    half = x.shape[-1] // 2
    inv = ROPE_THETA ** (-jnp.arange(half, dtype=jnp.float32) / half)
    ang = pos.astype(jnp.float32)[:, None] * inv[None, :]
    cos = jnp.cos(ang)[None, :, None, :]
    sin = jnp.sin(ang)[None, :, None, :]
    xf = x.astype(jnp.float32)
    x1, x2 = xf[..., :half], xf[..., half:]
    return jnp.concatenate([x1 * cos - x2 * sin, x2 * cos + x1 * sin], axis=-1).astype(x.dtype)


def _gla(q, k, v, log_a):
    B, S, H, dk = q.shape
    dv = v.shape[-1]
    C = GLA_CHUNK
    n = S // C

    def to_chunks(t):
        return t.reshape(B, n, C, H, t.shape[-1]).transpose(1, 0, 3, 2, 4)

    qc, kc, vc, ac = (to_chunks(t) for t in (q * (dk ** -0.5), k, v, log_a))
    causal = jnp.tril(jnp.ones((C, C), dtype=bool))

    def step(state, inp):
        qi, ki, vi, ai = inp
        b = jnp.cumsum(ai.astype(jnp.float32), axis=2)
        diff = b[:, :, :, None, :] - b[:, :, None, :, :]
        decay = jnp.exp(jnp.where(causal[:, :, None], diff, -jnp.inf))
        attn = jnp.einsum('bhtd,bhsd,bhtsd->bhts', qi, ki, decay)
        o = (jnp.einsum('bhts,bhsv->bhtv', attn, vi)
             + jnp.einsum('bhtd,bhdv->bhtv', qi * jnp.exp(b), state))
        b_last = b[:, :, -1:, :]
        state = (jnp.exp(b_last[:, :, 0, :])[..., None] * state
                 + jnp.einsum('bhsd,bhsv->bhdv', ki * jnp.exp(b_last - b), vi))
        return state, o

    state0 = jnp.zeros((B, H, dk, dv), jnp.float32)
    _, o = lax.scan(step, state0, (qc, kc, vc, ac))
    return o.transpose(1, 0, 3, 2, 4).reshape(B, S, H, dv)


def _swa(q, k, v, sinks):
    B, S, Hq, dh = q.shape
    Hkv = k.shape[2]
    G = Hq // Hkv
    W = SWA_BLOCK
    n = S // W
    qb = q.reshape(B, n, W, Hkv, G, dh)

    def with_prev(t):
        tb = t.reshape(B, n, W, Hkv, dh)
        prev = jnp.pad(tb[:, :-1], ((0, 0), (1, 0), (0, 0), (0, 0), (0, 0)))
        return jnp.concatenate([prev, tb], axis=2)

    kb, vb = with_prev(k), with_prev(v)
    s = jnp.einsum('bnqkgd,bnskd->bnkgqs', qb, kb).astype(jnp.float32) * (dh ** -0.5)
    qpos = jnp.arange(n)[:, None] * W + jnp.arange(W)[None, :]
    kpos = jnp.arange(n)[:, None] * W - W + jnp.arange(2 * W)[None, :]
    rel = qpos[:, :, None] - kpos[:, None, :]
    mask = (rel >= 0) & (rel < SWA_WINDOW) & (kpos[:, None, :] >= 0)
    s = jnp.where(mask[None, :, None, None], s, -jnp.inf)
    sink = sinks.astype(jnp.float32).reshape(Hkv, G)[None, None, :, :, None, None]
    m = jnp.maximum(jnp.max(s, axis=-1, keepdims=True), sink)
    p = jnp.exp(s - m)
    p = p / (jnp.sum(p, axis=-1, keepdims=True) + jnp.exp(sink - m))
    o = jnp.einsum('bnkgqs,bnskd->bnqkgd', p.astype(v.dtype), vb)
    return o.reshape(B, S, Hq, dh)


def _peer(y, w_q, keys_1, keys_2, down, up):
    B, S, D = y.shape
    H, K = PEER_HEADS, PEER_TOPK
    q = (y @ w_q).reshape(B, S, H, 2, PEER_HALF_DIM)
    s1 = jnp.einsum('bshd,kd->bshk', q[..., 0, :], keys_1).astype(jnp.float32)
    s2 = jnp.einsum('bshd,kd->bshk', q[..., 1, :], keys_2).astype(jnp.float32)
    v1, i1 = lax.top_k(s1, K)
    v2, i2 = lax.top_k(s2, K)
    cand = (v1[..., :, None] + v2[..., None, :]).reshape(B, S, H, K * K)
    cidx = (i1[..., :, None] * PEER_N_KEYS + i2[..., None, :]).reshape(B, S, H, K * K)
    top_s, pos = lax.top_k(cand, K)
    idx = jnp.take_along_axis(cidx, pos, axis=-1)
    gate = jax.nn.softmax(top_s, axis=-1)
    T = B * S
    nb = T // PEER_TOKEN_BLOCK
    yt = y.reshape(nb, PEER_TOKEN_BLOCK, D)
    it = idx.reshape(nb, PEER_TOKEN_BLOCK, H * K)
    gt = gate.reshape(nb, PEER_TOKEN_BLOCK, H * K)

    def block(args):
        yb, ib, gb = args
        u = jnp.take(down, ib, axis=0)
        vv = jnp.take(up, ib, axis=0)
        h = jax.nn.gelu(jnp.einsum('td,tkd->tk', yb, u).astype(jnp.float32), approximate=False) * gb
        return jnp.einsum('tk,tkd->td', h.astype(yb.dtype), vv)

    out = lax.map(block, (yt, it, gt))
    return out.reshape(B, S, D)


def setup_inputs(seed: int = 0) -> dict:
    key = jax.random.key(seed)
    ks = jax.random.split(key, 20)
    f32 = jnp.float32
    nrm = lambda k, shape, std: jax.random.normal(k, shape, f32) * std
    gain = lambda k, shape: 1.0 + 0.02 * jax.random.normal(k, shape, f32)
    L, D = DEPTH, D_MODEL
    return {
        'x': nrm(ks[0], (BATCH, SEQ, D), 1.0),
        'c': nrm(ks[1], (BATCH, D), 1.0),
        'w_ada': nrm(ks[2], (L, D, N_MOD * D), 0.005),
        'b_ada': nrm(ks[3], (L, N_MOD * D), 0.02),
        'w_in': nrm(ks[4], (L, D, IN_WIDTH), D ** -0.5),
        'w_gla_gate_up': nrm(ks[5], (L, GLA_GATE_RANK, GLA_KEY_WIDTH), GLA_GATE_RANK ** -0.5),
        'b_gla_gate': nrm(ks[6], (L, GLA_KEY_WIDTH), 0.1),
        'gla_out_norm': gain(ks[7], (L, GLA_DV)),
        'swa_q_norm': gain(ks[8], (L, SWA_HEAD_DIM)),
        'swa_k_norm': gain(ks[9], (L, SWA_HEAD_DIM)),
        'swa_sinks': nrm(ks[10], (L, SWA_Q_HEADS), 1.0),
        'swa_out_norm': gain(ks[11], (L, SWA_HEAD_DIM)),
        'w_out': nrm(ks[12], (L, MIX_WIDTH, D), MIX_WIDTH ** -0.5),
        'w_peer_q': nrm(ks[13], (L, D, PEER_HEADS * PEER_QUERY_DIM), D ** -0.5),
        'peer_sub_keys_1': nrm(ks[14], (L, PEER_N_KEYS, PEER_HALF_DIM), PEER_HALF_DIM ** -0.5),
        'peer_sub_keys_2': nrm(ks[15], (L, PEER_N_KEYS, PEER_HALF_DIM), PEER_HALF_DIM ** -0.5),
        'peer_expert_down': nrm(ks[16], (L, PEER_N_EXPERTS, D), D ** -0.5),
        'peer_expert_up': nrm(ks[17], (L, PEER_N_EXPERTS, D), 1.0),
    }


def reference(x, c, w_ada, b_ada, w_in, w_gla_gate_up, b_gla_gate, gla_out_norm,
              swa_q_norm, swa_k_norm, swa_sinks, swa_out_norm, w_out, w_peer_q,
              peer_sub_keys_1, peer_sub_keys_2, peer_expert_down, peer_expert_up):
    B, S, D = x.shape
    pos = jnp.arange(S)
    c_act = jax.nn.silu(c)
    for l in range(DEPTH):
        mod = (c_act @ w_ada[l] + b_ada[l])[:, None, :]
        sh1, sc1, g1, sh2, sc2, g2 = jnp.split(mod, N_MOD, axis=-1)

        h = _modulate(x, sh1, sc1)
        proj = h @ w_in[l]
        gq, gk, gv, gg, ga, sq, sk, sv = jnp.split(proj, IN_OFFSETS, axis=-1)

        log_a = jax.nn.log_sigmoid((ga @ w_gla_gate_up[l] + b_gla_gate[l]).astype(jnp.float32)) / GLA_GATE_TEMP
        o_gla = _gla(gq.reshape(B, S, GLA_HEADS, GLA_DK), gk.reshape(B, S, GLA_HEADS, GLA_DK),
                     gv.reshape(B, S, GLA_HEADS, GLA_DV), log_a.reshape(B, S, GLA_HEADS, GLA_DK))
        o_gla = _rms(o_gla, gla_out_norm[l]) * jax.nn.silu(gg.reshape(B, S, GLA_HEADS, GLA_DV))
        o_gla = o_gla.reshape(B, S, GLA_WIDTH)

        qh = _rope(_rms(sq.reshape(B, S, SWA_Q_HEADS, SWA_HEAD_DIM), swa_q_norm[l]), pos)
        kh = _rope(_rms(sk.reshape(B, S, SWA_KV_HEADS, SWA_HEAD_DIM), swa_k_norm[l]), pos)
        vh = sv.reshape(B, S, SWA_KV_HEADS, SWA_HEAD_DIM)
        o_swa = _rms(_swa(qh, kh, vh, swa_sinks[l]), swa_out_norm[l]).reshape(B, S, SWA_Q_WIDTH)

        mix = jnp.concatenate([o_gla.astype(x.dtype), o_swa.astype(x.dtype)], axis=-1) @ w_out[l]
        x = x + g1 * mix

        y = _modulate(x, sh2, sc2)
        x = x + g2 * _peer(y, w_peer_q[l], peer_sub_keys_1[l], peer_sub_keys_2[l],
                           peer_expert_down[l], peer_expert_up[l])
    return x
```

```cpp
#include <hip/hip_runtime.h>
#include <cstdio>
#include <cstdint>

#ifndef MK_N_LAUNCHES
#define MK_N_LAUNCHES 1
#endif
#ifndef PROBE_REP_PHASE
#define PROBE_REP_PHASE -1
#endif

#define GAS __attribute__((address_space(1)))
#define LAS __attribute__((address_space(3)))
typedef unsigned short bf16;
typedef unsigned v4u __attribute__((ext_vector_type(4)));
typedef unsigned v2u __attribute__((ext_vector_type(2)));
typedef float f32x4 __attribute__((ext_vector_type(4)));
typedef float f32x2 __attribute__((ext_vector_type(2)));
typedef float f32x16 __attribute__((ext_vector_type(16)));
typedef short bf16x8 __attribute__((ext_vector_type(8)));
using bf16x2 = __attribute__((ext_vector_type(2))) __bf16;

namespace pg8 {
#define PG8_LAS __attribute__((address_space(3)))
typedef unsigned short bf16_t;
typedef short bf16x8 __attribute__((ext_vector_type(8)));
typedef float f32x4 __attribute__((ext_vector_type(4)));
typedef unsigned u32x4 __attribute__((ext_vector_type(4)));
constexpr int BM = 256, BK = 64, HALF = 128, HTB = HALF * BK * 2, STAGE_BYTES = 8 * HTB, NXCD = 8, WGM = 8;

__host__ __device__ __forceinline__ int lds_byte(int r, int c) { const int st = (r >> 4) * 2 + (c >> 5), rr = r & 15, cc = c & 31, ob = rr * 64 + cc * 2; return st * 1024 + (ob ^ (((ob >> 9) & 1) << 5)); }
__host__ __device__ __forceinline__ void stage_rc(int b, int& R, int& C) { const int st = b / 1024, sb = b % 1024, swz = sb ^ (((sb >> 9) & 1) << 5); R = (st >> 1) * 16 + swz / 64; C = (st & 1) * 32 + (swz % 64) / 2; }
__host__ __device__ __forceinline__ int perm32(int rho) { const int n = rho >> 4, i = rho & 15; return 8 * (i >> 2) + 4 * n + (i & 3); }

struct Unit { int pm, pn; };
struct Gemm { const bf16_t* A; const bf16_t* Bt; int M, N, K; };

struct StaticOrder {
    int nM, nN, nwg, G, c;
    __host__ __device__ void init(int M, int N, int G_, int c_) { nM = M / BM; nN = N / BM; nwg = nM * nN; G = G_; c = c_; }
    __host__ __device__ bool next(int i, Unit& u) const {
        const long L = (long)i * G + c; if (L >= nwg) return false;
        int wgid = (int)L; { const int q = nwg / NXCD, r = nwg % NXCD, xcd = wgid % NXCD, off = wgid / NXCD; wgid = (xcd < r ? xcd * (q + 1) : r * (q + 1) + (xcd - r) * q) + off; }
        const int nig = WGM * nN, gid = wgid / nig, fm = gid * WGM, gsz = (nM - fm) < WGM ? (nM - fm) : WGM;
        u.pm = fm + ((wgid % nig) % gsz); u.pn = (wgid % nig) / gsz; return true;
    }
    __device__ __forceinline__ void a_ready(const Unit&) const {}
    __device__ __forceinline__ void done(const Unit&) const {}
};

__device__ __forceinline__ unsigned cvt_pk_bf16(float lo, float hi) { unsigned r; asm volatile("v_cvt_pk_bf16_f32 %0, %1, %2" : "=v"(r) : "v"(lo), "v"(hi)); return r; }

struct EpiBf16 {
    static constexpr bool PERM = true, AFTER_DRAIN = false;
    bf16_t* O; int ldc;
    __device__ __forceinline__ void operator()(const f32x4 (&acc)[2][2][4][2], const Unit& u, int wr, int wc, int fr, int fq) const {
        const int row0 = u.pm * BM + wr * 64 + fr; const int col0 = u.pn * BM + wc * 32 + 8 * fq;
#pragma unroll
        for (int ai = 0; ai < 2; ++ai)
#pragma unroll
            for (int m = 0; m < 4; ++m) { bf16_t* rowp = O + (size_t)(row0 + ai * HALF + m * 16) * ldc + col0;
#pragma unroll
                for (int bj = 0; bj < 2; ++bj) { const f32x4 v0 = acc[ai][bj][m][0], v1 = acc[ai][bj][m][1];
                    u32x4 w; w.x = cvt_pk_bf16(v0[0], v0[1]); w.y = cvt_pk_bf16(v0[2], v0[3]); w.z = cvt_pk_bf16(v1[0], v1[1]); w.w = cvt_pk_bf16(v1[2], v1[3]);
                    *(u32x4*)(rowp + bj * HALF) = w; } }
    }
};
struct EpiResid {
    static constexpr bool PERM = false, AFTER_DRAIN = false;
    const float* base; float* out; int ldc; const float* gate; int gate_stride; int tiles_per_batch;
    __device__ __forceinline__ void operator()(const f32x4 (&acc)[2][2][4][2], const Unit& u, int wr, int wc, int fr, int fq) const {
        const int row0 = u.pm * BM + wr * 64 + fr, col0 = u.pn * BM + wc * 32 + 4 * fq;
        const float* gp = gate + (size_t)(u.pm / tiles_per_batch) * gate_stride + col0;
        f32x4 gv[2][2];
#pragma unroll
        for (int bj = 0; bj < 2; ++bj)
#pragma unroll
            for (int n = 0; n < 2; ++n) gv[bj][n] = *(const f32x4*)(gp + bj * HALF + n * 16);
#pragma unroll
        for (int ai = 0; ai < 2; ++ai)
#pragma unroll
            for (int m = 0; m < 4; ++m) { const size_t off = (size_t)(row0 + ai * HALF + m * 16) * ldc + col0;
#pragma unroll
                for (int bj = 0; bj < 2; ++bj)
#pragma unroll
                    for (int n = 0; n < 2; ++n) { const f32x4 bs = *(const f32x4*)(base + off + bj * HALF + n * 16);
                        *(f32x4*)(out + off + bj * HALF + n * 16) = bs + gv[bj][n] * acc[ai][bj][m][n]; } }
    }
};

template <class Epi, class Sched, bool ALIGN_EPI = false, bool SP2 = false>
__device__ __forceinline__ void gemm_phase(PG8_LAS unsigned char* lds, const Gemm g, const Sched& S, const Epi& E) {
    const int tid = threadIdx.x, wid = __builtin_amdgcn_readfirstlane(tid >> 6), lane = tid & 63, wr = wid >> 2, wc = wid & 3, fr = lane & 15, fq = lane >> 4;
    const int K = g.K, nt = K / BK;
    unsigned voffA[2], voffB[2];
#pragma unroll
    for (int i = 0; i < 2; ++i) { int R, C; stage_rc(tid * 16 + i * 8192, R, C); const int Rb = Epi::PERM ? ((R & ~31) + perm32(R & 31)) : R;
        voffA[i] = (unsigned)(R * K + C) * 2u; voffB[i] = (unsigned)(Rb * K + C) * 2u; }
    const size_t kstep = (size_t)(BK * 2);
    const size_t hstep = (size_t)HALF * K * 2;
    const size_t tstep = 2 * hstep;
    const unsigned ldsw = (unsigned)wid * 1024u;
    const int aoff = lds_byte(wr * 64 + fr, fq * 8), boff = lds_byte(wc * 32 + fr, fq * 8);
#define PG8_SA(b, h) (((b) * 2 + (h)) * HTB)
#define PG8_SB(b, h) ((4 + (b) * 2 + (h)) * HTB)
#define PG8_STAGE(bufoff, gbase, voff) do { _Pragma("unroll") for (int _i = 0; _i < 2; ++_i) \
        __builtin_amdgcn_global_load_lds((const unsigned*)((const char*)(gbase) + (voff)[_i]), (PG8_LAS unsigned*)(lds + (bufoff) + ldsw + _i * 8192), 16, 0, 0); } while (0)
#define PG8_LDA(dst, b, h) do { _Pragma("unroll") for (int m = 0; m < 4; ++m) _Pragma("unroll") for (int k = 0; k < 2; ++k) dst[m][k] = *(const PG8_LAS bf16x8*)(lds + PG8_SA(b, h) + aoff + m * 2048 + k * 1024); } while (0)
#define PG8_LDB(dst, b, h) do { _Pragma("unroll") for (int n = 0; n < 2; ++n) _Pragma("unroll") for (int k = 0; k < 2; ++k) dst[n][k] = *(const PG8_LAS bf16x8*)(lds + PG8_SB(b, h) + boff + n * 2048 + k * 1024); } while (0)
#define PG8_MMA(ai, bj, At, Bt) do { __builtin_amdgcn_s_setprio(1); _Pragma("unroll") for (int m = 0; m < 4; ++m) _Pragma("unroll") for (int n = 0; n < 2; ++n) _Pragma("unroll") for (int k = 0; k < 2; ++k) \
        acc[ai][bj][m][n] = __builtin_amdgcn_mfma_f32_16x16x32_bf16(Bt[n][k], At[m][k], acc[ai][bj][m][n], 0, 0, 0); __builtin_amdgcn_s_setprio(0); } while (0)
#define PG8_WAIT_V(n) asm volatile("s_waitcnt vmcnt(" #n ")" ::: "memory")
#define PG8_WAIT_L(n) asm volatile("s_waitcnt lgkmcnt(" #n ")" ::: "memory")
#define PG8_BAR __builtin_amdgcn_s_barrier()
#define PG8_SCHED __builtin_amdgcn_sched_barrier(0)
    Unit cur, nxt; int ui = 0;
    if (!S.next(0, cur)) return;
    f32x4 acc[2][2][4][2];
#pragma unroll
    for (int a = 0; a < 2; ++a)
#pragma unroll
        for (int b = 0; b < 2; ++b)
#pragma unroll
            for (int m = 0; m < 4; ++m)
#pragma unroll
                for (int n = 0; n < 2; ++n) acc[a][b][m][n] = (f32x4){0.f, 0.f, 0.f, 0.f};
    bf16x8 At[4][2], B0[2][2], B1[2][2];
    const char* cA = (const char*)g.A + (size_t)cur.pm * tstep; const char* cB = (const char*)g.Bt + (size_t)cur.pn * tstep;
    S.a_ready(cur);
    if constexpr (SP2) {
        PG8_STAGE(PG8_SB(0, 0), cB, voffB); PG8_STAGE(PG8_SB(0, 1), cB + hstep, voffB); PG8_STAGE(PG8_SA(0, 0), cA, voffA); PG8_STAGE(PG8_SA(0, 1), cA + hstep, voffA);
        if (wr == 1) PG8_BAR;
        PG8_WAIT_V(2); PG8_BAR;
        PG8_STAGE(PG8_SB(1, 0), cB + kstep, voffB); PG8_STAGE(PG8_SA(1, 0), cA + kstep, voffA); PG8_STAGE(PG8_SB(1, 1), cB + hstep + kstep, voffB);
        PG8_WAIT_V(6); PG8_BAR;
    } else {
        PG8_STAGE(PG8_SB(0, 0), cB, voffB); PG8_STAGE(PG8_SA(0, 0), cA, voffA); PG8_STAGE(PG8_SB(0, 1), cB + hstep, voffB); PG8_STAGE(PG8_SA(0, 1), cA + hstep, voffA);
        if (wr == 1) PG8_BAR;
        PG8_WAIT_V(4); PG8_BAR;
        PG8_STAGE(PG8_SB(1, 0), cB + kstep, voffB); PG8_STAGE(PG8_SA(1, 0), cA + kstep, voffA); PG8_STAGE(PG8_SB(1, 1), cB + hstep + kstep, voffB);
        PG8_WAIT_V(6); PG8_BAR;
    }
    for (;;) {
        const bool has_next = S.next(ui + 1, nxt);
        const char* nA = has_next ? (const char*)g.A + (size_t)nxt.pm * tstep : cA; const char* nB = has_next ? (const char*)g.Bt + (size_t)nxt.pn * tstep : cB;
        for (int t = 0; t < nt; t += 2) {
            const bool last = (t == nt - 2);
            const char* a1 = cA + (size_t)(t + 1) * kstep;
            const char* a2 = last ? nA : cA + (size_t)(t + 2) * kstep; const char* b2 = last ? nB : cB + (size_t)(t + 2) * kstep;
            const char* a3 = a2 + kstep; const char* b3 = b2 + kstep;
            if (last && has_next) S.a_ready(nxt);
            if constexpr (SP2) {
            PG8_LDB(B0, 0, 0); PG8_LDB(B1, 0, 1); PG8_SCHED; PG8_LDA(At, 0, 0); PG8_STAGE(PG8_SA(1, 1), a1 + hstep, voffA);
            PG8_WAIT_V(8); PG8_WAIT_L(0); PG8_BAR; PG8_MMA(0, 0, At, B0); PG8_MMA(0, 1, At, B1); PG8_BAR; PG8_SCHED;
            PG8_LDA(At, 0, 1); PG8_STAGE(PG8_SB(0, 0), b2, voffB); PG8_STAGE(PG8_SB(0, 1), b2 + hstep, voffB); PG8_STAGE(PG8_SA(0, 0), a2, voffA);
            PG8_WAIT_V(8); PG8_WAIT_L(0); PG8_BAR; PG8_MMA(1, 0, At, B0); PG8_MMA(1, 1, At, B1); PG8_BAR; PG8_SCHED;
            PG8_LDB(B0, 1, 0); PG8_LDB(B1, 1, 1); PG8_SCHED; PG8_LDA(At, 1, 0); PG8_STAGE(PG8_SA(0, 1), a2 + hstep, voffA);
            PG8_WAIT_V(8); PG8_WAIT_L(0); PG8_BAR; PG8_MMA(0, 0, At, B0); PG8_MMA(0, 1, At, B1); PG8_BAR; PG8_SCHED;
            PG8_LDA(At, 1, 1); PG8_STAGE(PG8_SB(1, 0), b3, voffB); PG8_STAGE(PG8_SB(1, 1), b3 + hstep, voffB); PG8_STAGE(PG8_SA(1, 0), a3, voffA);
            PG8_WAIT_V(8); PG8_WAIT_L(0); PG8_BAR; PG8_MMA(1, 0, At, B0); PG8_MMA(1, 1, At, B1); PG8_BAR; PG8_SCHED;
            } else {
            PG8_LDB(B0, 0, 0); PG8_SCHED; PG8_LDA(At, 0, 0); PG8_STAGE(PG8_SA(1, 1), a1 + hstep, voffA);
            PG8_WAIT_L(8); PG8_BAR; PG8_WAIT_L(0); PG8_MMA(0, 0, At, B0); PG8_BAR; PG8_SCHED;
            PG8_LDB(B1, 0, 1); PG8_STAGE(PG8_SB(0, 0), b2, voffB);
            PG8_BAR; PG8_WAIT_L(0); PG8_MMA(0, 1, At, B1); PG8_BAR;
            PG8_LDA(At, 0, 1); PG8_STAGE(PG8_SA(0, 0), a2, voffA);
            PG8_BAR; PG8_WAIT_L(0); PG8_MMA(1, 0, At, B0); PG8_BAR; PG8_SCHED;
            PG8_STAGE(PG8_SB(0, 1), b2 + hstep, voffB);
            PG8_WAIT_V(6); PG8_BAR; PG8_MMA(1, 1, At, B1); PG8_BAR;
            PG8_LDB(B0, 1, 0); PG8_SCHED; PG8_LDA(At, 1, 0); PG8_STAGE(PG8_SA(0, 1), a2 + hstep, voffA);
            PG8_WAIT_L(8); PG8_BAR; PG8_WAIT_L(0); PG8_MMA(0, 0, At, B0); PG8_BAR; PG8_SCHED;
            PG8_LDB(B1, 1, 1); PG8_STAGE(PG8_SB(1, 0), b3, voffB);
            PG8_BAR; PG8_WAIT_L(0); PG8_MMA(0, 1, At, B1); PG8_BAR;
            PG8_LDA(At, 1, 1); PG8_STAGE(PG8_SA(1, 0), a3, voffA);
            PG8_BAR; PG8_WAIT_L(0); PG8_MMA(1, 0, At, B0); PG8_BAR; PG8_SCHED;
            PG8_STAGE(PG8_SB(1, 1), b3 + hstep, voffB);
            PG8_WAIT_V(6); PG8_BAR; PG8_MMA(1, 1, At, B1); PG8_BAR;
            }
        }
        if constexpr (ALIGN_EPI) { if (wr == 0) PG8_BAR; }
        if constexpr (!Epi::AFTER_DRAIN) { E(acc, cur, wr, wc, fr, fq); S.done(cur); }
        if (!has_next) break;
#pragma unroll
        for (int a = 0; a < 2; ++a)
#pragma unroll
            for (int b = 0; b < 2; ++b)
#pragma unroll
                for (int m = 0; m < 4; ++m)
#pragma unroll
                    for (int n = 0; n < 2; ++n) acc[a][b][m][n] = (f32x4){0.f, 0.f, 0.f, 0.f};
        cur = nxt; cA = nA; cB = nB; ++ui;
        if constexpr (ALIGN_EPI) { if (wr == 1) PG8_BAR; }
    }
    PG8_WAIT_V(0);
    if constexpr (!ALIGN_EPI) { if (wr == 0) PG8_BAR; }
    PG8_BAR;
#undef PG8_SA
#undef PG8_SB
#undef PG8_STAGE
#undef PG8_LDA
#undef PG8_LDB
#undef PG8_MMA
#undef PG8_WAIT_V
#undef PG8_WAIT_L
#undef PG8_BAR
#undef PG8_SCHED
}
}

constexpr int NWAVES = 8;
constexpr int NPHASE = 11;
constexpr int N_LAUNCHES = MK_N_LAUNCHES;
constexpr int BATCH = 4, SEQ = 2048, DM = 4096, NTOK = BATCH * SEQ;
constexpr int NMOD = 6 * DM;
constexpr int IN_WIDTH = 8720;
constexpr int NPROJ = 8960;
constexpr int C_GQ = 0, C_GK = 1024, C_GV = 2048, C_GG = 4096, C_SQ = 6144, C_SK = 8192, C_SV = 8448, C_GA = 8704;
constexpr int NEXP = 16384, PEER_N = 2048;
constexpr float EPS = 1e-6f;

constexpr size_t MiB = 1u << 20;
constexpr size_t WS_CTL = 0, CTL_ZERO_BYTES = 1 * MiB;
constexpr size_t WS_MOD = 1 * MiB;
constexpr size_t WS_ROPE = 2 * MiB;
constexpr size_t WS_BTIN = 4 * MiB;
constexpr size_t WS_BTOUT = 74 * MiB;
constexpr size_t WS_BTQ = 106 * MiB;
constexpr size_t WS_HBUF = 122 * MiB;
constexpr size_t WS_PROJ = 186 * MiB;
constexpr size_t WS_MIXIN = 326 * MiB;
constexpr size_t WS_QPEER = 390 * MiB;
constexpr size_t WS_IDX = 422 * MiB;
constexpr size_t WS_GATE = 426 * MiB;
constexpr size_t WS_DC8 = 430 * MiB;
constexpr size_t WS_UC8 = 494 * MiB;
constexpr size_t WS_YC8 = 558 * MiB;
constexpr size_t WS_ZP = 590 * MiB;
constexpr size_t WS_EIDX = 654 * MiB;
constexpr size_t WS_GATEQ = 658 * MiB;
constexpr size_t WS_HE = 662 * MiB;
constexpr size_t WS_DSC = 666 * MiB;
constexpr size_t WS_YSC = 667 * MiB;
constexpr size_t WS_EIDX16 = 668 * MiB;
constexpr size_t WS_END = 670 * MiB;
constexpr int CW_BAR = 4096;

constexpr int RING_BYTES = 131072;
constexpr int LDSCTL_OFF = RING_BYTES, MISC_OFF = LDSCTL_OFF + 320;
constexpr int LDS_BYTES = 155648;

#define LDS_WAIT() asm volatile("s_waitcnt lgkmcnt(0)" ::: "memory")
#define VM_WAIT() asm volatile("s_waitcnt vmcnt(0)" ::: "memory")
__device__ __forceinline__ unsigned f2bf(float f) { unsigned u = __builtin_bit_cast(unsigned, f); return (u + 0x7fffu + ((u >> 16) & 1u)) >> 16; }
__device__ __forceinline__ unsigned pk2(float lo, float hi) { return f2bf(lo) | (f2bf(hi) << 16); }
__device__ __forceinline__ float bflo(unsigned w) { return __builtin_bit_cast(float, w << 16); }
__device__ __forceinline__ float bfhi(unsigned w) { return __builtin_bit_cast(float, w & 0xffff0000u); }
__device__ __forceinline__ float dot2_bf16(unsigned w, unsigned x, float acc) { return __builtin_amdgcn_fdot2_f32_bf16(__builtin_bit_cast(bf16x2, w), __builtin_bit_cast(bf16x2, x), acc, false); }
__device__ __forceinline__ f32x16 mfma32(bf16x8 a, bf16x8 b, f32x16 c) { return __builtin_amdgcn_mfma_f32_32x32x16_bf16(a, b, c, 0, 0, 0); }
__device__ __forceinline__ f32x4 mfma16(bf16x8 a, bf16x8 b, f32x4 c) { return __builtin_amdgcn_mfma_f32_16x16x32_bf16(a, b, c, 0, 0, 0); }
__device__ __forceinline__ bf16x8 mk8(unsigned a, unsigned b, unsigned c, unsigned d) { v4u t = {a, b, c, d}; return __builtin_bit_cast(bf16x8, t); }
__device__ __forceinline__ float silu_f(float x) { return x / (1.0f + __expf(-x)); }

#define XB_TMO      128
#define XB_XCNT(j)  (256  + 64 * (j))
#define XB_XSUB(j)  (1280 + 64 * (j))
#define XB_XGEN(j)  (2304 + 64 * (j))
#define XB_TOP      3328
#define XB_TOPGEN   3392
#define XCD_BAR_WORDS 3456
#define XB_SPIN_CAP (1u << 18)
__device__ __forceinline__ unsigned xb_ld(unsigned* p)              { return __hip_atomic_load(p, __ATOMIC_RELAXED, __HIP_MEMORY_SCOPE_AGENT); }
__device__ __forceinline__ unsigned xb_add(unsigned* p, unsigned v) { return __hip_atomic_fetch_add(p, v, __ATOMIC_RELAXED, __HIP_MEMORY_SCOPE_AGENT); }
__device__ __forceinline__ unsigned xb_xcc_id() { return (unsigned)__builtin_amdgcn_s_getreg((3 << 11) | 20) & 0xFu; }
#define XB_SPIN(cond, bar) do { unsigned _sp = 0; while (cond) { __builtin_amdgcn_s_sleep(1); \
    if ((++_sp & 255u) == 0u) { if (xb_ld(&(bar)[XB_TMO])) break; if (_sp > XB_SPIN_CAP) { atomicAdd(&(bar)[XB_TMO], 1u); break; } } } } while (0)
struct XcdBarrier { unsigned* bar; unsigned x; volatile LAS unsigned* st; };
__device__ __forceinline__ XcdBarrier xcd_barrier_post(unsigned* bar, volatile LAS unsigned* st) {
    XcdBarrier b; b.bar = bar; b.x = xb_xcc_id(); b.st = st;
    if (threadIdx.x == 0) (void)xb_add(&bar[XB_XCNT(b.x)], 1u);
    return b;
}
__device__ __forceinline__ void xcd_barrier_complete(unsigned* bar, unsigned x, unsigned& nloc, unsigned& nx) {
    const unsigned G = gridDim.x * gridDim.y * gridDim.z;
    unsigned sum, cnt, mine, sp = 0u;
    for (;;) {
        sum = 0u; cnt = 0u; mine = 0u;
#pragma unroll
        for (unsigned j = 0; j < 16; ++j) { const unsigned c = xb_ld(&bar[XB_XCNT(j)]); sum += c; cnt += (c > 0u) ? 1u : 0u; mine = (j == x) ? c : mine; }
        if (sum == G) break;
        __builtin_amdgcn_s_sleep(1);
        if ((++sp & 255u) == 0u) { if (xb_ld(&bar[XB_TMO])) break; if (sp > XB_SPIN_CAP) { atomicAdd(&bar[XB_TMO], 1u); break; } }
    }
    nloc = mine > 0u ? mine : 1u; nx = cnt > 0u ? cnt : 1u;
}
__device__ __forceinline__ void xcd_barrier(const XcdBarrier& b) {
    asm volatile("s_waitcnt vmcnt(0)" ::: "memory");
    __syncthreads();
    if (threadIdx.x == 0) {
        unsigned* bar = b.bar;
        __builtin_amdgcn_s_waitcnt(0);
        unsigned nloc = b.st[0], nx = b.st[1];
        if (nloc == 0u) { xcd_barrier_complete(bar, b.x, nloc, nx); b.st[0] = nloc; b.st[1] = nx; }
        const unsigned old = xb_add(&bar[XB_XSUB(b.x)], 1u);
        const unsigned gen = old / nloc;
        if (old + 1u == (gen + 1u) * nloc) {
            __builtin_amdgcn_fence(__ATOMIC_RELEASE, "agent");
            asm volatile("s_waitcnt vmcnt(0)" ::: "memory");
            const unsigned og = xb_add(&bar[XB_TOP], 1u);
            const unsigned tg = og / nx;
            if (og + 1u == (tg + 1u) * nx) xb_add(&bar[XB_TOPGEN], 1u);
            else XB_SPIN(xb_ld(&bar[XB_TOPGEN]) == tg, bar);
            __builtin_amdgcn_fence(__ATOMIC_ACQUIRE, "agent");
            xb_add(&bar[XB_XGEN(b.x)], 1u);
            asm volatile("s_waitcnt vmcnt(0)" ::: "memory");
        } else {
            XB_SPIN(xb_ld(&bar[XB_XGEN(b.x)]) == gen, bar);
            __builtin_amdgcn_fence(__ATOMIC_ACQUIRE, "agent");
            asm volatile("s_waitcnt vmcnt(0)" ::: "memory");
        }
    }
    __syncthreads();
}

struct Frame {
    LAS unsigned char* lds;
    volatile LAS unsigned* MISC;
    unsigned* ctl;
    int tid, lane, wave, vcu, G;
    const float *x, *c, *w_ada, *b_ada, *w_in, *w_gate_up, *b_gla_gate, *gla_out_norm, *swa_q_norm, *swa_k_norm, *swa_sinks, *swa_out_norm, *w_out, *w_peer_q, *keys1, *keys2, *edown, *eup;
    float* out;
    float *MOD, *ROPE;
    bf16 *BTIN, *BTOUT, *BTQ, *HBUF, *PROJ, *MIXIN, *QPEER;
    unsigned char *DC8, *UC8, *YC8;
    int* ZP; unsigned *EIDX, *HE, *EIDX16; float *GATEQ, *DSC, *YSC;
};

__device__ __forceinline__ float wave_sum(float v) {
#pragma unroll
    for (int o = 1; o < 64; o <<= 1) v += __shfl_xor(v, o);
    return v;
}
__device__ __forceinline__ float wave_max(float v) {
#pragma unroll
    for (int o = 1; o < 64; o <<= 1) v = fmaxf(v, __shfl_xor(v, o));
    return v;
}
__device__ __forceinline__ unsigned pack4i(float a, float b, float c, float d) {
    const int q0 = (int)__builtin_rintf(a), q1 = (int)__builtin_rintf(b), q2 = (int)__builtin_rintf(c), q3 = (int)__builtin_rintf(d);
    return (unsigned)(q0 & 255) | ((unsigned)(q1 & 255) << 8) | ((unsigned)(q2 & 255) << 16) | ((unsigned)q3 << 24);
}

__device__ __forceinline__ void p0_tr_item(const float* W, int ldw, int sc0, int ncols, bf16* WT, int dr0, int k0, LAS float* scr, int lane) {
    const int c = lane & 31;
#pragma unroll 8
    for (int i = 0; i < 32; ++i) { const int kk = 2 * i + (lane >> 5); scr[kk * 33 + c] = (c < ncols) ? W[(size_t)(k0 + kk) * ldw + sc0 + c] : 0.f; }
    LDS_WAIT(); asm volatile("" ::: "memory");
    const int c8 = lane & 7;
#pragma unroll
    for (int j = 0; j < 4; ++j) { const int n = (lane >> 3) + 8 * j; const LAS float* s = scr + (8 * c8) * 33 + n;
        v4u o; o.x = pk2(s[0 * 33], s[1 * 33]); o.y = pk2(s[2 * 33], s[3 * 33]); o.z = pk2(s[4 * 33], s[5 * 33]); o.w = pk2(s[6 * 33], s[7 * 33]);
        if (n < ncols) *(GAS v4u*)(WT + (size_t)(dr0 + n) * DM + k0 + 8 * c8) = o; }
    LDS_WAIT(); asm volatile("" ::: "memory");
}

__device__ __forceinline__ void p0_prologue(Frame& F) {
    const int tid = F.tid, lane = F.lane, wave = F.wave;
    {
        LAS f32x4* cact = (LAS f32x4*)F.lds;
        LAS float* red = (LAS float*)(F.lds + 65536);
        for (int k = tid; k < DM; k += 512) { f32x4 v;
#pragma unroll
            for (int b = 0; b < 4; ++b) { const float cv = F.c[b * DM + k]; v[b] = cv / (1.0f + expf(-cv)); }
            cact[k] = v; }
        __syncthreads();
        for (int slice = F.vcu; slice < 256; slice += F.G) {
            const int col0 = slice * 96, sub = lane / 24, cl = lane - sub * 24;
            f32x4 acc[4];
#pragma unroll
            for (int b = 0; b < 4; ++b) acc[b] = (f32x4){0.f, 0.f, 0.f, 0.f};
            if (lane < 48) {
                const float* wp = F.w_ada + col0 + 4 * cl;
#pragma unroll 8
                for (int k = wave * 2 + sub; k < DM; k += 16) {
                    const f32x4 w = *(const GAS f32x4*)(wp + (size_t)k * NMOD); const f32x4 cv = cact[k];
#pragma unroll
                    for (int b = 0; b < 4; ++b) acc[b] += w * cv[b];
                }
#pragma unroll
                for (int b = 0; b < 4; ++b) *(LAS f32x4*)(red + (wave * 48 + lane) * 16 + 4 * b) = acc[b];
            }
            __syncthreads();
            if (tid < 384) { const int b = tid / 96, col = tid - b * 96, cl2 = col >> 2, e = col & 3; float s = 0.f;
#pragma unroll
                for (int w = 0; w < 8; ++w) { s += red[(w * 48 + cl2) * 16 + 4 * b + e]; s += red[(w * 48 + 24 + cl2) * 16 + 4 * b + e]; }
                F.MOD[b * NMOD + col0 + col] = s + F.b_ada[col0 + col]; }
            __syncthreads();
        }
    }
    const int gw = F.vcu * NWAVES + wave, NGW = F.G * NWAVES;
    {
        LAS float* scr = (LAS float*)(F.lds + wave * 16384);
        constexpr int NB0 = 192, NB1 = 80, NB2 = 1, NB3 = 128, NB4 = 64, NBT = NB0 + NB1 + NB2 + NB3 + NB4;
        for (int it = gw; it < NBT * 64; it += NGW) {
            int nb = it >> 6; const int k0 = (it & 63) * 64;
            if (nb < NB0) { p0_tr_item(F.w_in, IN_WIDTH, 32 * nb, 32, F.BTIN, 32 * nb, k0, scr, lane); continue; } nb -= NB0;
            if (nb < NB1) { p0_tr_item(F.w_in, IN_WIDTH, 6160 + 32 * nb, 32, F.BTIN, 6144 + 32 * nb, k0, scr, lane); continue; } nb -= NB1;
            if (nb < NB2) { p0_tr_item(F.w_in, IN_WIDTH, 6144, 16, F.BTIN, C_GA, k0, scr, lane); continue; } nb -= NB2;
            if (nb < NB3) { p0_tr_item(F.w_out, DM, 32 * nb, 32, F.BTOUT, 32 * nb, k0, scr, lane); continue; } nb -= NB3;
            p0_tr_item(F.w_peer_q, PEER_N, 32 * nb, 32, F.BTQ, 32 * nb, k0, scr, lane);
        }
        const size_t gt = (size_t)F.vcu * 512 + tid, NT = (size_t)F.G * 512;
        GAS v4u* z = (GAS v4u*)(F.BTIN + (size_t)(C_GA + 16) * DM);
        for (size_t i = gt; i < (size_t)240 * DM / 8; i += NT) z[i] = (v4u){0u, 0u, 0u, 0u};
        for (int e = gw; e < NEXP; e += NGW) {
            {
                const GAS f32x4* src = (const GAS f32x4*)(F.edown + (size_t)e * DM);
                f32x4 a[8], b[8]; float m = 0.f;
#pragma unroll
                for (int j = 0; j < 8; ++j) { a[j] = src[2 * (lane + 64 * j)]; b[j] = src[2 * (lane + 64 * j) + 1];
#pragma unroll
                    for (int q = 0; q < 4; ++q) m = fmaxf(m, fmaxf(fabsf(a[j][q]), fabsf(b[j][q]))); }
                m = wave_max(m);
                const float inv = m > 0.f ? 127.0f / m : 0.f;
                if (lane == 0) F.DSC[e] = m * (1.0f / 127.0f);
#pragma unroll
                for (int j = 0; j < 8; ++j) { v2u o; o.x = pack4i(a[j][0] * inv, a[j][1] * inv, a[j][2] * inv, a[j][3] * inv); o.y = pack4i(b[j][0] * inv, b[j][1] * inv, b[j][2] * inv, b[j][3] * inv);
                    *(GAS v2u*)(F.DC8 + ((size_t)(lane + 64 * j) * NEXP + e) * 8) = o; }
            }
            {
                const GAS f32x4* src = (const GAS f32x4*)(F.eup + (size_t)e * DM);
                f32x4 a[8], b[8];
#pragma unroll
                for (int j = 0; j < 8; ++j) { a[j] = src[2 * (lane + 64 * j)]; b[j] = src[2 * (lane + 64 * j) + 1]; }
#pragma unroll
                for (int j = 0; j < 8; ++j) { int w0 = __builtin_amdgcn_cvt_pk_fp8_f32(a[j][0], a[j][1], 0, false); w0 = __builtin_amdgcn_cvt_pk_fp8_f32(a[j][2], a[j][3], w0, true);
                    int w1 = __builtin_amdgcn_cvt_pk_fp8_f32(b[j][0], b[j][1], 0, false); w1 = __builtin_amdgcn_cvt_pk_fp8_f32(b[j][2], b[j][3], w1, true);
                    v2u o; o.x = (unsigned)w0; o.y = (unsigned)w1;
                    *(GAS v2u*)(F.UC8 + ((size_t)(lane + 64 * j) * NEXP + e) * 8) = o; }
            }
        }
        for (size_t e = gt; e < (size_t)SEQ * 32; e += NT) { const int pos = (int)(e >> 5), i = (int)(e & 31);
            const float inv = exp2f(-(float)i * (13.287712379549449f / 32.0f));
            const float ang = (float)pos * inv;
            const double rev = (double)ang * 0.15915494309189535; const float fr = (float)(rev - floor(rev));
            F.ROPE[e] = __builtin_amdgcn_cosf(fr); F.ROPE[SEQ * 32 + e] = __builtin_amdgcn_sinf(fr); }
    }
}

__device__ __forceinline__ void modulate_rows(Frame& F, const float* src, bf16* dst, int sh_off, int sc_off) {
    const int gw = F.vcu * NWAVES + F.wave, NGW = F.G * NWAVES, lane = F.lane;
    for (int m = gw; m < NTOK; m += NGW) {
        const int b = m >> 11;
        const GAS f32x4* xr = (const GAS f32x4*)(src + (size_t)m * DM) + lane;
        f32x4 v[16]; float s = 0.f;
#pragma unroll
        for (int j = 0; j < 16; ++j) { v[j] = xr[64 * j]; s += (v[j].x * v[j].x + v[j].y * v[j].y) + (v[j].z * v[j].z + v[j].w * v[j].w); }
        const float rstd = 1.0f / sqrtf(wave_sum(s) * (1.0f / DM) + EPS);
        const GAS f32x4* shp = (const GAS f32x4*)(F.MOD + b * NMOD + sh_off) + lane;
        const GAS f32x4* scp = (const GAS f32x4*)(F.MOD + b * NMOD + sc_off) + lane;
        GAS v2u* o8 = (GAS v2u*)(dst + (size_t)m * DM) + lane;
#pragma unroll
        for (int j = 0; j < 16; ++j) { const f32x4 sh = shp[64 * j], sc = scp[64 * j]; const f32x4 y = v[j] * rstd * (sc + 1.0f) + sh;
            v2u o; o.x = pk2(y.x, y.y); o.y = pk2(y.z, y.w); o8[64 * j] = o; }
    }
}


__device__ __forceinline__ void p5_modulate_quant(Frame& F) {
    const int gw = F.vcu * NWAVES + F.wave, NGW = F.G * NWAVES, lane = F.lane;
    for (int m = gw; m < NTOK; m += NGW) {
        const int b = m >> 11;
        const GAS f32x4* xr = (const GAS f32x4*)(F.out + (size_t)m * DM);
        f32x4 a[8], c[8]; float s = 0.f;
#pragma unroll
        for (int j = 0; j < 8; ++j) { a[j] = xr[2 * (lane + 64 * j)]; c[j] = xr[2 * (lane + 64 * j) + 1];
            s += (a[j].x * a[j].x + a[j].y * a[j].y) + (a[j].z * a[j].z + a[j].w * a[j].w) + (c[j].x * c[j].x + c[j].y * c[j].y) + (c[j].z * c[j].z + c[j].w * c[j].w); }
        const float rstd = 1.0f / sqrtf(wave_sum(s) * (1.0f / DM) + EPS);
        const GAS f32x4* shp = (const GAS f32x4*)(F.MOD + b * NMOD + 3 * DM);
        const GAS f32x4* scp = (const GAS f32x4*)(F.MOD + b * NMOD + 4 * DM);
        float mx = 0.f;
#pragma unroll
        for (int j = 0; j < 8; ++j) { const int i0 = 2 * (lane + 64 * j);
            a[j] = a[j] * rstd * (scp[i0] + 1.0f) + shp[i0]; c[j] = c[j] * rstd * (scp[i0 + 1] + 1.0f) + shp[i0 + 1];
#pragma unroll
            for (int q = 0; q < 4; ++q) mx = fmaxf(mx, fmaxf(fabsf(a[j][q]), fabsf(c[j][q])));
            *(GAS v4u*)(F.HBUF + (size_t)m * DM + 8 * (lane + 64 * j)) = (v4u){pk2(a[j].x, a[j].y), pk2(a[j].z, a[j].w), pk2(c[j].x, c[j].y), pk2(c[j].z, c[j].w)}; }
        mx = wave_max(mx);
        const float inv = mx > 0.f ? 127.0f / mx : 0.f;
        if (lane == 0) F.YSC[m] = mx * (1.0f / 127.0f);
#pragma unroll
        for (int j = 0; j < 8; ++j) { v2u o; o.x = pack4i(a[j].x * inv, a[j].y * inv, a[j].z * inv, a[j].w * inv); o.y = pack4i(c[j].x * inv, c[j].y * inv, c[j].z * inv, c[j].w * inv);
            *(GAS v2u*)(F.YC8 + ((size_t)(lane + 64 * j) * NTOK + m) * 8) = o; }
    }
}

__device__ __forceinline__ void swa_unit(Frame& F, int u) {
    const int b = u >> 6, kvh = (u >> 4) & 3, n = u & 15, t0 = n * 128;
    LAS unsigned char* KL = F.lds;
    LAS unsigned char* VL = F.lds + 36864;
    const float* COS = F.ROPE; const float* SIN = F.ROPE + SEQ * 32;
    {
        const int key = F.tid >> 1, p = F.tid & 1, kpos = t0 - 128 + key;
        v4u ka[2] = {{0u, 0u, 0u, 0u}, {0u, 0u, 0u, 0u}}, kb[2] = {{0u, 0u, 0u, 0u}, {0u, 0u, 0u, 0u}}, vv[4] = {{0u, 0u, 0u, 0u}, {0u, 0u, 0u, 0u}, {0u, 0u, 0u, 0u}, {0u, 0u, 0u, 0u}};
        float cs[16], sn[16];
#pragma unroll
        for (int i = 0; i < 16; ++i) { cs[i] = 1.f; sn[i] = 0.f; }
        if (kpos >= 0) {
            const bf16* pr = F.PROJ + (size_t)(b * SEQ + kpos) * NPROJ;
            const GAS v4u* kr = (const GAS v4u*)(pr + C_SK + kvh * 64);
            ka[0] = kr[2 * p]; ka[1] = kr[2 * p + 1]; kb[0] = kr[4 + 2 * p]; kb[1] = kr[4 + 2 * p + 1];
            const GAS v4u* vr = (const GAS v4u*)(pr + C_SV + kvh * 64 + 32 * p);
#pragma unroll
            for (int j = 0; j < 4; ++j) vv[j] = vr[j];
            const GAS f32x4* cp = (const GAS f32x4*)(COS + kpos * 32 + 16 * p); const GAS f32x4* sp = (const GAS f32x4*)(SIN + kpos * 32 + 16 * p);
#pragma unroll
            for (int j = 0; j < 4; ++j) { const f32x4 c4 = cp[j], s4 = sp[j];
#pragma unroll
                for (int e = 0; e < 4; ++e) { cs[4 * j + e] = c4[e]; sn[4 * j + e] = s4[e]; } }
        }
        float x1[16], x2[16]; float ss = 0.f;
#pragma unroll
        for (int j = 0; j < 2; ++j)
#pragma unroll
            for (int e = 0; e < 4; ++e) { x1[8 * j + 2 * e] = bflo(ka[j][e]); x1[8 * j + 2 * e + 1] = bfhi(ka[j][e]); x2[8 * j + 2 * e] = bflo(kb[j][e]); x2[8 * j + 2 * e + 1] = bfhi(kb[j][e]); }
#pragma unroll
        for (int i = 0; i < 16; ++i) ss += x1[i] * x1[i] + x2[i] * x2[i];
        ss += __shfl_xor(ss, 1);
        const float rstd = 1.0f / sqrtf(ss * (1.0f / 64.0f) + EPS);
        unsigned o1[8], o2[8];
#pragma unroll
        for (int i = 0; i < 8; ++i) {
            float y1[2], y2[2];
#pragma unroll
            for (int e = 0; e < 2; ++e) { const int d = 2 * i + e; const float a = x1[d] * rstd * F.swa_k_norm[16 * p + d], c = x2[d] * rstd * F.swa_k_norm[32 + 16 * p + d];
                y1[e] = a * cs[d] - c * sn[d]; y2[e] = c * cs[d] + a * sn[d]; }
            o1[i] = pk2(y1[0], y1[1]); o2[i] = pk2(y2[0], y2[1]);
        }
        LAS v4u* kd = (LAS v4u*)(KL + key * 144 + 32 * p);
        kd[0] = (v4u){o1[0], o1[1], o1[2], o1[3]}; kd[1] = (v4u){o1[4], o1[5], o1[6], o1[7]};
        LAS v4u* kd2 = (LAS v4u*)(KL + key * 144 + 64 + 32 * p);
        kd2[0] = (v4u){o2[0], o2[1], o2[2], o2[3]}; kd2[1] = (v4u){o2[4], o2[5], o2[6], o2[7]};
#pragma unroll
        for (int j = 0; j < 4; ++j)
#pragma unroll
            for (int e = 0; e < 4; ++e) { const int d = 32 * p + 8 * j + 2 * e; const unsigned w = vv[j][e];
                *(LAS unsigned short*)(VL + d * 520 + key * 2) = (unsigned short)(w & 0xffffu);
                *(LAS unsigned short*)(VL + (d + 1) * 520 + key * 2) = (unsigned short)(w >> 16); }
    }
    __syncthreads();
    {
        const int g = F.wave, hq = kvh * 8 + g, r = F.lane & 31, h = F.lane >> 5;
        const float sink = F.swa_sinks[hq];
        for (int qt = 0; qt < 4; ++qt) {
            const int qpos = t0 + 32 * qt + r;
            const size_t tok = (size_t)(b * SEQ + qpos);
            const GAS v4u* qr = (const GAS v4u*)(F.PROJ + tok * NPROJ + C_SQ + hq * 64);
            v4u qraw[4];
#pragma unroll
            for (int kk = 0; kk < 4; ++kk) qraw[kk] = qr[2 * kk + h];
            float qf[4][8]; float ss = 0.f;
#pragma unroll
            for (int kk = 0; kk < 4; ++kk)
#pragma unroll
                for (int e = 0; e < 4; ++e) { qf[kk][2 * e] = bflo(qraw[kk][e]); qf[kk][2 * e + 1] = bfhi(qraw[kk][e]); }
#pragma unroll
            for (int kk = 0; kk < 4; ++kk)
#pragma unroll
                for (int j = 0; j < 8; ++j) ss += qf[kk][j] * qf[kk][j];
            ss += __shfl_xor(ss, 32);
            const float rstd = 0.125f / sqrtf(ss * (1.0f / 64.0f) + EPS);
            bf16x8 qfrag[4];
#pragma unroll
            for (int kk = 0; kk < 2; ++kk) {
                float y1[8], y2[8];
                const GAS f32x4* cp = (const GAS f32x4*)(COS + qpos * 32 + 16 * kk + 8 * h); const GAS f32x4* sp = (const GAS f32x4*)(SIN + qpos * 32 + 16 * kk + 8 * h);
                const f32x4 c0 = cp[0], c1 = cp[1], s0 = sp[0], s1 = sp[1];
#pragma unroll
                for (int j = 0; j < 8; ++j) { const int d = 16 * kk + 8 * h + j; const float cc = j < 4 ? c0[j & 3] : c1[j & 3], sv = j < 4 ? s0[j & 3] : s1[j & 3];
                    const float a = qf[kk][j] * rstd * F.swa_q_norm[d], c = qf[kk + 2][j] * rstd * F.swa_q_norm[d + 32];
                    y1[j] = a * cc - c * sv; y2[j] = c * cc + a * sv; }
                qfrag[kk] = mk8(pk2(y1[0], y1[1]), pk2(y1[2], y1[3]), pk2(y1[4], y1[5]), pk2(y1[6], y1[7]));
                qfrag[kk + 2] = mk8(pk2(y2[0], y2[1]), pk2(y2[2], y2[3]), pk2(y2[4], y2[5]), pk2(y2[6], y2[7]));
            }
            f32x16 sacc[5];
#pragma unroll
            for (int tt = 0; tt < 5; ++tt) { f32x16 a = {0.f, 0.f, 0.f, 0.f, 0.f, 0.f, 0.f, 0.f, 0.f, 0.f, 0.f, 0.f, 0.f, 0.f, 0.f, 0.f};
#pragma unroll
                for (int kk = 0; kk < 4; ++kk) { const bf16x8 kf = *(const LAS bf16x8*)(KL + (32 * (qt + tt) + r) * 144 + (16 * kk + 8 * h) * 2); a = mfma32(kf, qfrag[kk], a); }
                sacc[tt] = a; }
            float mx = sink;
#pragma unroll
            for (int tt = 0; tt < 5; ++tt)
#pragma unroll
                for (int i = 0; i < 16; ++i) { const int koff = (i & 3) + 8 * (i >> 2) + 4 * h; const int rel = r + 128 - 32 * tt - koff; const int kidx = 32 * (qt + tt) + koff;
                    const bool valid = (rel >= 0) && (rel < 128) && (t0 - 128 + kidx >= 0);
                    const float s = valid ? sacc[tt][i] : -INFINITY; sacc[tt][i] = s; mx = fmaxf(mx, s); }
            mx = fmaxf(mx, __shfl_xor(mx, 32));
            float sum = 0.f;
#pragma unroll
            for (int tt = 0; tt < 5; ++tt)
#pragma unroll
                for (int i = 0; i < 16; ++i) { const float pv = __expf(sacc[tt][i] - mx); sacc[tt][i] = pv; sum += pv; }
            sum += __shfl_xor(sum, 32);
            const float inv = 1.0f / (sum + __expf(sink - mx));
            f32x16 oacc[2];
#pragma unroll
            for (int dt = 0; dt < 2; ++dt) oacc[dt] = (f32x16){0.f, 0.f, 0.f, 0.f, 0.f, 0.f, 0.f, 0.f, 0.f, 0.f, 0.f, 0.f, 0.f, 0.f, 0.f, 0.f};
#pragma unroll
            for (int tt = 0; tt < 5; ++tt)
#pragma unroll
                for (int s2 = 0; s2 < 2; ++s2) {
                    const bf16x8 pf = mk8(pk2(sacc[tt][8 * s2], sacc[tt][8 * s2 + 1]), pk2(sacc[tt][8 * s2 + 2], sacc[tt][8 * s2 + 3]), pk2(sacc[tt][8 * s2 + 4], sacc[tt][8 * s2 + 5]), pk2(sacc[tt][8 * s2 + 6], sacc[tt][8 * s2 + 7]));
#pragma unroll
                    for (int dt = 0; dt < 2; ++dt) { const LAS unsigned char* vp = VL + (32 * dt + r) * 520 + (32 * (qt + tt) + 16 * s2 + 4 * h) * 2;
                        const v2u lo = *(const LAS v2u*)vp, hi = *(const LAS v2u*)(vp + 16);
                        oacc[dt] = mfma32(mk8(lo.x, lo.y, hi.x, hi.y), pf, oacc[dt]); }
                }
            float so = 0.f;
#pragma unroll
            for (int dt = 0; dt < 2; ++dt)
#pragma unroll
                for (int i = 0; i < 16; ++i) { const float o = oacc[dt][i] * inv; oacc[dt][i] = o; so += o * o; }
            so += __shfl_xor(so, 32);
            const float rs2 = 1.0f / sqrtf(so * (1.0f / 64.0f) + EPS);
            bf16* orow = F.MIXIN + tok * DM + 2048 + hq * 64;
#pragma unroll
            for (int dt = 0; dt < 2; ++dt)
#pragma unroll
                for (int gq = 0; gq < 4; ++gq) { const int d0 = 32 * dt + 8 * gq + 4 * h; const f32x4 gn = *(const GAS f32x4*)(F.swa_out_norm + d0);
                    v2u o; o.x = pk2(oacc[dt][4 * gq] * rs2 * gn[0], oacc[dt][4 * gq + 1] * rs2 * gn[1]); o.y = pk2(oacc[dt][4 * gq + 2] * rs2 * gn[2], oacc[dt][4 * gq + 3] * rs2 * gn[3]);
                    *(GAS v2u*)(orow + d0) = o; }
        }
    }
    __syncthreads();
}

__device__ __forceinline__ void gla_unit(Frame& F, int u) {
    const int b = u >> 4, h = u & 15, tid = F.tid, lane = F.lane, w = F.wave;
    LAS unsigned char* QT = F.lds;
    LAS unsigned char* KT = F.lds + 9216;
    LAS unsigned char* KHT = F.lds + 18432;
    LAS unsigned char* VT = F.lds + 27648;
    LAS float* GV = (LAS float*)(F.lds + 46080);
    LAS float* WG = (LAS float*)(F.lds + 46336);
    LAS float* BG = (LAS float*)(F.lds + 50432);
    LAS float* OB = (LAS float*)(F.lds + 50688);
    for (int i = tid; i < 1024; i += 512) WG[i] = F.w_gate_up[(i >> 6) * 1024 + h * 64 + (i & 63)];
    if (tid < 64) BG[tid] = F.b_gla_gate[h * 64 + tid];
    f32x4 S[4];
#pragma unroll
    for (int i = 0; i < 4; ++i) S[i] = (f32x4){0.f, 0.f, 0.f, 0.f};
    __syncthreads();
    const int r = lane & 15, g = lane >> 4;
    for (int chunk = 0; chunk < 32; ++chunk) {
        const size_t row0 = (size_t)b * SEQ + chunk * 64;
        {
            const bf16* pr = F.PROJ + (row0 + lane) * NPROJ;
            const v4u qv = *(const GAS v4u*)(pr + C_GQ + h * 64 + 8 * w), kv = *(const GAS v4u*)(pr + C_GK + h * 64 + 8 * w);
            const v4u g0 = *(const GAS v4u*)(pr + C_GA), g1 = *(const GAS v4u*)(pr + C_GA + 8);
            float ga[16];
#pragma unroll
            for (int e = 0; e < 4; ++e) { ga[2 * e] = bflo(g0[e]); ga[2 * e + 1] = bfhi(g0[e]); ga[8 + 2 * e] = bflo(g1[e]); ga[8 + 2 * e + 1] = bfhi(g1[e]); }
            float z[8];
            { const f32x4 b0 = *(const LAS f32x4*)(BG + 8 * w), b1 = *(const LAS f32x4*)(BG + 8 * w + 4);
#pragma unroll
              for (int i = 0; i < 4; ++i) { z[i] = b0[i]; z[4 + i] = b1[i]; } }
#pragma unroll
            for (int j = 0; j < 16; ++j) { const f32x4 w0 = *(const LAS f32x4*)(WG + j * 64 + 8 * w), w1 = *(const LAS f32x4*)(WG + j * 64 + 8 * w + 4);
#pragma unroll
                for (int i = 0; i < 4; ++i) { z[i] += ga[j] * w0[i]; z[4 + i] += ga[j] * w1[i]; } }
            float bb[8];
#pragma unroll
            for (int i = 0; i < 8; ++i) { const float zz = z[i]; bb[i] = (fminf(zz, 0.f) - log1pf(__expf(-fabsf(zz)))) * (1.0f / 16.0f); }
#pragma unroll
            for (int off = 1; off < 64; off <<= 1)
#pragma unroll
                for (int i = 0; i < 8; ++i) { const float v = __shfl_up(bb[i], off); if (lane >= off) bb[i] += v; }
            float qn[8], kn[8], kh[8];
#pragma unroll
            for (int e = 0; e < 4; ++e) { qn[2 * e] = bflo(qv[e]); qn[2 * e + 1] = bfhi(qv[e]); kn[2 * e] = bflo(kv[e]); kn[2 * e + 1] = bfhi(kv[e]); }
#pragma unroll
            for (int i = 0; i < 8; ++i) { const float bl = __shfl(bb[i], 63); const float eb = __expf(bb[i]);
                qn[i] = qn[i] * 0.125f * eb; kh[i] = kn[i] * __expf(bl - bb[i]); kn[i] = kn[i] * __expf(-bb[i]);
                if (lane == 0) GV[8 * w + i] = __expf(bl); }
            *(LAS v4u*)(QT + lane * 144 + 16 * w) = (v4u){pk2(qn[0], qn[1]), pk2(qn[2], qn[3]), pk2(qn[4], qn[5]), pk2(qn[6], qn[7])};
            *(LAS v4u*)(KT + lane * 144 + 16 * w) = (v4u){pk2(kn[0], kn[1]), pk2(kn[2], kn[3]), pk2(kn[4], kn[5]), pk2(kn[6], kn[7])};
#pragma unroll
            for (int i = 0; i < 8; ++i) *(LAS unsigned short*)(KHT + (8 * w + i) * 144 + lane * 2) = (unsigned short)f2bf(kh[i]);
            const int t2 = tid >> 3, seg = tid & 7;
            const GAS v4u* vr = (const GAS v4u*)(F.PROJ + (row0 + t2) * NPROJ + C_GV + h * 128 + 16 * seg);
            const v4u v0 = vr[0], v1 = vr[1];
#pragma unroll
            for (int e = 0; e < 4; ++e) {
                *(LAS unsigned short*)(VT + (16 * seg + 2 * e) * 144 + t2 * 2) = (unsigned short)(v0[e] & 0xffffu);
                *(LAS unsigned short*)(VT + (16 * seg + 2 * e + 1) * 144 + t2 * 2) = (unsigned short)(v0[e] >> 16);
                *(LAS unsigned short*)(VT + (16 * seg + 8 + 2 * e) * 144 + t2 * 2) = (unsigned short)(v1[e] & 0xffffu);
                *(LAS unsigned short*)(VT + (16 * seg + 8 + 2 * e + 1) * 144 + t2 * 2) = (unsigned short)(v1[e] >> 16); }
        }
        __syncthreads();
        {
            unsigned dp[4][4][2];
#pragma unroll
            for (int tt = 0; tt < 4; ++tt) {
                const bf16x8 bq0 = *(const LAS bf16x8*)(QT + (16 * tt + r) * 144 + (8 * g) * 2), bq1 = *(const LAS bf16x8*)(QT + (16 * tt + r) * 144 + (32 + 8 * g) * 2);
#pragma unroll
                for (int st = 0; st < 4; ++st) {
                    if (st <= tt) {
                        const bf16x8 ak0 = *(const LAS bf16x8*)(KT + (16 * st + r) * 144 + (8 * g) * 2), ak1 = *(const LAS bf16x8*)(KT + (16 * st + r) * 144 + (32 + 8 * g) * 2);
                        f32x4 d = {0.f, 0.f, 0.f, 0.f}; d = mfma16(ak0, bq0, d); d = mfma16(ak1, bq1, d);
                        if (st == tt) {
#pragma unroll
                            for (int i = 0; i < 4; ++i) if (4 * g + i > r) d[i] = 0.f; }
                        dp[st][tt][0] = pk2(d[0], d[1]); dp[st][tt][1] = pk2(d[2], d[3]);
                    } else { dp[st][tt][0] = 0u; dp[st][tt][1] = 0u; }
                }
            }
#pragma unroll
            for (int tt = 0; tt < 4; ++tt) {
                f32x4 o = {0.f, 0.f, 0.f, 0.f};
#pragma unroll
                for (int kk = 0; kk < 2; ++kk) {
                    const LAS unsigned char* qp = QT + (16 * tt + r) * 144 + (32 * kk + 4 * g) * 2;
                    const v2u lo = *(const LAS v2u*)qp, hi = *(const LAS v2u*)(qp + 32);
                    const bf16x8 bs = mk8(pk2(S[2 * kk][0], S[2 * kk][1]), pk2(S[2 * kk][2], S[2 * kk][3]), pk2(S[2 * kk + 1][0], S[2 * kk + 1][1]), pk2(S[2 * kk + 1][2], S[2 * kk + 1][3]));
                    o = mfma16(mk8(lo.x, lo.y, hi.x, hi.y), bs, o);
                }
#pragma unroll
                for (int kk = 0; kk < 2; ++kk) {
                    if (2 * kk <= tt) {
                        const LAS unsigned char* vp = VT + (16 * w + r) * 144 + (32 * kk + 4 * g) * 2;
                        const v2u lo = *(const LAS v2u*)vp, hi = *(const LAS v2u*)(vp + 32);
                        o = mfma16(mk8(dp[2 * kk][tt][0], dp[2 * kk][tt][1], dp[2 * kk + 1][tt][0], dp[2 * kk + 1][tt][1]), mk8(lo.x, lo.y, hi.x, hi.y), o);
                    }
                }
#pragma unroll
                for (int i = 0; i < 4; ++i) OB[(16 * tt + 4 * g + i) * 132 + 16 * w + r] = o[i];
            }
#pragma unroll
            for (int dt = 0; dt < 4; ++dt) {
                const f32x4 gv = *(const LAS f32x4*)(GV + 16 * dt + 4 * g);
                S[dt] = S[dt] * gv;
#pragma unroll
                for (int kk = 0; kk < 2; ++kk) { const bf16x8 a = *(const LAS bf16x8*)(KHT + (16 * dt + r) * 144 + (32 * kk + 8 * g) * 2), bv = *(const LAS bf16x8*)(VT + (16 * w + r) * 144 + (32 * kk + 8 * g) * 2);
                    S[dt] = mfma16(a, bv, S[dt]); }
            }
        }
        __syncthreads();
        {
            const int t2 = tid >> 3, seg = tid & 7;
            float o[16]; float ss = 0.f;
#pragma unroll
            for (int j = 0; j < 4; ++j) { const f32x4 v = *(const LAS f32x4*)(OB + t2 * 132 + 16 * seg + 4 * j);
#pragma unroll
                for (int e = 0; e < 4; ++e) { o[4 * j + e] = v[e]; ss += v[e] * v[e]; } }
            ss += __shfl_xor(ss, 1); ss += __shfl_xor(ss, 2); ss += __shfl_xor(ss, 4);
            const float rstd = 1.0f / sqrtf(ss * (1.0f / 128.0f) + EPS);
            const GAS v4u* gr = (const GAS v4u*)(F.PROJ + (row0 + t2) * NPROJ + C_GG + h * 128 + 16 * seg);
            const v4u gg0 = gr[0], gg1 = gr[1];
            float gg[16];
#pragma unroll
            for (int e = 0; e < 4; ++e) { gg[2 * e] = bflo(gg0[e]); gg[2 * e + 1] = bfhi(gg0[e]); gg[8 + 2 * e] = bflo(gg1[e]); gg[8 + 2 * e + 1] = bfhi(gg1[e]); }
            unsigned ow[8];
#pragma unroll
            for (int e = 0; e < 8; ++e) { const float a = o[2 * e] * rstd * F.gla_out_norm[16 * seg + 2 * e] * silu_f(gg[2 * e]), c = o[2 * e + 1] * rstd * F.gla_out_norm[16 * seg + 2 * e + 1] * silu_f(gg[2 * e + 1]);
                ow[e] = pk2(a, c); }
            GAS v4u* op = (GAS v4u*)(F.MIXIN + (row0 + t2) * DM + h * 128 + 16 * seg);
            op[0] = (v4u){ow[0], ow[1], ow[2], ow[3]}; op[1] = (v4u){ow[4], ow[5], ow[6], ow[7]};
        }
        __syncthreads();
    }
}

__device__ __forceinline__ void p3_mixer(Frame& F) {
    const int nG = F.G;
    if (nG >= 128) {
        if (F.vcu < 64) { gla_unit(F, F.vcu); }
        else { for (int u = F.vcu - 64; u < 256; u += nG - 64) swa_unit(F, u); }
    } else {
        for (int u = F.vcu; u < 64; u += nG) gla_unit(F, u);
        for (int u = F.vcu; u < 256; u += nG) swa_unit(F, u);
    }
}

__device__ __forceinline__ unsigned f2s(float f) { const unsigned u = __builtin_bit_cast(unsigned, f); return (u & 0x80000000u) ? ~u : (u | 0x80000000u); }
__device__ __forceinline__ float s2f(unsigned s) { const unsigned u = (s & 0x80000000u) ? (s & 0x7fffffffu) : ~s; return __builtin_bit_cast(float, u); }
#define TOPK_INSERT(list, xin) do { unsigned _x = (xin); _Pragma("unroll") for (int _p = 0; _p < 16; ++_p) { const unsigned _hi = list[_p] > _x ? list[_p] : _x; _x = list[_p] > _x ? _x : list[_p]; list[_p] = _hi; } } while (0)

__device__ __forceinline__ void p7_topk(Frame& F) {
    const int tid = F.tid, lane = F.lane, wave = F.wave;
    LAS unsigned char* KY = F.lds;
    LAS unsigned* SC = (LAS unsigned*)(F.lds + 69632 + wave * 4096);
    for (int i = tid; i < 2 * 128 * 64; i += 512) { const int hf = i >> 13, key = (i >> 6) & 127, dp2 = i & 63;
        const float* kp = (hf ? F.keys2 : F.keys1) + key * 128 + 2 * dp2;
        *(LAS unsigned*)(KY + hf * 34816 + key * 272 + dp2 * 4) = pk2(kp[0], kp[1]); }
    __syncthreads();
    const int gw = F.vcu * NWAVES + wave, NGW = F.G * NWAVES;
    const int r = lane & 31, h = lane >> 5;
    for (int task = gw; task < 256 * 8; task += NGW) {
        const int tile = task >> 3, hd = task & 7, tok = tile * 32 + r;
        for (int hf = 0; hf < 2; ++hf) {
            const GAS v4u* qr = (const GAS v4u*)(F.QPEER + (size_t)tok * PEER_N + hd * 256 + hf * 128);
            bf16x8 qf[8];
#pragma unroll
            for (int kk = 0; kk < 8; ++kk) qf[kk] = __builtin_bit_cast(bf16x8, qr[2 * kk + h]);
            unsigned list[16];
#pragma unroll
            for (int p = 0; p < 16; ++p) list[p] = 0u;
#pragma unroll
            for (int T = 0; T < 4; ++T) {
                f32x16 a = {0.f, 0.f, 0.f, 0.f, 0.f, 0.f, 0.f, 0.f, 0.f, 0.f, 0.f, 0.f, 0.f, 0.f, 0.f, 0.f};
#pragma unroll
                for (int kk = 0; kk < 8; ++kk) { const bf16x8 kf = *(const LAS bf16x8*)(KY + hf * 34816 + (32 * T + r) * 272 + (16 * kk + 8 * h) * 2); a = mfma32(kf, qf[kk], a); }
#pragma unroll
                for (int i = 0; i < 16; ++i) { const int key = 32 * T + (i & 3) + 8 * (i >> 2) + 4 * h; const unsigned pkd = (f2s(a[i]) & ~127u) | (unsigned)(127 - key); TOPK_INSERT(list, pkd); }
            }
            unsigned other[16];
#pragma unroll
            for (int p = 0; p < 16; ++p) other[p] = (unsigned)__shfl_xor((int)list[p], 32);
#pragma unroll
            for (int p = 0; p < 16; ++p) TOPK_INSERT(list, other[p]);
            if (h == 0) {
#pragma unroll
                for (int p = 0; p < 16; ++p) SC[(hf * 16 + p) * 32 + r] = list[p]; }
        }
        LDS_WAIT(); asm volatile("" ::: "memory");
        float v1[16], v2[16];
#pragma unroll
        for (int p = 0; p < 16; ++p) { v1[p] = s2f(SC[p * 32 + r] & ~127u); v2[p] = s2f(SC[(16 + p) * 32 + r] & ~127u); }
        unsigned cl[16];
#pragma unroll
        for (int p = 0; p < 16; ++p) cl[p] = 0u;
#pragma unroll
        for (int i = 0; i < 16; ++i)
#pragma unroll
            for (int j = 0; j < 16; ++j) if ((i + 1) * (j + 1) <= 16) { const unsigned pkd = (f2s(v1[i] + v2[j]) & ~255u) | (unsigned)(255 - (i * 16 + j)); TOPK_INSERT(cl, pkd); }
        float val[8]; int eidx[8]; float mx = -INFINITY;
#pragma unroll
        for (int p = 0; p < 16; ++p) { const int pos = 255 - (int)(cl[p] & 255u), i = pos >> 4, j = pos & 15;
            const unsigned a = SC[i * 32 + r], b2 = SC[(16 + j) * 32 + r];
            const float v = s2f(a & ~127u) + s2f(b2 & ~127u); mx = fmaxf(mx, v);
            if ((p >> 3) == h) { val[p & 7] = v; eidx[p & 7] = (127 - (int)(a & 127u)) * 128 + (127 - (int)(b2 & 127u)); } }
        float sum = 0.f, ex[8];
#pragma unroll
        for (int p = 0; p < 8; ++p) { ex[p] = __expf(val[p] - mx); sum += ex[p]; }
        sum += __shfl_xor(sum, 32);
        const float inv = 1.0f / sum;
        const int p4a = hd * 4 + 2 * h;
        GAS v4u* ip = (GAS v4u*)F.EIDX; GAS f32x4* gp = (GAS f32x4*)F.GATEQ;
        ip[(size_t)p4a * NTOK + tok] = (v4u){(unsigned)eidx[0], (unsigned)eidx[1], (unsigned)eidx[2], (unsigned)eidx[3]}; ip[(size_t)(p4a + 1) * NTOK + tok] = (v4u){(unsigned)eidx[4], (unsigned)eidx[5], (unsigned)eidx[6], (unsigned)eidx[7]};
        ((GAS v4u*)F.EIDX16)[(size_t)(hd * 2 + h) * NTOK + tok] = (v4u){(unsigned)eidx[0] | ((unsigned)eidx[1] << 16), (unsigned)eidx[2] | ((unsigned)eidx[3] << 16), (unsigned)eidx[4] | ((unsigned)eidx[5] << 16), (unsigned)eidx[6] | ((unsigned)eidx[7] << 16)};
        gp[(size_t)p4a * NTOK + tok] = (f32x4){ex[0] * inv, ex[1] * inv, ex[2] * inv, ex[3] * inv}; gp[(size_t)(p4a + 1) * NTOK + tok] = (f32x4){ex[4] * inv, ex[5] * inv, ex[6] * inv, ex[7] * inv};
        LDS_WAIT(); asm volatile("" ::: "memory");
    }
}

typedef int i32x4 __attribute__((ext_vector_type(4)));
__device__ __forceinline__ void lds_fill_128k(Frame& F, const unsigned char* src) {
#pragma unroll
    for (int i = 0; i < 16; ++i)
        __builtin_amdgcn_global_load_lds((const unsigned*)(src + (size_t)(i * 512 + F.tid) * 16), (LAS unsigned*)(F.lds + i * 8192 + F.wave * 1024), 16, 0, 0);
}
constexpr int P8_ZOFF = 139264;
constexpr int P8_YB = 132096;
constexpr int P8_DUMMY = 140288;
#define P8_WAITV0() asm volatile("s_waitcnt vmcnt(0)" ::: "memory")
#define P8_BAR() do { asm volatile("s_waitcnt lgkmcnt(0)" ::: "memory"); __builtin_amdgcn_s_barrier(); asm volatile("" ::: "memory"); } while (0)
__device__ __forceinline__ void p8a_sddmm(Frame& F) {
    const int wv = F.wave;
    for (int u = F.vcu; u < 256; u += F.G) {
        const int tg = u & 15, dr = u >> 4, t = tg * 512 + F.tid;
        unsigned id[64];
#pragma unroll
        for (int p8 = 0; p8 < 16; ++p8) { const v4u v = ((const GAS v4u*)F.EIDX16)[(size_t)p8 * NTOK + t]; id[4 * p8] = v.x; id[4 * p8 + 1] = v.y; id[4 * p8 + 2] = v.z; id[4 * p8 + 3] = v.w; }
        int acc[128];
#pragma unroll
        for (int p = 0; p < 128; ++p) acc[p] = 0;
        const unsigned char* tab = F.DC8 + (size_t)(dr * 32) * 131072;
        const unsigned char* ysrc = F.YC8 + ((size_t)(dr * 32) * NTOK + tg * 512) * 8 + (wv & 3) * 1024 + F.lane * 16;
        for (int sl = 0; sl < 32; ++sl) {
#pragma unroll
            for (int i = 0; i < 64; ++i) asm volatile("" : "+v"(id[i]));
            P8_WAITV0();
            P8_BAR();
            lds_fill_128k(F, tab + (size_t)sl * 131072);
            if (wv < 4) __builtin_amdgcn_global_load_lds((const unsigned*)(ysrc + (size_t)sl * NTOK * 8), (LAS unsigned*)(F.lds + P8_YB + wv * 1024), 16, 0, 0);
            P8_WAITV0();
            P8_BAR();
            if (sl + 1 < 32) __builtin_amdgcn_global_load_lds((const unsigned*)(tab + (size_t)(sl + 1) * 131072 + (size_t)tg * 8192 + wv * 1024 + F.lane * 16), (LAS unsigned*)(F.lds + P8_DUMMY + wv * 1024), 16, 0, 0);
            const v2u yv = *(const LAS v2u*)(F.lds + P8_YB + F.tid * 8);
#pragma unroll
            for (int p = 0; p < 128; ++p) {
                const unsigned off = (p & 1) ? ((id[p >> 1] >> 13) & 0x7fff8u) : ((id[p >> 1] << 3) & 0x7fff8u);
                const v2u d = *(const LAS v2u*)(F.lds + off);
                acc[p] = __builtin_amdgcn_sdot4((int)d.x, (int)yv.x, acc[p], false);
                acc[p] = __builtin_amdgcn_sdot4((int)d.y, (int)yv.y, acc[p], false);
                asm volatile("" : "+v"(acc[p]));
                if ((p & 7) == 7) __builtin_amdgcn_sched_barrier(0);
            }
        }
#pragma unroll
        for (int p4 = 0; p4 < 32; ++p4) ((GAS i32x4*)F.ZP)[((size_t)(dr * 32 + p4)) * NTOK + t] = (i32x4){acc[4 * p4], acc[4 * p4 + 1], acc[4 * p4 + 2], acc[4 * p4 + 3]};
    }
    P8_WAITV0();
    __syncthreads();
}
__device__ __forceinline__ void p8h_gate(Frame& F) {
    const size_t gt = (size_t)F.vcu * 512 + F.tid, NT = (size_t)F.G * 512;
    for (size_t i = gt; i < (size_t)32 * NTOK; i += NT) {
        const int p4 = (int)(i >> 13), t = (int)(i & (NTOK - 1));
        i32x4 z = {0, 0, 0, 0};
#pragma unroll
        for (int dr = 0; dr < 16; ++dr) z += ((const GAS i32x4*)F.ZP)[((size_t)(dr * 32 + p4)) * NTOK + t];
        const v4u e4 = ((const GAS v4u*)F.EIDX)[i]; const f32x4 g4 = ((const GAS f32x4*)F.GATEQ)[i]; const float ys = F.YSC[t];
        v4u he;
#pragma unroll
        for (int c = 0; c < 4; ++c) { const float zz = (float)z[c] * ys * F.DSC[e4[c]]; const float hv = 0.5f * zz * (1.0f + erff(zz * 0.70710678118654752f)) * g4[c]; he[c] = (f2bf(hv) << 16) | e4[c]; }
        ((GAS v4u*)F.HE)[i] = he;
    }
}
template <int MODE  > __device__ __forceinline__ void p8b_spmm(Frame& F, float* dst) {
    for (int u = F.vcu; u < 256; u += F.G) {
        const int tg = u & 15, sr = u >> 4, t = tg * 512 + F.tid, b = t >> 11;
        unsigned he[128];
#pragma unroll
        for (int p4 = 0; p4 < 32; ++p4) { const v4u v = ((const GAS v4u*)F.HE)[(size_t)p4 * NTOK + t]; he[4 * p4] = v.x; he[4 * p4 + 1] = v.y; he[4 * p4 + 2] = v.z; he[4 * p4 + 3] = v.w; }
        const float* xrow = F.out + (size_t)t * DM; float* orow = dst + (size_t)t * DM; const float* g2 = F.MOD + b * NMOD + 5 * DM;
        for (int sg = 0; sg < 8; ++sg) {
            f32x2 acc[4][4];
#pragma unroll
            for (int k = 0; k < 4; ++k) {
                const int s = sr * 32 + sg * 4 + k;
#pragma unroll
                for (int i = 0; i < 128; ++i) asm volatile("" : "+v"(he[i]));
                P8_WAITV0();
                P8_BAR();
                if (MODE != 1) lds_fill_128k(F, F.UC8 + (size_t)s * 131072);
                P8_WAITV0();
                P8_BAR();
                if (MODE != 1 && (sg * 4 + k) + 1 < 32) __builtin_amdgcn_global_load_lds((const unsigned*)(F.UC8 + (size_t)(s + 1) * 131072 + (size_t)tg * 8192 + F.wave * 1024 + F.lane * 16), (LAS unsigned*)(F.lds + P8_DUMMY + F.wave * 1024), 16, 0, 0);
#pragma unroll
                for (int q = 0; q < 4; ++q) acc[k][q] = (f32x2){0.f, 0.f};
#pragma unroll
                for (int p = 0; p < (MODE == 2 ? 8 : 128); ++p) {
                    const v2u w = *(const LAS v2u*)(F.lds + ((he[p] & 0xffffu) << 3));
                    const float hv = __builtin_bit_cast(float, he[p] & 0xffff0000u); const f32x2 h2 = {hv, hv};
                    acc[k][0] += __builtin_amdgcn_cvt_pk_f32_fp8((int)w.x, false) * h2; acc[k][1] += __builtin_amdgcn_cvt_pk_f32_fp8((int)w.x, true) * h2;
                    acc[k][2] += __builtin_amdgcn_cvt_pk_f32_fp8((int)w.y, false) * h2; acc[k][3] += __builtin_amdgcn_cvt_pk_f32_fp8((int)w.y, true) * h2;
                    if ((p & 7) == 7) { asm volatile("" : "+v"(acc[k][0]), "+v"(acc[k][1]), "+v"(acc[k][2]), "+v"(acc[k][3])); __builtin_amdgcn_sched_barrier(0); }
                }
            }
            const int c0 = (sr * 32 + sg * 4) * 8;
#pragma unroll
            for (int k = 0; k < 4; ++k) {
                const f32x4 xa = *(const GAS f32x4*)(xrow + c0 + 8 * k), xb = *(const GAS f32x4*)(xrow + c0 + 8 * k + 4), ga = *(const GAS f32x4*)(g2 + c0 + 8 * k), gb = *(const GAS f32x4*)(g2 + c0 + 8 * k + 4);
                *(GAS f32x4*)(orow + c0 + 8 * k) = (f32x4){xa[0] + ga[0] * acc[k][0].x, xa[1] + ga[1] * acc[k][0].y, xa[2] + ga[2] * acc[k][1].x, xa[3] + ga[3] * acc[k][1].y};
                *(GAS f32x4*)(orow + c0 + 8 * k + 4) = (f32x4){xb[0] + gb[0] * acc[k][2].x, xb[1] + gb[1] * acc[k][2].y, xb[2] + gb[2] * acc[k][3].x, xb[3] + gb[3] * acc[k][3].y};
            }
        }
    }
    P8_WAITV0();
    __syncthreads();
}

struct Args { const float* in[18]; float* out; unsigned char* ws; int ph_lo, ph_hi; };
__global__ void __launch_bounds__(NWAVES * 64, 2) mega_fwd(Args args) {
    extern __shared__ __attribute__((aligned(16))) unsigned char lds[];
    Frame F;
    F.lds = (LAS unsigned char*)lds;
    F.MISC = (volatile LAS unsigned*)(F.lds + MISC_OFF);
    F.tid = threadIdx.x; F.lane = F.tid & 63; F.wave = __builtin_amdgcn_readfirstlane(F.tid >> 6);
    F.G = gridDim.x; { const int bx = blockIdx.x; F.vcu = (F.G % 8 == 0) ? (bx % 8) * (F.G / 8) + bx / 8 : bx; }
    unsigned char* ws = args.ws;
    F.ctl = (unsigned*)(ws + WS_CTL);
    F.x = args.in[0]; F.c = args.in[1]; F.w_ada = args.in[2]; F.b_ada = args.in[3]; F.w_in = args.in[4]; F.w_gate_up = args.in[5]; F.b_gla_gate = args.in[6]; F.gla_out_norm = args.in[7];
    F.swa_q_norm = args.in[8]; F.swa_k_norm = args.in[9]; F.swa_sinks = args.in[10]; F.swa_out_norm = args.in[11]; F.w_out = args.in[12]; F.w_peer_q = args.in[13];
    F.keys1 = args.in[14]; F.keys2 = args.in[15]; F.edown = args.in[16]; F.eup = args.in[17];
    F.out = args.out;
    F.MOD = (float*)(ws + WS_MOD); F.ROPE = (float*)(ws + WS_ROPE);
    F.BTIN = (bf16*)(ws + WS_BTIN); F.BTOUT = (bf16*)(ws + WS_BTOUT); F.BTQ = (bf16*)(ws + WS_BTQ); F.HBUF = (bf16*)(ws + WS_HBUF); F.PROJ = (bf16*)(ws + WS_PROJ);
    F.MIXIN = (bf16*)(ws + WS_MIXIN); F.QPEER = (bf16*)(ws + WS_QPEER);
    F.DC8 = ws + WS_DC8; F.UC8 = ws + WS_UC8; F.YC8 = ws + WS_YC8; F.ZP = (int*)(ws + WS_ZP); F.EIDX = (unsigned*)(ws + WS_EIDX); F.HE = (unsigned*)(ws + WS_HE);
    F.EIDX16 = (unsigned*)(ws + WS_EIDX16); F.GATEQ = (float*)(ws + WS_GATEQ); F.DSC = (float*)(ws + WS_DSC); F.YSC = (float*)(ws + WS_YSC);
    for (int u = F.tid; u < (LDS_BYTES - LDSCTL_OFF) / 4; u += NWAVES * 64) ((LAS unsigned*)(F.lds + LDSCTL_OFF))[u] = 0u;
    __syncthreads();
    XcdBarrier bar; bar.bar = F.ctl + CW_BAR; bar.x = 0; bar.st = nullptr;
    if (N_LAUNCHES == 1) bar = xcd_barrier_post(F.ctl + CW_BAR, F.MISC + 8);
#define GRID_BAR() do { if (N_LAUNCHES == 1) xcd_barrier(bar); } while (0)
    const int lo = args.ph_lo, hi = args.ph_hi;
#define IN(k) (lo <= (k) && (k) < hi)
#define BOTH(k) (IN(k) && IN((k) + 1))

    for (int rep_ = 0; rep_ < (PROBE_REP_PHASE == 0 ? 2 : 1); ++rep_) if (IN(0)) { p0_prologue(F); if (BOTH(0)) GRID_BAR(); }
    for (int rep_ = 0; rep_ < (PROBE_REP_PHASE == 1 ? 2 : 1); ++rep_) if (IN(1)) { modulate_rows(F, F.x, F.HBUF, 0, DM); if (BOTH(1)) GRID_BAR(); }
    for (int rep_ = 0; rep_ < (PROBE_REP_PHASE == 2 ? 2 : 1); ++rep_) if (IN(2)) {
        pg8::Gemm g{F.HBUF, F.BTIN, NTOK, NPROJ, DM}; pg8::StaticOrder S; S.init(NTOK, NPROJ, F.G, (int)blockIdx.x);
        pg8::EpiBf16 E{F.PROJ, NPROJ};
        pg8::gemm_phase<pg8::EpiBf16, pg8::StaticOrder, true, true>(F.lds, g, S, E);
        if (BOTH(2)) GRID_BAR();
    }
    for (int rep_ = 0; rep_ < (PROBE_REP_PHASE == 3 ? 2 : 1); ++rep_) if (IN(3)) { p3_mixer(F); if (BOTH(3)) GRID_BAR(); }
    for (int rep_ = 0; rep_ < (PROBE_REP_PHASE == 4 ? 2 : 1); ++rep_) if (IN(4)) {
        pg8::Gemm g{F.MIXIN, F.BTOUT, NTOK, DM, DM}; pg8::StaticOrder S; S.init(NTOK, DM, F.G, (int)blockIdx.x);
        pg8::EpiResid E{F.x, F.out, DM, F.MOD + 2 * DM, NMOD, SEQ / 256};
        pg8::gemm_phase<pg8::EpiResid, pg8::StaticOrder, true, true>(F.lds, g, S, E);
        if (BOTH(4)) GRID_BAR();
    }
    for (int rep_ = 0; rep_ < (PROBE_REP_PHASE == 5 ? 2 : 1); ++rep_) if (IN(5)) { p5_modulate_quant(F); if (BOTH(5)) GRID_BAR(); }
    for (int rep_ = 0; rep_ < (PROBE_REP_PHASE == 6 ? 2 : 1); ++rep_) if (IN(6)) {
        pg8::Gemm g{F.HBUF, F.BTQ, NTOK, PEER_N, DM}; pg8::StaticOrder S; S.init(NTOK, PEER_N, F.G, (int)blockIdx.x);
        pg8::EpiBf16 E{F.QPEER, PEER_N};
        pg8::gemm_phase<pg8::EpiBf16, pg8::StaticOrder, true, true>(F.lds, g, S, E);
        if (BOTH(6)) GRID_BAR();
    }
    for (int rep_ = 0; rep_ < (PROBE_REP_PHASE == 7 ? 2 : 1); ++rep_) if (IN(7)) { p7_topk(F); if (BOTH(7)) GRID_BAR(); }
    for (int rep_ = 0; rep_ < (PROBE_REP_PHASE == 8 ? 2 : 1); ++rep_) if (IN(8)) { p8a_sddmm(F); if (BOTH(8)) GRID_BAR(); }
    for (int rep_ = 0; rep_ < (PROBE_REP_PHASE == 9 ? 2 : 1); ++rep_) if (IN(9)) { p8h_gate(F); if (BOTH(9)) GRID_BAR(); }
    if (PROBE_REP_PHASE == 10 && IN(10)) { p8b_spmm<0>(F, (float*)F.PROJ); GRID_BAR(); }
    if (PROBE_REP_PHASE == 11 && IN(10)) { p8b_spmm<1>(F, (float*)F.PROJ); GRID_BAR(); }
    if (PROBE_REP_PHASE == 12 && IN(10)) { p8b_spmm<2>(F, (float*)F.PROJ); GRID_BAR(); }
    if (IN(10)) { p8b_spmm<0>(F, F.out); }
#undef IN
#undef BOTH
}

extern "C" void kernel_launch(void* const* d_in, const int* in_sizes, int n_in, void* d_out, int out_size, void* d_ws, size_t ws_size, hipStream_t stream) {
    static int grid = 0;
    if (grid == 0) {
        if (n_in != 18 || out_size != NTOK * DM || ws_size < WS_END) { fprintf(stderr, "kernel_launch: unexpected shapes (n_in %d, out %d, ws %zu); nothing launched\n", n_in, out_size, ws_size); grid = -1; return; }
        int dev = 0, cus = 0, per_cu = 0;
        if (hipGetDevice(&dev) != hipSuccess || hipDeviceGetAttribute(&cus, hipDeviceAttributeMultiprocessorCount, dev) != hipSuccess) { grid = -1; return; }
        if (hipFuncSetAttribute((const void*)mega_fwd, hipFuncAttributeMaxDynamicSharedMemorySize, LDS_BYTES) != hipSuccess) { fprintf(stderr, "kernel_launch: hipFuncSetAttribute failed\n"); grid = -1; return; }
        if (hipOccupancyMaxActiveBlocksPerMultiprocessor(&per_cu, (const void*)mega_fwd, NWAVES * 64, LDS_BYTES) != hipSuccess || per_cu < 1)
            fprintf(stderr, "kernel_launch: note: occupancy query reports %d workgroups per CU\n", per_cu);
        (void)hipGetLastError();
        grid = cus;
    }
    if (grid < 0) return;
    (void)hipMemsetAsync((char*)d_ws + WS_CTL, 0, CTL_ZERO_BYTES, stream);
    Args a{};
    for (int i = 0; i < 18; ++i) a.in[i] = (const float*)d_in[i];
    a.out = (float*)d_out; a.ws = (unsigned char*)d_ws;
    if (N_LAUNCHES == 1) { a.ph_lo = 0; a.ph_hi = NPHASE; hipLaunchKernelGGL(mega_fwd, dim3(grid), dim3(NWAVES * 64), LDS_BYTES, stream, a); }
    else for (int p = 0; p < NPHASE; ++p) { a.ph_lo = p; a.ph_hi = p + 1; hipLaunchKernelGGL(mega_fwd, dim3(grid), dim3(NWAVES * 64), LDS_BYTES, stream, a); }
}
```

```cpp
#include <hip/hip_runtime.h>
#include <cstdio>
#include <cstdint>

#ifndef MK_N_LAUNCHES
#define MK_N_LAUNCHES 1
#endif
#ifndef PROBE_REP_PHASE
#define PROBE_REP_PHASE -1
#endif

#define GAS __attribute__((address_space(1)))
#define LAS __attribute__((address_space(3)))
typedef unsigned short bf16;
typedef unsigned v4u __attribute__((ext_vector_type(4)));
typedef unsigned v2u __attribute__((ext_vector_type(2)));
typedef float f32x4 __attribute__((ext_vector_type(4)));
typedef float f32x2 __attribute__((ext_vector_type(2)));
typedef float f32x16 __attribute__((ext_vector_type(16)));
typedef short bf16x8 __attribute__((ext_vector_type(8)));
using bf16x2 = __attribute__((ext_vector_type(2))) __bf16;

namespace pg8 {
#define PG8_LAS __attribute__((address_space(3)))
typedef unsigned short bf16_t;
typedef short bf16x8 __attribute__((ext_vector_type(8)));
typedef float f32x4 __attribute__((ext_vector_type(4)));
typedef unsigned u32x4 __attribute__((ext_vector_type(4)));
constexpr int BM = 256, BK = 64, HALF = 128, HTB = HALF * BK * 2, STAGE_BYTES = 8 * HTB, NXCD = 8, WGM = 8;

__host__ __device__ __forceinline__ int lds_byte(int r, int c) { const int st = (r >> 4) * 2 + (c >> 5), rr = r & 15, cc = c & 31, ob = rr * 64 + cc * 2; return st * 1024 + (ob ^ (((ob >> 9) & 1) << 5)); }
__host__ __device__ __forceinline__ void stage_rc(int b, int& R, int& C) { const int st = b / 1024, sb = b % 1024, swz = sb ^ (((sb >> 9) & 1) << 5); R = (st >> 1) * 16 + swz / 64; C = (st & 1) * 32 + (swz % 64) / 2; }
__host__ __device__ __forceinline__ int perm32(int rho) { const int n = rho >> 4, i = rho & 15; return 8 * (i >> 2) + 4 * n + (i & 3); }

struct Unit { int pm, pn; };
struct Gemm { const bf16_t* A; const bf16_t* Bt; int M, N, K; };

struct StaticOrder {
    int nM, nN, nwg, G, c;
    __host__ __device__ void init(int M, int N, int G_, int c_) { nM = M / BM; nN = N / BM; nwg = nM * nN; G = G_; c = c_; }
    __host__ __device__ bool next(int i, Unit& u) const {
        const long L = (long)i * G + c; if (L >= nwg) return false;
        int wgid = (int)L; { const int q = nwg / NXCD, r = nwg % NXCD, xcd = wgid % NXCD, off = wgid / NXCD; wgid = (xcd < r ? xcd * (q + 1) : r * (q + 1) + (xcd - r) * q) + off; }
        const int nig = WGM * nN, gid = wgid / nig, fm = gid * WGM, gsz = (nM - fm) < WGM ? (nM - fm) : WGM;
        u.pm = fm + ((wgid % nig) % gsz); u.pn = (wgid % nig) / gsz; return true;
    }
    __device__ __forceinline__ void a_ready(const Unit&) const {}
    __device__ __forceinline__ void done(const Unit&) const {}
};

__device__ __forceinline__ unsigned cvt_pk_bf16(float lo, float hi) { unsigned r; asm volatile("v_cvt_pk_bf16_f32 %0, %1, %2" : "=v"(r) : "v"(lo), "v"(hi)); return r; }

struct EpiBf16 {
    static constexpr bool PERM = true, AFTER_DRAIN = false;
    bf16_t* O; int ldc;
    __device__ __forceinline__ void operator()(const f32x4 (&acc)[2][2][4][2], const Unit& u, int wr, int wc, int fr, int fq) const {
        const int row0 = u.pm * BM + wr * 64 + fr; const int col0 = u.pn * BM + wc * 32 + 8 * fq;
#pragma unroll
        for (int ai = 0; ai < 2; ++ai)
#pragma unroll
            for (int m = 0; m < 4; ++m) { bf16_t* rowp = O + (size_t)(row0 + ai * HALF + m * 16) * ldc + col0;
#pragma unroll
                for (int bj = 0; bj < 2; ++bj) { const f32x4 v0 = acc[ai][bj][m][0], v1 = acc[ai][bj][m][1];
                    u32x4 w; w.x = cvt_pk_bf16(v0[0], v0[1]); w.y = cvt_pk_bf16(v0[2], v0[3]); w.z = cvt_pk_bf16(v1[0], v1[1]); w.w = cvt_pk_bf16(v1[2], v1[3]);
                    *(u32x4*)(rowp + bj * HALF) = w; } }
    }
};
struct EpiResid {
    static constexpr bool PERM = false, AFTER_DRAIN = false;
    const float* base; float* out; int ldc; const float* gate; int gate_stride; int tiles_per_batch;
    __device__ __forceinline__ void operator()(const f32x4 (&acc)[2][2][4][2], const Unit& u, int wr, int wc, int fr, int fq) const {
        const int row0 = u.pm * BM + wr * 64 + fr, col0 = u.pn * BM + wc * 32 + 4 * fq;
        const float* gp = gate + (size_t)(u.pm / tiles_per_batch) * gate_stride + col0;
        f32x4 gv[2][2];
#pragma unroll
        for (int bj = 0; bj < 2; ++bj)
#pragma unroll
            for (int n = 0; n < 2; ++n) gv[bj][n] = *(const f32x4*)(gp + bj * HALF + n * 16);
#pragma unroll
        for (int ai = 0; ai < 2; ++ai)
#pragma unroll
            for (int m = 0; m < 4; ++m) { const size_t off = (size_t)(row0 + ai * HALF + m * 16) * ldc + col0;
#pragma unroll
                for (int bj = 0; bj < 2; ++bj)
#pragma unroll
                    for (int n = 0; n < 2; ++n) { const f32x4 bs = *(const f32x4*)(base + off + bj * HALF + n * 16);
                        *(f32x4*)(out + off + bj * HALF + n * 16) = bs + gv[bj][n] * acc[ai][bj][m][n]; } }
    }
};

template <class Epi, class Sched, bool ALIGN_EPI = false, bool SP2 = false>
__device__ __forceinline__ void gemm_phase(PG8_LAS unsigned char* lds, const Gemm g, const Sched& S, const Epi& E) {
    const int tid = threadIdx.x, wid = __builtin_amdgcn_readfirstlane(tid >> 6), lane = tid & 63, wr = wid >> 2, wc = wid & 3, fr = lane & 15, fq = lane >> 4;
    const int K = g.K, nt = K / BK;
    unsigned voffA[2], voffB[2];
#pragma unroll
    for (int i = 0; i < 2; ++i) { int R, C; stage_rc(tid * 16 + i * 8192, R, C); const int Rb = Epi::PERM ? ((R & ~31) + perm32(R & 31)) : R;
        voffA[i] = (unsigned)(R * K + C) * 2u; voffB[i] = (unsigned)(Rb * K + C) * 2u; }
    const size_t kstep = (size_t)(BK * 2);
    const size_t hstep = (size_t)HALF * K * 2;
    const size_t tstep = 2 * hstep;
    const unsigned ldsw = (unsigned)wid * 1024u;
    const int aoff = lds_byte(wr * 64 + fr, fq * 8), boff = lds_byte(wc * 32 + fr, fq * 8);
#define PG8_SA(b, h) (((b) * 2 + (h)) * HTB)
#define PG8_SB(b, h) ((4 + (b) * 2 + (h)) * HTB)
#define PG8_STAGE(bufoff, gbase, voff) do { _Pragma("unroll") for (int _i = 0; _i < 2; ++_i) \
        __builtin_amdgcn_global_load_lds((const unsigned*)((const char*)(gbase) + (voff)[_i]), (PG8_LAS unsigned*)(lds + (bufoff) + ldsw + _i * 8192), 16, 0, 0); } while (0)
#define PG8_LDA(dst, b, h) do { _Pragma("unroll") for (int m = 0; m < 4; ++m) _Pragma("unroll") for (int k = 0; k < 2; ++k) dst[m][k] = *(const PG8_LAS bf16x8*)(lds + PG8_SA(b, h) + aoff + m * 2048 + k * 1024); } while (0)
#define PG8_LDB(dst, b, h) do { _Pragma("unroll") for (int n = 0; n < 2; ++n) _Pragma("unroll") for (int k = 0; k < 2; ++k) dst[n][k] = *(const PG8_LAS bf16x8*)(lds + PG8_SB(b, h) + boff + n * 2048 + k * 1024); } while (0)
#define PG8_MMA(ai, bj, At, Bt) do { __builtin_amdgcn_s_setprio(1); _Pragma("unroll") for (int m = 0; m < 4; ++m) _Pragma("unroll") for (int n = 0; n < 2; ++n) _Pragma("unroll") for (int k = 0; k < 2; ++k) \
        acc[ai][bj][m][n] = __builtin_amdgcn_mfma_f32_16x16x32_bf16(Bt[n][k], At[m][k], acc[ai][bj][m][n], 0, 0, 0); __builtin_amdgcn_s_setprio(0); } while (0)
#define PG8_WAIT_V(n) asm volatile("s_waitcnt vmcnt(" #n ")" ::: "memory")
#define PG8_WAIT_L(n) asm volatile("s_waitcnt lgkmcnt(" #n ")" ::: "memory")
#define PG8_BAR __builtin_amdgcn_s_barrier()
#define PG8_SCHED __builtin_amdgcn_sched_barrier(0)
    Unit cur, nxt; int ui = 0;
    if (!S.next(0, cur)) return;
    f32x4 acc[2][2][4][2];
#pragma unroll
    for (int a = 0; a < 2; ++a)
#pragma unroll
        for (int b = 0; b < 2; ++b)
#pragma unroll
            for (int m = 0; m < 4; ++m)
#pragma unroll
                for (int n = 0; n < 2; ++n) acc[a][b][m][n] = (f32x4){0.f, 0.f, 0.f, 0.f};
    bf16x8 At[4][2], B0[2][2], B1[2][2];
    const char* cA = (const char*)g.A + (size_t)cur.pm * tstep; const char* cB = (const char*)g.Bt + (size_t)cur.pn * tstep;
    S.a_ready(cur);
    if constexpr (SP2) {
        PG8_STAGE(PG8_SB(0, 0), cB, voffB); PG8_STAGE(PG8_SB(0, 1), cB + hstep, voffB); PG8_STAGE(PG8_SA(0, 0), cA, voffA); PG8_STAGE(PG8_SA(0, 1), cA + hstep, voffA);
        if (wr == 1) PG8_BAR;
        PG8_WAIT_V(2); PG8_BAR;
        PG8_STAGE(PG8_SB(1, 0), cB + kstep, voffB); PG8_STAGE(PG8_SA(1, 0), cA + kstep, voffA); PG8_STAGE(PG8_SB(1, 1), cB + hstep + kstep, voffB);
        PG8_WAIT_V(6); PG8_BAR;
    } else {
        PG8_STAGE(PG8_SB(0, 0), cB, voffB); PG8_STAGE(PG8_SA(0, 0), cA, voffA); PG8_STAGE(PG8_SB(0, 1), cB + hstep, voffB); PG8_STAGE(PG8_SA(0, 1), cA + hstep, voffA);
        if (wr == 1) PG8_BAR;
        PG8_WAIT_V(4); PG8_BAR;
        PG8_STAGE(PG8_SB(1, 0), cB + kstep, voffB); PG8_STAGE(PG8_SA(1, 0), cA + kstep, voffA); PG8_STAGE(PG8_SB(1, 1), cB + hstep + kstep, voffB);
        PG8_WAIT_V(6); PG8_BAR;
    }
    for (;;) {
        const bool has_next = S.next(ui + 1, nxt);
        const char* nA = has_next ? (const char*)g.A + (size_t)nxt.pm * tstep : cA; const char* nB = has_next ? (const char*)g.Bt + (size_t)nxt.pn * tstep : cB;
        for (int t = 0; t < nt; t += 2) {
            const bool last = (t == nt - 2);
            const char* a1 = cA + (size_t)(t + 1) * kstep;
            const char* a2 = last ? nA : cA + (size_t)(t + 2) * kstep; const char* b2 = last ? nB : cB + (size_t)(t + 2) * kstep;
            const char* a3 = a2 + kstep; const char* b3 = b2 + kstep;
            if (last && has_next) S.a_ready(nxt);
            if constexpr (SP2) {
            PG8_LDB(B0, 0, 0); PG8_LDB(B1, 0, 1); PG8_SCHED; PG8_LDA(At, 0, 0); PG8_STAGE(PG8_SA(1, 1), a1 + hstep, voffA);
            PG8_WAIT_V(8); PG8_WAIT_L(0); PG8_BAR; PG8_MMA(0, 0, At, B0); PG8_MMA(0, 1, At, B1); PG8_BAR; PG8_SCHED;
            PG8_LDA(At, 0, 1); PG8_STAGE(PG8_SB(0, 0), b2, voffB); PG8_STAGE(PG8_SB(0, 1), b2 + hstep, voffB); PG8_STAGE(PG8_SA(0, 0), a2, voffA);
            PG8_WAIT_V(8); PG8_WAIT_L(0); PG8_BAR; PG8_MMA(1, 0, At, B0); PG8_MMA(1, 1, At, B1); PG8_BAR; PG8_SCHED;
            PG8_LDB(B0, 1, 0); PG8_LDB(B1, 1, 1); PG8_SCHED; PG8_LDA(At, 1, 0); PG8_STAGE(PG8_SA(0, 1), a2 + hstep, voffA);
            PG8_WAIT_V(8); PG8_WAIT_L(0); PG8_BAR; PG8_MMA(0, 0, At, B0); PG8_MMA(0, 1, At, B1); PG8_BAR; PG8_SCHED;
            PG8_LDA(At, 1, 1); PG8_STAGE(PG8_SB(1, 0), b3, voffB); PG8_STAGE(PG8_SB(1, 1), b3 + hstep, voffB); PG8_STAGE(PG8_SA(1, 0), a3, voffA);
            PG8_WAIT_V(8); PG8_WAIT_L(0); PG8_BAR; PG8_MMA(1, 0, At, B0); PG8_MMA(1, 1, At, B1); PG8_BAR; PG8_SCHED;
            } else {
            PG8_LDB(B0, 0, 0); PG8_SCHED; PG8_LDA(At, 0, 0); PG8_STAGE(PG8_SA(1, 1), a1 + hstep, voffA);
            PG8_WAIT_L(8); PG8_BAR; PG8_WAIT_L(0); PG8_MMA(0, 0, At, B0); PG8_BAR; PG8_SCHED;
            PG8_LDB(B1, 0, 1); PG8_STAGE(PG8_SB(0, 0), b2, voffB);
            PG8_BAR; PG8_WAIT_L(0); PG8_MMA(0, 1, At, B1); PG8_BAR;
            PG8_LDA(At, 0, 1); PG8_STAGE(PG8_SA(0, 0), a2, voffA);
            PG8_BAR; PG8_WAIT_L(0); PG8_MMA(1, 0, At, B0); PG8_BAR; PG8_SCHED;
            PG8_STAGE(PG8_SB(0, 1), b2 + hstep, voffB);
            PG8_WAIT_V(6); PG8_BAR; PG8_MMA(1, 1, At, B1); PG8_BAR;
            PG8_LDB(B0, 1, 0); PG8_SCHED; PG8_LDA(At, 1, 0); PG8_STAGE(PG8_SA(0, 1), a2 + hstep, voffA);
            PG8_WAIT_L(8); PG8_BAR; PG8_WAIT_L(0); PG8_MMA(0, 0, At, B0); PG8_BAR; PG8_SCHED;
            PG8_LDB(B1, 1, 1); PG8_STAGE(PG8_SB(1, 0), b3, voffB);
            PG8_BAR; PG8_WAIT_L(0); PG8_MMA(0, 1, At, B1); PG8_BAR;
            PG8_LDA(At, 1, 1); PG8_STAGE(PG8_SA(1, 0), a3, voffA);
            PG8_BAR; PG8_WAIT_L(0); PG8_MMA(1, 0, At, B0); PG8_BAR; PG8_SCHED;
            PG8_STAGE(PG8_SB(1, 1), b3 + hstep, voffB);
            PG8_WAIT_V(6); PG8_BAR; PG8_MMA(1, 1, At, B1); PG8_BAR;
            }
        }
        if constexpr (ALIGN_EPI) { if (wr == 0) PG8_BAR; }
        if constexpr (!Epi::AFTER_DRAIN) { E(acc, cur, wr, wc, fr, fq); S.done(cur); }
        if (!has_next) break;
#pragma unroll
        for (int a = 0; a < 2; ++a)
#pragma unroll
            for (int b = 0; b < 2; ++b)
#pragma unroll
                for (int m = 0; m < 4; ++m)
#pragma unroll
                    for (int n = 0; n < 2; ++n) acc[a][b][m][n] = (f32x4){0.f, 0.f, 0.f, 0.f};
        cur = nxt; cA = nA; cB = nB; ++ui;
        if constexpr (ALIGN_EPI) { if (wr == 1) PG8_BAR; }
    }
    PG8_WAIT_V(0);
    if constexpr (!ALIGN_EPI) { if (wr == 0) PG8_BAR; }
    PG8_BAR;
#undef PG8_SA
#undef PG8_SB
#undef PG8_STAGE
#undef PG8_LDA
#undef PG8_LDB
#undef PG8_MMA
#undef PG8_WAIT_V
#undef PG8_WAIT_L
#undef PG8_BAR
#undef PG8_SCHED
}
}

constexpr int NWAVES = 8;
constexpr int NPHASE = 11;
constexpr int N_LAUNCHES = MK_N_LAUNCHES;
constexpr int BATCH = 4, SEQ = 2048, DM = 4096, NTOK = BATCH * SEQ;
constexpr int NMOD = 6 * DM;
constexpr int IN_WIDTH = 8720;
constexpr int NPROJ = 8960;
constexpr int C_GQ = 0, C_GK = 1024, C_GV = 2048, C_GG = 4096, C_SQ = 6144, C_SK = 8192, C_SV = 8448, C_GA = 8704;
constexpr int NEXP = 16384, PEER_N = 2048;
constexpr float EPS = 1e-6f;

constexpr size_t MiB = 1u << 20;
constexpr size_t WS_CTL = 0, CTL_ZERO_BYTES = 1 * MiB;
constexpr size_t WS_MOD = 1 * MiB;
constexpr size_t WS_ROPE = 2 * MiB;
constexpr size_t WS_BTIN = 4 * MiB;
constexpr size_t WS_BTOUT = 74 * MiB;
constexpr size_t WS_BTQ = 106 * MiB;
constexpr size_t WS_HBUF = 122 * MiB;
constexpr size_t WS_PROJ = 186 * MiB;
constexpr size_t WS_MIXIN = 326 * MiB;
constexpr size_t WS_QPEER = 390 * MiB;
constexpr size_t WS_IDX = 422 * MiB;
constexpr size_t WS_GATE = 426 * MiB;
constexpr size_t WS_DC8 = 430 * MiB;
constexpr size_t WS_UC8 = 494 * MiB;
constexpr size_t WS_YC8 = 558 * MiB;
constexpr size_t WS_ZP = 590 * MiB;
constexpr size_t WS_EIDX = 654 * MiB;
constexpr size_t WS_GATEQ = 658 * MiB;
constexpr size_t WS_HE = 662 * MiB;
constexpr size_t WS_DSC = 666 * MiB;
constexpr size_t WS_YSC = 667 * MiB;
constexpr size_t WS_EIDX16 = 668 * MiB;
constexpr size_t WS_END = 670 * MiB;
constexpr int CW_BAR = 4096;

constexpr int RING_BYTES = 131072;
constexpr int LDSCTL_OFF = RING_BYTES, MISC_OFF = LDSCTL_OFF + 320;
constexpr int LDS_BYTES = 155648;

#define LDS_WAIT() asm volatile("s_waitcnt lgkmcnt(0)" ::: "memory")
#define VM_WAIT() asm volatile("s_waitcnt vmcnt(0)" ::: "memory")
__device__ __forceinline__ unsigned f2bf(float f) { unsigned u = __builtin_bit_cast(unsigned, f); return (u + 0x7fffu + ((u >> 16) & 1u)) >> 16; }
__device__ __forceinline__ unsigned pk2(float lo, float hi) { return f2bf(lo) | (f2bf(hi) << 16); }
__device__ __forceinline__ float bflo(unsigned w) { return __builtin_bit_cast(float, w << 16); }
__device__ __forceinline__ float bfhi(unsigned w) { return __builtin_bit_cast(float, w & 0xffff0000u); }
__device__ __forceinline__ float dot2_bf16(unsigned w, unsigned x, float acc) { return __builtin_amdgcn_fdot2_f32_bf16(__builtin_bit_cast(bf16x2, w), __builtin_bit_cast(bf16x2, x), acc, false); }
__device__ __forceinline__ f32x16 mfma32(bf16x8 a, bf16x8 b, f32x16 c) { return __builtin_amdgcn_mfma_f32_32x32x16_bf16(a, b, c, 0, 0, 0); }
__device__ __forceinline__ f32x4 mfma16(bf16x8 a, bf16x8 b, f32x4 c) { return __builtin_amdgcn_mfma_f32_16x16x32_bf16(a, b, c, 0, 0, 0); }
__device__ __forceinline__ bf16x8 mk8(unsigned a, unsigned b, unsigned c, unsigned d) { v4u t = {a, b, c, d}; return __builtin_bit_cast(bf16x8, t); }
__device__ __forceinline__ float silu_f(float x) { return x / (1.0f + __expf(-x)); }

#define XB_TMO      128
#define XB_XCNT(j)  (256  + 64 * (j))
#define XB_XSUB(j)  (1280 + 64 * (j))
#define XB_XGEN(j)  (2304 + 64 * (j))
#define XB_TOP      3328
#define XB_TOPGEN   3392
#define XCD_BAR_WORDS 3456
#define XB_SPIN_CAP (1u << 18)
__device__ __forceinline__ unsigned xb_ld(unsigned* p)              { return __hip_atomic_load(p, __ATOMIC_RELAXED, __HIP_MEMORY_SCOPE_AGENT); }
__device__ __forceinline__ unsigned xb_add(unsigned* p, unsigned v) { return __hip_atomic_fetch_add(p, v, __ATOMIC_RELAXED, __HIP_MEMORY_SCOPE_AGENT); }
__device__ __forceinline__ unsigned xb_xcc_id() { return (unsigned)__builtin_amdgcn_s_getreg((3 << 11) | 20) & 0xFu; }
#define XB_SPIN(cond, bar) do { unsigned _sp = 0; while (cond) { __builtin_amdgcn_s_sleep(1); \
    if ((++_sp & 255u) == 0u) { if (xb_ld(&(bar)[XB_TMO])) break; if (_sp > XB_SPIN_CAP) { atomicAdd(&(bar)[XB_TMO], 1u); break; } } } } while (0)
struct XcdBarrier { unsigned* bar; unsigned x; volatile LAS unsigned* st; };
__device__ __forceinline__ XcdBarrier xcd_barrier_post(unsigned* bar, volatile LAS unsigned* st) {
    XcdBarrier b; b.bar = bar; b.x = xb_xcc_id(); b.st = st;
    if (threadIdx.x == 0) (void)xb_add(&bar[XB_XCNT(b.x)], 1u);
    return b;
}
__device__ __forceinline__ void xcd_barrier_complete(unsigned* bar, unsigned x, unsigned& nloc, unsigned& nx) {
    const unsigned G = gridDim.x * gridDim.y * gridDim.z;
    unsigned sum, cnt, mine, sp = 0u;
    for (;;) {
        sum = 0u; cnt = 0u; mine = 0u;
#pragma unroll
        for (unsigned j = 0; j < 16; ++j) { const unsigned c = xb_ld(&bar[XB_XCNT(j)]); sum += c; cnt += (c > 0u) ? 1u : 0u; mine = (j == x) ? c : mine; }
        if (sum == G) break;
        __builtin_amdgcn_s_sleep(1);
        if ((++sp & 255u) == 0u) { if (xb_ld(&bar[XB_TMO])) break; if (sp > XB_SPIN_CAP) { atomicAdd(&bar[XB_TMO], 1u); break; } }
    }
    nloc = mine > 0u ? mine : 1u; nx = cnt > 0u ? cnt : 1u;
}
__device__ __forceinline__ void xcd_barrier(const XcdBarrier& b) {
    asm volatile("s_waitcnt vmcnt(0)" ::: "memory");
    __syncthreads();
    if (threadIdx.x == 0) {
        unsigned* bar = b.bar;
        __builtin_amdgcn_s_waitcnt(0);
        unsigned nloc = b.st[0], nx = b.st[1];
        if (nloc == 0u) { xcd_barrier_complete(bar, b.x, nloc, nx); b.st[0] = nloc; b.st[1] = nx; }
        const unsigned old = xb_add(&bar[XB_XSUB(b.x)], 1u);
        const unsigned gen = old / nloc;
        if (old + 1u == (gen + 1u) * nloc) {
            __builtin_amdgcn_fence(__ATOMIC_RELEASE, "agent");
            asm volatile("s_waitcnt vmcnt(0)" ::: "memory");
            const unsigned og = xb_add(&bar[XB_TOP], 1u);
            const unsigned tg = og / nx;
            if (og + 1u == (tg + 1u) * nx) xb_add(&bar[XB_TOPGEN], 1u);
            else XB_SPIN(xb_ld(&bar[XB_TOPGEN]) == tg, bar);
            __builtin_amdgcn_fence(__ATOMIC_ACQUIRE, "agent");
            xb_add(&bar[XB_XGEN(b.x)], 1u);
            asm volatile("s_waitcnt vmcnt(0)" ::: "memory");
        } else {
            XB_SPIN(xb_ld(&bar[XB_XGEN(b.x)]) == gen, bar);
            __builtin_amdgcn_fence(__ATOMIC_ACQUIRE, "agent");
            asm volatile("s_waitcnt vmcnt(0)" ::: "memory");
        }
    }
    __syncthreads();
}

struct Frame {
    LAS unsigned char* lds;
    volatile LAS unsigned* MISC;
    unsigned* ctl;
    int tid, lane, wave, vcu, G;
    const float *x, *c, *w_ada, *b_ada, *w_in, *w_gate_up, *b_gla_gate, *gla_out_norm, *swa_q_norm, *swa_k_norm, *swa_sinks, *swa_out_norm, *w_out, *w_peer_q, *keys1, *keys2, *edown, *eup;
    float* out;
    float *MOD, *ROPE;
    bf16 *BTIN, *BTOUT, *BTQ, *HBUF, *PROJ, *MIXIN, *QPEER;
    unsigned char *DC8, *UC8, *YC8;
    int* ZP; unsigned *EIDX, *HE, *EIDX16; float *GATEQ, *DSC, *YSC;
    bf16 *GQT, *GST; float *GUT, *GG;
};

__device__ __forceinline__ float wave_sum(float v) {
#pragma unroll
    for (int o = 1; o < 64; o <<= 1) v += __shfl_xor(v, o);
    return v;
}
__device__ __forceinline__ float wave_max(float v) {
#pragma unroll
    for (int o = 1; o < 64; o <<= 1) v = fmaxf(v, __shfl_xor(v, o));
    return v;
}
__device__ __forceinline__ unsigned pack4i(float a, float b, float c, float d) {
    const int q0 = (int)__builtin_rintf(a), q1 = (int)__builtin_rintf(b), q2 = (int)__builtin_rintf(c), q3 = (int)__builtin_rintf(d);
    return (unsigned)(q0 & 255) | ((unsigned)(q1 & 255) << 8) | ((unsigned)(q2 & 255) << 16) | ((unsigned)q3 << 24);
}

__device__ __forceinline__ void p0_tr_item(const float* W, int ldw, int sc0, int ncols, bf16* WT, int dr0, int k0, LAS float* scr, int lane) {
    const int c4 = (lane & 7) * 4, kr = lane >> 3;
    f32x4 v[8];
#pragma unroll
    for (int i = 0; i < 8; ++i) v[i] = (c4 < ncols) ? *(const GAS f32x4*)(W + (size_t)(k0 + kr + 8 * i) * ldw + sc0 + c4) : (f32x4){0.f, 0.f, 0.f, 0.f};
#pragma unroll
    for (int i = 0; i < 8; ++i) { LAS float* d = scr + (kr + 8 * i) * 33 + c4; d[0] = v[i][0]; d[1] = v[i][1]; d[2] = v[i][2]; d[3] = v[i][3]; }
    LDS_WAIT(); asm volatile("" ::: "memory");
    const int c8 = lane & 7;
#pragma unroll
    for (int j = 0; j < 4; ++j) { const int n = (lane >> 3) + 8 * j; const LAS float* s = scr + (8 * c8) * 33 + n;
        v4u o; o.x = pk2(s[0 * 33], s[1 * 33]); o.y = pk2(s[2 * 33], s[3 * 33]); o.z = pk2(s[4 * 33], s[5 * 33]); o.w = pk2(s[6 * 33], s[7 * 33]);
        if (n < ncols) *(GAS v4u*)(WT + (size_t)(dr0 + n) * DM + k0 + 8 * c8) = o; }
    LDS_WAIT(); asm volatile("" ::: "memory");
}

__device__ __forceinline__ void p0a_ada(Frame& F) {
    const int tid = F.tid, lane = F.lane, wave = F.wave;
    {
        LAS f32x4* cact = (LAS f32x4*)F.lds;
        LAS float* red = (LAS float*)(F.lds + 65536);
        for (int k = tid; k < DM; k += 512) { f32x4 v;
#pragma unroll
            for (int b = 0; b < 4; ++b) { const float cv = F.c[b * DM + k]; v[b] = cv / (1.0f + expf(-cv)); }
            cact[k] = v; }
        __syncthreads();
        for (int slice = F.vcu; slice < 256; slice += F.G) {
            const int col0 = slice * 96, sub = lane / 24, cl = lane - sub * 24;
            f32x4 acc[4];
#pragma unroll
            for (int b = 0; b < 4; ++b) acc[b] = (f32x4){0.f, 0.f, 0.f, 0.f};
            if (lane < 48) {
                const float* wp = F.w_ada + col0 + 4 * cl;
#pragma unroll 16
                for (int k = wave * 2 + sub; k < DM; k += 16) {
                    const f32x4 w = *(const GAS f32x4*)(wp + (size_t)k * NMOD); const f32x4 cv = cact[k];
#pragma unroll
                    for (int b = 0; b < 4; ++b) acc[b] += w * cv[b];
                }
#pragma unroll
                for (int b = 0; b < 4; ++b) *(LAS f32x4*)(red + (wave * 48 + lane) * 16 + 4 * b) = acc[b];
            }
            __syncthreads();
            if (tid < 384) { const int b = tid / 96, col = tid - b * 96, cl2 = col >> 2, e = col & 3; float s = 0.f;
#pragma unroll
                for (int w = 0; w < 8; ++w) { s += red[(w * 48 + cl2) * 16 + 4 * b + e]; s += red[(w * 48 + 24 + cl2) * 16 + 4 * b + e]; }
                F.MOD[b * NMOD + col0 + col] = s + F.b_ada[col0 + col]; }
            __syncthreads();
        }
    }
}
__device__ __forceinline__ void p0b_weights(Frame& F) {
    const int tid = F.tid, lane = F.lane, wave = F.wave;
    const int gw = F.vcu * NWAVES + wave, NGW = F.G * NWAVES;
    {
        LAS float* scr = (LAS float*)(F.lds + wave * 16384);
        constexpr int NB0 = 192, NB1 = 80, NB2 = 1, NB3 = 128, NB4 = 64, NBT = NB0 + NB1 + NB2 + NB3 + NB4;
        for (int it = gw; it < NBT * 64; it += NGW) {
            int nb = it >> 6; const int k0 = (it & 63) * 64;
            if (nb < NB0) { p0_tr_item(F.w_in, IN_WIDTH, 32 * nb, 32, F.BTIN, 32 * nb, k0, scr, lane); continue; } nb -= NB0;
            if (nb < NB1) { p0_tr_item(F.w_in, IN_WIDTH, 6160 + 32 * nb, 32, F.BTIN, 6144 + 32 * nb, k0, scr, lane); continue; } nb -= NB1;
            if (nb < NB2) { p0_tr_item(F.w_in, IN_WIDTH, 6144, 16, F.BTIN, C_GA, k0, scr, lane); continue; } nb -= NB2;
            if (nb < NB3) { p0_tr_item(F.w_out, DM, 32 * nb, 32, F.BTOUT, 32 * nb, k0, scr, lane); continue; } nb -= NB3;
            p0_tr_item(F.w_peer_q, PEER_N, 32 * nb, 32, F.BTQ, 32 * nb, k0, scr, lane);
        }
        const size_t gt = (size_t)F.vcu * 512 + tid, NT = (size_t)F.G * 512;
        GAS v4u* z = (GAS v4u*)(F.BTIN + (size_t)(C_GA + 16) * DM);
        for (size_t i = gt; i < (size_t)240 * DM / 8; i += NT) z[i] = (v4u){0u, 0u, 0u, 0u};
        for (size_t e = gt; e < (size_t)SEQ * 32; e += NT) { const int pos = (int)(e >> 5), i = (int)(e & 31);
            const float inv = exp2f(-(float)i * (13.287712379549449f / 32.0f));
            const float ang = (float)pos * inv;
            const double rev = (double)ang * 0.15915494309189535; const float fr = (float)(rev - floor(rev));
            F.ROPE[e] = __builtin_amdgcn_cosf(fr); F.ROPE[SEQ * 32 + e] = __builtin_amdgcn_sinf(fr); }
    }
}
__device__ __forceinline__ void p0c_tables(Frame& F) {
    const int tid = F.tid, lane = F.lane, wave = F.wave;
    {
        __syncthreads();
        for (int tb = 0; tb < 2; ++tb) {
            const float* srcT = tb ? F.eup : F.edown; unsigned char* dstT = tb ? F.UC8 : F.DC8;
            for (int e0 = F.vcu * 32; e0 < NEXP; e0 += F.G * 32) {
#pragma unroll 1
                for (int r = 0; r < 4; ++r) {
                    const int el = wave * 4 + r, e = e0 + el;
                    const GAS f32x4* src = (const GAS f32x4*)(srcT + (size_t)e * DM);
                    f32x4 a[8], b[8];
#pragma unroll
                    for (int j = 0; j < 8; ++j) { a[j] = src[2 * (lane + 64 * j)]; b[j] = src[2 * (lane + 64 * j) + 1]; }
                    if (tb == 0) {
                        float m = 0.f;
#pragma unroll
                        for (int j = 0; j < 8; ++j)
#pragma unroll
                            for (int q = 0; q < 4; ++q) m = fmaxf(m, fmaxf(fabsf(a[j][q]), fabsf(b[j][q])));
                        m = wave_max(m);
                        const float inv = m > 0.f ? 127.0f / m : 0.f;
                        if (lane == 0) F.DSC[e] = m * (1.0f / 127.0f);
#pragma unroll
                        for (int j = 0; j < 8; ++j) { v2u o; o.x = pack4i(a[j][0] * inv, a[j][1] * inv, a[j][2] * inv, a[j][3] * inv); o.y = pack4i(b[j][0] * inv, b[j][1] * inv, b[j][2] * inv, b[j][3] * inv);
                            *(LAS v2u*)(F.lds + el * 4096 + ((lane + 64 * j + el) & 511) * 8) = o; }
                    } else {
#pragma unroll
                        for (int j = 0; j < 8; ++j) { int w0 = __builtin_amdgcn_cvt_pk_fp8_f32(a[j][0], a[j][1], 0, false); w0 = __builtin_amdgcn_cvt_pk_fp8_f32(a[j][2], a[j][3], w0, true);
                            int w1 = __builtin_amdgcn_cvt_pk_fp8_f32(b[j][0], b[j][1], 0, false); w1 = __builtin_amdgcn_cvt_pk_fp8_f32(b[j][2], b[j][3], w1, true);
                            v2u o; o.x = (unsigned)w0; o.y = (unsigned)w1;
                            *(LAS v2u*)(F.lds + el * 4096 + ((lane + 64 * j + el) & 511) * 8) = o; }
                    }
                }
                __syncthreads();
                { const int el = tid & 31;
#pragma unroll 4
                  for (int it = 0; it < 32; ++it) { const int sc = it * 16 + (tid >> 5);
                      const v2u o = *(const LAS v2u*)(F.lds + el * 4096 + ((sc + el) & 511) * 8);
                      *(GAS v2u*)(dstT + ((size_t)sc * NEXP + e0 + el) * 8) = o; } }
                __syncthreads();
            }
        }
    }
}
__device__ __forceinline__ void p0_prologue(Frame& F) { p0a_ada(F); p0b_weights(F); p0c_tables(F); }

__device__ __forceinline__ void modulate_rows(Frame& F, const float* src, bf16* dst, int sh_off, int sc_off) {
    const int gw = F.vcu * NWAVES + F.wave, NGW = F.G * NWAVES, lane = F.lane;
    for (int m = gw; m < NTOK; m += NGW) {
        const int b = m >> 11;
        const GAS f32x4* xr = (const GAS f32x4*)(src + (size_t)m * DM) + lane;
        f32x4 v[16]; float s = 0.f;
#pragma unroll
        for (int j = 0; j < 16; ++j) { v[j] = xr[64 * j]; s += (v[j].x * v[j].x + v[j].y * v[j].y) + (v[j].z * v[j].z + v[j].w * v[j].w); }
        const float rstd = 1.0f / sqrtf(wave_sum(s) * (1.0f / DM) + EPS);
        const GAS f32x4* shp = (const GAS f32x4*)(F.MOD + b * NMOD + sh_off) + lane;
        const GAS f32x4* scp = (const GAS f32x4*)(F.MOD + b * NMOD + sc_off) + lane;
        GAS v2u* o8 = (GAS v2u*)(dst + (size_t)m * DM) + lane;
#pragma unroll
        for (int j = 0; j < 16; ++j) { const f32x4 sh = shp[64 * j], sc = scp[64 * j]; const f32x4 y = v[j] * rstd * (sc + 1.0f) + sh;
            v2u o; o.x = pk2(y.x, y.y); o.y = pk2(y.z, y.w); o8[64 * j] = o; }
    }
}


__device__ __forceinline__ void p5_modulate_quant(Frame& F) {
    const int gw = F.vcu * NWAVES + F.wave, NGW = F.G * NWAVES, lane = F.lane;
    for (int m = gw; m < NTOK; m += NGW) {
        const int b = m >> 11;
        const GAS f32x4* xr = (const GAS f32x4*)(F.out + (size_t)m * DM);
        f32x4 a[8], c[8]; float s = 0.f;
#pragma unroll
        for (int j = 0; j < 8; ++j) { a[j] = xr[2 * (lane + 64 * j)]; c[j] = xr[2 * (lane + 64 * j) + 1];
            s += (a[j].x * a[j].x + a[j].y * a[j].y) + (a[j].z * a[j].z + a[j].w * a[j].w) + (c[j].x * c[j].x + c[j].y * c[j].y) + (c[j].z * c[j].z + c[j].w * c[j].w); }
        const float rstd = 1.0f / sqrtf(wave_sum(s) * (1.0f / DM) + EPS);
        const GAS f32x4* shp = (const GAS f32x4*)(F.MOD + b * NMOD + 3 * DM);
        const GAS f32x4* scp = (const GAS f32x4*)(F.MOD + b * NMOD + 4 * DM);
        float mx = 0.f;
#pragma unroll
        for (int j = 0; j < 8; ++j) { const int i0 = 2 * (lane + 64 * j);
            a[j] = a[j] * rstd * (scp[i0] + 1.0f) + shp[i0]; c[j] = c[j] * rstd * (scp[i0 + 1] + 1.0f) + shp[i0 + 1];
#pragma unroll
            for (int q = 0; q < 4; ++q) mx = fmaxf(mx, fmaxf(fabsf(a[j][q]), fabsf(c[j][q])));
            *(GAS v4u*)(F.HBUF + (size_t)m * DM + 8 * (lane + 64 * j)) = (v4u){pk2(a[j].x, a[j].y), pk2(a[j].z, a[j].w), pk2(c[j].x, c[j].y), pk2(c[j].z, c[j].w)}; }
        mx = wave_max(mx);
        const float inv = mx > 0.f ? 127.0f / mx : 0.f;
        if (lane == 0) F.YSC[m] = mx * (1.0f / 127.0f);
#pragma unroll
        for (int j = 0; j < 8; ++j) { v2u o; o.x = pack4i(a[j].x * inv, a[j].y * inv, a[j].z * inv, a[j].w * inv); o.y = pack4i(c[j].x * inv, c[j].y * inv, c[j].z * inv, c[j].w * inv);
            *(GAS v2u*)(F.YC8 + ((size_t)(lane + 64 * j) * NTOK + m) * 8) = o; }
    }
}

__device__ __forceinline__ void swa_unit(Frame& F, int u) {
    const int b = u >> 6, kvh = (u >> 4) & 3, n = u & 15, t0 = n * 128;
    LAS unsigned char* KL = F.lds;
    LAS unsigned char* VL = F.lds + 36864;
    const float* COS = F.ROPE; const float* SIN = F.ROPE + SEQ * 32;
    {
        const int key = F.tid >> 1, p = F.tid & 1, kpos = t0 - 128 + key;
        v4u ka[2] = {{0u, 0u, 0u, 0u}, {0u, 0u, 0u, 0u}}, kb[2] = {{0u, 0u, 0u, 0u}, {0u, 0u, 0u, 0u}}, vv[4] = {{0u, 0u, 0u, 0u}, {0u, 0u, 0u, 0u}, {0u, 0u, 0u, 0u}, {0u, 0u, 0u, 0u}};
        float cs[16], sn[16];
#pragma unroll
        for (int i = 0; i < 16; ++i) { cs[i] = 1.f; sn[i] = 0.f; }
        if (kpos >= 0) {
            const bf16* pr = F.PROJ + (size_t)(b * SEQ + kpos) * NPROJ;
            const GAS v4u* kr = (const GAS v4u*)(pr + C_SK + kvh * 64);
            ka[0] = kr[2 * p]; ka[1] = kr[2 * p + 1]; kb[0] = kr[4 + 2 * p]; kb[1] = kr[4 + 2 * p + 1];
            const GAS v4u* vr = (const GAS v4u*)(pr + C_SV + kvh * 64 + 32 * p);
#pragma unroll
            for (int j = 0; j < 4; ++j) vv[j] = vr[j];
            const GAS f32x4* cp = (const GAS f32x4*)(COS + kpos * 32 + 16 * p); const GAS f32x4* sp = (const GAS f32x4*)(SIN + kpos * 32 + 16 * p);
#pragma unroll
            for (int j = 0; j < 4; ++j) { const f32x4 c4 = cp[j], s4 = sp[j];
#pragma unroll
                for (int e = 0; e < 4; ++e) { cs[4 * j + e] = c4[e]; sn[4 * j + e] = s4[e]; } }
        }
        float x1[16], x2[16]; float ss = 0.f;
#pragma unroll
        for (int j = 0; j < 2; ++j)
#pragma unroll
            for (int e = 0; e < 4; ++e) { x1[8 * j + 2 * e] = bflo(ka[j][e]); x1[8 * j + 2 * e + 1] = bfhi(ka[j][e]); x2[8 * j + 2 * e] = bflo(kb[j][e]); x2[8 * j + 2 * e + 1] = bfhi(kb[j][e]); }
#pragma unroll
        for (int i = 0; i < 16; ++i) ss += x1[i] * x1[i] + x2[i] * x2[i];
        ss += __shfl_xor(ss, 1);
        const float rstd = 1.0f / sqrtf(ss * (1.0f / 64.0f) + EPS);
        unsigned o1[8], o2[8];
#pragma unroll
        for (int i = 0; i < 8; ++i) {
            float y1[2], y2[2];
#pragma unroll
            for (int e = 0; e < 2; ++e) { const int d = 2 * i + e; const float a = x1[d] * rstd * F.swa_k_norm[16 * p + d], c = x2[d] * rstd * F.swa_k_norm[32 + 16 * p + d];
                y1[e] = a * cs[d] - c * sn[d]; y2[e] = c * cs[d] + a * sn[d]; }
            o1[i] = pk2(y1[0], y1[1]); o2[i] = pk2(y2[0], y2[1]);
        }
        LAS v4u* kd = (LAS v4u*)(KL + key * 144 + 32 * p);
        kd[0] = (v4u){o1[0], o1[1], o1[2], o1[3]}; kd[1] = (v4u){o1[4], o1[5], o1[6], o1[7]};
        LAS v4u* kd2 = (LAS v4u*)(KL + key * 144 + 64 + 32 * p);
        kd2[0] = (v4u){o2[0], o2[1], o2[2], o2[3]}; kd2[1] = (v4u){o2[4], o2[5], o2[6], o2[7]};
#pragma unroll
        for (int j = 0; j < 4; ++j)
#pragma unroll
            for (int e = 0; e < 4; ++e) { const int d = 32 * p + 8 * j + 2 * e; const unsigned w = vv[j][e];
                *(LAS unsigned short*)(VL + d * 520 + key * 2) = (unsigned short)(w & 0xffffu);
                *(LAS unsigned short*)(VL + (d + 1) * 520 + key * 2) = (unsigned short)(w >> 16); }
    }
    __syncthreads();
    {
        const int g = F.wave, hq = kvh * 8 + g, r = F.lane & 31, h = F.lane >> 5;
        const float sink = F.swa_sinks[hq];
        for (int qt = 0; qt < 4; ++qt) {
            const int qpos = t0 + 32 * qt + r;
            const size_t tok = (size_t)(b * SEQ + qpos);
            const GAS v4u* qr = (const GAS v4u*)(F.PROJ + tok * NPROJ + C_SQ + hq * 64);
            v4u qraw[4];
#pragma unroll
            for (int kk = 0; kk < 4; ++kk) qraw[kk] = qr[2 * kk + h];
            float qf[4][8]; float ss = 0.f;
#pragma unroll
            for (int kk = 0; kk < 4; ++kk)
#pragma unroll
                for (int e = 0; e < 4; ++e) { qf[kk][2 * e] = bflo(qraw[kk][e]); qf[kk][2 * e + 1] = bfhi(qraw[kk][e]); }
#pragma unroll
            for (int kk = 0; kk < 4; ++kk)
#pragma unroll
                for (int j = 0; j < 8; ++j) ss += qf[kk][j] * qf[kk][j];
            ss += __shfl_xor(ss, 32);
            const float rstd = 0.125f / sqrtf(ss * (1.0f / 64.0f) + EPS);
            bf16x8 qfrag[4];
#pragma unroll
            for (int kk = 0; kk < 2; ++kk) {
                float y1[8], y2[8];
                const GAS f32x4* cp = (const GAS f32x4*)(COS + qpos * 32 + 16 * kk + 8 * h); const GAS f32x4* sp = (const GAS f32x4*)(SIN + qpos * 32 + 16 * kk + 8 * h);
                const f32x4 c0 = cp[0], c1 = cp[1], s0 = sp[0], s1 = sp[1];
#pragma unroll
                for (int j = 0; j < 8; ++j) { const int d = 16 * kk + 8 * h + j; const float cc = j < 4 ? c0[j & 3] : c1[j & 3], sv = j < 4 ? s0[j & 3] : s1[j & 3];
                    const float a = qf[kk][j] * rstd * F.swa_q_norm[d], c = qf[kk + 2][j] * rstd * F.swa_q_norm[d + 32];
                    y1[j] = a * cc - c * sv; y2[j] = c * cc + a * sv; }
                qfrag[kk] = mk8(pk2(y1[0], y1[1]), pk2(y1[2], y1[3]), pk2(y1[4], y1[5]), pk2(y1[6], y1[7]));
                qfrag[kk + 2] = mk8(pk2(y2[0], y2[1]), pk2(y2[2], y2[3]), pk2(y2[4], y2[5]), pk2(y2[6], y2[7]));
            }
            f32x16 sacc[5];
#pragma unroll
            for (int tt = 0; tt < 5; ++tt) { f32x16 a = {0.f, 0.f, 0.f, 0.f, 0.f, 0.f, 0.f, 0.f, 0.f, 0.f, 0.f, 0.f, 0.f, 0.f, 0.f, 0.f};
#pragma unroll
                for (int kk = 0; kk < 4; ++kk) { const bf16x8 kf = *(const LAS bf16x8*)(KL + (32 * (qt + tt) + r) * 144 + (16 * kk + 8 * h) * 2); a = mfma32(kf, qfrag[kk], a); }
                sacc[tt] = a; }
            float mx = sink;
#pragma unroll
            for (int tt = 0; tt < 5; ++tt)
#pragma unroll
                for (int i = 0; i < 16; ++i) { const int koff = (i & 3) + 8 * (i >> 2) + 4 * h; const int rel = r + 128 - 32 * tt - koff; const int kidx = 32 * (qt + tt) + koff;
                    const bool valid = (rel >= 0) && (rel < 128) && (t0 - 128 + kidx >= 0);
                    const float s = valid ? sacc[tt][i] : -INFINITY; sacc[tt][i] = s; mx = fmaxf(mx, s); }
            mx = fmaxf(mx, __shfl_xor(mx, 32));
            float sum = 0.f;
#pragma unroll
            for (int tt = 0; tt < 5; ++tt)
#pragma unroll
                for (int i = 0; i < 16; ++i) { const float pv = __expf(sacc[tt][i] - mx); sacc[tt][i] = pv; sum += pv; }
            sum += __shfl_xor(sum, 32);
            const float inv = 1.0f / (sum + __expf(sink - mx));
            f32x16 oacc[2];
#pragma unroll
            for (int dt = 0; dt < 2; ++dt) oacc[dt] = (f32x16){0.f, 0.f, 0.f, 0.f, 0.f, 0.f, 0.f, 0.f, 0.f, 0.f, 0.f, 0.f, 0.f, 0.f, 0.f, 0.f};
#pragma unroll
            for (int tt = 0; tt < 5; ++tt)
#pragma unroll
                for (int s2 = 0; s2 < 2; ++s2) {
                    const bf16x8 pf = mk8(pk2(sacc[tt][8 * s2], sacc[tt][8 * s2 + 1]), pk2(sacc[tt][8 * s2 + 2], sacc[tt][8 * s2 + 3]), pk2(sacc[tt][8 * s2 + 4], sacc[tt][8 * s2 + 5]), pk2(sacc[tt][8 * s2 + 6], sacc[tt][8 * s2 + 7]));
#pragma unroll
                    for (int dt = 0; dt < 2; ++dt) { const LAS unsigned char* vp = VL + (32 * dt + r) * 520 + (32 * (qt + tt) + 16 * s2 + 4 * h) * 2;
                        const v2u lo = *(const LAS v2u*)vp, hi = *(const LAS v2u*)(vp + 16);
                        oacc[dt] = mfma32(mk8(lo.x, lo.y, hi.x, hi.y), pf, oacc[dt]); }
                }
            float so = 0.f;
#pragma unroll
            for (int dt = 0; dt < 2; ++dt)
#pragma unroll
                for (int i = 0; i < 16; ++i) { const float o = oacc[dt][i] * inv; oacc[dt][i] = o; so += o * o; }
            so += __shfl_xor(so, 32);
            const float rs2 = 1.0f / sqrtf(so * (1.0f / 64.0f) + EPS);
            bf16* orow = F.MIXIN + tok * DM + 2048 + hq * 64;
#pragma unroll
            for (int dt = 0; dt < 2; ++dt)
#pragma unroll
                for (int gq = 0; gq < 4; ++gq) { const int d0 = 32 * dt + 8 * gq + 4 * h; const f32x4 gn = *(const GAS f32x4*)(F.swa_out_norm + d0);
                    v2u o; o.x = pk2(oacc[dt][4 * gq] * rs2 * gn[0], oacc[dt][4 * gq + 1] * rs2 * gn[1]); o.y = pk2(oacc[dt][4 * gq + 2] * rs2 * gn[2], oacc[dt][4 * gq + 3] * rs2 * gn[3]);
                    *(GAS v2u*)(orow + d0) = o; }
        }
    }
    __syncthreads();
}

constexpr int GL_QT = 0, GL_KT = 9216, GL_KHT = 18432, GL_VT = 27648, GL_WG = 46336, GL_BG = 50432, GL_OB = 50688;
__device__ __forceinline__ void gla_g1_units(Frame& F, int u0, int nu) {
    const int bh = u0 >> 5, b = bh >> 4, h = bh & 15, tid = F.tid, lane = F.lane, w = F.wave;
    LAS unsigned char* QT = F.lds + GL_QT;
    LAS unsigned char* KT = F.lds + GL_KT;
    LAS unsigned char* KHT = F.lds + GL_KHT;
    LAS unsigned char* VT = F.lds + GL_VT;
    LAS float* WG = (LAS float*)(F.lds + GL_WG);
    LAS float* BG = (LAS float*)(F.lds + GL_BG);
    LAS float* OB = (LAS float*)(F.lds + GL_OB);
    __syncthreads();
    for (int i = tid; i < 1024; i += 512) WG[i] = F.w_gate_up[(i >> 6) * 1024 + h * 64 + (i & 63)];
    if (tid < 64) BG[tid] = F.b_gla_gate[h * 64 + tid];
    __syncthreads();
    const int r = lane & 15, g = lane >> 4;
    const int t2 = tid >> 3, seg = tid & 7;
    v4u qv, kv, g0, g1, vv0, vv1;
    { const size_t row0 = (size_t)b * SEQ + (u0 & 31) * 64; const bf16* pr = F.PROJ + (row0 + lane) * NPROJ;
      qv = *(const GAS v4u*)(pr + C_GQ + h * 64 + 8 * w); kv = *(const GAS v4u*)(pr + C_GK + h * 64 + 8 * w); g0 = *(const GAS v4u*)(pr + C_GA); g1 = *(const GAS v4u*)(pr + C_GA + 8);
      const GAS v4u* vr = (const GAS v4u*)(F.PROJ + (row0 + t2) * NPROJ + C_GV + h * 128 + 16 * seg); vv0 = vr[0]; vv1 = vr[1]; }
    for (int ui = 0; ui < nu; ++ui) {
        const int u = u0 + ui, chunk = u & 31;
        const size_t row0 = (size_t)b * SEQ + chunk * 64;
        {
            float ga[16];
#pragma unroll
            for (int e = 0; e < 4; ++e) { ga[2 * e] = bflo(g0[e]); ga[2 * e + 1] = bfhi(g0[e]); ga[8 + 2 * e] = bflo(g1[e]); ga[8 + 2 * e + 1] = bfhi(g1[e]); }
            float z[8];
            { const f32x4 b0 = *(const LAS f32x4*)(BG + 8 * w), b1 = *(const LAS f32x4*)(BG + 8 * w + 4);
#pragma unroll
              for (int i = 0; i < 4; ++i) { z[i] = b0[i]; z[4 + i] = b1[i]; } }
#pragma unroll
            for (int j = 0; j < 16; ++j) { const f32x4 w0 = *(const LAS f32x4*)(WG + j * 64 + 8 * w), w1 = *(const LAS f32x4*)(WG + j * 64 + 8 * w + 4);
#pragma unroll
                for (int i = 0; i < 4; ++i) { z[i] += ga[j] * w0[i]; z[4 + i] += ga[j] * w1[i]; } }
            float bb[8];
#pragma unroll
            for (int i = 0; i < 8; ++i) { const float zz = z[i]; bb[i] = (fminf(zz, 0.f) - __logf(1.0f + __expf(-fabsf(zz)))) * (1.0f / 16.0f); }
#pragma unroll
            for (int off = 1; off < 64; off <<= 1)
#pragma unroll
                for (int i = 0; i < 8; ++i) { const float v = __shfl_up(bb[i], off); if (lane >= off) bb[i] += v; }
            float qn[8], kn[8], kh[8];
#pragma unroll
            for (int e = 0; e < 4; ++e) { qn[2 * e] = bflo(qv[e]); qn[2 * e + 1] = bfhi(qv[e]); kn[2 * e] = bflo(kv[e]); kn[2 * e + 1] = bfhi(kv[e]); }
#pragma unroll
            for (int i = 0; i < 8; ++i) { const float bl = __shfl(bb[i], 63); const float eb = __expf(bb[i]);
                qn[i] = qn[i] * 0.125f * eb; kh[i] = kn[i] * __expf(bl - bb[i]); kn[i] = kn[i] * __expf(-bb[i]);
                if (lane == 0) F.GG[(size_t)u * 64 + 8 * w + i] = __expf(bl); }
            const v4u qpk = {pk2(qn[0], qn[1]), pk2(qn[2], qn[3]), pk2(qn[4], qn[5]), pk2(qn[6], qn[7])};
            *(LAS v4u*)(QT + lane * 144 + 16 * w) = qpk;
            *(GAS v4u*)(F.GQT + ((size_t)u * 64 + lane) * 64 + 8 * w) = qpk;
            *(LAS v4u*)(KT + lane * 144 + 16 * w) = (v4u){pk2(kn[0], kn[1]), pk2(kn[2], kn[3]), pk2(kn[4], kn[5]), pk2(kn[6], kn[7])};
#pragma unroll
            for (int i = 0; i < 8; ++i) *(LAS unsigned short*)(KHT + (8 * w + i) * 144 + lane * 2) = (unsigned short)f2bf(kh[i]);
#pragma unroll
            for (int e = 0; e < 4; ++e) {
                *(LAS unsigned short*)(VT + (16 * seg + 2 * e) * 144 + t2 * 2) = (unsigned short)(vv0[e] & 0xffffu);
                *(LAS unsigned short*)(VT + (16 * seg + 2 * e + 1) * 144 + t2 * 2) = (unsigned short)(vv0[e] >> 16);
                *(LAS unsigned short*)(VT + (16 * seg + 8 + 2 * e) * 144 + t2 * 2) = (unsigned short)(vv1[e] & 0xffffu);
                *(LAS unsigned short*)(VT + (16 * seg + 8 + 2 * e + 1) * 144 + t2 * 2) = (unsigned short)(vv1[e] >> 16); }
        }
        if (ui + 1 < nu) {
            const size_t rown = row0 + 64; const bf16* pr = F.PROJ + (rown + lane) * NPROJ;
            qv = *(const GAS v4u*)(pr + C_GQ + h * 64 + 8 * w); kv = *(const GAS v4u*)(pr + C_GK + h * 64 + 8 * w); g0 = *(const GAS v4u*)(pr + C_GA); g1 = *(const GAS v4u*)(pr + C_GA + 8);
            const GAS v4u* vr = (const GAS v4u*)(F.PROJ + (rown + t2) * NPROJ + C_GV + h * 128 + 16 * seg); vv0 = vr[0]; vv1 = vr[1]; }
        __syncthreads();
        {
            unsigned dp[4][4][2];
#pragma unroll
            for (int tt = 0; tt < 4; ++tt) {
                const bf16x8 bq0 = *(const LAS bf16x8*)(QT + (16 * tt + r) * 144 + (8 * g) * 2), bq1 = *(const LAS bf16x8*)(QT + (16 * tt + r) * 144 + (32 + 8 * g) * 2);
#pragma unroll
                for (int st = 0; st < 4; ++st) {
                    if (st <= tt) {
                        const bf16x8 ak0 = *(const LAS bf16x8*)(KT + (16 * st + r) * 144 + (8 * g) * 2), ak1 = *(const LAS bf16x8*)(KT + (16 * st + r) * 144 + (32 + 8 * g) * 2);
                        f32x4 d = {0.f, 0.f, 0.f, 0.f}; d = mfma16(ak0, bq0, d); d = mfma16(ak1, bq1, d);
                        if (st == tt) {
#pragma unroll
                            for (int i = 0; i < 4; ++i) if (4 * g + i > r) d[i] = 0.f; }
                        dp[st][tt][0] = pk2(d[0], d[1]); dp[st][tt][1] = pk2(d[2], d[3]);
                    } else { dp[st][tt][0] = 0u; dp[st][tt][1] = 0u; }
                }
            }
#pragma unroll
            for (int tt = 0; tt < 4; ++tt) {
                f32x4 o = {0.f, 0.f, 0.f, 0.f};
#pragma unroll
                for (int kk = 0; kk < 2; ++kk) {
                    if (2 * kk <= tt) {
                        const LAS unsigned char* vp = VT + (16 * w + r) * 144 + (32 * kk + 4 * g) * 2;
                        const v2u lo = *(const LAS v2u*)vp, hi = *(const LAS v2u*)(vp + 32);
                        o = mfma16(mk8(dp[2 * kk][tt][0], dp[2 * kk][tt][1], dp[2 * kk + 1][tt][0], dp[2 * kk + 1][tt][1]), mk8(lo.x, lo.y, hi.x, hi.y), o);
                    }
                }
#pragma unroll
                for (int i = 0; i < 4; ++i) OB[(16 * tt + 4 * g + i) * 132 + 16 * w + r] = o[i];
            }
#pragma unroll
            for (int dt = 0; dt < 4; ++dt) {
                f32x4 uacc = {0.f, 0.f, 0.f, 0.f};
#pragma unroll
                for (int kk = 0; kk < 2; ++kk) { const bf16x8 a = *(const LAS bf16x8*)(KHT + (16 * dt + r) * 144 + (32 * kk + 8 * g) * 2), bv = *(const LAS bf16x8*)(VT + (16 * w + r) * 144 + (32 * kk + 8 * g) * 2);
                    uacc = mfma16(a, bv, uacc); }
                *(GAS f32x4*)(F.GUT + ((size_t)u * 128 + 16 * w + r) * 64 + 16 * dt + 4 * g) = uacc;
            }
        }
        __syncthreads();
        {
            unsigned ow[8];
#pragma unroll
            for (int j = 0; j < 4; ++j) { const f32x4 v = *(const LAS f32x4*)(OB + t2 * 132 + 16 * seg + 4 * j); ow[2 * j] = pk2(v[0], v[1]); ow[2 * j + 1] = pk2(v[2], v[3]); }
            GAS v4u* op = (GAS v4u*)(F.MIXIN + (row0 + t2) * DM + h * 128 + 16 * seg);
            op[0] = (v4u){ow[0], ow[1], ow[2], ow[3]}; op[1] = (v4u){ow[4], ow[5], ow[6], ow[7]};
        }
    }
}
__device__ __forceinline__ void gla_scan(Frame& F) {
    const size_t gt = (size_t)F.vcu * 512 + F.tid, NT = (size_t)F.G * 512;
    for (size_t i = gt; i < (size_t)64 * 128 * 16; i += NT) {
        const int bh = (int)(i >> 11), v = (int)((i >> 4) & 127), d4 = (int)(i & 15);
        f32x4 S = {0.f, 0.f, 0.f, 0.f};
#pragma unroll 8
        for (int c = 0; c < 32; ++c) {
            const size_t u = (size_t)bh * 32 + c;
            const f32x4 U = *(const GAS f32x4*)(F.GUT + (u * 128 + v) * 64 + 4 * d4), gg = *(const GAS f32x4*)(F.GG + u * 64 + 4 * d4);
            *(GAS v2u*)(F.GST + (u * 128 + v) * 64 + 4 * d4) = (v2u){pk2(S[0], S[1]), pk2(S[2], S[3])};
            S = gg * S + U;
        }
    }
}
__device__ __forceinline__ void gla_g3_units(Frame& F, int u0, int nu) {
    const int bh = u0 >> 5, b = bh >> 4, h = bh & 15, tid = F.tid, lane = F.lane, w = F.wave;
    LAS float* OB = (LAS float*)(F.lds + GL_OB);
    const int r = lane & 15, g = lane >> 4, t2 = tid >> 3, seg = tid & 7;
    __syncthreads();
    for (int ui = 0; ui < nu; ++ui) {
        const int u = u0 + ui, chunk = u & 31;
        const size_t row0 = (size_t)b * SEQ + chunk * 64;
        const GAS v4u* oip = (const GAS v4u*)(F.MIXIN + (row0 + t2) * DM + h * 128 + 16 * seg);
        const v4u oi0 = oip[0], oi1 = oip[1];
        const GAS v4u* gr = (const GAS v4u*)(F.PROJ + (row0 + t2) * NPROJ + C_GG + h * 128 + 16 * seg);
        const v4u gg0 = gr[0], gg1 = gr[1];
        {
            bf16x8 bs[2];
#pragma unroll
            for (int kk = 0; kk < 2; ++kk) { const bf16* sp = F.GST + ((size_t)u * 128 + 16 * w + r) * 64 + 32 * kk + 4 * g;
                const v2u lo = *(const GAS v2u*)sp, hi = *(const GAS v2u*)(sp + 16); bs[kk] = mk8(lo.x, lo.y, hi.x, hi.y); }
#pragma unroll
            for (int tt = 0; tt < 4; ++tt) {
                f32x4 o = {0.f, 0.f, 0.f, 0.f};
#pragma unroll
                for (int kk = 0; kk < 2; ++kk) { const bf16* qp = F.GQT + ((size_t)u * 64 + 16 * tt + r) * 64 + 32 * kk + 4 * g;
                    const v2u lo = *(const GAS v2u*)qp, hi = *(const GAS v2u*)(qp + 16);
                    o = mfma16(mk8(lo.x, lo.y, hi.x, hi.y), bs[kk], o); }
#pragma unroll
                for (int i = 0; i < 4; ++i) OB[(16 * tt + 4 * g + i) * 132 + 16 * w + r] = o[i];
            }
        }
        __syncthreads();
        {
            float o[16]; float ss = 0.f;
#pragma unroll
            for (int j = 0; j < 4; ++j) { const f32x4 v = *(const LAS f32x4*)(OB + t2 * 132 + 16 * seg + 4 * j);
#pragma unroll
                for (int e = 0; e < 4; ++e) o[4 * j + e] = v[e]; }
#pragma unroll
            for (int e = 0; e < 4; ++e) { o[2 * e] += bflo(oi0[e]); o[2 * e + 1] += bfhi(oi0[e]); o[8 + 2 * e] += bflo(oi1[e]); o[8 + 2 * e + 1] += bfhi(oi1[e]); }
#pragma unroll
            for (int e = 0; e < 16; ++e) ss += o[e] * o[e];
            ss += __shfl_xor(ss, 1); ss += __shfl_xor(ss, 2); ss += __shfl_xor(ss, 4);
            const float rstd = 1.0f / sqrtf(ss * (1.0f / 128.0f) + EPS);
            float gg[16];
#pragma unroll
            for (int e = 0; e < 4; ++e) { gg[2 * e] = bflo(gg0[e]); gg[2 * e + 1] = bfhi(gg0[e]); gg[8 + 2 * e] = bflo(gg1[e]); gg[8 + 2 * e + 1] = bfhi(gg1[e]); }
            unsigned ow[8];
#pragma unroll
            for (int e = 0; e < 8; ++e) { const float a = o[2 * e] * rstd * F.gla_out_norm[16 * seg + 2 * e] * silu_f(gg[2 * e]), c = o[2 * e + 1] * rstd * F.gla_out_norm[16 * seg + 2 * e + 1] * silu_f(gg[2 * e + 1]);
                ow[e] = pk2(a, c); }
            GAS v4u* op = (GAS v4u*)(F.MIXIN + (row0 + t2) * DM + h * 128 + 16 * seg);
            op[0] = (v4u){ow[0], ow[1], ow[2], ow[3]}; op[1] = (v4u){ow[4], ow[5], ow[6], ow[7]};
        }
        __syncthreads();
    }
}

__device__ __forceinline__ void p3a_mixer(Frame& F) {
    for (int u = F.vcu; u < 256; u += F.G) swa_unit(F, u);
    for (int q = F.vcu; q < 256; q += F.G) gla_g1_units(F, q * 8, 8);
}
__device__ __forceinline__ void p3c_mixer(Frame& F) {
    for (int q = F.vcu; q < 256; q += F.G) gla_g3_units(F, q * 8, 8);
}

__device__ __forceinline__ unsigned f2s(float f) { const unsigned u = __builtin_bit_cast(unsigned, f); return (u & 0x80000000u) ? ~u : (u | 0x80000000u); }
__device__ __forceinline__ float s2f(unsigned s) { const unsigned u = (s & 0x80000000u) ? (s & 0x7fffffffu) : ~s; return __builtin_bit_cast(float, u); }
#define TOPK_INSERT(list, xin) do { unsigned _x = (xin); _Pragma("unroll") for (int _p = 0; _p < 16; ++_p) { const unsigned _hi = list[_p] > _x ? list[_p] : _x; _x = list[_p] > _x ? _x : list[_p]; list[_p] = _hi; } } while (0)

__device__ __forceinline__ void p7_topk(Frame& F) {
    const int tid = F.tid, lane = F.lane, wave = F.wave;
    LAS unsigned char* KY = F.lds;
    LAS unsigned* SC = (LAS unsigned*)(F.lds + 69632 + wave * 4096);
    for (int i = tid; i < 2 * 128 * 64; i += 512) { const int hf = i >> 13, key = (i >> 6) & 127, dp2 = i & 63;
        const float* kp = (hf ? F.keys2 : F.keys1) + key * 128 + 2 * dp2;
        *(LAS unsigned*)(KY + hf * 34816 + key * 272 + dp2 * 4) = pk2(kp[0], kp[1]); }
    __syncthreads();
    const int gw = F.vcu * NWAVES + wave, NGW = F.G * NWAVES;
    const int r = lane & 31, h = lane >> 5;
    for (int task = gw; task < 256 * 8; task += NGW) {
        const int tile = task >> 3, hd = task & 7, tok = tile * 32 + r;
        for (int hf = 0; hf < 2; ++hf) {
            const GAS v4u* qr = (const GAS v4u*)(F.QPEER + (size_t)tok * PEER_N + hd * 256 + hf * 128);
            bf16x8 qf[8];
#pragma unroll
            for (int kk = 0; kk < 8; ++kk) qf[kk] = __builtin_bit_cast(bf16x8, qr[2 * kk + h]);
            unsigned list[16];
#pragma unroll
            for (int p = 0; p < 16; ++p) list[p] = 0u;
#pragma unroll
            for (int T = 0; T < 4; ++T) {
                f32x16 a = {0.f, 0.f, 0.f, 0.f, 0.f, 0.f, 0.f, 0.f, 0.f, 0.f, 0.f, 0.f, 0.f, 0.f, 0.f, 0.f};
#pragma unroll
                for (int kk = 0; kk < 8; ++kk) { const bf16x8 kf = *(const LAS bf16x8*)(KY + hf * 34816 + (32 * T + r) * 272 + (16 * kk + 8 * h) * 2); a = mfma32(kf, qf[kk], a); }
#pragma unroll
                for (int i = 0; i < 16; ++i) { const int key = 32 * T + (i & 3) + 8 * (i >> 2) + 4 * h; const unsigned pkd = (f2s(a[i]) & ~127u) | (unsigned)(127 - key); TOPK_INSERT(list, pkd); }
            }
            unsigned other[16];
#pragma unroll
            for (int p = 0; p < 16; ++p) other[p] = (unsigned)__shfl_xor((int)list[p], 32);
#pragma unroll
            for (int p = 0; p < 16; ++p) TOPK_INSERT(list, other[p]);
            if (h == 0) {
#pragma unroll
                for (int p = 0; p < 16; ++p) SC[(hf * 16 + p) * 32 + r] = list[p]; }
        }
        LDS_WAIT(); asm volatile("" ::: "memory");
        float v1[16], v2[16];
#pragma unroll
        for (int p = 0; p < 16; ++p) { v1[p] = s2f(SC[p * 32 + r] & ~127u); v2[p] = s2f(SC[(16 + p) * 32 + r] & ~127u); }
        unsigned cl[16];
#pragma unroll
        for (int p = 0; p < 16; ++p) cl[p] = 0u;
#pragma unroll
        for (int i = 0; i < 16; ++i)
#pragma unroll
            for (int j = 0; j < 16; ++j) if ((i + 1) * (j + 1) <= 16) { const unsigned pkd = (f2s(v1[i] + v2[j]) & ~255u) | (unsigned)(255 - (i * 16 + j)); TOPK_INSERT(cl, pkd); }
        float val[8]; int eidx[8]; float mx = -INFINITY;
#pragma unroll
        for (int p = 0; p < 16; ++p) { const int pos = 255 - (int)(cl[p] & 255u), i = pos >> 4, j = pos & 15;
            const unsigned a = SC[i * 32 + r], b2 = SC[(16 + j) * 32 + r];
            const float v = s2f(a & ~127u) + s2f(b2 & ~127u); mx = fmaxf(mx, v);
            if ((p >> 3) == h) { val[p & 7] = v; eidx[p & 7] = (127 - (int)(a & 127u)) * 128 + (127 - (int)(b2 & 127u)); } }
        float sum = 0.f, ex[8];
#pragma unroll
        for (int p = 0; p < 8; ++p) { ex[p] = __expf(val[p] - mx); sum += ex[p]; }
        sum += __shfl_xor(sum, 32);
        const float inv = 1.0f / sum;
        const int p4a = hd * 4 + 2 * h;
        GAS v4u* ip = (GAS v4u*)F.EIDX; GAS f32x4* gp = (GAS f32x4*)F.GATEQ;
        ip[(size_t)p4a * NTOK + tok] = (v4u){(unsigned)eidx[0], (unsigned)eidx[1], (unsigned)eidx[2], (unsigned)eidx[3]}; ip[(size_t)(p4a + 1) * NTOK + tok] = (v4u){(unsigned)eidx[4], (unsigned)eidx[5], (unsigned)eidx[6], (unsigned)eidx[7]};
        ((GAS v4u*)F.EIDX16)[(size_t)(hd * 2 + h) * NTOK + tok] = (v4u){(unsigned)eidx[0] | ((unsigned)eidx[1] << 16), (unsigned)eidx[2] | ((unsigned)eidx[3] << 16), (unsigned)eidx[4] | ((unsigned)eidx[5] << 16), (unsigned)eidx[6] | ((unsigned)eidx[7] << 16)};
        gp[(size_t)p4a * NTOK + tok] = (f32x4){ex[0] * inv, ex[1] * inv, ex[2] * inv, ex[3] * inv}; gp[(size_t)(p4a + 1) * NTOK + tok] = (f32x4){ex[4] * inv, ex[5] * inv, ex[6] * inv, ex[7] * inv};
        LDS_WAIT(); asm volatile("" ::: "memory");
    }
}

typedef int i32x4 __attribute__((ext_vector_type(4)));
__device__ __forceinline__ void lds_fill_128k(Frame& F, const unsigned char* src) {
#pragma unroll
    for (int i = 0; i < 16; ++i)
        __builtin_amdgcn_global_load_lds((const unsigned*)(src + (size_t)(i * 512 + F.tid) * 16), (LAS unsigned*)(F.lds + i * 8192 + F.wave * 1024), 16, 0, 0);
}
constexpr int P8_ZOFF = 139264;
constexpr int P8_YB = 132096;
constexpr int P8_DUMMY = 140288;
#define P8_WAITV0() asm volatile("s_waitcnt vmcnt(0)" ::: "memory")
#define P8_BAR() do { asm volatile("s_waitcnt lgkmcnt(0)" ::: "memory"); __builtin_amdgcn_s_barrier(); asm volatile("" ::: "memory"); } while (0)
__device__ __forceinline__ void p8a_sddmm(Frame& F) {
    const int wv = F.wave;
    for (int u = F.vcu; u < 256; u += F.G) {
        const int tg = u & 15, dr = u >> 4, t = tg * 512 + F.tid;
        unsigned id[64];
#pragma unroll
        for (int p8 = 0; p8 < 16; ++p8) { const v4u v = ((const GAS v4u*)F.EIDX16)[(size_t)p8 * NTOK + t]; id[4 * p8] = v.x; id[4 * p8 + 1] = v.y; id[4 * p8 + 2] = v.z; id[4 * p8 + 3] = v.w; }
        int acc[128];
#pragma unroll
        for (int p = 0; p < 128; ++p) acc[p] = 0;
        const unsigned char* tab = F.DC8 + (size_t)(dr * 32) * 131072;
        const unsigned char* ysrc = F.YC8 + ((size_t)(dr * 32) * NTOK + tg * 512) * 8 + (wv & 3) * 1024 + F.lane * 16;
        for (int sl = 0; sl < 32; ++sl) {
#pragma unroll
            for (int i = 0; i < 64; ++i) asm volatile("" : "+v"(id[i]));
            P8_WAITV0();
            P8_BAR();
            lds_fill_128k(F, tab + (size_t)sl * 131072);
            if (wv < 4) __builtin_amdgcn_global_load_lds((const unsigned*)(ysrc + (size_t)sl * NTOK * 8), (LAS unsigned*)(F.lds + P8_YB + wv * 1024), 16, 0, 0);
            P8_WAITV0();
            P8_BAR();
            if (sl + 1 < 32) __builtin_amdgcn_global_load_lds((const unsigned*)(tab + (size_t)(sl + 1) * 131072 + (size_t)tg * 8192 + wv * 1024 + F.lane * 16), (LAS unsigned*)(F.lds + P8_DUMMY + wv * 1024), 16, 0, 0);
            const v2u yv = *(const LAS v2u*)(F.lds + P8_YB + F.tid * 8);
#pragma unroll
            for (int p = 0; p < 128; ++p) {
                const unsigned off = (p & 1) ? ((id[p >> 1] >> 13) & 0x7fff8u) : ((id[p >> 1] << 3) & 0x7fff8u);
                const v2u d = *(const LAS v2u*)(F.lds + off);
                acc[p] = __builtin_amdgcn_sdot4((int)d.x, (int)yv.x, acc[p], false);
                acc[p] = __builtin_amdgcn_sdot4((int)d.y, (int)yv.y, acc[p], false);
                asm volatile("" : "+v"(acc[p]));
                if ((p & 7) == 7) __builtin_amdgcn_sched_barrier(0);
            }
        }
#pragma unroll
        for (int p4 = 0; p4 < 32; ++p4) ((GAS i32x4*)F.ZP)[((size_t)(dr * 32 + p4)) * NTOK + t] = (i32x4){acc[4 * p4], acc[4 * p4 + 1], acc[4 * p4 + 2], acc[4 * p4 + 3]};
    }
    P8_WAITV0();
    __syncthreads();
}
__device__ __forceinline__ void p8h_gate(Frame& F) {
    const size_t gt = (size_t)F.vcu * 512 + F.tid, NT = (size_t)F.G * 512;
    for (size_t i = gt; i < (size_t)32 * NTOK; i += NT) {
        const int p4 = (int)(i >> 13), t = (int)(i & (NTOK - 1));
        i32x4 z = {0, 0, 0, 0};
#pragma unroll
        for (int dr = 0; dr < 16; ++dr) z += ((const GAS i32x4*)F.ZP)[((size_t)(dr * 32 + p4)) * NTOK + t];
        const v4u e4 = ((const GAS v4u*)F.EIDX)[i]; const f32x4 g4 = ((const GAS f32x4*)F.GATEQ)[i]; const float ys = F.YSC[t];
        v4u he;
#pragma unroll
        for (int c = 0; c < 4; ++c) { const float zz = (float)z[c] * ys * F.DSC[e4[c]]; const float hv = 0.5f * zz * (1.0f + erff(zz * 0.70710678118654752f)) * g4[c]; he[c] = (f2bf(hv) << 16) | e4[c]; }
        ((GAS v4u*)F.HE)[i] = he;
    }
}
template <int MODE  > __device__ __forceinline__ void p8b_spmm(Frame& F, float* dst) {
    for (int u = F.vcu; u < 256; u += F.G) {
        const int tg = u & 15, sr = u >> 4, t = tg * 512 + F.tid, b = t >> 11;
        unsigned he[128];
#pragma unroll
        for (int p4 = 0; p4 < 32; ++p4) { const v4u v = ((const GAS v4u*)F.HE)[(size_t)p4 * NTOK + t]; he[4 * p4] = v.x; he[4 * p4 + 1] = v.y; he[4 * p4 + 2] = v.z; he[4 * p4 + 3] = v.w; }
        const float* xrow = F.out + (size_t)t * DM; float* orow = dst + (size_t)t * DM; const float* g2 = F.MOD + b * NMOD + 5 * DM;
        for (int sg = 0; sg < 8; ++sg) {
            f32x2 acc[4][4];
#pragma unroll
            for (int k = 0; k < 4; ++k) {
                const int s = sr * 32 + sg * 4 + k;
#pragma unroll
                for (int i = 0; i < 128; ++i) asm volatile("" : "+v"(he[i]));
                P8_WAITV0();
                P8_BAR();
                if (MODE != 1) lds_fill_128k(F, F.UC8 + (size_t)s * 131072);
                P8_WAITV0();
                P8_BAR();
                if (MODE != 1 && (sg * 4 + k) + 1 < 32) __builtin_amdgcn_global_load_lds((const unsigned*)(F.UC8 + (size_t)(s + 1) * 131072 + (size_t)tg * 8192 + F.wave * 1024 + F.lane * 16), (LAS unsigned*)(F.lds + P8_DUMMY + F.wave * 1024), 16, 0, 0);
#pragma unroll
                for (int q = 0; q < 4; ++q) acc[k][q] = (f32x2){0.f, 0.f};
#pragma unroll
                for (int p = 0; p < (MODE == 2 ? 8 : 128); ++p) {
                    const v2u w = *(const LAS v2u*)(F.lds + ((he[p] & 0xffffu) << 3));
                    const float hv = __builtin_bit_cast(float, he[p] & 0xffff0000u); const f32x2 h2 = {hv, hv};
                    acc[k][0] += __builtin_amdgcn_cvt_pk_f32_fp8((int)w.x, false) * h2; acc[k][1] += __builtin_amdgcn_cvt_pk_f32_fp8((int)w.x, true) * h2;
                    acc[k][2] += __builtin_amdgcn_cvt_pk_f32_fp8((int)w.y, false) * h2; acc[k][3] += __builtin_amdgcn_cvt_pk_f32_fp8((int)w.y, true) * h2;
                    if ((p & 7) == 7) { asm volatile("" : "+v"(acc[k][0]), "+v"(acc[k][1]), "+v"(acc[k][2]), "+v"(acc[k][3])); __builtin_amdgcn_sched_barrier(0); }
                }
            }
            const int c0 = (sr * 32 + sg * 4) * 8;
#pragma unroll
            for (int k = 0; k < 4; ++k) {
                const f32x4 xa = *(const GAS f32x4*)(xrow + c0 + 8 * k), xb = *(const GAS f32x4*)(xrow + c0 + 8 * k + 4), ga = *(const GAS f32x4*)(g2 + c0 + 8 * k), gb = *(const GAS f32x4*)(g2 + c0 + 8 * k + 4);
                *(GAS f32x4*)(orow + c0 + 8 * k) = (f32x4){xa[0] + ga[0] * acc[k][0].x, xa[1] + ga[1] * acc[k][0].y, xa[2] + ga[2] * acc[k][1].x, xa[3] + ga[3] * acc[k][1].y};
                *(GAS f32x4*)(orow + c0 + 8 * k + 4) = (f32x4){xb[0] + gb[0] * acc[k][2].x, xb[1] + gb[1] * acc[k][2].y, xb[2] + gb[2] * acc[k][3].x, xb[3] + gb[3] * acc[k][3].y};
            }
        }
    }
    P8_WAITV0();
    __syncthreads();
}

struct Args { const float* in[18]; float* out; unsigned char* ws; int ph_lo, ph_hi; };
__global__ void __launch_bounds__(NWAVES * 64, 2) mega_fwd(Args args) {
    extern __shared__ __attribute__((aligned(16))) unsigned char lds[];
    Frame F;
    F.lds = (LAS unsigned char*)lds;
    F.MISC = (volatile LAS unsigned*)(F.lds + MISC_OFF);
    F.tid = threadIdx.x; F.lane = F.tid & 63; F.wave = __builtin_amdgcn_readfirstlane(F.tid >> 6);
    F.G = gridDim.x; { const int bx = blockIdx.x; F.vcu = (F.G % 8 == 0) ? (bx % 8) * (F.G / 8) + bx / 8 : bx; }
    unsigned char* ws = args.ws;
    F.ctl = (unsigned*)(ws + WS_CTL);
    F.x = args.in[0]; F.c = args.in[1]; F.w_ada = args.in[2]; F.b_ada = args.in[3]; F.w_in = args.in[4]; F.w_gate_up = args.in[5]; F.b_gla_gate = args.in[6]; F.gla_out_norm = args.in[7];
    F.swa_q_norm = args.in[8]; F.swa_k_norm = args.in[9]; F.swa_sinks = args.in[10]; F.swa_out_norm = args.in[11]; F.w_out = args.in[12]; F.w_peer_q = args.in[13];
    F.keys1 = args.in[14]; F.keys2 = args.in[15]; F.edown = args.in[16]; F.eup = args.in[17];
    F.out = args.out;
    F.MOD = (float*)(ws + WS_MOD); F.ROPE = (float*)(ws + WS_ROPE);
    F.BTIN = (bf16*)(ws + WS_BTIN); F.BTOUT = (bf16*)(ws + WS_BTOUT); F.BTQ = (bf16*)(ws + WS_BTQ); F.HBUF = (bf16*)(ws + WS_HBUF); F.PROJ = (bf16*)(ws + WS_PROJ);
    F.MIXIN = (bf16*)(ws + WS_MIXIN); F.QPEER = (bf16*)(ws + WS_QPEER);
    F.DC8 = ws + WS_DC8; F.UC8 = ws + WS_UC8; F.YC8 = ws + WS_YC8; F.ZP = (int*)(ws + WS_ZP); F.EIDX = (unsigned*)(ws + WS_EIDX); F.HE = (unsigned*)(ws + WS_HE);
    F.EIDX16 = (unsigned*)(ws + WS_EIDX16);
    F.GQT = (bf16*)(ws + WS_QPEER); F.GST = (bf16*)(ws + WS_YC8); F.GUT = (float*)(ws + WS_ZP); F.GG = (float*)(ws + WS_IDX); F.GATEQ = (float*)(ws + WS_GATEQ); F.DSC = (float*)(ws + WS_DSC); F.YSC = (float*)(ws + WS_YSC);
    for (int u = F.tid; u < (LDS_BYTES - LDSCTL_OFF) / 4; u += NWAVES * 64) ((LAS unsigned*)(F.lds + LDSCTL_OFF))[u] = 0u;
    __syncthreads();
    XcdBarrier bar; bar.bar = F.ctl + CW_BAR; bar.x = 0; bar.st = nullptr;
    if (N_LAUNCHES == 1) bar = xcd_barrier_post(F.ctl + CW_BAR, F.MISC + 8);
#define GRID_BAR() do { if (N_LAUNCHES == 1) xcd_barrier(bar); } while (0)
    const int lo = args.ph_lo, hi = args.ph_hi;
#define IN(k) (lo <= (k) && (k) < hi)
#define BOTH(k) (IN(k) && IN((k) + 1))

    if (PROBE_REP_PHASE == 20 && IN(0)) { p0a_ada(F); GRID_BAR(); }
    if (PROBE_REP_PHASE == 21 && IN(0)) { p0b_weights(F); GRID_BAR(); }
    if (PROBE_REP_PHASE == 22 && IN(0)) { p0c_tables(F); GRID_BAR(); }
    for (int rep_ = 0; rep_ < (PROBE_REP_PHASE == 0 ? 2 : 1); ++rep_) if (IN(0)) { p0_prologue(F); if (BOTH(0)) GRID_BAR(); }
    for (int rep_ = 0; rep_ < (PROBE_REP_PHASE == 1 ? 2 : 1); ++rep_) if (IN(1)) { modulate_rows(F, F.x, F.HBUF, 0, DM); if (BOTH(1)) GRID_BAR(); }
    for (int rep_ = 0; rep_ < (PROBE_REP_PHASE == 2 ? 2 : 1); ++rep_) if (IN(2)) {
        pg8::Gemm g{F.HBUF, F.BTIN, NTOK, NPROJ, DM}; pg8::StaticOrder S; S.init(NTOK, NPROJ, F.G, (int)blockIdx.x);
        pg8::EpiBf16 E{F.PROJ, NPROJ};
        pg8::gemm_phase<pg8::EpiBf16, pg8::StaticOrder, true, true>(F.lds, g, S, E);
        if (BOTH(2)) GRID_BAR();
    }
    for (int rep_ = 0; rep_ < (PROBE_REP_PHASE == 3 ? 2 : 1); ++rep_) if (IN(3)) { p3a_mixer(F); GRID_BAR(); gla_scan(F); GRID_BAR(); p3c_mixer(F); if (BOTH(3)) GRID_BAR(); }
    for (int rep_ = 0; rep_ < (PROBE_REP_PHASE == 4 ? 2 : 1); ++rep_) if (IN(4)) {
        pg8::Gemm g{F.MIXIN, F.BTOUT, NTOK, DM, DM}; pg8::StaticOrder S; S.init(NTOK, DM, F.G, (int)blockIdx.x);
        pg8::EpiResid E{F.x, F.out, DM, F.MOD + 2 * DM, NMOD, SEQ / 256};
        pg8::gemm_phase<pg8::EpiResid, pg8::StaticOrder, true, true>(F.lds, g, S, E);
        if (BOTH(4)) GRID_BAR();
    }
    for (int rep_ = 0; rep_ < (PROBE_REP_PHASE == 5 ? 2 : 1); ++rep_) if (IN(5)) { p5_modulate_quant(F); if (BOTH(5)) GRID_BAR(); }
    for (int rep_ = 0; rep_ < (PROBE_REP_PHASE == 6 ? 2 : 1); ++rep_) if (IN(6)) {
        pg8::Gemm g{F.HBUF, F.BTQ, NTOK, PEER_N, DM}; pg8::StaticOrder S; S.init(NTOK, PEER_N, F.G, (int)blockIdx.x);
        pg8::EpiBf16 E{F.QPEER, PEER_N};
        pg8::gemm_phase<pg8::EpiBf16, pg8::StaticOrder, true, true>(F.lds, g, S, E);
        if (BOTH(6)) GRID_BAR();
    }
    for (int rep_ = 0; rep_ < (PROBE_REP_PHASE == 7 ? 2 : 1); ++rep_) if (IN(7)) { p7_topk(F); if (BOTH(7)) GRID_BAR(); }
    for (int rep_ = 0; rep_ < (PROBE_REP_PHASE == 8 ? 2 : 1); ++rep_) if (IN(8)) { p8a_sddmm(F); if (BOTH(8)) GRID_BAR(); }
    for (int rep_ = 0; rep_ < (PROBE_REP_PHASE == 9 ? 2 : 1); ++rep_) if (IN(9)) { p8h_gate(F); if (BOTH(9)) GRID_BAR(); }
    if (PROBE_REP_PHASE == 10 && IN(10)) { p8b_spmm<0>(F, (float*)F.PROJ); GRID_BAR(); }
    if (PROBE_REP_PHASE == 11 && IN(10)) { p8b_spmm<1>(F, (float*)F.PROJ); GRID_BAR(); }
    if (PROBE_REP_PHASE == 12 && IN(10)) { p8b_spmm<2>(F, (float*)F.PROJ); GRID_BAR(); }
    if (IN(10)) { p8b_spmm<0>(F, F.out); }
#undef IN
#undef BOTH
}

extern "C" void kernel_launch(void* const* d_in, const int* in_sizes, int n_in, void* d_out, int out_size, void* d_ws, size_t ws_size, hipStream_t stream) {
    static int grid = 0;
    if (grid == 0) {
        if (n_in != 18 || out_size != NTOK * DM || ws_size < WS_END) { fprintf(stderr, "kernel_launch: unexpected shapes (n_in %d, out %d, ws %zu); nothing launched\n", n_in, out_size, ws_size); grid = -1; return; }
        int dev = 0, cus = 0, per_cu = 0;
        if (hipGetDevice(&dev) != hipSuccess || hipDeviceGetAttribute(&cus, hipDeviceAttributeMultiprocessorCount, dev) != hipSuccess) { grid = -1; return; }
        if (hipFuncSetAttribute((const void*)mega_fwd, hipFuncAttributeMaxDynamicSharedMemorySize, LDS_BYTES) != hipSuccess) { fprintf(stderr, "kernel_launch: hipFuncSetAttribute failed\n"); grid = -1; return; }
        if (hipOccupancyMaxActiveBlocksPerMultiprocessor(&per_cu, (const void*)mega_fwd, NWAVES * 64, LDS_BYTES) != hipSuccess || per_cu < 1)
            fprintf(stderr, "kernel_launch: note: occupancy query reports %d workgroups per CU\n", per_cu);
        (void)hipGetLastError();
        grid = cus;
    }
    if (grid < 0) return;
    (void)hipMemsetAsync((char*)d_ws + WS_CTL, 0, CTL_ZERO_BYTES, stream);
    Args a{};
    for (int i = 0; i < 18; ++i) a.in[i] = (const float*)d_in[i];
    a.out = (float*)d_out; a.ws = (unsigned char*)d_ws;
    if (N_LAUNCHES == 1) { a.ph_lo = 0; a.ph_hi = NPHASE; hipLaunchKernelGGL(mega_fwd, dim3(grid), dim3(NWAVES * 64), LDS_BYTES, stream, a); }
    else for (int p = 0; p < NPHASE; ++p) { a.ph_lo = p; a.ph_hi = p + 1; hipLaunchKernelGGL(mega_fwd, dim3(grid), dim3(NWAVES * 64), LDS_BYTES, stream, a); }
}
```

```cpp
#include <hip/hip_runtime.h>
#include <cstdio>
#include <cstdint>

#ifndef MK_N_LAUNCHES
#define MK_N_LAUNCHES 1
#endif
#ifndef PROBE_REP_PHASE
#define PROBE_REP_PHASE -1
#endif

#define GAS __attribute__((address_space(1)))
#define LAS __attribute__((address_space(3)))
typedef unsigned short bf16;
typedef unsigned v4u __attribute__((ext_vector_type(4)));
typedef unsigned v2u __attribute__((ext_vector_type(2)));
typedef float f32x4 __attribute__((ext_vector_type(4)));
typedef float f32x2 __attribute__((ext_vector_type(2)));
typedef float f32x16 __attribute__((ext_vector_type(16)));
typedef short bf16x8 __attribute__((ext_vector_type(8)));
using bf16x2 = __attribute__((ext_vector_type(2))) __bf16;

namespace pg8 {
#define PG8_LAS __attribute__((address_space(3)))
typedef unsigned short bf16_t;
typedef short bf16x8 __attribute__((ext_vector_type(8)));
typedef float f32x4 __attribute__((ext_vector_type(4)));
typedef unsigned u32x4 __attribute__((ext_vector_type(4)));
constexpr int BM = 256, BK = 64, HALF = 128, HTB = HALF * BK * 2, STAGE_BYTES = 8 * HTB, NXCD = 8, WGM = 8;

__host__ __device__ __forceinline__ int lds_byte(int r, int c) { const int st = (r >> 4) * 2 + (c >> 5), rr = r & 15, cc = c & 31, ob = rr * 64 + cc * 2; return st * 1024 + (ob ^ (((ob >> 9) & 1) << 5)); }
__host__ __device__ __forceinline__ void stage_rc(int b, int& R, int& C) { const int st = b / 1024, sb = b % 1024, swz = sb ^ (((sb >> 9) & 1) << 5); R = (st >> 1) * 16 + swz / 64; C = (st & 1) * 32 + (swz % 64) / 2; }
__host__ __device__ __forceinline__ int perm32(int rho) { const int n = rho >> 4, i = rho & 15; return 8 * (i >> 2) + 4 * n + (i & 3); }

struct Unit { int pm, pn; };
struct Gemm { const bf16_t* A; const bf16_t* Bt; int M, N, K; };

struct StaticOrder {
    int nM, nN, nwg, G, c;
    __host__ __device__ void init(int M, int N, int G_, int c_) { nM = M / BM; nN = N / BM; nwg = nM * nN; G = G_; c = c_; }
    __host__ __device__ bool next(int i, Unit& u) const {
        const long L = (long)i * G + c; if (L >= nwg) return false;
        int wgid = (int)L; { const int q = nwg / NXCD, r = nwg % NXCD, xcd = wgid % NXCD, off = wgid / NXCD; wgid = (xcd < r ? xcd * (q + 1) : r * (q + 1) + (xcd - r) * q) + off; }
        const int nig = WGM * nN, gid = wgid / nig, fm = gid * WGM, gsz = (nM - fm) < WGM ? (nM - fm) : WGM;
        u.pm = fm + ((wgid % nig) % gsz); u.pn = (wgid % nig) / gsz; return true;
    }
    __device__ __forceinline__ void a_ready(const Unit&) const {}
    __device__ __forceinline__ void done(const Unit&) const {}
};

__device__ __forceinline__ unsigned cvt_pk_bf16(float lo, float hi) { unsigned r; asm volatile("v_cvt_pk_bf16_f32 %0, %1, %2" : "=v"(r) : "v"(lo), "v"(hi)); return r; }

struct EpiBf16 {
    static constexpr bool PERM = true, AFTER_DRAIN = false;
    bf16_t* O; int ldc;
    __device__ __forceinline__ void operator()(const f32x4 (&acc)[2][2][4][2], const Unit& u, int wr, int wc, int fr, int fq) const {
        const int row0 = u.pm * BM + wr * 64 + fr; const int col0 = u.pn * BM + wc * 32 + 8 * fq;
#pragma unroll
        for (int ai = 0; ai < 2; ++ai)
#pragma unroll
            for (int m = 0; m < 4; ++m) { bf16_t* rowp = O + (size_t)(row0 + ai * HALF + m * 16) * ldc + col0;
#pragma unroll
                for (int bj = 0; bj < 2; ++bj) { const f32x4 v0 = acc[ai][bj][m][0], v1 = acc[ai][bj][m][1];
                    u32x4 w; w.x = cvt_pk_bf16(v0[0], v0[1]); w.y = cvt_pk_bf16(v0[2], v0[3]); w.z = cvt_pk_bf16(v1[0], v1[1]); w.w = cvt_pk_bf16(v1[2], v1[3]);
                    *(u32x4*)(rowp + bj * HALF) = w; } }
    }
};
struct EpiResid {
    static constexpr bool PERM = false, AFTER_DRAIN = false;
    const float* base; float* out; int ldc; const float* gate; int gate_stride; int tiles_per_batch;
    __device__ __forceinline__ void operator()(const f32x4 (&acc)[2][2][4][2], const Unit& u, int wr, int wc, int fr, int fq) const {
        const int row0 = u.pm * BM + wr * 64 + fr, col0 = u.pn * BM + wc * 32 + 4 * fq;
        const float* gp = gate + (size_t)(u.pm / tiles_per_batch) * gate_stride + col0;
        f32x4 gv[2][2];
#pragma unroll
        for (int bj = 0; bj < 2; ++bj)
#pragma unroll
            for (int n = 0; n < 2; ++n) gv[bj][n] = *(const f32x4*)(gp + bj * HALF + n * 16);
#pragma unroll
        for (int ai = 0; ai < 2; ++ai)
#pragma unroll
            for (int m = 0; m < 4; ++m) { const size_t off = (size_t)(row0 + ai * HALF + m * 16) * ldc + col0;
#pragma unroll
                for (int bj = 0; bj < 2; ++bj)
#pragma unroll
                    for (int n = 0; n < 2; ++n) { const f32x4 bs = *(const f32x4*)(base + off + bj * HALF + n * 16);
                        *(f32x4*)(out + off + bj * HALF + n * 16) = bs + gv[bj][n] * acc[ai][bj][m][n]; } }
    }
};

template <class Epi, class Sched, bool ALIGN_EPI = false, bool SP2 = false>
__device__ __forceinline__ void gemm_phase(PG8_LAS unsigned char* lds, const Gemm g, const Sched& S, const Epi& E) {
    const int tid = threadIdx.x, wid = __builtin_amdgcn_readfirstlane(tid >> 6), lane = tid & 63, wr = wid >> 2, wc = wid & 3, fr = lane & 15, fq = lane >> 4;
    const int K = g.K, nt = K / BK;
    unsigned voffA[2], voffB[2];
#pragma unroll
    for (int i = 0; i < 2; ++i) { int R, C; stage_rc(tid * 16 + i * 8192, R, C); const int Rb = Epi::PERM ? ((R & ~31) + perm32(R & 31)) : R;
        voffA[i] = (unsigned)(R * K + C) * 2u; voffB[i] = (unsigned)(Rb * K + C) * 2u; }
    const size_t kstep = (size_t)(BK * 2);
    const size_t hstep = (size_t)HALF * K * 2;
    const size_t tstep = 2 * hstep;
    const unsigned ldsw = (unsigned)wid * 1024u;
    const int aoff = lds_byte(wr * 64 + fr, fq * 8), boff = lds_byte(wc * 32 + fr, fq * 8);
#define PG8_SA(b, h) (((b) * 2 + (h)) * HTB)
#define PG8_SB(b, h) ((4 + (b) * 2 + (h)) * HTB)
#define PG8_STAGE(bufoff, gbase, voff) do { const unsigned long long _g = (unsigned long long)(gbase); const unsigned _lo = __builtin_amdgcn_readfirstlane((unsigned)_g), _hi = __builtin_amdgcn_readfirstlane((unsigned)(_g >> 32)); \
        const char* _gb = (const char*)(((unsigned long long)_hi << 32) | _lo); _Pragma("unroll") for (int _i = 0; _i < 2; ++_i) \
        __builtin_amdgcn_global_load_lds((const unsigned*)(_gb + (size_t)_i * (size_t)(64 * K * 2) + (voff)[0]), (PG8_LAS unsigned*)(lds + (bufoff) + ldsw + _i * 8192), 16, 0, 0); } while (0)
#define PG8_LDA(dst, b, h) do { _Pragma("unroll") for (int m = 0; m < 4; ++m) _Pragma("unroll") for (int k = 0; k < 2; ++k) dst[m][k] = *(const PG8_LAS bf16x8*)(lds + PG8_SA(b, h) + aoff + m * 2048 + k * 1024); } while (0)
#define PG8_LDB(dst, b, h) do { _Pragma("unroll") for (int n = 0; n < 2; ++n) _Pragma("unroll") for (int k = 0; k < 2; ++k) dst[n][k] = *(const PG8_LAS bf16x8*)(lds + PG8_SB(b, h) + boff + n * 2048 + k * 1024); } while (0)
#define PG8_MMA(ai, bj, At, Bt) do { __builtin_amdgcn_s_setprio(1); _Pragma("unroll") for (int m = 0; m < 4; ++m) _Pragma("unroll") for (int n = 0; n < 2; ++n) _Pragma("unroll") for (int k = 0; k < 2; ++k) \
        acc[ai][bj][m][n] = __builtin_amdgcn_mfma_f32_16x16x32_bf16(Bt[n][k], At[m][k], acc[ai][bj][m][n], 0, 0, 0); __builtin_amdgcn_s_setprio(0); } while (0)
#define PG8_WAIT_V(n) asm volatile("s_waitcnt vmcnt(" #n ")" ::: "memory")
#define PG8_WAIT_L(n) asm volatile("s_waitcnt lgkmcnt(" #n ")" ::: "memory")
#define PG8_BAR __builtin_amdgcn_s_barrier()
#define PG8_SCHED __builtin_amdgcn_sched_barrier(0)
    Unit cur, nxt; int ui = 0;
    if (!S.next(0, cur)) return;
    f32x4 acc[2][2][4][2];
#pragma unroll
    for (int a = 0; a < 2; ++a)
#pragma unroll
        for (int b = 0; b < 2; ++b)
#pragma unroll
            for (int m = 0; m < 4; ++m)
#pragma unroll
                for (int n = 0; n < 2; ++n) acc[a][b][m][n] = (f32x4){0.f, 0.f, 0.f, 0.f};
    bf16x8 At[4][2], B0[2][2], B1[2][2];
    const char* cA = (const char*)g.A + (size_t)cur.pm * tstep; const char* cB = (const char*)g.Bt + (size_t)cur.pn * tstep;
    S.a_ready(cur);
    if constexpr (SP2) {
        PG8_STAGE(PG8_SB(0, 0), cB, voffB); PG8_STAGE(PG8_SB(0, 1), cB + hstep, voffB); PG8_STAGE(PG8_SA(0, 0), cA, voffA); PG8_STAGE(PG8_SA(0, 1), cA + hstep, voffA);
        if (wr == 1) PG8_BAR;
        PG8_WAIT_V(2); PG8_BAR;
        PG8_STAGE(PG8_SB(1, 0), cB + kstep, voffB); PG8_STAGE(PG8_SA(1, 0), cA + kstep, voffA); PG8_STAGE(PG8_SB(1, 1), cB + hstep + kstep, voffB);
        PG8_WAIT_V(6); PG8_BAR;
    } else {
        PG8_STAGE(PG8_SB(0, 0), cB, voffB); PG8_STAGE(PG8_SA(0, 0), cA, voffA); PG8_STAGE(PG8_SB(0, 1), cB + hstep, voffB); PG8_STAGE(PG8_SA(0, 1), cA + hstep, voffA);
        if (wr == 1) PG8_BAR;
        PG8_WAIT_V(4); PG8_BAR;
        PG8_STAGE(PG8_SB(1, 0), cB + kstep, voffB); PG8_STAGE(PG8_SA(1, 0), cA + kstep, voffA); PG8_STAGE(PG8_SB(1, 1), cB + hstep + kstep, voffB);
        PG8_WAIT_V(6); PG8_BAR;
    }
    for (;;) {
        const bool has_next = S.next(ui + 1, nxt);
        const char* nA = has_next ? (const char*)g.A + (size_t)nxt.pm * tstep : cA; const char* nB = has_next ? (const char*)g.Bt + (size_t)nxt.pn * tstep : cB;
        for (int t = 0; t < nt; t += 2) {
            const bool last = (t == nt - 2);
            const char* a1 = cA + (size_t)(t + 1) * kstep;
            const char* a2 = last ? nA : cA + (size_t)(t + 2) * kstep; const char* b2 = last ? nB : cB + (size_t)(t + 2) * kstep;
            const char* a3 = a2 + kstep; const char* b3 = b2 + kstep;
            if (last && has_next) S.a_ready(nxt);
            if constexpr (SP2) {
            PG8_LDB(B0, 0, 0); PG8_LDB(B1, 0, 1); PG8_SCHED; PG8_LDA(At, 0, 0); PG8_STAGE(PG8_SA(1, 1), a1 + hstep, voffA);
            PG8_WAIT_V(8); PG8_WAIT_L(0); PG8_BAR; PG8_MMA(0, 0, At, B0); PG8_MMA(0, 1, At, B1); PG8_BAR; PG8_SCHED;
            PG8_LDA(At, 0, 1); PG8_STAGE(PG8_SB(0, 0), b2, voffB); PG8_STAGE(PG8_SB(0, 1), b2 + hstep, voffB); PG8_STAGE(PG8_SA(0, 0), a2, voffA);
            PG8_WAIT_V(8); PG8_WAIT_L(0); PG8_BAR; PG8_MMA(1, 0, At, B0); PG8_MMA(1, 1, At, B1); PG8_BAR; PG8_SCHED;
            PG8_LDB(B0, 1, 0); PG8_LDB(B1, 1, 1); PG8_SCHED; PG8_LDA(At, 1, 0); PG8_STAGE(PG8_SA(0, 1), a2 + hstep, voffA);
            PG8_WAIT_V(8); PG8_WAIT_L(0); PG8_BAR; PG8_MMA(0, 0, At, B0); PG8_MMA(0, 1, At, B1); PG8_BAR; PG8_SCHED;
            PG8_LDA(At, 1, 1); PG8_STAGE(PG8_SB(1, 0), b3, voffB); PG8_STAGE(PG8_SB(1, 1), b3 + hstep, voffB); PG8_STAGE(PG8_SA(1, 0), a3, voffA);
            PG8_WAIT_V(8); PG8_WAIT_L(0); PG8_BAR; PG8_MMA(1, 0, At, B0); PG8_MMA(1, 1, At, B1); PG8_BAR; PG8_SCHED;
            } else {
            PG8_LDB(B0, 0, 0); PG8_SCHED; PG8_LDA(At, 0, 0); PG8_STAGE(PG8_SA(1, 1), a1 + hstep, voffA);
            PG8_WAIT_L(8); PG8_BAR; PG8_WAIT_L(0); PG8_MMA(0, 0, At, B0); PG8_BAR; PG8_SCHED;
            PG8_LDB(B1, 0, 1); PG8_STAGE(PG8_SB(0, 0), b2, voffB);
            PG8_BAR; PG8_WAIT_L(0); PG8_MMA(0, 1, At, B1); PG8_BAR;
            PG8_LDA(At, 0, 1); PG8_STAGE(PG8_SA(0, 0), a2, voffA);
            PG8_BAR; PG8_WAIT_L(0); PG8_MMA(1, 0, At, B0); PG8_BAR; PG8_SCHED;
            PG8_STAGE(PG8_SB(0, 1), b2 + hstep, voffB);
            PG8_WAIT_V(6); PG8_BAR; PG8_MMA(1, 1, At, B1); PG8_BAR;
            PG8_LDB(B0, 1, 0); PG8_SCHED; PG8_LDA(At, 1, 0); PG8_STAGE(PG8_SA(0, 1), a2 + hstep, voffA);
            PG8_WAIT_L(8); PG8_BAR; PG8_WAIT_L(0); PG8_MMA(0, 0, At, B0); PG8_BAR; PG8_SCHED;
            PG8_LDB(B1, 1, 1); PG8_STAGE(PG8_SB(1, 0), b3, voffB);
            PG8_BAR; PG8_WAIT_L(0); PG8_MMA(0, 1, At, B1); PG8_BAR;
            PG8_LDA(At, 1, 1); PG8_STAGE(PG8_SA(1, 0), a3, voffA);
            PG8_BAR; PG8_WAIT_L(0); PG8_MMA(1, 0, At, B0); PG8_BAR; PG8_SCHED;
            PG8_STAGE(PG8_SB(1, 1), b3 + hstep, voffB);
            PG8_WAIT_V(6); PG8_BAR; PG8_MMA(1, 1, At, B1); PG8_BAR;
            }
        }
        if constexpr (ALIGN_EPI) { if (wr == 0) PG8_BAR; }
        if constexpr (!Epi::AFTER_DRAIN) { E(acc, cur, wr, wc, fr, fq); S.done(cur); }
        if (!has_next) break;
#pragma unroll
        for (int a = 0; a < 2; ++a)
#pragma unroll
            for (int b = 0; b < 2; ++b)
#pragma unroll
                for (int m = 0; m < 4; ++m)
#pragma unroll
                    for (int n = 0; n < 2; ++n) acc[a][b][m][n] = (f32x4){0.f, 0.f, 0.f, 0.f};
        cur = nxt; cA = nA; cB = nB; ++ui;
        if constexpr (ALIGN_EPI) { if (wr == 1) PG8_BAR; }
    }
    PG8_WAIT_V(0);
    if constexpr (!ALIGN_EPI) { if (wr == 0) PG8_BAR; }
    PG8_BAR;
#undef PG8_SA
#undef PG8_SB
#undef PG8_STAGE
#undef PG8_LDA
#undef PG8_LDB
#undef PG8_MMA
#undef PG8_WAIT_V
#undef PG8_WAIT_L
#undef PG8_BAR
#undef PG8_SCHED
}
}

constexpr int NWAVES = 8;
constexpr int NPHASE = 11;
constexpr int N_LAUNCHES = MK_N_LAUNCHES;
constexpr int BATCH = 4, SEQ = 2048, DM = 4096, NTOK = BATCH * SEQ;
constexpr int NMOD = 6 * DM;
constexpr int IN_WIDTH = 8720;
constexpr int NPROJ = 8960;
constexpr int C_GQ = 0, C_GK = 1024, C_GV = 2048, C_GG = 4096, C_SQ = 6144, C_SK = 8192, C_SV = 8448, C_GA = 8704;
constexpr int NEXP = 16384, PEER_N = 2048;
constexpr float EPS = 1e-6f;

constexpr size_t MiB = 1u << 20;
constexpr size_t WS_CTL = 0, CTL_ZERO_BYTES = 1 * MiB;
constexpr size_t WS_MOD = 1 * MiB;
constexpr size_t WS_ROPE = 2 * MiB;
constexpr size_t WS_BTIN = 4 * MiB;
constexpr size_t WS_BTOUT = 74 * MiB;
constexpr size_t WS_BTQ = 106 * MiB;
constexpr size_t WS_HBUF = 122 * MiB;
constexpr size_t WS_PROJ = 186 * MiB;
constexpr size_t WS_MIXIN = 326 * MiB;
constexpr size_t WS_QPEER = 390 * MiB;
constexpr size_t WS_IDX = 422 * MiB;
constexpr size_t WS_GATE = 426 * MiB;
constexpr size_t WS_DC8 = 430 * MiB;
constexpr size_t WS_UC8 = 494 * MiB;
constexpr size_t WS_YC8 = 558 * MiB;
constexpr size_t WS_ZP = 590 * MiB;
constexpr size_t WS_EIDX = 654 * MiB;
constexpr size_t WS_GATEQ = 658 * MiB;
constexpr size_t WS_HE = 662 * MiB;
constexpr size_t WS_DSC = 666 * MiB;
constexpr size_t WS_YSC = 667 * MiB;
constexpr size_t WS_EIDX16 = 668 * MiB;
constexpr size_t WS_END = 670 * MiB;
constexpr int CW_BAR = 4096;

constexpr int RING_BYTES = 131072;
constexpr int LDSCTL_OFF = RING_BYTES, MISC_OFF = LDSCTL_OFF + 320;
constexpr int LDS_BYTES = 155648;

#define LDS_WAIT() asm volatile("s_waitcnt lgkmcnt(0)" ::: "memory")
#define VM_WAIT() asm volatile("s_waitcnt vmcnt(0)" ::: "memory")
__device__ __forceinline__ unsigned f2bf(float f) { unsigned u = __builtin_bit_cast(unsigned, f); return (u + 0x7fffu + ((u >> 16) & 1u)) >> 16; }
__device__ __forceinline__ unsigned pk2(float lo, float hi) { return f2bf(lo) | (f2bf(hi) << 16); }
__device__ __forceinline__ float bflo(unsigned w) { return __builtin_bit_cast(float, w << 16); }
__device__ __forceinline__ float bfhi(unsigned w) { return __builtin_bit_cast(float, w & 0xffff0000u); }
__device__ __forceinline__ float dot2_bf16(unsigned w, unsigned x, float acc) { return __builtin_amdgcn_fdot2_f32_bf16(__builtin_bit_cast(bf16x2, w), __builtin_bit_cast(bf16x2, x), acc, false); }
__device__ __forceinline__ f32x16 mfma32(bf16x8 a, bf16x8 b, f32x16 c) { return __builtin_amdgcn_mfma_f32_32x32x16_bf16(a, b, c, 0, 0, 0); }
__device__ __forceinline__ f32x4 mfma16(bf16x8 a, bf16x8 b, f32x4 c) { return __builtin_amdgcn_mfma_f32_16x16x32_bf16(a, b, c, 0, 0, 0); }
__device__ __forceinline__ bf16x8 mk8(unsigned a, unsigned b, unsigned c, unsigned d) { v4u t = {a, b, c, d}; return __builtin_bit_cast(bf16x8, t); }
__device__ __forceinline__ float silu_f(float x) { return x / (1.0f + __expf(-x)); }

#define XB_TMO      128
#define XB_XCNT(j)  (256  + 64 * (j))
#define XB_XSUB(j)  (1280 + 64 * (j))
#define XB_XGEN(j)  (2304 + 64 * (j))
#define XB_TOP      3328
#define XB_TOPGEN   3392
#define XCD_BAR_WORDS 3456
#define XB_SPIN_CAP (1u << 18)
__device__ __forceinline__ unsigned xb_ld(unsigned* p)              { return __hip_atomic_load(p, __ATOMIC_RELAXED, __HIP_MEMORY_SCOPE_AGENT); }
__device__ __forceinline__ unsigned xb_add(unsigned* p, unsigned v) { return __hip_atomic_fetch_add(p, v, __ATOMIC_RELAXED, __HIP_MEMORY_SCOPE_AGENT); }
__device__ __forceinline__ unsigned xb_xcc_id() { return (unsigned)__builtin_amdgcn_s_getreg((3 << 11) | 20) & 0xFu; }
#define XB_SPIN(cond, bar) do { unsigned _sp = 0; while (cond) { __builtin_amdgcn_s_sleep(1); \
    if ((++_sp & 255u) == 0u) { if (xb_ld(&(bar)[XB_TMO])) break; if (_sp > XB_SPIN_CAP) { atomicAdd(&(bar)[XB_TMO], 1u); break; } } } } while (0)
struct XcdBarrier { unsigned* bar; unsigned x; volatile LAS unsigned* st; };
__device__ __forceinline__ XcdBarrier xcd_barrier_post(unsigned* bar, volatile LAS unsigned* st) {
    XcdBarrier b; b.bar = bar; b.x = xb_xcc_id(); b.st = st;
    if (threadIdx.x == 0) (void)xb_add(&bar[XB_XCNT(b.x)], 1u);
    return b;
}
__device__ __forceinline__ void xcd_barrier_complete(unsigned* bar, unsigned x, unsigned& nloc, unsigned& nx) {
    const unsigned G = gridDim.x * gridDim.y * gridDim.z;
    unsigned sum, cnt, mine, sp = 0u;
    for (;;) {
        sum = 0u; cnt = 0u; mine = 0u;
#pragma unroll
        for (unsigned j = 0; j < 16; ++j) { const unsigned c = xb_ld(&bar[XB_XCNT(j)]); sum += c; cnt += (c > 0u) ? 1u : 0u; mine = (j == x) ? c : mine; }
        if (sum == G) break;
        __builtin_amdgcn_s_sleep(1);
        if ((++sp & 255u) == 0u) { if (xb_ld(&bar[XB_TMO])) break; if (sp > XB_SPIN_CAP) { atomicAdd(&bar[XB_TMO], 1u); break; } }
    }
    nloc = mine > 0u ? mine : 1u; nx = cnt > 0u ? cnt : 1u;
}
__device__ __forceinline__ void xcd_barrier(const XcdBarrier& b) {
    asm volatile("s_waitcnt vmcnt(0)" ::: "memory");
    __syncthreads();
    if (threadIdx.x == 0) {
        unsigned* bar = b.bar;
        __builtin_amdgcn_s_waitcnt(0);
        unsigned nloc = b.st[0], nx = b.st[1];
        if (nloc == 0u) { xcd_barrier_complete(bar, b.x, nloc, nx); b.st[0] = nloc; b.st[1] = nx; }
        const unsigned old = xb_add(&bar[XB_XSUB(b.x)], 1u);
        const unsigned gen = old / nloc;
        if (old + 1u == (gen + 1u) * nloc) {
            __builtin_amdgcn_fence(__ATOMIC_RELEASE, "agent");
            asm volatile("s_waitcnt vmcnt(0)" ::: "memory");
            const unsigned og = xb_add(&bar[XB_TOP], 1u);
            const unsigned tg = og / nx;
            if (og + 1u == (tg + 1u) * nx) xb_add(&bar[XB_TOPGEN], 1u);
            else XB_SPIN(xb_ld(&bar[XB_TOPGEN]) == tg, bar);
            __builtin_amdgcn_fence(__ATOMIC_ACQUIRE, "agent");
            xb_add(&bar[XB_XGEN(b.x)], 1u);
            asm volatile("s_waitcnt vmcnt(0)" ::: "memory");
        } else {
            XB_SPIN(xb_ld(&bar[XB_XGEN(b.x)]) == gen, bar);
            __builtin_amdgcn_fence(__ATOMIC_ACQUIRE, "agent");
            asm volatile("s_waitcnt vmcnt(0)" ::: "memory");
        }
    }
    __syncthreads();
}

struct Frame {
    LAS unsigned char* lds;
    volatile LAS unsigned* MISC;
    unsigned* ctl;
    int tid, lane, wave, vcu, G;
    const float *x, *c, *w_ada, *b_ada, *w_in, *w_gate_up, *b_gla_gate, *gla_out_norm, *swa_q_norm, *swa_k_norm, *swa_sinks, *swa_out_norm, *w_out, *w_peer_q, *keys1, *keys2, *edown, *eup;
    float* out;
    float *MOD, *ROPE;
    bf16 *BTIN, *BTOUT, *BTQ, *HBUF, *PROJ, *MIXIN, *QPEER;
    unsigned char *DC8, *UC8, *YC8;
    int* ZP; unsigned *EIDX, *HE, *EIDX16; float *GATEQ, *DSC, *YSC;
    bf16 *GQT, *GST; float *GUT, *GG;
};

__device__ __forceinline__ float wave_sum(float v) {
#pragma unroll
    for (int o = 1; o < 64; o <<= 1) v += __shfl_xor(v, o);
    return v;
}
__device__ __forceinline__ float wave_max(float v) {
#pragma unroll
    for (int o = 1; o < 64; o <<= 1) v = fmaxf(v, __shfl_xor(v, o));
    return v;
}
__device__ __forceinline__ unsigned pack4i(float a, float b, float c, float d) {
    const int q0 = (int)__builtin_rintf(a), q1 = (int)__builtin_rintf(b), q2 = (int)__builtin_rintf(c), q3 = (int)__builtin_rintf(d);
    return (unsigned)(q0 & 255) | ((unsigned)(q1 & 255) << 8) | ((unsigned)(q2 & 255) << 16) | ((unsigned)q3 << 24);
}

__device__ __forceinline__ void p0_tr_item(const float* W, int ldw, int sc0, int ncols, bf16* WT, int dr0, int k0, LAS float* scr, int lane) {
    const int c4 = (lane & 7) * 4, kr = lane >> 3;
    f32x4 v[8];
#pragma unroll
    for (int i = 0; i < 8; ++i) v[i] = (c4 < ncols) ? *(const GAS f32x4*)(W + (size_t)(k0 + kr + 8 * i) * ldw + sc0 + c4) : (f32x4){0.f, 0.f, 0.f, 0.f};
#pragma unroll
    for (int i = 0; i < 8; ++i) { LAS float* d = scr + (kr + 8 * i) * 33 + c4; d[0] = v[i][0]; d[1] = v[i][1]; d[2] = v[i][2]; d[3] = v[i][3]; }
    LDS_WAIT(); asm volatile("" ::: "memory");
    const int c8 = lane & 7;
#pragma unroll
    for (int j = 0; j < 4; ++j) { const int n = (lane >> 3) + 8 * j; const LAS float* s = scr + (8 * c8) * 33 + n;
        v4u o; o.x = pk2(s[0 * 33], s[1 * 33]); o.y = pk2(s[2 * 33], s[3 * 33]); o.z = pk2(s[4 * 33], s[5 * 33]); o.w = pk2(s[6 * 33], s[7 * 33]);
        if (n < ncols) *(GAS v4u*)(WT + (size_t)(dr0 + n) * DM + k0 + 8 * c8) = o; }
    LDS_WAIT(); asm volatile("" ::: "memory");
}

__device__ __forceinline__ void p0a_ada(Frame& F) {
    const int tid = F.tid, lane = F.lane, wave = F.wave;
    {
        LAS f32x4* cact = (LAS f32x4*)F.lds;
        LAS float* red = (LAS float*)(F.lds + 65536);
        for (int k = tid; k < DM; k += 512) { f32x4 v;
#pragma unroll
            for (int b = 0; b < 4; ++b) { const float cv = F.c[b * DM + k]; v[b] = cv / (1.0f + expf(-cv)); }
            cact[k] = v; }
        __syncthreads();
        for (int slice = F.vcu; slice < 256; slice += F.G) {
            const int col0 = slice * 96, sub = lane / 24, cl = lane - sub * 24;
            f32x4 acc[4];
#pragma unroll
            for (int b = 0; b < 4; ++b) acc[b] = (f32x4){0.f, 0.f, 0.f, 0.f};
            if (lane < 48) {
                const float* wp = F.w_ada + col0 + 4 * cl;
#pragma unroll 16
                for (int k = wave * 2 + sub; k < DM; k += 16) {
                    const f32x4 w = *(const GAS f32x4*)(wp + (size_t)k * NMOD); const f32x4 cv = cact[k];
#pragma unroll
                    for (int b = 0; b < 4; ++b) acc[b] += w * cv[b];
                }
#pragma unroll
                for (int b = 0; b < 4; ++b) *(LAS f32x4*)(red + (wave * 48 + lane) * 16 + 4 * b) = acc[b];
            }
            __syncthreads();
            if (tid < 384) { const int b = tid / 96, col = tid - b * 96, cl2 = col >> 2, e = col & 3; float s = 0.f;
#pragma unroll
                for (int w = 0; w < 8; ++w) { s += red[(w * 48 + cl2) * 16 + 4 * b + e]; s += red[(w * 48 + 24 + cl2) * 16 + 4 * b + e]; }
                F.MOD[b * NMOD + col0 + col] = s + F.b_ada[col0 + col]; }
            __syncthreads();
        }
    }
}
__device__ __forceinline__ void p0b_weights(Frame& F) {
    const int tid = F.tid, lane = F.lane, wave = F.wave;
    const int gw = F.vcu * NWAVES + wave, NGW = F.G * NWAVES;
    {
        LAS float* scr = (LAS float*)(F.lds + wave * 16384);
        constexpr int NB0 = 192, NB1 = 80, NB2 = 1, NB3 = 128, NB4 = 64, NBT = NB0 + NB1 + NB2 + NB3 + NB4;
        for (int it = gw; it < NBT * 64; it += NGW) {
            int nb = it >> 6; const int k0 = (it & 63) * 64;
            if (nb < NB0) { p0_tr_item(F.w_in, IN_WIDTH, 32 * nb, 32, F.BTIN, 32 * nb, k0, scr, lane); continue; } nb -= NB0;
            if (nb < NB1) { p0_tr_item(F.w_in, IN_WIDTH, 6160 + 32 * nb, 32, F.BTIN, 6144 + 32 * nb, k0, scr, lane); continue; } nb -= NB1;
            if (nb < NB2) { p0_tr_item(F.w_in, IN_WIDTH, 6144, 16, F.BTIN, C_GA, k0, scr, lane); continue; } nb -= NB2;
            if (nb < NB3) { p0_tr_item(F.w_out, DM, 32 * nb, 32, F.BTOUT, 32 * nb, k0, scr, lane); continue; } nb -= NB3;
            p0_tr_item(F.w_peer_q, PEER_N, 32 * nb, 32, F.BTQ, 32 * nb, k0, scr, lane);
        }
        const size_t gt = (size_t)F.vcu * 512 + tid, NT = (size_t)F.G * 512;
        GAS v4u* z = (GAS v4u*)(F.BTIN + (size_t)(C_GA + 16) * DM);
        for (size_t i = gt; i < (size_t)240 * DM / 8; i += NT) z[i] = (v4u){0u, 0u, 0u, 0u};
        for (size_t e = gt; e < (size_t)SEQ * 32; e += NT) { const int pos = (int)(e >> 5), i = (int)(e & 31);
            const float inv = exp2f(-(float)i * (13.287712379549449f / 32.0f));
            const float ang = (float)pos * inv;
            const double rev = (double)ang * 0.15915494309189535; const float fr = (float)(rev - floor(rev));
            F.ROPE[e] = __builtin_amdgcn_cosf(fr); F.ROPE[SEQ * 32 + e] = __builtin_amdgcn_sinf(fr); }
    }
}
__device__ __forceinline__ void p0c_tables(Frame& F) {
    const int tid = F.tid, lane = F.lane, wave = F.wave;
    {
        __syncthreads();
        for (int tb = 0; tb < 2; ++tb) {
            const float* srcT = tb ? F.eup : F.edown; unsigned char* dstT = tb ? F.UC8 : F.DC8;
            for (int e0 = F.vcu * 32; e0 < NEXP; e0 += F.G * 32) {
#pragma unroll 1
                for (int r = 0; r < 4; ++r) {
                    const int el = wave * 4 + r, e = e0 + el;
                    const GAS f32x4* src = (const GAS f32x4*)(srcT + (size_t)e * DM);
                    f32x4 a[8], b[8];
#pragma unroll
                    for (int j = 0; j < 8; ++j) { a[j] = src[2 * (lane + 64 * j)]; b[j] = src[2 * (lane + 64 * j) + 1]; }
                    if (tb == 0) {
                        float m = 0.f;
#pragma unroll
                        for (int j = 0; j < 8; ++j)
#pragma unroll
                            for (int q = 0; q < 4; ++q) m = fmaxf(m, fmaxf(fabsf(a[j][q]), fabsf(b[j][q])));
                        m = wave_max(m);
                        const float inv = m > 0.f ? 127.0f / m : 0.f;
                        if (lane == 0) F.DSC[e] = m * (1.0f / 127.0f);
#pragma unroll
                        for (int j = 0; j < 8; ++j) { v2u o; o.x = pack4i(a[j][0] * inv, a[j][1] * inv, a[j][2] * inv, a[j][3] * inv); o.y = pack4i(b[j][0] * inv, b[j][1] * inv, b[j][2] * inv, b[j][3] * inv);
                            *(LAS v2u*)(F.lds + el * 4096 + ((lane + 64 * j + el) & 511) * 8) = o; }
                    } else {
#pragma unroll
                        for (int j = 0; j < 8; ++j) { int w0 = __builtin_amdgcn_cvt_pk_fp8_f32(a[j][0], a[j][1], 0, false); w0 = __builtin_amdgcn_cvt_pk_fp8_f32(a[j][2], a[j][3], w0, true);
                            int w1 = __builtin_amdgcn_cvt_pk_fp8_f32(b[j][0], b[j][1], 0, false); w1 = __builtin_amdgcn_cvt_pk_fp8_f32(b[j][2], b[j][3], w1, true);
                            v2u o; o.x = (unsigned)w0; o.y = (unsigned)w1;
                            *(LAS v2u*)(F.lds + el * 4096 + ((lane + 64 * j + el) & 511) * 8) = o; }
                    }
                }
                __syncthreads();
                { const int el = tid & 31;
#pragma unroll 4
                  for (int it = 0; it < 32; ++it) { const int sc = it * 16 + (tid >> 5);
                      const v2u o = *(const LAS v2u*)(F.lds + el * 4096 + ((sc + el) & 511) * 8);
                      *(GAS v2u*)(dstT + ((size_t)sc * NEXP + e0 + el) * 8) = o; } }
                __syncthreads();
            }
        }
    }
}
__device__ __forceinline__ void p0_prologue(Frame& F) { p0a_ada(F); p0b_weights(F); p0c_tables(F); }

__device__ __forceinline__ void modulate_rows(Frame& F, const float* src, bf16* dst, int sh_off, int sc_off) {
    const int gw = F.vcu * NWAVES + F.wave, NGW = F.G * NWAVES, lane = F.lane;
    for (int m = gw; m < NTOK; m += NGW) {
        const int b = m >> 11;
        const GAS f32x4* xr = (const GAS f32x4*)(src + (size_t)m * DM) + lane;
        f32x4 v[16]; float s = 0.f;
#pragma unroll
        for (int j = 0; j < 16; ++j) { v[j] = xr[64 * j]; s += (v[j].x * v[j].x + v[j].y * v[j].y) + (v[j].z * v[j].z + v[j].w * v[j].w); }
        const float rstd = 1.0f / sqrtf(wave_sum(s) * (1.0f / DM) + EPS);
        const GAS f32x4* shp = (const GAS f32x4*)(F.MOD + b * NMOD + sh_off) + lane;
        const GAS f32x4* scp = (const GAS f32x4*)(F.MOD + b * NMOD + sc_off) + lane;
        GAS v2u* o8 = (GAS v2u*)(dst + (size_t)m * DM) + lane;
#pragma unroll
        for (int j = 0; j < 16; ++j) { const f32x4 sh = shp[64 * j], sc = scp[64 * j]; const f32x4 y = v[j] * rstd * (sc + 1.0f) + sh;
            v2u o; o.x = pk2(y.x, y.y); o.y = pk2(y.z, y.w); o8[64 * j] = o; }
    }
}


__device__ __forceinline__ void p5_modulate_quant(Frame& F) {
    const int gw = F.vcu * NWAVES + F.wave, NGW = F.G * NWAVES, lane = F.lane;
    for (int m = gw; m < NTOK; m += NGW) {
        const int b = m >> 11;
        const GAS f32x4* xr = (const GAS f32x4*)(F.out + (size_t)m * DM);
        f32x4 a[8], c[8]; float s = 0.f;
#pragma unroll
        for (int j = 0; j < 8; ++j) { a[j] = xr[2 * (lane + 64 * j)]; c[j] = xr[2 * (lane + 64 * j) + 1];
            s += (a[j].x * a[j].x + a[j].y * a[j].y) + (a[j].z * a[j].z + a[j].w * a[j].w) + (c[j].x * c[j].x + c[j].y * c[j].y) + (c[j].z * c[j].z + c[j].w * c[j].w); }
        const float rstd = 1.0f / sqrtf(wave_sum(s) * (1.0f / DM) + EPS);
        const GAS f32x4* shp = (const GAS f32x4*)(F.MOD + b * NMOD + 3 * DM);
        const GAS f32x4* scp = (const GAS f32x4*)(F.MOD + b * NMOD + 4 * DM);
        float mx = 0.f;
#pragma unroll
        for (int j = 0; j < 8; ++j) { const int i0 = 2 * (lane + 64 * j);
            a[j] = a[j] * rstd * (scp[i0] + 1.0f) + shp[i0]; c[j] = c[j] * rstd * (scp[i0 + 1] + 1.0f) + shp[i0 + 1];
#pragma unroll
            for (int q = 0; q < 4; ++q) mx = fmaxf(mx, fmaxf(fabsf(a[j][q]), fabsf(c[j][q])));
            *(GAS v4u*)(F.HBUF + (size_t)m * DM + 8 * (lane + 64 * j)) = (v4u){pk2(a[j].x, a[j].y), pk2(a[j].z, a[j].w), pk2(c[j].x, c[j].y), pk2(c[j].z, c[j].w)}; }
        mx = wave_max(mx);
        const float inv = mx > 0.f ? 127.0f / mx : 0.f;
        if (lane == 0) F.YSC[m] = mx * (1.0f / 127.0f);
#pragma unroll
        for (int j = 0; j < 8; ++j) { v2u o; o.x = pack4i(a[j].x * inv, a[j].y * inv, a[j].z * inv, a[j].w * inv); o.y = pack4i(c[j].x * inv, c[j].y * inv, c[j].z * inv, c[j].w * inv);
            *(GAS v2u*)(F.YC8 + ((size_t)(lane + 64 * j) * NTOK + m) * 8) = o; }
    }
}

__device__ __forceinline__ void swa_unit(Frame& F, int u) {
    const int b = u >> 6, kvh = (u >> 4) & 3, n = u & 15, t0 = n * 128;
    LAS unsigned char* KL = F.lds;
    LAS unsigned char* VL = F.lds + 36864;
    const float* COS = F.ROPE; const float* SIN = F.ROPE + SEQ * 32;
    {
        const int key = F.tid >> 1, p = F.tid & 1, kpos = t0 - 128 + key;
        v4u ka[2] = {{0u, 0u, 0u, 0u}, {0u, 0u, 0u, 0u}}, kb[2] = {{0u, 0u, 0u, 0u}, {0u, 0u, 0u, 0u}}, vv[4] = {{0u, 0u, 0u, 0u}, {0u, 0u, 0u, 0u}, {0u, 0u, 0u, 0u}, {0u, 0u, 0u, 0u}};
        float cs[16], sn[16];
#pragma unroll
        for (int i = 0; i < 16; ++i) { cs[i] = 1.f; sn[i] = 0.f; }
        if (kpos >= 0) {
            const bf16* pr = F.PROJ + (size_t)(b * SEQ + kpos) * NPROJ;
            const GAS v4u* kr = (const GAS v4u*)(pr + C_SK + kvh * 64);
            ka[0] = kr[2 * p]; ka[1] = kr[2 * p + 1]; kb[0] = kr[4 + 2 * p]; kb[1] = kr[4 + 2 * p + 1];
            const GAS v4u* vr = (const GAS v4u*)(pr + C_SV + kvh * 64 + 32 * p);
#pragma unroll
            for (int j = 0; j < 4; ++j) vv[j] = vr[j];
            const GAS f32x4* cp = (const GAS f32x4*)(COS + kpos * 32 + 16 * p); const GAS f32x4* sp = (const GAS f32x4*)(SIN + kpos * 32 + 16 * p);
#pragma unroll
            for (int j = 0; j < 4; ++j) { const f32x4 c4 = cp[j], s4 = sp[j];
#pragma unroll
                for (int e = 0; e < 4; ++e) { cs[4 * j + e] = c4[e]; sn[4 * j + e] = s4[e]; } }
        }
        float x1[16], x2[16]; float ss = 0.f;
#pragma unroll
        for (int j = 0; j < 2; ++j)
#pragma unroll
            for (int e = 0; e < 4; ++e) { x1[8 * j + 2 * e] = bflo(ka[j][e]); x1[8 * j + 2 * e + 1] = bfhi(ka[j][e]); x2[8 * j + 2 * e] = bflo(kb[j][e]); x2[8 * j + 2 * e + 1] = bfhi(kb[j][e]); }
#pragma unroll
        for (int i = 0; i < 16; ++i) ss += x1[i] * x1[i] + x2[i] * x2[i];
        ss += __shfl_xor(ss, 1);
        const float rstd = 1.0f / sqrtf(ss * (1.0f / 64.0f) + EPS);
        unsigned o1[8], o2[8];
#pragma unroll
        for (int i = 0; i < 8; ++i) {
            float y1[2], y2[2];
#pragma unroll
            for (int e = 0; e < 2; ++e) { const int d = 2 * i + e; const float a = x1[d] * rstd * F.swa_k_norm[16 * p + d], c = x2[d] * rstd * F.swa_k_norm[32 + 16 * p + d];
                y1[e] = a * cs[d] - c * sn[d]; y2[e] = c * cs[d] + a * sn[d]; }
            o1[i] = pk2(y1[0], y1[1]); o2[i] = pk2(y2[0], y2[1]);
        }
        LAS v4u* kd = (LAS v4u*)(KL + key * 144 + 32 * p);
        kd[0] = (v4u){o1[0], o1[1], o1[2], o1[3]}; kd[1] = (v4u){o1[4], o1[5], o1[6], o1[7]};
        LAS v4u* kd2 = (LAS v4u*)(KL + key * 144 + 64 + 32 * p);
        kd2[0] = (v4u){o2[0], o2[1], o2[2], o2[3]}; kd2[1] = (v4u){o2[4], o2[5], o2[6], o2[7]};
#pragma unroll
        for (int j = 0; j < 4; ++j)
#pragma unroll
            for (int e = 0; e < 4; ++e) { const int d = 32 * p + 8 * j + 2 * e; const unsigned w = vv[j][e];
                *(LAS unsigned short*)(VL + d * 520 + key * 2) = (unsigned short)(w & 0xffffu);
                *(LAS unsigned short*)(VL + (d + 1) * 520 + key * 2) = (unsigned short)(w >> 16); }
    }
    __syncthreads();
    {
        const int g = F.wave, hq = kvh * 8 + g, r = F.lane & 31, h = F.lane >> 5;
        const float sink = F.swa_sinks[hq];
        for (int qt = 0; qt < 4; ++qt) {
            const int qpos = t0 + 32 * qt + r;
            const size_t tok = (size_t)(b * SEQ + qpos);
            const GAS v4u* qr = (const GAS v4u*)(F.PROJ + tok * NPROJ + C_SQ + hq * 64);
            v4u qraw[4];
#pragma unroll
            for (int kk = 0; kk < 4; ++kk) qraw[kk] = qr[2 * kk + h];
            float qf[4][8]; float ss = 0.f;
#pragma unroll
            for (int kk = 0; kk < 4; ++kk)
#pragma unroll
                for (int e = 0; e < 4; ++e) { qf[kk][2 * e] = bflo(qraw[kk][e]); qf[kk][2 * e + 1] = bfhi(qraw[kk][e]); }
#pragma unroll
            for (int kk = 0; kk < 4; ++kk)
#pragma unroll
                for (int j = 0; j < 8; ++j) ss += qf[kk][j] * qf[kk][j];
            ss += __shfl_xor(ss, 32);
            const float rstd = 0.125f / sqrtf(ss * (1.0f / 64.0f) + EPS);
            bf16x8 qfrag[4];
#pragma unroll
            for (int kk = 0; kk < 2; ++kk) {
                float y1[8], y2[8];
                const GAS f32x4* cp = (const GAS f32x4*)(COS + qpos * 32 + 16 * kk + 8 * h); const GAS f32x4* sp = (const GAS f32x4*)(SIN + qpos * 32 + 16 * kk + 8 * h);
                const f32x4 c0 = cp[0], c1 = cp[1], s0 = sp[0], s1 = sp[1];
#pragma unroll
                for (int j = 0; j < 8; ++j) { const int d = 16 * kk + 8 * h + j; const float cc = j < 4 ? c0[j & 3] : c1[j & 3], sv = j < 4 ? s0[j & 3] : s1[j & 3];
                    const float a = qf[kk][j] * rstd * F.swa_q_norm[d], c = qf[kk + 2][j] * rstd * F.swa_q_norm[d + 32];
                    y1[j] = a * cc - c * sv; y2[j] = c * cc + a * sv; }
                qfrag[kk] = mk8(pk2(y1[0], y1[1]), pk2(y1[2], y1[3]), pk2(y1[4], y1[5]), pk2(y1[6], y1[7]));
                qfrag[kk + 2] = mk8(pk2(y2[0], y2[1]), pk2(y2[2], y2[3]), pk2(y2[4], y2[5]), pk2(y2[6], y2[7]));
            }
            f32x16 sacc[5];
#pragma unroll
            for (int tt = 0; tt < 5; ++tt) { f32x16 a = {0.f, 0.f, 0.f, 0.f, 0.f, 0.f, 0.f, 0.f, 0.f, 0.f, 0.f, 0.f, 0.f, 0.f, 0.f, 0.f};
#pragma unroll
                for (int kk = 0; kk < 4; ++kk) { const bf16x8 kf = *(const LAS bf16x8*)(KL + (32 * (qt + tt) + r) * 144 + (16 * kk + 8 * h) * 2); a = mfma32(kf, qfrag[kk], a); }
                sacc[tt] = a; }
            float mx = sink;
#pragma unroll
            for (int tt = 0; tt < 5; ++tt)
#pragma unroll
                for (int i = 0; i < 16; ++i) { const int koff = (i & 3) + 8 * (i >> 2) + 4 * h; const int rel = r + 128 - 32 * tt - koff; const int kidx = 32 * (qt + tt) + koff;
                    const bool valid = (rel >= 0) && (rel < 128) && (t0 - 128 + kidx >= 0);
                    const float s = valid ? sacc[tt][i] : -INFINITY; sacc[tt][i] = s; mx = fmaxf(mx, s); }
            mx = fmaxf(mx, __shfl_xor(mx, 32));
            float sum = 0.f;
#pragma unroll
            for (int tt = 0; tt < 5; ++tt)
#pragma unroll
                for (int i = 0; i < 16; ++i) { const float pv = __expf(sacc[tt][i] - mx); sacc[tt][i] = pv; sum += pv; }
            sum += __shfl_xor(sum, 32);
            const float inv = 1.0f / (sum + __expf(sink - mx));
            f32x16 oacc[2];
#pragma unroll
            for (int dt = 0; dt < 2; ++dt) oacc[dt] = (f32x16){0.f, 0.f, 0.f, 0.f, 0.f, 0.f, 0.f, 0.f, 0.f, 0.f, 0.f, 0.f, 0.f, 0.f, 0.f, 0.f};
#pragma unroll
            for (int tt = 0; tt < 5; ++tt)
#pragma unroll
                for (int s2 = 0; s2 < 2; ++s2) {
                    const bf16x8 pf = mk8(pk2(sacc[tt][8 * s2], sacc[tt][8 * s2 + 1]), pk2(sacc[tt][8 * s2 + 2], sacc[tt][8 * s2 + 3]), pk2(sacc[tt][8 * s2 + 4], sacc[tt][8 * s2 + 5]), pk2(sacc[tt][8 * s2 + 6], sacc[tt][8 * s2 + 7]));
#pragma unroll
                    for (int dt = 0; dt < 2; ++dt) { const LAS unsigned char* vp = VL + (32 * dt + r) * 520 + (32 * (qt + tt) + 16 * s2 + 4 * h) * 2;
                        const v2u lo = *(const LAS v2u*)vp, hi = *(const LAS v2u*)(vp + 16);
                        oacc[dt] = mfma32(mk8(lo.x, lo.y, hi.x, hi.y), pf, oacc[dt]); }
                }
            float so = 0.f;
#pragma unroll
            for (int dt = 0; dt < 2; ++dt)
#pragma unroll
                for (int i = 0; i < 16; ++i) { const float o = oacc[dt][i] * inv; oacc[dt][i] = o; so += o * o; }
            so += __shfl_xor(so, 32);
            const float rs2 = 1.0f / sqrtf(so * (1.0f / 64.0f) + EPS);
            bf16* orow = F.MIXIN + tok * DM + 2048 + hq * 64;
#pragma unroll
            for (int dt = 0; dt < 2; ++dt)
#pragma unroll
                for (int gq = 0; gq < 4; ++gq) { const int d0 = 32 * dt + 8 * gq + 4 * h; const f32x4 gn = *(const GAS f32x4*)(F.swa_out_norm + d0);
                    v2u o; o.x = pk2(oacc[dt][4 * gq] * rs2 * gn[0], oacc[dt][4 * gq + 1] * rs2 * gn[1]); o.y = pk2(oacc[dt][4 * gq + 2] * rs2 * gn[2], oacc[dt][4 * gq + 3] * rs2 * gn[3]);
                    *(GAS v2u*)(orow + d0) = o; }
        }
    }
    __syncthreads();
}

constexpr int GL_QT = 0, GL_KT = 9216, GL_KHT = 18432, GL_VT = 27648, GL_WG = 46336, GL_BG = 50432, GL_OB = 50688;
__device__ __forceinline__ void gla_g1_units(Frame& F, int u0, int nu) {
    const int bh = u0 >> 5, b = bh >> 4, h = bh & 15, tid = F.tid, lane = F.lane, w = F.wave;
    LAS unsigned char* QT = F.lds + GL_QT;
    LAS unsigned char* KT = F.lds + GL_KT;
    LAS unsigned char* KHT = F.lds + GL_KHT;
    LAS unsigned char* VT = F.lds + GL_VT;
    LAS float* WG = (LAS float*)(F.lds + GL_WG);
    LAS float* BG = (LAS float*)(F.lds + GL_BG);
    LAS float* OB = (LAS float*)(F.lds + GL_OB);
    __syncthreads();
    for (int i = tid; i < 1024; i += 512) WG[i] = F.w_gate_up[(i >> 6) * 1024 + h * 64 + (i & 63)];
    if (tid < 64) BG[tid] = F.b_gla_gate[h * 64 + tid];
    __syncthreads();
    const int r = lane & 15, g = lane >> 4;
    const int t2 = tid >> 3, seg = tid & 7;
    v4u qv, kv, g0, g1, vv0, vv1;
    { const size_t row0 = (size_t)b * SEQ + (u0 & 31) * 64; const bf16* pr = F.PROJ + (row0 + lane) * NPROJ;
      qv = *(const GAS v4u*)(pr + C_GQ + h * 64 + 8 * w); kv = *(const GAS v4u*)(pr + C_GK + h * 64 + 8 * w); g0 = *(const GAS v4u*)(pr + C_GA); g1 = *(const GAS v4u*)(pr + C_GA + 8);
      const GAS v4u* vr = (const GAS v4u*)(F.PROJ + (row0 + t2) * NPROJ + C_GV + h * 128 + 16 * seg); vv0 = vr[0]; vv1 = vr[1]; }
    for (int ui = 0; ui < nu; ++ui) {
        const int u = u0 + ui, chunk = u & 31;
        const size_t row0 = (size_t)b * SEQ + chunk * 64;
        {
            float ga[16];
#pragma unroll
            for (int e = 0; e < 4; ++e) { ga[2 * e] = bflo(g0[e]); ga[2 * e + 1] = bfhi(g0[e]); ga[8 + 2 * e] = bflo(g1[e]); ga[8 + 2 * e + 1] = bfhi(g1[e]); }
            float z[8];
            { const f32x4 b0 = *(const LAS f32x4*)(BG + 8 * w), b1 = *(const LAS f32x4*)(BG + 8 * w + 4);
#pragma unroll
              for (int i = 0; i < 4; ++i) { z[i] = b0[i]; z[4 + i] = b1[i]; } }
#pragma unroll
            for (int j = 0; j < 16; ++j) { const f32x4 w0 = *(const LAS f32x4*)(WG + j * 64 + 8 * w), w1 = *(const LAS f32x4*)(WG + j * 64 + 8 * w + 4);
#pragma unroll
                for (int i = 0; i < 4; ++i) { z[i] += ga[j] * w0[i]; z[4 + i] += ga[j] * w1[i]; } }
            float bb[8];
#pragma unroll
            for (int i = 0; i < 8; ++i) { const float zz = z[i]; bb[i] = (fminf(zz, 0.f) - __logf(1.0f + __expf(-fabsf(zz)))) * (1.0f / 16.0f); }
#pragma unroll
            for (int off = 1; off < 64; off <<= 1)
#pragma unroll
                for (int i = 0; i < 8; ++i) { const float v = __shfl_up(bb[i], off); if (lane >= off) bb[i] += v; }
            float qn[8], kn[8], kh[8];
#pragma unroll
            for (int e = 0; e < 4; ++e) { qn[2 * e] = bflo(qv[e]); qn[2 * e + 1] = bfhi(qv[e]); kn[2 * e] = bflo(kv[e]); kn[2 * e + 1] = bfhi(kv[e]); }
#pragma unroll
            for (int i = 0; i < 8; ++i) { const float bl = __shfl(bb[i], 63); const float eb = __expf(bb[i]);
                qn[i] = qn[i] * 0.125f * eb; kh[i] = kn[i] * __expf(bl - bb[i]); kn[i] = kn[i] * __expf(-bb[i]);
                if (lane == 0) F.GG[(size_t)u * 64 + 8 * w + i] = __expf(bl); }
            const v4u qpk = {pk2(qn[0], qn[1]), pk2(qn[2], qn[3]), pk2(qn[4], qn[5]), pk2(qn[6], qn[7])};
            *(LAS v4u*)(QT + lane * 144 + 16 * w) = qpk;
            *(GAS v4u*)(F.GQT + ((size_t)u * 64 + lane) * 64 + 8 * w) = qpk;
            *(LAS v4u*)(KT + lane * 144 + 16 * w) = (v4u){pk2(kn[0], kn[1]), pk2(kn[2], kn[3]), pk2(kn[4], kn[5]), pk2(kn[6], kn[7])};
#pragma unroll
            for (int i = 0; i < 8; ++i) *(LAS unsigned short*)(KHT + (8 * w + i) * 144 + lane * 2) = (unsigned short)f2bf(kh[i]);
#pragma unroll
            for (int e = 0; e < 4; ++e) {
                *(LAS unsigned short*)(VT + (16 * seg + 2 * e) * 144 + t2 * 2) = (unsigned short)(vv0[e] & 0xffffu);
                *(LAS unsigned short*)(VT + (16 * seg + 2 * e + 1) * 144 + t2 * 2) = (unsigned short)(vv0[e] >> 16);
                *(LAS unsigned short*)(VT + (16 * seg + 8 + 2 * e) * 144 + t2 * 2) = (unsigned short)(vv1[e] & 0xffffu);
                *(LAS unsigned short*)(VT + (16 * seg + 8 + 2 * e + 1) * 144 + t2 * 2) = (unsigned short)(vv1[e] >> 16); }
        }
        if (ui + 1 < nu) {
            const size_t rown = row0 + 64; const bf16* pr = F.PROJ + (rown + lane) * NPROJ;
            qv = *(const GAS v4u*)(pr + C_GQ + h * 64 + 8 * w); kv = *(const GAS v4u*)(pr + C_GK + h * 64 + 8 * w); g0 = *(const GAS v4u*)(pr + C_GA); g1 = *(const GAS v4u*)(pr + C_GA + 8);
            const GAS v4u* vr = (const GAS v4u*)(F.PROJ + (rown + t2) * NPROJ + C_GV + h * 128 + 16 * seg); vv0 = vr[0]; vv1 = vr[1]; }
        __syncthreads();
        {
            unsigned dp[4][4][2];
#pragma unroll
            for (int tt = 0; tt < 4; ++tt) {
                const bf16x8 bq0 = *(const LAS bf16x8*)(QT + (16 * tt + r) * 144 + (8 * g) * 2), bq1 = *(const LAS bf16x8*)(QT + (16 * tt + r) * 144 + (32 + 8 * g) * 2);
#pragma unroll
                for (int st = 0; st < 4; ++st) {
                    if (st <= tt) {
                        const bf16x8 ak0 = *(const LAS bf16x8*)(KT + (16 * st + r) * 144 + (8 * g) * 2), ak1 = *(const LAS bf16x8*)(KT + (16 * st + r) * 144 + (32 + 8 * g) * 2);
                        f32x4 d = {0.f, 0.f, 0.f, 0.f}; d = mfma16(ak0, bq0, d); d = mfma16(ak1, bq1, d);
                        if (st == tt) {
#pragma unroll
                            for (int i = 0; i < 4; ++i) if (4 * g + i > r) d[i] = 0.f; }
                        dp[st][tt][0] = pk2(d[0], d[1]); dp[st][tt][1] = pk2(d[2], d[3]);
                    } else { dp[st][tt][0] = 0u; dp[st][tt][1] = 0u; }
                }
            }
#pragma unroll
            for (int tt = 0; tt < 4; ++tt) {
                f32x4 o = {0.f, 0.f, 0.f, 0.f};
#pragma unroll
                for (int kk = 0; kk < 2; ++kk) {
                    if (2 * kk <= tt) {
                        const LAS unsigned char* vp = VT + (16 * w + r) * 144 + (32 * kk + 4 * g) * 2;
                        const v2u lo = *(const LAS v2u*)vp, hi = *(const LAS v2u*)(vp + 32);
                        o = mfma16(mk8(dp[2 * kk][tt][0], dp[2 * kk][tt][1], dp[2 * kk + 1][tt][0], dp[2 * kk + 1][tt][1]), mk8(lo.x, lo.y, hi.x, hi.y), o);
                    }
                }
#pragma unroll
                for (int i = 0; i < 4; ++i) OB[(16 * tt + 4 * g + i) * 132 + 16 * w + r] = o[i];
            }
#pragma unroll
            for (int dt = 0; dt < 4; ++dt) {
                f32x4 uacc = {0.f, 0.f, 0.f, 0.f};
#pragma unroll
                for (int kk = 0; kk < 2; ++kk) { const bf16x8 a = *(const LAS bf16x8*)(KHT + (16 * dt + r) * 144 + (32 * kk + 8 * g) * 2), bv = *(const LAS bf16x8*)(VT + (16 * w + r) * 144 + (32 * kk + 8 * g) * 2);
                    uacc = mfma16(a, bv, uacc); }
                *(GAS f32x4*)(F.GUT + ((size_t)u * 128 + 16 * w + r) * 64 + 16 * dt + 4 * g) = uacc;
            }
        }
        __syncthreads();
        {
            unsigned ow[8];
#pragma unroll
            for (int j = 0; j < 4; ++j) { const f32x4 v = *(const LAS f32x4*)(OB + t2 * 132 + 16 * seg + 4 * j); ow[2 * j] = pk2(v[0], v[1]); ow[2 * j + 1] = pk2(v[2], v[3]); }
            GAS v4u* op = (GAS v4u*)(F.MIXIN + (row0 + t2) * DM + h * 128 + 16 * seg);
            op[0] = (v4u){ow[0], ow[1], ow[2], ow[3]}; op[1] = (v4u){ow[4], ow[5], ow[6], ow[7]};
        }
    }
}
__device__ __forceinline__ void gla_scan(Frame& F) {
    const size_t gt = (size_t)F.vcu * 512 + F.tid, NT = (size_t)F.G * 512;
    for (size_t i = gt; i < (size_t)64 * 128 * 16; i += NT) {
        const int bh = (int)(i >> 11), v = (int)((i >> 4) & 127), d4 = (int)(i & 15);
        f32x4 S = {0.f, 0.f, 0.f, 0.f};
#pragma unroll 8
        for (int c = 0; c < 32; ++c) {
            const size_t u = (size_t)bh * 32 + c;
            const f32x4 U = *(const GAS f32x4*)(F.GUT + (u * 128 + v) * 64 + 4 * d4), gg = *(const GAS f32x4*)(F.GG + u * 64 + 4 * d4);
            *(GAS v2u*)(F.GST + (u * 128 + v) * 64 + 4 * d4) = (v2u){pk2(S[0], S[1]), pk2(S[2], S[3])};
            S = gg * S + U;
        }
    }
}
struct G3Ops { v4u oi0, oi1, gg0, gg1; v2u slo[2], shi[2], qlo[4][2], qhi[4][2]; };
__device__ __forceinline__ void gla_g3_load(Frame& F, G3Ops& P, int u, int b, int h, int w, int r, int g, int t2, int seg) {
    const size_t row0 = (size_t)b * SEQ + (u & 31) * 64;
    const GAS v4u* oip = (const GAS v4u*)(F.MIXIN + (row0 + t2) * DM + h * 128 + 16 * seg); P.oi0 = oip[0]; P.oi1 = oip[1];
    const GAS v4u* gr = (const GAS v4u*)(F.PROJ + (row0 + t2) * NPROJ + C_GG + h * 128 + 16 * seg); P.gg0 = gr[0]; P.gg1 = gr[1];
#pragma unroll
    for (int kk = 0; kk < 2; ++kk) { const bf16* sp = F.GST + ((size_t)u * 128 + 16 * w + r) * 64 + 32 * kk + 4 * g; P.slo[kk] = *(const GAS v2u*)sp; P.shi[kk] = *(const GAS v2u*)(sp + 16); }
#pragma unroll
    for (int tt = 0; tt < 4; ++tt)
#pragma unroll
        for (int kk = 0; kk < 2; ++kk) { const bf16* qp = F.GQT + ((size_t)u * 64 + 16 * tt + r) * 64 + 32 * kk + 4 * g; P.qlo[tt][kk] = *(const GAS v2u*)qp; P.qhi[tt][kk] = *(const GAS v2u*)(qp + 16); }
}
__device__ __forceinline__ void gla_g3_units(Frame& F, int u0, int nu) {
    const int bh = u0 >> 5, b = bh >> 4, h = bh & 15, tid = F.tid, lane = F.lane, w = F.wave;
    LAS float* OB = (LAS float*)(F.lds + GL_OB);
    const int r = lane & 15, g = lane >> 4, t2 = tid >> 3, seg = tid & 7;
    __syncthreads();
    G3Ops cur, nxt;
    gla_g3_load(F, cur, u0, b, h, w, r, g, t2, seg);
    for (int ui = 0; ui < nu; ++ui) {
        const int u = u0 + ui, chunk = u & 31;
        const size_t row0 = (size_t)b * SEQ + chunk * 64;
        {
            bf16x8 bs[2];
#pragma unroll
            for (int kk = 0; kk < 2; ++kk) bs[kk] = mk8(cur.slo[kk].x, cur.slo[kk].y, cur.shi[kk].x, cur.shi[kk].y);
#pragma unroll
            for (int tt = 0; tt < 4; ++tt) {
                f32x4 o = {0.f, 0.f, 0.f, 0.f};
#pragma unroll
                for (int kk = 0; kk < 2; ++kk) o = mfma16(mk8(cur.qlo[tt][kk].x, cur.qlo[tt][kk].y, cur.qhi[tt][kk].x, cur.qhi[tt][kk].y), bs[kk], o);
#pragma unroll
                for (int i = 0; i < 4; ++i) OB[(16 * tt + 4 * g + i) * 132 + 16 * w + r] = o[i];
            }
        }
        if (ui + 1 < nu) gla_g3_load(F, nxt, u + 1, b, h, w, r, g, t2, seg);
        __syncthreads();
        {
            float o[16]; float ss = 0.f;
#pragma unroll
            for (int j = 0; j < 4; ++j) { const f32x4 v = *(const LAS f32x4*)(OB + t2 * 132 + 16 * seg + 4 * j);
#pragma unroll
                for (int e = 0; e < 4; ++e) o[4 * j + e] = v[e]; }
#pragma unroll
            for (int e = 0; e < 4; ++e) { o[2 * e] += bflo(cur.oi0[e]); o[2 * e + 1] += bfhi(cur.oi0[e]); o[8 + 2 * e] += bflo(cur.oi1[e]); o[8 + 2 * e + 1] += bfhi(cur.oi1[e]); }
#pragma unroll
            for (int e = 0; e < 16; ++e) ss += o[e] * o[e];
            ss += __shfl_xor(ss, 1); ss += __shfl_xor(ss, 2); ss += __shfl_xor(ss, 4);
            const float rstd = 1.0f / sqrtf(ss * (1.0f / 128.0f) + EPS);
            float gg[16];
#pragma unroll
            for (int e = 0; e < 4; ++e) { gg[2 * e] = bflo(cur.gg0[e]); gg[2 * e + 1] = bfhi(cur.gg0[e]); gg[8 + 2 * e] = bflo(cur.gg1[e]); gg[8 + 2 * e + 1] = bfhi(cur.gg1[e]); }
            unsigned ow[8];
#pragma unroll
            for (int e = 0; e < 8; ++e) { const float a = o[2 * e] * rstd * F.gla_out_norm[16 * seg + 2 * e] * silu_f(gg[2 * e]), c = o[2 * e + 1] * rstd * F.gla_out_norm[16 * seg + 2 * e + 1] * silu_f(gg[2 * e + 1]);
                ow[e] = pk2(a, c); }
            GAS v4u* op = (GAS v4u*)(F.MIXIN + (row0 + t2) * DM + h * 128 + 16 * seg);
            op[0] = (v4u){ow[0], ow[1], ow[2], ow[3]}; op[1] = (v4u){ow[4], ow[5], ow[6], ow[7]};
        }
        __syncthreads();
        cur = nxt;
    }
}

__device__ __forceinline__ void p3a_mixer(Frame& F) {
    for (int u = F.vcu; u < 256; u += F.G) swa_unit(F, u);
    for (int q = F.vcu; q < 256; q += F.G) gla_g1_units(F, q * 8, 8);
}
__device__ __forceinline__ void p3c_mixer(Frame& F) {
    for (int q = F.vcu; q < 256; q += F.G) gla_g3_units(F, q * 8, 8);
}

__device__ __forceinline__ unsigned f2s(float f) { const unsigned u = __builtin_bit_cast(unsigned, f); return (u & 0x80000000u) ? ~u : (u | 0x80000000u); }
__device__ __forceinline__ float s2f(unsigned s) { const unsigned u = (s & 0x80000000u) ? (s & 0x7fffffffu) : ~s; return __builtin_bit_cast(float, u); }
#define TOPK_INSERT(list, xin) do { unsigned _x = (xin); _Pragma("unroll") for (int _p = 0; _p < 16; ++_p) { const unsigned _hi = list[_p] > _x ? list[_p] : _x; _x = list[_p] > _x ? _x : list[_p]; list[_p] = _hi; } } while (0)

__device__ __forceinline__ void p7_topk(Frame& F) {
    const int tid = F.tid, lane = F.lane, wave = F.wave;
    LAS unsigned char* KY = F.lds;
    LAS unsigned* SC = (LAS unsigned*)(F.lds + 69632 + wave * 4096);
    for (int i = tid; i < 2 * 128 * 64; i += 512) { const int hf = i >> 13, key = (i >> 6) & 127, dp2 = i & 63;
        const float* kp = (hf ? F.keys2 : F.keys1) + key * 128 + 2 * dp2;
        *(LAS unsigned*)(KY + hf * 34816 + key * 272 + dp2 * 4) = pk2(kp[0], kp[1]); }
    __syncthreads();
    const int gw = F.vcu * NWAVES + wave, NGW = F.G * NWAVES;
    const int r = lane & 31, h = lane >> 5;
    for (int task = gw; task < 256 * 8; task += NGW) {
        const int tile = task >> 3, hd = task & 7, tok = tile * 32 + r;
        for (int hf = 0; hf < 2; ++hf) {
            const GAS v4u* qr = (const GAS v4u*)(F.QPEER + (size_t)tok * PEER_N + hd * 256 + hf * 128);
            bf16x8 qf[8];
#pragma unroll
            for (int kk = 0; kk < 8; ++kk) qf[kk] = __builtin_bit_cast(bf16x8, qr[2 * kk + h]);
            unsigned list[16];
#pragma unroll
            for (int p = 0; p < 16; ++p) list[p] = 0u;
#pragma unroll
            for (int T = 0; T < 4; ++T) {
                f32x16 a = {0.f, 0.f, 0.f, 0.f, 0.f, 0.f, 0.f, 0.f, 0.f, 0.f, 0.f, 0.f, 0.f, 0.f, 0.f, 0.f};
#pragma unroll
                for (int kk = 0; kk < 8; ++kk) { const bf16x8 kf = *(const LAS bf16x8*)(KY + hf * 34816 + (32 * T + r) * 272 + (16 * kk + 8 * h) * 2); a = mfma32(kf, qf[kk], a); }
#pragma unroll
                for (int i = 0; i < 16; ++i) { const int key = 32 * T + (i & 3) + 8 * (i >> 2) + 4 * h; const unsigned pkd = (f2s(a[i]) & ~127u) | (unsigned)(127 - key); TOPK_INSERT(list, pkd); }
            }
            unsigned other[16];
#pragma unroll
            for (int p = 0; p < 16; ++p) other[p] = (unsigned)__shfl_xor((int)list[p], 32);
#pragma unroll
            for (int p = 0; p < 16; ++p) TOPK_INSERT(list, other[p]);
            if (h == 0) {
#pragma unroll
                for (int p = 0; p < 16; ++p) SC[(hf * 16 + p) * 32 + r] = list[p]; }
        }
        LDS_WAIT(); asm volatile("" ::: "memory");
        float v1[16], v2[16];
#pragma unroll
        for (int p = 0; p < 16; ++p) { v1[p] = s2f(SC[p * 32 + r] & ~127u); v2[p] = s2f(SC[(16 + p) * 32 + r] & ~127u); }
        unsigned cl[16];
#pragma unroll
        for (int p = 0; p < 16; ++p) cl[p] = 0u;
#pragma unroll
        for (int i = 0; i < 16; ++i)
#pragma unroll
            for (int j = 0; j < 16; ++j) if ((i + 1) * (j + 1) <= 16) { const unsigned pkd = (f2s(v1[i] + v2[j]) & ~255u) | (unsigned)(255 - (i * 16 + j)); TOPK_INSERT(cl, pkd); }
        float val[8]; int eidx[8]; float mx = -INFINITY;
#pragma unroll
        for (int p = 0; p < 16; ++p) { const int pos = 255 - (int)(cl[p] & 255u), i = pos >> 4, j = pos & 15;
            const unsigned a = SC[i * 32 + r], b2 = SC[(16 + j) * 32 + r];
            const float v = s2f(a & ~127u) + s2f(b2 & ~127u); mx = fmaxf(mx, v);
            if ((p >> 3) == h) { val[p & 7] = v; eidx[p & 7] = (127 - (int)(a & 127u)) * 128 + (127 - (int)(b2 & 127u)); } }
        float sum = 0.f, ex[8];
#pragma unroll
        for (int p = 0; p < 8; ++p) { ex[p] = __expf(val[p] - mx); sum += ex[p]; }
        sum += __shfl_xor(sum, 32);
        const float inv = 1.0f / sum;
        const int p4a = hd * 4 + 2 * h;
        GAS v4u* ip = (GAS v4u*)F.EIDX; GAS f32x4* gp = (GAS f32x4*)F.GATEQ;
        ip[(size_t)p4a * NTOK + tok] = (v4u){(unsigned)eidx[0], (unsigned)eidx[1], (unsigned)eidx[2], (unsigned)eidx[3]}; ip[(size_t)(p4a + 1) * NTOK + tok] = (v4u){(unsigned)eidx[4], (unsigned)eidx[5], (unsigned)eidx[6], (unsigned)eidx[7]};
        ((GAS v4u*)F.EIDX16)[(size_t)(hd * 2 + h) * NTOK + tok] = (v4u){(unsigned)eidx[0] | ((unsigned)eidx[1] << 16), (unsigned)eidx[2] | ((unsigned)eidx[3] << 16), (unsigned)eidx[4] | ((unsigned)eidx[5] << 16), (unsigned)eidx[6] | ((unsigned)eidx[7] << 16)};
        gp[(size_t)p4a * NTOK + tok] = (f32x4){ex[0] * inv, ex[1] * inv, ex[2] * inv, ex[3] * inv}; gp[(size_t)(p4a + 1) * NTOK + tok] = (f32x4){ex[4] * inv, ex[5] * inv, ex[6] * inv, ex[7] * inv};
        LDS_WAIT(); asm volatile("" ::: "memory");
    }
}

typedef int i32x4 __attribute__((ext_vector_type(4)));
__device__ __forceinline__ void lds_fill_128k(Frame& F, const unsigned char* src) {
#pragma unroll
    for (int i = 0; i < 16; ++i)
        __builtin_amdgcn_global_load_lds((const unsigned*)(src + (size_t)(i * 512 + F.tid) * 16), (LAS unsigned*)(F.lds + i * 8192 + F.wave * 1024), 16, 0, 0);
}
constexpr int P8_ZOFF = 139264;
constexpr int P8_YB = 132096;
constexpr int P8_DUMMY = 140288;
#define P8_WAITV0() asm volatile("s_waitcnt vmcnt(0)" ::: "memory")
#define P8_BAR() do { asm volatile("s_waitcnt lgkmcnt(0)" ::: "memory"); __builtin_amdgcn_s_barrier(); asm volatile("" ::: "memory"); } while (0)
__device__ __forceinline__ void p8a_sddmm(Frame& F) {
    const int wv = F.wave;
    for (int u = F.vcu; u < 256; u += F.G) {
        const int tg = u & 15, dr = u >> 4, t = tg * 512 + F.tid;
        unsigned id[64];
#pragma unroll
        for (int p8 = 0; p8 < 16; ++p8) { const v4u v = ((const GAS v4u*)F.EIDX16)[(size_t)p8 * NTOK + t]; id[4 * p8] = v.x; id[4 * p8 + 1] = v.y; id[4 * p8 + 2] = v.z; id[4 * p8 + 3] = v.w; }
        int acc[128];
#pragma unroll
        for (int p = 0; p < 128; ++p) acc[p] = 0;
        const unsigned char* tab = F.DC8 + (size_t)(dr * 32) * 131072;
        const unsigned char* ysrc = F.YC8 + ((size_t)(dr * 32) * NTOK + tg * 512) * 8 + (wv & 3) * 1024 + F.lane * 16;
        for (int sl = 0; sl < 32; ++sl) {
#pragma unroll
            for (int i = 0; i < 64; ++i) asm volatile("" : "+v"(id[i]));
            P8_WAITV0();
            P8_BAR();
            lds_fill_128k(F, tab + (size_t)sl * 131072);
            if (wv < 4) __builtin_amdgcn_global_load_lds((const unsigned*)(ysrc + (size_t)sl * NTOK * 8), (LAS unsigned*)(F.lds + P8_YB + wv * 1024), 16, 0, 0);
            P8_WAITV0();
            P8_BAR();
            if (sl + 1 < 32) __builtin_amdgcn_global_load_lds((const unsigned*)(tab + (size_t)(sl + 1) * 131072 + (size_t)tg * 8192 + wv * 1024 + F.lane * 16), (LAS unsigned*)(F.lds + P8_DUMMY + wv * 1024), 16, 0, 0);
            const v2u yv = *(const LAS v2u*)(F.lds + P8_YB + F.tid * 8);
#pragma unroll
            for (int p = 0; p < 128; ++p) {
                const unsigned off = (p & 1) ? ((id[p >> 1] >> 13) & 0x7fff8u) : ((id[p >> 1] << 3) & 0x7fff8u);
                const v2u d = *(const LAS v2u*)(F.lds + off);
                acc[p] = __builtin_amdgcn_sdot4((int)d.x, (int)yv.x, acc[p], false);
                acc[p] = __builtin_amdgcn_sdot4((int)d.y, (int)yv.y, acc[p], false);
                asm volatile("" : "+v"(acc[p]));
                if ((p & 7) == 7) __builtin_amdgcn_sched_barrier(0);
            }
        }
#pragma unroll
        for (int p4 = 0; p4 < 32; ++p4) ((GAS i32x4*)F.ZP)[((size_t)(dr * 32 + p4)) * NTOK + t] = (i32x4){acc[4 * p4], acc[4 * p4 + 1], acc[4 * p4 + 2], acc[4 * p4 + 3]};
    }
    P8_WAITV0();
    __syncthreads();
}
__device__ __forceinline__ void p8h_gate(Frame& F) {
    const size_t gt = (size_t)F.vcu * 512 + F.tid, NT = (size_t)F.G * 512;
    for (size_t i = gt; i < (size_t)32 * NTOK; i += NT) {
        const int p4 = (int)(i >> 13), t = (int)(i & (NTOK - 1));
        i32x4 z = {0, 0, 0, 0};
#pragma unroll
        for (int dr = 0; dr < 16; ++dr) z += ((const GAS i32x4*)F.ZP)[((size_t)(dr * 32 + p4)) * NTOK + t];
        const v4u e4 = ((const GAS v4u*)F.EIDX)[i]; const f32x4 g4 = ((const GAS f32x4*)F.GATEQ)[i]; const float ys = F.YSC[t];
        v4u he;
#pragma unroll
        for (int c = 0; c < 4; ++c) { const float zz = (float)z[c] * ys * F.DSC[e4[c]]; const float hv = 0.5f * zz * (1.0f + erff(zz * 0.70710678118654752f)) * g4[c]; he[c] = (f2bf(hv) << 16) | e4[c]; }
        ((GAS v4u*)F.HE)[i] = he;
    }
}
template <int MODE  > __device__ __forceinline__ void p8b_spmm(Frame& F, float* dst) {
    for (int u = F.vcu; u < 256; u += F.G) {
        const int tg = u & 15, sr = u >> 4, t = tg * 512 + F.tid, b = t >> 11;
        unsigned he[128];
#pragma unroll
        for (int p4 = 0; p4 < 32; ++p4) { const v4u v = ((const GAS v4u*)F.HE)[(size_t)p4 * NTOK + t]; he[4 * p4] = v.x; he[4 * p4 + 1] = v.y; he[4 * p4 + 2] = v.z; he[4 * p4 + 3] = v.w; }
        const float* xrow = F.out + (size_t)t * DM; float* orow = dst + (size_t)t * DM; const float* g2 = F.MOD + b * NMOD + 5 * DM;
        for (int sg = 0; sg < 8; ++sg) {
            f32x2 acc[4][4];
#pragma unroll
            for (int k = 0; k < 4; ++k) {
                const int s = sr * 32 + sg * 4 + k;
#pragma unroll
                for (int i = 0; i < 128; ++i) asm volatile("" : "+v"(he[i]));
                P8_WAITV0();
                P8_BAR();
                if (MODE != 1) lds_fill_128k(F, F.UC8 + (size_t)s * 131072);
                P8_WAITV0();
                P8_BAR();
                if (MODE != 1 && (sg * 4 + k) + 1 < 32) __builtin_amdgcn_global_load_lds((const unsigned*)(F.UC8 + (size_t)(s + 1) * 131072 + (size_t)tg * 8192 + F.wave * 1024 + F.lane * 16), (LAS unsigned*)(F.lds + P8_DUMMY + F.wave * 1024), 16, 0, 0);
#pragma unroll
                for (int q = 0; q < 4; ++q) acc[k][q] = (f32x2){0.f, 0.f};
#pragma unroll
                for (int p = 0; p < (MODE == 2 ? 8 : 128); ++p) {
                    const v2u w = *(const LAS v2u*)(F.lds + ((he[p] & 0xffffu) << 3));
                    const float hv = __builtin_bit_cast(float, he[p] & 0xffff0000u); const f32x2 h2 = {hv, hv};
                    acc[k][0] += __builtin_amdgcn_cvt_pk_f32_fp8((int)w.x, false) * h2; acc[k][1] += __builtin_amdgcn_cvt_pk_f32_fp8((int)w.x, true) * h2;
                    acc[k][2] += __builtin_amdgcn_cvt_pk_f32_fp8((int)w.y, false) * h2; acc[k][3] += __builtin_amdgcn_cvt_pk_f32_fp8((int)w.y, true) * h2;
                    if ((p & 7) == 7) { asm volatile("" : "+v"(acc[k][0]), "+v"(acc[k][1]), "+v"(acc[k][2]), "+v"(acc[k][3])); __builtin_amdgcn_sched_barrier(0); }
                }
            }
            const int c0 = (sr * 32 + sg * 4) * 8;
#pragma unroll
            for (int k = 0; k < 4; ++k) {
                const f32x4 xa = *(const GAS f32x4*)(xrow + c0 + 8 * k), xb = *(const GAS f32x4*)(xrow + c0 + 8 * k + 4), ga = *(const GAS f32x4*)(g2 + c0 + 8 * k), gb = *(const GAS f32x4*)(g2 + c0 + 8 * k + 4);
                *(GAS f32x4*)(orow + c0 + 8 * k) = (f32x4){xa[0] + ga[0] * acc[k][0].x, xa[1] + ga[1] * acc[k][0].y, xa[2] + ga[2] * acc[k][1].x, xa[3] + ga[3] * acc[k][1].y};
                *(GAS f32x4*)(orow + c0 + 8 * k + 4) = (f32x4){xb[0] + gb[0] * acc[k][2].x, xb[1] + gb[1] * acc[k][2].y, xb[2] + gb[2] * acc[k][3].x, xb[3] + gb[3] * acc[k][3].y};
            }
        }
    }
    P8_WAITV0();
    __syncthreads();
}

struct Args { const float* in[18]; float* out; unsigned char* ws; int ph_lo, ph_hi; };
__global__ void __launch_bounds__(NWAVES * 64, 2) mega_fwd(Args args) {
    extern __shared__ __attribute__((aligned(16))) unsigned char lds[];
    Frame F;
    F.lds = (LAS unsigned char*)lds;
    F.MISC = (volatile LAS unsigned*)(F.lds + MISC_OFF);
    F.tid = threadIdx.x; F.lane = F.tid & 63; F.wave = __builtin_amdgcn_readfirstlane(F.tid >> 6);
    F.G = gridDim.x; { const int bx = blockIdx.x; F.vcu = (F.G % 8 == 0) ? (bx % 8) * (F.G / 8) + bx / 8 : bx; }
    unsigned char* ws = args.ws;
    F.ctl = (unsigned*)(ws + WS_CTL);
    F.x = args.in[0]; F.c = args.in[1]; F.w_ada = args.in[2]; F.b_ada = args.in[3]; F.w_in = args.in[4]; F.w_gate_up = args.in[5]; F.b_gla_gate = args.in[6]; F.gla_out_norm = args.in[7];
    F.swa_q_norm = args.in[8]; F.swa_k_norm = args.in[9]; F.swa_sinks = args.in[10]; F.swa_out_norm = args.in[11]; F.w_out = args.in[12]; F.w_peer_q = args.in[13];
    F.keys1 = args.in[14]; F.keys2 = args.in[15]; F.edown = args.in[16]; F.eup = args.in[17];
    F.out = args.out;
    F.MOD = (float*)(ws + WS_MOD); F.ROPE = (float*)(ws + WS_ROPE);
    F.BTIN = (bf16*)(ws + WS_BTIN); F.BTOUT = (bf16*)(ws + WS_BTOUT); F.BTQ = (bf16*)(ws + WS_BTQ); F.HBUF = (bf16*)(ws + WS_HBUF); F.PROJ = (bf16*)(ws + WS_PROJ);
    F.MIXIN = (bf16*)(ws + WS_MIXIN); F.QPEER = (bf16*)(ws + WS_QPEER);
    F.DC8 = ws + WS_DC8; F.UC8 = ws + WS_UC8; F.YC8 = ws + WS_YC8; F.ZP = (int*)(ws + WS_ZP); F.EIDX = (unsigned*)(ws + WS_EIDX); F.HE = (unsigned*)(ws + WS_HE);
    F.EIDX16 = (unsigned*)(ws + WS_EIDX16);
    F.GQT = (bf16*)(ws + WS_QPEER); F.GST = (bf16*)(ws + WS_YC8); F.GUT = (float*)(ws + WS_ZP); F.GG = (float*)(ws + WS_IDX); F.GATEQ = (float*)(ws + WS_GATEQ); F.DSC = (float*)(ws + WS_DSC); F.YSC = (float*)(ws + WS_YSC);
    for (int u = F.tid; u < (LDS_BYTES - LDSCTL_OFF) / 4; u += NWAVES * 64) ((LAS unsigned*)(F.lds + LDSCTL_OFF))[u] = 0u;
    __syncthreads();
    XcdBarrier bar; bar.bar = F.ctl + CW_BAR; bar.x = 0; bar.st = nullptr;
    if (N_LAUNCHES == 1) bar = xcd_barrier_post(F.ctl + CW_BAR, F.MISC + 8);
#define GRID_BAR() do { if (N_LAUNCHES == 1) xcd_barrier(bar); } while (0)
    const int lo = args.ph_lo, hi = args.ph_hi;
#define IN(k) (lo <= (k) && (k) < hi)
#define BOTH(k) (IN(k) && IN((k) + 1))

    if (PROBE_REP_PHASE == 20 && IN(0)) { p0a_ada(F); GRID_BAR(); }
    if (PROBE_REP_PHASE == 21 && IN(0)) { p0b_weights(F); GRID_BAR(); }
    if (PROBE_REP_PHASE == 22 && IN(0)) { p0c_tables(F); GRID_BAR(); }
    for (int rep_ = 0; rep_ < (PROBE_REP_PHASE == 0 ? 2 : 1); ++rep_) if (IN(0)) { p0_prologue(F); if (BOTH(0)) GRID_BAR(); }
    for (int rep_ = 0; rep_ < (PROBE_REP_PHASE == 1 ? 2 : 1); ++rep_) if (IN(1)) { modulate_rows(F, F.x, F.HBUF, 0, DM); if (BOTH(1)) GRID_BAR(); }
    for (int rep_ = 0; rep_ < (PROBE_REP_PHASE == 2 ? 2 : 1); ++rep_) if (IN(2)) {
        pg8::Gemm g{F.HBUF, F.BTIN, NTOK, NPROJ, DM}; pg8::StaticOrder S; S.init(NTOK, NPROJ, F.G, (int)blockIdx.x);
        pg8::EpiBf16 E{F.PROJ, NPROJ};
        pg8::gemm_phase<pg8::EpiBf16, pg8::StaticOrder, true, true>(F.lds, g, S, E);
        if (BOTH(2)) GRID_BAR();
    }
    for (int rep_ = 0; rep_ < (PROBE_REP_PHASE == 3 ? 2 : 1); ++rep_) if (IN(3)) { p3a_mixer(F); GRID_BAR(); gla_scan(F); GRID_BAR(); p3c_mixer(F); if (BOTH(3)) GRID_BAR(); }
    for (int rep_ = 0; rep_ < (PROBE_REP_PHASE == 4 ? 2 : 1); ++rep_) if (IN(4)) {
        pg8::Gemm g{F.MIXIN, F.BTOUT, NTOK, DM, DM}; pg8::StaticOrder S; S.init(NTOK, DM, F.G, (int)blockIdx.x);
        pg8::EpiResid E{F.x, F.out, DM, F.MOD + 2 * DM, NMOD, SEQ / 256};
        pg8::gemm_phase<pg8::EpiResid, pg8::StaticOrder, true, true>(F.lds, g, S, E);
        if (BOTH(4)) GRID_BAR();
    }
    for (int rep_ = 0; rep_ < (PROBE_REP_PHASE == 5 ? 2 : 1); ++rep_) if (IN(5)) { p5_modulate_quant(F); if (BOTH(5)) GRID_BAR(); }
    for (int rep_ = 0; rep_ < (PROBE_REP_PHASE == 6 ? 2 : 1); ++rep_) if (IN(6)) {
        pg8::Gemm g{F.HBUF, F.BTQ, NTOK, PEER_N, DM}; pg8::StaticOrder S; S.init(NTOK, PEER_N, F.G, (int)blockIdx.x);
        pg8::EpiBf16 E{F.QPEER, PEER_N};
        pg8::gemm_phase<pg8::EpiBf16, pg8::StaticOrder, true, true>(F.lds, g, S, E);
        if (BOTH(6)) GRID_BAR();
    }
    for (int rep_ = 0; rep_ < (PROBE_REP_PHASE == 7 ? 2 : 1); ++rep_) if (IN(7)) { p7_topk(F); if (BOTH(7)) GRID_BAR(); }
    for (int rep_ = 0; rep_ < (PROBE_REP_PHASE == 8 ? 2 : 1); ++rep_) if (IN(8)) { p8a_sddmm(F); if (BOTH(8)) GRID_BAR(); }
    for (int rep_ = 0; rep_ < (PROBE_REP_PHASE == 9 ? 2 : 1); ++rep_) if (IN(9)) { p8h_gate(F); if (BOTH(9)) GRID_BAR(); }
    if (PROBE_REP_PHASE == 10 && IN(10)) { p8b_spmm<0>(F, (float*)F.PROJ); GRID_BAR(); }
    if (PROBE_REP_PHASE == 11 && IN(10)) { p8b_spmm<1>(F, (float*)F.PROJ); GRID_BAR(); }
    if (PROBE_REP_PHASE == 12 && IN(10)) { p8b_spmm<2>(F, (float*)F.PROJ); GRID_BAR(); }
    if (IN(10)) { p8b_spmm<0>(F, F.out); }
#undef IN
#undef BOTH
}

extern "C" void kernel_launch(void* const* d_in, const int* in_sizes, int n_in, void* d_out, int out_size, void* d_ws, size_t ws_size, hipStream_t stream) {
    static int grid = 0;
    if (grid == 0) {
        if (n_in != 18 || out_size != NTOK * DM || ws_size < WS_END) { fprintf(stderr, "kernel_launch: unexpected shapes (n_in %d, out %d, ws %zu); nothing launched\n", n_in, out_size, ws_size); grid = -1; return; }
        int dev = 0, cus = 0, per_cu = 0;
        if (hipGetDevice(&dev) != hipSuccess || hipDeviceGetAttribute(&cus, hipDeviceAttributeMultiprocessorCount, dev) != hipSuccess) { grid = -1; return; }
        if (hipFuncSetAttribute((const void*)mega_fwd, hipFuncAttributeMaxDynamicSharedMemorySize, LDS_BYTES) != hipSuccess) { fprintf(stderr, "kernel_launch: hipFuncSetAttribute failed\n"); grid = -1; return; }
        if (hipOccupancyMaxActiveBlocksPerMultiprocessor(&per_cu, (const void*)mega_fwd, NWAVES * 64, LDS_BYTES) != hipSuccess || per_cu < 1)
            fprintf(stderr, "kernel_launch: note: occupancy query reports %d workgroups per CU\n", per_cu);
        (void)hipGetLastError();
        grid = cus;
    }
    if (grid < 0) return;
    (void)hipMemsetAsync((char*)d_ws + WS_CTL, 0, CTL_ZERO_BYTES, stream);
    Args a{};
    for (int i = 0; i < 18; ++i) a.in[i] = (const float*)d_in[i];
    a.out = (float*)d_out; a.ws = (unsigned char*)d_ws;
    if (N_LAUNCHES == 1) { a.ph_lo = 0; a.ph_hi = NPHASE; hipLaunchKernelGGL(mega_fwd, dim3(grid), dim3(NWAVES * 64), LDS_BYTES, stream, a); }
    else for (int p = 0; p < NPHASE; ++p) { a.ph_lo = p; a.ph_hi = p + 1; hipLaunchKernelGGL(mega_fwd, dim3(grid), dim3(NWAVES * 64), LDS_BYTES, stream, a); }
}
```

```cpp
#include <hip/hip_runtime.h>
#include <cstdio>
#include <cstdint>

#ifndef MK_N_LAUNCHES
#define MK_N_LAUNCHES 1
#endif
#ifndef PROBE_REP_PHASE
#define PROBE_REP_PHASE -1
#endif

#define GAS __attribute__((address_space(1)))
#define LAS __attribute__((address_space(3)))
typedef unsigned short bf16;
typedef unsigned v4u __attribute__((ext_vector_type(4)));
typedef unsigned v2u __attribute__((ext_vector_type(2)));
typedef float f32x4 __attribute__((ext_vector_type(4)));
typedef float f32x2 __attribute__((ext_vector_type(2)));
typedef float f32x16 __attribute__((ext_vector_type(16)));
typedef short bf16x8 __attribute__((ext_vector_type(8)));
using bf16x2 = __attribute__((ext_vector_type(2))) __bf16;

namespace pg8 {
#define PG8_LAS __attribute__((address_space(3)))
typedef unsigned short bf16_t;
typedef short bf16x8 __attribute__((ext_vector_type(8)));
typedef float f32x4 __attribute__((ext_vector_type(4)));
typedef unsigned u32x4 __attribute__((ext_vector_type(4)));
constexpr int BM = 256, BK = 64, HALF = 128, HTB = HALF * BK * 2, STAGE_BYTES = 8 * HTB, NXCD = 8, WGM = 8;

__host__ __device__ __forceinline__ int lds_byte(int r, int c) { const int st = (r >> 4) * 2 + (c >> 5), rr = r & 15, cc = c & 31, ob = rr * 64 + cc * 2; return st * 1024 + (ob ^ (((ob >> 9) & 1) << 5)); }
__host__ __device__ __forceinline__ void stage_rc(int b, int& R, int& C) { const int st = b / 1024, sb = b % 1024, swz = sb ^ (((sb >> 9) & 1) << 5); R = (st >> 1) * 16 + swz / 64; C = (st & 1) * 32 + (swz % 64) / 2; }
__host__ __device__ __forceinline__ int perm32(int rho) { const int n = rho >> 4, i = rho & 15; return 8 * (i >> 2) + 4 * n + (i & 3); }

struct Unit { int pm, pn; };
struct Gemm { const bf16_t* A; const bf16_t* Bt; int M, N, K; };

struct StaticOrder {
    int nM, nN, nwg, G, c;
    __host__ __device__ void init(int M, int N, int G_, int c_) { nM = M / BM; nN = N / BM; nwg = nM * nN; G = G_; c = c_; }
    __host__ __device__ bool next(int i, Unit& u) const {
        const long L = (long)i * G + c; if (L >= nwg) return false;
        int wgid = (int)L; { const int q = nwg / NXCD, r = nwg % NXCD, xcd = wgid % NXCD, off = wgid / NXCD; wgid = (xcd < r ? xcd * (q + 1) : r * (q + 1) + (xcd - r) * q) + off; }
        const int nig = WGM * nN, gid = wgid / nig, fm = gid * WGM, gsz = (nM - fm) < WGM ? (nM - fm) : WGM;
        u.pm = fm + ((wgid % nig) % gsz); u.pn = (wgid % nig) / gsz; return true;
    }
    __device__ __forceinline__ void a_ready(const Unit&) const {}
    __device__ __forceinline__ void done(const Unit&) const {}
};

__device__ __forceinline__ unsigned cvt_pk_bf16(float lo, float hi) { unsigned r; asm volatile("v_cvt_pk_bf16_f32 %0, %1, %2" : "=v"(r) : "v"(lo), "v"(hi)); return r; }

struct EpiBf16 {
    static constexpr bool PERM = true, AFTER_DRAIN = false;
    bf16_t* O; int ldc;
    __device__ __forceinline__ void operator()(const f32x4 (&acc)[2][2][4][2], const Unit& u, int wr, int wc, int fr, int fq) const {
        const int row0 = u.pm * BM + wr * 64 + fr; const int col0 = u.pn * BM + wc * 32 + 8 * fq;
#pragma unroll
        for (int ai = 0; ai < 2; ++ai)
#pragma unroll
            for (int m = 0; m < 4; ++m) { bf16_t* rowp = O + (size_t)(row0 + ai * HALF + m * 16) * ldc + col0;
#pragma unroll
                for (int bj = 0; bj < 2; ++bj) { const f32x4 v0 = acc[ai][bj][m][0], v1 = acc[ai][bj][m][1];
                    u32x4 w; w.x = cvt_pk_bf16(v0[0], v0[1]); w.y = cvt_pk_bf16(v0[2], v0[3]); w.z = cvt_pk_bf16(v1[0], v1[1]); w.w = cvt_pk_bf16(v1[2], v1[3]);
                    *(u32x4*)(rowp + bj * HALF) = w; } }
    }
};
struct EpiResid {
    static constexpr bool PERM = true, AFTER_DRAIN = false;
    const float* base; bf16_t* out; int ldc; const float* gate; int gate_stride; int tiles_per_batch;
    __device__ __forceinline__ void operator()(const f32x4 (&acc)[2][2][4][2], const Unit& u, int wr, int wc, int fr, int fq) const {
        const int row0 = u.pm * BM + wr * 64 + fr, col0 = u.pn * BM + wc * 32 + 8 * fq;
        const float* gp = gate + (size_t)(u.pm / tiles_per_batch) * gate_stride + col0;
        f32x4 gv[2][2];
#pragma unroll
        for (int bj = 0; bj < 2; ++bj)
#pragma unroll
            for (int n = 0; n < 2; ++n) gv[bj][n] = *(const f32x4*)(gp + bj * HALF + 4 * n);
#pragma unroll
        for (int ai = 0; ai < 2; ++ai)
#pragma unroll
            for (int m = 0; m < 4; ++m) { const size_t off = (size_t)(row0 + ai * HALF + m * 16) * ldc + col0;
#pragma unroll
                for (int bj = 0; bj < 2; ++bj) { const f32x4 b0 = *(const f32x4*)(base + off + bj * HALF), b1 = *(const f32x4*)(base + off + bj * HALF + 4);
                    const f32x4 v0 = b0 + gv[bj][0] * acc[ai][bj][m][0], v1 = b1 + gv[bj][1] * acc[ai][bj][m][1];
                    u32x4 w; w.x = cvt_pk_bf16(v0[0], v0[1]); w.y = cvt_pk_bf16(v0[2], v0[3]); w.z = cvt_pk_bf16(v1[0], v1[1]); w.w = cvt_pk_bf16(v1[2], v1[3]);
                    *(u32x4*)(out + off + bj * HALF) = w; } }
    }
};

template <class Epi, class Sched, bool ALIGN_EPI = false, bool SP2 = false>
__device__ __forceinline__ void gemm_phase(PG8_LAS unsigned char* lds, const Gemm g, const Sched& S, const Epi& E) {
    const int tid = threadIdx.x, wid = __builtin_amdgcn_readfirstlane(tid >> 6), lane = tid & 63, wr = wid >> 2, wc = wid & 3, fr = lane & 15, fq = lane >> 4;
    const int K = g.K, nt = K / BK;
    unsigned voffA[2], voffB[2];
#pragma unroll
    for (int i = 0; i < 2; ++i) { int R, C; stage_rc(tid * 16 + i * 8192, R, C); const int Rb = Epi::PERM ? ((R & ~31) + perm32(R & 31)) : R;
        voffA[i] = (unsigned)(R * K + C) * 2u; voffB[i] = (unsigned)(Rb * K + C) * 2u; }
    const size_t kstep = (size_t)(BK * 2);
    const size_t hstep = (size_t)HALF * K * 2;
    const size_t tstep = 2 * hstep;
    const unsigned ldsw = (unsigned)wid * 1024u;
    const int aoff = lds_byte(wr * 64 + fr, fq * 8), boff = lds_byte(wc * 32 + fr, fq * 8);
#define PG8_SA(b, h) (((b) * 2 + (h)) * HTB)
#define PG8_SB(b, h) ((4 + (b) * 2 + (h)) * HTB)
#define PG8_STAGE(bufoff, gbase, voff) do { const unsigned long long _g = (unsigned long long)(gbase); const unsigned _lo = __builtin_amdgcn_readfirstlane((unsigned)_g), _hi = __builtin_amdgcn_readfirstlane((unsigned)(_g >> 32)); \
        const char* _gb = (const char*)(((unsigned long long)_hi << 32) | _lo); _Pragma("unroll") for (int _i = 0; _i < 2; ++_i) \
        __builtin_amdgcn_global_load_lds((const unsigned*)(_gb + (size_t)_i * (size_t)(64 * K * 2) + (voff)[0]), (PG8_LAS unsigned*)(lds + (bufoff) + ldsw + _i * 8192), 16, 0, 0); } while (0)
#define PG8_LDA(dst, b, h) do { _Pragma("unroll") for (int m = 0; m < 4; ++m) _Pragma("unroll") for (int k = 0; k < 2; ++k) dst[m][k] = *(const PG8_LAS bf16x8*)(lds + PG8_SA(b, h) + aoff + m * 2048 + k * 1024); } while (0)
#define PG8_LDB(dst, b, h) do { _Pragma("unroll") for (int n = 0; n < 2; ++n) _Pragma("unroll") for (int k = 0; k < 2; ++k) dst[n][k] = *(const PG8_LAS bf16x8*)(lds + PG8_SB(b, h) + boff + n * 2048 + k * 1024); } while (0)
#define PG8_MMA(ai, bj, At, Bt) do { __builtin_amdgcn_s_setprio(1); _Pragma("unroll") for (int m = 0; m < 4; ++m) _Pragma("unroll") for (int n = 0; n < 2; ++n) _Pragma("unroll") for (int k = 0; k < 2; ++k) \
        acc[ai][bj][m][n] = __builtin_amdgcn_mfma_f32_16x16x32_bf16(Bt[n][k], At[m][k], acc[ai][bj][m][n], 0, 0, 0); __builtin_amdgcn_s_setprio(0); } while (0)
#define PG8_WAIT_V(n) asm volatile("s_waitcnt vmcnt(" #n ")" ::: "memory")
#define PG8_WAIT_L(n) asm volatile("s_waitcnt lgkmcnt(" #n ")" ::: "memory")
#define PG8_BAR __builtin_amdgcn_s_barrier()
#define PG8_SCHED __builtin_amdgcn_sched_barrier(0)
    Unit cur, nxt; int ui = 0;
    if (!S.next(0, cur)) return;
    f32x4 acc[2][2][4][2];
#pragma unroll
    for (int a = 0; a < 2; ++a)
#pragma unroll
        for (int b = 0; b < 2; ++b)
#pragma unroll
            for (int m = 0; m < 4; ++m)
#pragma unroll
                for (int n = 0; n < 2; ++n) acc[a][b][m][n] = (f32x4){0.f, 0.f, 0.f, 0.f};
    bf16x8 At[4][2], B0[2][2], B1[2][2];
    const char* cA = (const char*)g.A + (size_t)cur.pm * tstep; const char* cB = (const char*)g.Bt + (size_t)cur.pn * tstep;
    S.a_ready(cur);
    if constexpr (SP2) {
        PG8_STAGE(PG8_SB(0, 0), cB, voffB); PG8_STAGE(PG8_SB(0, 1), cB + hstep, voffB); PG8_STAGE(PG8_SA(0, 0), cA, voffA); PG8_STAGE(PG8_SA(0, 1), cA + hstep, voffA);
        if (wr == 1) PG8_BAR;
        PG8_WAIT_V(2); PG8_BAR;
        PG8_STAGE(PG8_SB(1, 0), cB + kstep, voffB); PG8_STAGE(PG8_SA(1, 0), cA + kstep, voffA); PG8_STAGE(PG8_SB(1, 1), cB + hstep + kstep, voffB);
        PG8_WAIT_V(6); PG8_BAR;
    } else {
        PG8_STAGE(PG8_SB(0, 0), cB, voffB); PG8_STAGE(PG8_SA(0, 0), cA, voffA); PG8_STAGE(PG8_SB(0, 1), cB + hstep, voffB); PG8_STAGE(PG8_SA(0, 1), cA + hstep, voffA);
        if (wr == 1) PG8_BAR;
        PG8_WAIT_V(4); PG8_BAR;
        PG8_STAGE(PG8_SB(1, 0), cB + kstep, voffB); PG8_STAGE(PG8_SA(1, 0), cA + kstep, voffA); PG8_STAGE(PG8_SB(1, 1), cB + hstep + kstep, voffB);
        PG8_WAIT_V(6); PG8_BAR;
    }
    for (;;) {
        const bool has_next = S.next(ui + 1, nxt);
        const char* nA = has_next ? (const char*)g.A + (size_t)nxt.pm * tstep : cA; const char* nB = has_next ? (const char*)g.Bt + (size_t)nxt.pn * tstep : cB;
        for (int t = 0; t < nt; t += 2) {
            const bool last = (t == nt - 2);
            const char* a1 = cA + (size_t)(t + 1) * kstep;
            const char* a2 = last ? nA : cA + (size_t)(t + 2) * kstep; const char* b2 = last ? nB : cB + (size_t)(t + 2) * kstep;
            const char* a3 = a2 + kstep; const char* b3 = b2 + kstep;
            if (last && has_next) S.a_ready(nxt);
            if constexpr (SP2) {
            PG8_LDB(B0, 0, 0); PG8_LDB(B1, 0, 1); PG8_SCHED; PG8_LDA(At, 0, 0); PG8_STAGE(PG8_SA(1, 1), a1 + hstep, voffA);
            PG8_WAIT_V(8); PG8_WAIT_L(0); PG8_BAR; PG8_MMA(0, 0, At, B0); PG8_MMA(0, 1, At, B1); PG8_BAR; PG8_SCHED;
            PG8_LDA(At, 0, 1); PG8_STAGE(PG8_SB(0, 0), b2, voffB); PG8_STAGE(PG8_SB(0, 1), b2 + hstep, voffB); PG8_STAGE(PG8_SA(0, 0), a2, voffA);
            PG8_WAIT_V(8); PG8_WAIT_L(0); PG8_BAR; PG8_MMA(1, 0, At, B0); PG8_MMA(1, 1, At, B1); PG8_BAR; PG8_SCHED;
            PG8_LDB(B0, 1, 0); PG8_LDB(B1, 1, 1); PG8_SCHED; PG8_LDA(At, 1, 0); PG8_STAGE(PG8_SA(0, 1), a2 + hstep, voffA);
            PG8_WAIT_V(8); PG8_WAIT_L(0); PG8_BAR; PG8_MMA(0, 0, At, B0); PG8_MMA(0, 1, At, B1); PG8_BAR; PG8_SCHED;
            PG8_LDA(At, 1, 1); PG8_STAGE(PG8_SB(1, 0), b3, voffB); PG8_STAGE(PG8_SB(1, 1), b3 + hstep, voffB); PG8_STAGE(PG8_SA(1, 0), a3, voffA);
            PG8_WAIT_V(8); PG8_WAIT_L(0); PG8_BAR; PG8_MMA(1, 0, At, B0); PG8_MMA(1, 1, At, B1); PG8_BAR; PG8_SCHED;
            } else {
            PG8_LDB(B0, 0, 0); PG8_SCHED; PG8_LDA(At, 0, 0); PG8_STAGE(PG8_SA(1, 1), a1 + hstep, voffA);
            PG8_WAIT_L(8); PG8_BAR; PG8_WAIT_L(0); PG8_MMA(0, 0, At, B0); PG8_BAR; PG8_SCHED;
            PG8_LDB(B1, 0, 1); PG8_STAGE(PG8_SB(0, 0), b2, voffB);
            PG8_BAR; PG8_WAIT_L(0); PG8_MMA(0, 1, At, B1); PG8_BAR;
            PG8_LDA(At, 0, 1); PG8_STAGE(PG8_SA(0, 0), a2, voffA);
            PG8_BAR; PG8_WAIT_L(0); PG8_MMA(1, 0, At, B0); PG8_BAR; PG8_SCHED;
            PG8_STAGE(PG8_SB(0, 1), b2 + hstep, voffB);
            PG8_WAIT_V(6); PG8_BAR; PG8_MMA(1, 1, At, B1); PG8_BAR;
            PG8_LDB(B0, 1, 0); PG8_SCHED; PG8_LDA(At, 1, 0); PG8_STAGE(PG8_SA(0, 1), a2 + hstep, voffA);
            PG8_WAIT_L(8); PG8_BAR; PG8_WAIT_L(0); PG8_MMA(0, 0, At, B0); PG8_BAR; PG8_SCHED;
            PG8_LDB(B1, 1, 1); PG8_STAGE(PG8_SB(1, 0), b3, voffB);
            PG8_BAR; PG8_WAIT_L(0); PG8_MMA(0, 1, At, B1); PG8_BAR;
            PG8_LDA(At, 1, 1); PG8_STAGE(PG8_SA(1, 0), a3, voffA);
            PG8_BAR; PG8_WAIT_L(0); PG8_MMA(1, 0, At, B0); PG8_BAR; PG8_SCHED;
            PG8_STAGE(PG8_SB(1, 1), b3 + hstep, voffB);
            PG8_WAIT_V(6); PG8_BAR; PG8_MMA(1, 1, At, B1); PG8_BAR;
            }
        }
        if constexpr (ALIGN_EPI) { if (wr == 0) PG8_BAR; }
        if constexpr (!Epi::AFTER_DRAIN) { E(acc, cur, wr, wc, fr, fq); S.done(cur); }
        if (!has_next) break;
#pragma unroll
        for (int a = 0; a < 2; ++a)
#pragma unroll
            for (int b = 0; b < 2; ++b)
#pragma unroll
                for (int m = 0; m < 4; ++m)
#pragma unroll
                    for (int n = 0; n < 2; ++n) acc[a][b][m][n] = (f32x4){0.f, 0.f, 0.f, 0.f};
        cur = nxt; cA = nA; cB = nB; ++ui;
        if constexpr (ALIGN_EPI) { if (wr == 1) PG8_BAR; }
    }
    PG8_WAIT_V(0);
    if constexpr (!ALIGN_EPI) { if (wr == 0) PG8_BAR; }
    PG8_BAR;
#undef PG8_SA
#undef PG8_SB
#undef PG8_STAGE
#undef PG8_LDA
#undef PG8_LDB
#undef PG8_MMA
#undef PG8_WAIT_V
#undef PG8_WAIT_L
#undef PG8_BAR
#undef PG8_SCHED
}
}

constexpr int NWAVES = 8;
constexpr int NPHASE = 11;
constexpr int N_LAUNCHES = MK_N_LAUNCHES;
constexpr int BATCH = 4, SEQ = 2048, DM = 4096, NTOK = BATCH * SEQ;
constexpr int NMOD = 6 * DM;
constexpr int IN_WIDTH = 8720;
constexpr int NPROJ = 8960;
constexpr int C_GQ = 0, C_GK = 1024, C_GV = 2048, C_GG = 4096, C_SQ = 6144, C_SK = 8192, C_SV = 8448, C_GA = 8704;
constexpr int NEXP = 16384, PEER_N = 2048;
constexpr float EPS = 1e-6f;

constexpr size_t MiB = 1u << 20;
constexpr size_t WS_CTL = 0, CTL_ZERO_BYTES = 1 * MiB;
constexpr size_t WS_MOD = 1 * MiB;
constexpr size_t WS_ROPE = 2 * MiB;
constexpr size_t WS_BTIN = 4 * MiB;
constexpr size_t WS_BTOUT = 74 * MiB;
constexpr size_t WS_BTQ = 106 * MiB;
constexpr size_t WS_HBUF = 122 * MiB;
constexpr size_t WS_PROJ = 186 * MiB;
constexpr size_t WS_MIXIN = 326 * MiB;
constexpr size_t WS_QPEER = 390 * MiB;
constexpr size_t WS_IDX = 422 * MiB;
constexpr size_t WS_GATE = 426 * MiB;
constexpr size_t WS_DC8 = 430 * MiB;
constexpr size_t WS_UC8 = 494 * MiB;
constexpr size_t WS_YC8 = 558 * MiB;
constexpr size_t WS_ZP = 590 * MiB;
constexpr size_t WS_EIDX = 654 * MiB;
constexpr size_t WS_GATEQ = 658 * MiB;
constexpr size_t WS_HE = 662 * MiB;
constexpr size_t WS_DSC = 666 * MiB;
constexpr size_t WS_YSC = 667 * MiB;
constexpr size_t WS_EIDX16 = 668 * MiB;
constexpr size_t WS_END = 670 * MiB;
constexpr int CW_BAR = 4096;

constexpr int RING_BYTES = 131072;
constexpr int LDSCTL_OFF = RING_BYTES, MISC_OFF = LDSCTL_OFF + 320;
constexpr int LDS_BYTES = 155648;

#define LDS_WAIT() asm volatile("s_waitcnt lgkmcnt(0)" ::: "memory")
#define VM_WAIT() asm volatile("s_waitcnt vmcnt(0)" ::: "memory")
__device__ __forceinline__ unsigned f2bf(float f) { unsigned u = __builtin_bit_cast(unsigned, f); return (u + 0x7fffu + ((u >> 16) & 1u)) >> 16; }
__device__ __forceinline__ unsigned pk2(float lo, float hi) { return f2bf(lo) | (f2bf(hi) << 16); }
__device__ __forceinline__ float bflo(unsigned w) { return __builtin_bit_cast(float, w << 16); }
__device__ __forceinline__ float bfhi(unsigned w) { return __builtin_bit_cast(float, w & 0xffff0000u); }
__device__ __forceinline__ float dot2_bf16(unsigned w, unsigned x, float acc) { return __builtin_amdgcn_fdot2_f32_bf16(__builtin_bit_cast(bf16x2, w), __builtin_bit_cast(bf16x2, x), acc, false); }
__device__ __forceinline__ f32x16 mfma32(bf16x8 a, bf16x8 b, f32x16 c) { return __builtin_amdgcn_mfma_f32_32x32x16_bf16(a, b, c, 0, 0, 0); }
__device__ __forceinline__ f32x4 mfma16(bf16x8 a, bf16x8 b, f32x4 c) { return __builtin_amdgcn_mfma_f32_16x16x32_bf16(a, b, c, 0, 0, 0); }
__device__ __forceinline__ bf16x8 mk8(unsigned a, unsigned b, unsigned c, unsigned d) { v4u t = {a, b, c, d}; return __builtin_bit_cast(bf16x8, t); }
__device__ __forceinline__ float silu_f(float x) { return x / (1.0f + __expf(-x)); }

#define XB_TMO      128
#define XB_XCNT(j)  (256  + 64 * (j))
#define XB_XSUB(j)  (1280 + 64 * (j))
#define XB_XGEN(j)  (2304 + 64 * (j))
#define XB_TOP      3328
#define XB_TOPGEN   3392
#define XCD_BAR_WORDS 3456
#define XB_SPIN_CAP (1u << 18)
__device__ __forceinline__ unsigned xb_ld(unsigned* p)              { return __hip_atomic_load(p, __ATOMIC_RELAXED, __HIP_MEMORY_SCOPE_AGENT); }
__device__ __forceinline__ unsigned xb_add(unsigned* p, unsigned v) { return __hip_atomic_fetch_add(p, v, __ATOMIC_RELAXED, __HIP_MEMORY_SCOPE_AGENT); }
__device__ __forceinline__ unsigned xb_xcc_id() { return (unsigned)__builtin_amdgcn_s_getreg((3 << 11) | 20) & 0xFu; }
#define XB_SPIN(cond, bar) do { unsigned _sp = 0; while (cond) { __builtin_amdgcn_s_sleep(1); \
    if ((++_sp & 255u) == 0u) { if (xb_ld(&(bar)[XB_TMO])) break; if (_sp > XB_SPIN_CAP) { atomicAdd(&(bar)[XB_TMO], 1u); break; } } } } while (0)
struct XcdBarrier { unsigned* bar; unsigned x; volatile LAS unsigned* st; };
__device__ __forceinline__ XcdBarrier xcd_barrier_post(unsigned* bar, volatile LAS unsigned* st) {
    XcdBarrier b; b.bar = bar; b.x = xb_xcc_id(); b.st = st;
    if (threadIdx.x == 0) (void)xb_add(&bar[XB_XCNT(b.x)], 1u);
    return b;
}
__device__ __forceinline__ void xcd_barrier_complete(unsigned* bar, unsigned x, unsigned& nloc, unsigned& nx) {
    const unsigned G = gridDim.x * gridDim.y * gridDim.z;
    unsigned sum, cnt, mine, sp = 0u;
    for (;;) {
        sum = 0u; cnt = 0u; mine = 0u;
#pragma unroll
        for (unsigned j = 0; j < 16; ++j) { const unsigned c = xb_ld(&bar[XB_XCNT(j)]); sum += c; cnt += (c > 0u) ? 1u : 0u; mine = (j == x) ? c : mine; }
        if (sum == G) break;
        __builtin_amdgcn_s_sleep(1);
        if ((++sp & 255u) == 0u) { if (xb_ld(&bar[XB_TMO])) break; if (sp > XB_SPIN_CAP) { atomicAdd(&bar[XB_TMO], 1u); break; } }
    }
    nloc = mine > 0u ? mine : 1u; nx = cnt > 0u ? cnt : 1u;
}
__device__ __forceinline__ void xcd_barrier(const XcdBarrier& b) {
    asm volatile("s_waitcnt vmcnt(0)" ::: "memory");
    __syncthreads();
    if (threadIdx.x == 0) {
        unsigned* bar = b.bar;
        __builtin_amdgcn_s_waitcnt(0);
        unsigned nloc = b.st[0], nx = b.st[1];
        if (nloc == 0u) { xcd_barrier_complete(bar, b.x, nloc, nx); b.st[0] = nloc; b.st[1] = nx; }
        const unsigned old = xb_add(&bar[XB_XSUB(b.x)], 1u);
        const unsigned gen = old / nloc;
        if (old + 1u == (gen + 1u) * nloc) {
            __builtin_amdgcn_fence(__ATOMIC_RELEASE, "agent");
            asm volatile("s_waitcnt vmcnt(0)" ::: "memory");
            const unsigned og = xb_add(&bar[XB_TOP], 1u);
            const unsigned tg = og / nx;
            if (og + 1u == (tg + 1u) * nx) xb_add(&bar[XB_TOPGEN], 1u);
            else XB_SPIN(xb_ld(&bar[XB_TOPGEN]) == tg, bar);
            __builtin_amdgcn_fence(__ATOMIC_ACQUIRE, "agent");
            xb_add(&bar[XB_XGEN(b.x)], 1u);
            asm volatile("s_waitcnt vmcnt(0)" ::: "memory");
        } else {
            XB_SPIN(xb_ld(&bar[XB_XGEN(b.x)]) == gen, bar);
            __builtin_amdgcn_fence(__ATOMIC_ACQUIRE, "agent");
            asm volatile("s_waitcnt vmcnt(0)" ::: "memory");
        }
    }
    __syncthreads();
}

struct Frame {
    LAS unsigned char* lds;
    volatile LAS unsigned* MISC;
    unsigned* ctl;
    int tid, lane, wave, vcu, G;
    const float *x, *c, *w_ada, *b_ada, *w_in, *w_gate_up, *b_gla_gate, *gla_out_norm, *swa_q_norm, *swa_k_norm, *swa_sinks, *swa_out_norm, *w_out, *w_peer_q, *keys1, *keys2, *edown, *eup;
    float* out;
    unsigned char* ws;
    float *MOD, *ROPE;
    bf16 *BTIN, *BTOUT, *BTQ, *HBUF, *PROJ, *MIXIN, *QPEER;
    unsigned char *DC8, *UC8, *YC8;
    int* ZP; unsigned *EIDX, *HE, *EIDX16; float *GATEQ, *DSC, *YSC;
    bf16 *GQT, *GST, *X1; float *GUT, *GG;
};

__device__ __forceinline__ float wave_sum(float v) {
#pragma unroll
    for (int o = 1; o < 64; o <<= 1) v += __shfl_xor(v, o);
    return v;
}
__device__ __forceinline__ float wave_max(float v) {
#pragma unroll
    for (int o = 1; o < 64; o <<= 1) v = fmaxf(v, __shfl_xor(v, o));
    return v;
}
__device__ __forceinline__ unsigned pack4i(float a, float b, float c, float d) {
    const int q0 = (int)__builtin_rintf(a), q1 = (int)__builtin_rintf(b), q2 = (int)__builtin_rintf(c), q3 = (int)__builtin_rintf(d);
    return (unsigned)(q0 & 255) | ((unsigned)(q1 & 255) << 8) | ((unsigned)(q2 & 255) << 16) | ((unsigned)q3 << 24);
}

__device__ __forceinline__ void p0_tr_item(const float* W, int ldw, int sc0, int ncols, bf16* WT, int dr0, int k0, LAS float* scr, int lane) {
    const int c4 = (lane & 7) * 4, kr = lane >> 3;
    f32x4 v[8];
#pragma unroll
    for (int i = 0; i < 8; ++i) v[i] = (c4 < ncols) ? *(const GAS f32x4*)(W + (size_t)(k0 + kr + 8 * i) * ldw + sc0 + c4) : (f32x4){0.f, 0.f, 0.f, 0.f};
#pragma unroll
    for (int i = 0; i < 8; ++i) { LAS float* d = scr + (kr + 8 * i) * 33 + c4; d[0] = v[i][0]; d[1] = v[i][1]; d[2] = v[i][2]; d[3] = v[i][3]; }
    LDS_WAIT(); asm volatile("" ::: "memory");
    const int c8 = lane & 7;
#pragma unroll
    for (int j = 0; j < 4; ++j) { const int n = (lane >> 3) + 8 * j; const LAS float* s = scr + (8 * c8) * 33 + n;
        v4u o; o.x = pk2(s[0 * 33], s[1 * 33]); o.y = pk2(s[2 * 33], s[3 * 33]); o.z = pk2(s[4 * 33], s[5 * 33]); o.w = pk2(s[6 * 33], s[7 * 33]);
        if (n < ncols) *(GAS v4u*)(WT + (size_t)(dr0 + n) * DM + k0 + 8 * c8) = o; }
    LDS_WAIT(); asm volatile("" ::: "memory");
}

__device__ __forceinline__ void p0a_ada(Frame& F) {
    const int tid = F.tid, lane = F.lane, wave = F.wave;
    {
        LAS f32x4* cact = (LAS f32x4*)F.lds;
        LAS float* red = (LAS float*)(F.lds + 65536);
        for (int k = tid; k < DM; k += 512) { f32x4 v;
#pragma unroll
            for (int b = 0; b < 4; ++b) { const float cv = F.c[b * DM + k]; v[b] = cv / (1.0f + expf(-cv)); }
            cact[k] = v; }
        __syncthreads();
        for (int slice = F.vcu; slice < 256; slice += F.G) {
            const int col0 = slice * 96, sub = lane / 24, cl = lane - sub * 24;
            f32x4 acc[4];
#pragma unroll
            for (int b = 0; b < 4; ++b) acc[b] = (f32x4){0.f, 0.f, 0.f, 0.f};
            if (lane < 48) {
                const float* wp = F.w_ada + col0 + 4 * cl;
#pragma unroll 16
                for (int k = wave * 2 + sub; k < DM; k += 16) {
                    const f32x4 w = *(const GAS f32x4*)(wp + (size_t)k * NMOD); const f32x4 cv = cact[k];
#pragma unroll
                    for (int b = 0; b < 4; ++b) acc[b] += w * cv[b];
                }
#pragma unroll
                for (int b = 0; b < 4; ++b) *(LAS f32x4*)(red + (wave * 48 + lane) * 16 + 4 * b) = acc[b];
            }
            __syncthreads();
            if (tid < 384) { const int b = tid / 96, col = tid - b * 96, cl2 = col >> 2, e = col & 3; float s = 0.f;
#pragma unroll
                for (int w = 0; w < 8; ++w) { s += red[(w * 48 + cl2) * 16 + 4 * b + e]; s += red[(w * 48 + 24 + cl2) * 16 + 4 * b + e]; }
                F.MOD[b * NMOD + col0 + col] = s + F.b_ada[col0 + col]; }
            __syncthreads();
        }
    }
}
__device__ __forceinline__ void p0b_weights(Frame& F) {
    const int tid = F.tid, lane = F.lane, wave = F.wave;
    const int gw = F.vcu * NWAVES + wave, NGW = F.G * NWAVES;
    {
        LAS float* scr = (LAS float*)(F.lds + wave * 16384);
        constexpr int NB0 = 192, NB1 = 80, NB2 = 1, NB3 = 128, NB4 = 64, NBT = NB0 + NB1 + NB2 + NB3 + NB4;
        for (int it = gw; it < NBT * 64; it += NGW) {
            int nb = it >> 6; const int k0 = (it & 63) * 64;
            if (nb < NB0) { p0_tr_item(F.w_in, IN_WIDTH, 32 * nb, 32, F.BTIN, 32 * nb, k0, scr, lane); continue; } nb -= NB0;
            if (nb < NB1) { p0_tr_item(F.w_in, IN_WIDTH, 6160 + 32 * nb, 32, F.BTIN, 6144 + 32 * nb, k0, scr, lane); continue; } nb -= NB1;
            if (nb < NB2) { p0_tr_item(F.w_in, IN_WIDTH, 6144, 16, F.BTIN, C_GA, k0, scr, lane); continue; } nb -= NB2;
            if (nb < NB3) { p0_tr_item(F.w_out, DM, 32 * nb, 32, F.BTOUT, 32 * nb, k0, scr, lane); continue; } nb -= NB3;
            p0_tr_item(F.w_peer_q, PEER_N, 32 * nb, 32, F.BTQ, 32 * nb, k0, scr, lane);
        }
        const size_t gt = (size_t)F.vcu * 512 + tid, NT = (size_t)F.G * 512;
        GAS v4u* z = (GAS v4u*)(F.BTIN + (size_t)(C_GA + 16) * DM);
        for (size_t i = gt; i < (size_t)240 * DM / 8; i += NT) z[i] = (v4u){0u, 0u, 0u, 0u};
        for (size_t e = gt; e < (size_t)SEQ * 32; e += NT) { const int pos = (int)(e >> 5), i = (int)(e & 31);
            const float inv = exp2f(-(float)i * (13.287712379549449f / 32.0f));
            const float ang = (float)pos * inv;
            const double rev = (double)ang * 0.15915494309189535; const float fr = (float)(rev - floor(rev));
            F.ROPE[e] = __builtin_amdgcn_cosf(fr); F.ROPE[SEQ * 32 + e] = __builtin_amdgcn_sinf(fr); }
    }
}
__device__ __forceinline__ void convert_expert_groups(Frame& F, int g_lo, int g_hi, int g_step) {
    const int tid = F.tid, lane = F.lane, wave = F.wave;
    __syncthreads();
    for (int tb = 0; tb < 2; ++tb) {
        const float* srcT = tb ? F.eup : F.edown; unsigned char* dstT = tb ? F.UC8 : F.DC8;
        for (int grp = g_lo; grp < g_hi; grp += g_step) {
            const int e0 = grp * 32;
#pragma unroll 1
            for (int r = 0; r < 4; ++r) {
                const int el = wave * 4 + r, e = e0 + el;
                const GAS f32x4* src = (const GAS f32x4*)(srcT + (size_t)e * DM);
                f32x4 a[8], b[8];
#pragma unroll
                for (int j = 0; j < 8; ++j) { a[j] = src[2 * (lane + 64 * j)]; b[j] = src[2 * (lane + 64 * j) + 1]; }
                if (tb == 0) {
                    float m = 0.f;
#pragma unroll
                    for (int j = 0; j < 8; ++j)
#pragma unroll
                        for (int q = 0; q < 4; ++q) m = fmaxf(m, fmaxf(fabsf(a[j][q]), fabsf(b[j][q])));
                    m = wave_max(m);
                    const float inv = m > 0.f ? 127.0f / m : 0.f;
                    if (lane == 0) F.DSC[e] = m * (1.0f / 127.0f);
#pragma unroll
                    for (int j = 0; j < 8; ++j) { v2u o; o.x = pack4i(a[j][0] * inv, a[j][1] * inv, a[j][2] * inv, a[j][3] * inv); o.y = pack4i(b[j][0] * inv, b[j][1] * inv, b[j][2] * inv, b[j][3] * inv);
                        *(LAS v2u*)(F.lds + el * 4096 + ((lane + 64 * j + el) & 511) * 8) = o; }
                } else {
#pragma unroll
                    for (int j = 0; j < 8; ++j) { int w0 = __builtin_amdgcn_cvt_pk_fp8_f32(a[j][0], a[j][1], 0, false); w0 = __builtin_amdgcn_cvt_pk_fp8_f32(a[j][2], a[j][3], w0, true);
                        int w1 = __builtin_amdgcn_cvt_pk_fp8_f32(b[j][0], b[j][1], 0, false); w1 = __builtin_amdgcn_cvt_pk_fp8_f32(b[j][2], b[j][3], w1, true);
                        v2u o; o.x = (unsigned)w0; o.y = (unsigned)w1;
                        *(LAS v2u*)(F.lds + el * 4096 + ((lane + 64 * j + el) & 511) * 8) = o; }
                }
            }
            __syncthreads();
            { const int el = tid & 31;
#pragma unroll 4
              for (int it = 0; it < 32; ++it) { const int sc = it * 16 + (tid >> 5);
                  const v2u o = *(const LAS v2u*)(F.lds + el * 4096 + ((sc + el) & 511) * 8);
                  *(GAS v2u*)(dstT + ((size_t)sc * NEXP + e0 + el) * 8) = o; } }
            __syncthreads();
        }
    }
}
constexpr int GEMM1_UNITS = (NTOK / 256) * (NPROJ / 256);
__host__ __device__ constexpr int tail_groups(int G) { return (GEMM1_UNITS % G) ? (512 - G > 0 ? 512 - G : 0) : 0; }
__device__ __forceinline__ void p0c_tables(Frame& F) {
    convert_expert_groups(F, tail_groups(F.G) + F.vcu, 512, F.G);
}
__device__ __forceinline__ void p0_prologue(Frame& F) { p0a_ada(F); p0b_weights(F); p0c_tables(F); }

__device__ __forceinline__ void modulate_rows(Frame& F, const float* src, bf16* dst, int sh_off, int sc_off) {
    const int gw = F.vcu * NWAVES + F.wave, NGW = F.G * NWAVES, lane = F.lane;
    for (int m = gw; m < NTOK; m += NGW) {
        const int b = m >> 11;
        const GAS f32x4* xr = (const GAS f32x4*)(src + (size_t)m * DM) + lane;
        f32x4 v[16]; float s = 0.f;
#pragma unroll
        for (int j = 0; j < 16; ++j) { v[j] = xr[64 * j]; s += (v[j].x * v[j].x + v[j].y * v[j].y) + (v[j].z * v[j].z + v[j].w * v[j].w); }
        const float rstd = 1.0f / sqrtf(wave_sum(s) * (1.0f / DM) + EPS);
        const GAS f32x4* shp = (const GAS f32x4*)(F.MOD + b * NMOD + sh_off) + lane;
        const GAS f32x4* scp = (const GAS f32x4*)(F.MOD + b * NMOD + sc_off) + lane;
        GAS v2u* o8 = (GAS v2u*)(dst + (size_t)m * DM) + lane;
#pragma unroll
        for (int j = 0; j < 16; ++j) { const f32x4 sh = shp[64 * j], sc = scp[64 * j]; const f32x4 y = v[j] * rstd * (sc + 1.0f) + sh;
            v2u o; o.x = pk2(y.x, y.y); o.y = pk2(y.z, y.w); o8[64 * j] = o; }
    }
}


__device__ __forceinline__ void p5_modulate_quant(Frame& F) {
    const int gw = F.vcu * NWAVES + F.wave, NGW = F.G * NWAVES, lane = F.lane;
    for (int m = gw; m < NTOK; m += NGW) {
        const int b = m >> 11;
        const GAS v4u* xr = (const GAS v4u*)(F.X1 + (size_t)m * DM);
        f32x4 a[8], c[8]; float s = 0.f;
#pragma unroll
        for (int j = 0; j < 8; ++j) { const v4u w = xr[lane + 64 * j]; a[j] = (f32x4){bflo(w.x), bfhi(w.x), bflo(w.y), bfhi(w.y)}; c[j] = (f32x4){bflo(w.z), bfhi(w.z), bflo(w.w), bfhi(w.w)};
            s += (a[j].x * a[j].x + a[j].y * a[j].y) + (a[j].z * a[j].z + a[j].w * a[j].w) + (c[j].x * c[j].x + c[j].y * c[j].y) + (c[j].z * c[j].z + c[j].w * c[j].w); }
        const float rstd = 1.0f / sqrtf(wave_sum(s) * (1.0f / DM) + EPS);
        const GAS f32x4* shp = (const GAS f32x4*)(F.MOD + b * NMOD + 3 * DM);
        const GAS f32x4* scp = (const GAS f32x4*)(F.MOD + b * NMOD + 4 * DM);
        float mx = 0.f;
#pragma unroll
        for (int j = 0; j < 8; ++j) { const int i0 = 2 * (lane + 64 * j);
            a[j] = a[j] * rstd * (scp[i0] + 1.0f) + shp[i0]; c[j] = c[j] * rstd * (scp[i0 + 1] + 1.0f) + shp[i0 + 1];
#pragma unroll
            for (int q = 0; q < 4; ++q) mx = fmaxf(mx, fmaxf(fabsf(a[j][q]), fabsf(c[j][q])));
            *(GAS v4u*)(F.HBUF + (size_t)m * DM + 8 * (lane + 64 * j)) = (v4u){pk2(a[j].x, a[j].y), pk2(a[j].z, a[j].w), pk2(c[j].x, c[j].y), pk2(c[j].z, c[j].w)}; }
        mx = wave_max(mx);
        const float inv = mx > 0.f ? 127.0f / mx : 0.f;
        if (lane == 0) F.YSC[m] = mx * (1.0f / 127.0f);
#pragma unroll
        for (int j = 0; j < 8; ++j) { v2u o; o.x = pack4i(a[j].x * inv, a[j].y * inv, a[j].z * inv, a[j].w * inv); o.y = pack4i(c[j].x * inv, c[j].y * inv, c[j].z * inv, c[j].w * inv);
            *(GAS v2u*)(F.YC8 + ((size_t)(lane + 64 * j) * NTOK + m) * 8) = o; }
    }
}

__device__ __forceinline__ void swa_unit(Frame& F, int u) {
    const int b = u >> 6, kvh = (u >> 4) & 3, n = u & 15, t0 = n * 128;
    LAS unsigned char* KL = F.lds;
    LAS unsigned char* VL = F.lds + 36864;
    const float* COS = F.ROPE; const float* SIN = F.ROPE + SEQ * 32;
    {
        const int key = F.tid >> 1, p = F.tid & 1, kpos = t0 - 128 + key;
        v4u ka[2] = {{0u, 0u, 0u, 0u}, {0u, 0u, 0u, 0u}}, kb[2] = {{0u, 0u, 0u, 0u}, {0u, 0u, 0u, 0u}}, vv[4] = {{0u, 0u, 0u, 0u}, {0u, 0u, 0u, 0u}, {0u, 0u, 0u, 0u}, {0u, 0u, 0u, 0u}};
        float cs[16], sn[16];
#pragma unroll
        for (int i = 0; i < 16; ++i) { cs[i] = 1.f; sn[i] = 0.f; }
        if (kpos >= 0) {
            const bf16* pr = F.PROJ + (size_t)(b * SEQ + kpos) * NPROJ;
            const GAS v4u* kr = (const GAS v4u*)(pr + C_SK + kvh * 64);
            ka[0] = kr[2 * p]; ka[1] = kr[2 * p + 1]; kb[0] = kr[4 + 2 * p]; kb[1] = kr[4 + 2 * p + 1];
            const GAS v4u* vr = (const GAS v4u*)(pr + C_SV + kvh * 64 + 32 * p);
#pragma unroll
            for (int j = 0; j < 4; ++j) vv[j] = vr[j];
            const GAS f32x4* cp = (const GAS f32x4*)(COS + kpos * 32 + 16 * p); const GAS f32x4* sp = (const GAS f32x4*)(SIN + kpos * 32 + 16 * p);
#pragma unroll
            for (int j = 0; j < 4; ++j) { const f32x4 c4 = cp[j], s4 = sp[j];
#pragma unroll
                for (int e = 0; e < 4; ++e) { cs[4 * j + e] = c4[e]; sn[4 * j + e] = s4[e]; } }
        }
        float x1[16], x2[16]; float ss = 0.f;
#pragma unroll
        for (int j = 0; j < 2; ++j)
#pragma unroll
            for (int e = 0; e < 4; ++e) { x1[8 * j + 2 * e] = bflo(ka[j][e]); x1[8 * j + 2 * e + 1] = bfhi(ka[j][e]); x2[8 * j + 2 * e] = bflo(kb[j][e]); x2[8 * j + 2 * e + 1] = bfhi(kb[j][e]); }
#pragma unroll
        for (int i = 0; i < 16; ++i) ss += x1[i] * x1[i] + x2[i] * x2[i];
        ss += __shfl_xor(ss, 1);
        const float rstd = 1.0f / sqrtf(ss * (1.0f / 64.0f) + EPS);
        unsigned o1[8], o2[8];
#pragma unroll
        for (int i = 0; i < 8; ++i) {
            float y1[2], y2[2];
#pragma unroll
            for (int e = 0; e < 2; ++e) { const int d = 2 * i + e; const float a = x1[d] * rstd * F.swa_k_norm[16 * p + d], c = x2[d] * rstd * F.swa_k_norm[32 + 16 * p + d];
                y1[e] = a * cs[d] - c * sn[d]; y2[e] = c * cs[d] + a * sn[d]; }
            o1[i] = pk2(y1[0], y1[1]); o2[i] = pk2(y2[0], y2[1]);
        }
        LAS v4u* kd = (LAS v4u*)(KL + key * 144 + 32 * p);
        kd[0] = (v4u){o1[0], o1[1], o1[2], o1[3]}; kd[1] = (v4u){o1[4], o1[5], o1[6], o1[7]};
        LAS v4u* kd2 = (LAS v4u*)(KL + key * 144 + 64 + 32 * p);
        kd2[0] = (v4u){o2[0], o2[1], o2[2], o2[3]}; kd2[1] = (v4u){o2[4], o2[5], o2[6], o2[7]};
#pragma unroll
        for (int j = 0; j < 4; ++j)
#pragma unroll
            for (int e = 0; e < 4; ++e) { const int d = 32 * p + 8 * j + 2 * e; const unsigned w = vv[j][e];
                *(LAS unsigned short*)(VL + d * 520 + key * 2) = (unsigned short)(w & 0xffffu);
                *(LAS unsigned short*)(VL + (d + 1) * 520 + key * 2) = (unsigned short)(w >> 16); }
    }
    __syncthreads();
    {
        const int g = F.wave, hq = kvh * 8 + g, r = F.lane & 31, h = F.lane >> 5;
        const float sink = F.swa_sinks[hq];
        for (int qt = 0; qt < 4; ++qt) {
            const int qpos = t0 + 32 * qt + r;
            const size_t tok = (size_t)(b * SEQ + qpos);
            const GAS v4u* qr = (const GAS v4u*)(F.PROJ + tok * NPROJ + C_SQ + hq * 64);
            v4u qraw[4];
#pragma unroll
            for (int kk = 0; kk < 4; ++kk) qraw[kk] = qr[2 * kk + h];
            float qf[4][8]; float ss = 0.f;
#pragma unroll
            for (int kk = 0; kk < 4; ++kk)
#pragma unroll
                for (int e = 0; e < 4; ++e) { qf[kk][2 * e] = bflo(qraw[kk][e]); qf[kk][2 * e + 1] = bfhi(qraw[kk][e]); }
#pragma unroll
            for (int kk = 0; kk < 4; ++kk)
#pragma unroll
                for (int j = 0; j < 8; ++j) ss += qf[kk][j] * qf[kk][j];
            ss += __shfl_xor(ss, 32);
            const float rstd = 0.125f / sqrtf(ss * (1.0f / 64.0f) + EPS);
            bf16x8 qfrag[4];
#pragma unroll
            for (int kk = 0; kk < 2; ++kk) {
                float y1[8], y2[8];
                const GAS f32x4* cp = (const GAS f32x4*)(COS + qpos * 32 + 16 * kk + 8 * h); const GAS f32x4* sp = (const GAS f32x4*)(SIN + qpos * 32 + 16 * kk + 8 * h);
                const f32x4 c0 = cp[0], c1 = cp[1], s0 = sp[0], s1 = sp[1];
#pragma unroll
                for (int j = 0; j < 8; ++j) { const int d = 16 * kk + 8 * h + j; const float cc = j < 4 ? c0[j & 3] : c1[j & 3], sv = j < 4 ? s0[j & 3] : s1[j & 3];
                    const float a = qf[kk][j] * rstd * F.swa_q_norm[d], c = qf[kk + 2][j] * rstd * F.swa_q_norm[d + 32];
                    y1[j] = a * cc - c * sv; y2[j] = c * cc + a * sv; }
                qfrag[kk] = mk8(pk2(y1[0], y1[1]), pk2(y1[2], y1[3]), pk2(y1[4], y1[5]), pk2(y1[6], y1[7]));
                qfrag[kk + 2] = mk8(pk2(y2[0], y2[1]), pk2(y2[2], y2[3]), pk2(y2[4], y2[5]), pk2(y2[6], y2[7]));
            }
            f32x16 sacc[5];
#pragma unroll
            for (int tt = 0; tt < 5; ++tt) { f32x16 a = {0.f, 0.f, 0.f, 0.f, 0.f, 0.f, 0.f, 0.f, 0.f, 0.f, 0.f, 0.f, 0.f, 0.f, 0.f, 0.f};
#pragma unroll
                for (int kk = 0; kk < 4; ++kk) { const bf16x8 kf = *(const LAS bf16x8*)(KL + (32 * (qt + tt) + r) * 144 + (16 * kk + 8 * h) * 2); a = mfma32(kf, qfrag[kk], a); }
                sacc[tt] = a; }
            float mx = sink;
#pragma unroll
            for (int tt = 0; tt < 5; ++tt)
#pragma unroll
                for (int i = 0; i < 16; ++i) { const int koff = (i & 3) + 8 * (i >> 2) + 4 * h; const int rel = r + 128 - 32 * tt - koff; const int kidx = 32 * (qt + tt) + koff;
                    const bool valid = (rel >= 0) && (rel < 128) && (t0 - 128 + kidx >= 0);
                    const float s = valid ? sacc[tt][i] : -INFINITY; sacc[tt][i] = s; mx = fmaxf(mx, s); }
            mx = fmaxf(mx, __shfl_xor(mx, 32));
            float sum = 0.f;
#pragma unroll
            for (int tt = 0; tt < 5; ++tt)
#pragma unroll
                for (int i = 0; i < 16; ++i) { const float pv = __expf(sacc[tt][i] - mx); sacc[tt][i] = pv; sum += pv; }
            sum += __shfl_xor(sum, 32);
            const float inv = 1.0f / (sum + __expf(sink - mx));
            f32x16 oacc[2];
#pragma unroll
            for (int dt = 0; dt < 2; ++dt) oacc[dt] = (f32x16){0.f, 0.f, 0.f, 0.f, 0.f, 0.f, 0.f, 0.f, 0.f, 0.f, 0.f, 0.f, 0.f, 0.f, 0.f, 0.f};
#pragma unroll
            for (int tt = 0; tt < 5; ++tt)
#pragma unroll
                for (int s2 = 0; s2 < 2; ++s2) {
                    const bf16x8 pf = mk8(pk2(sacc[tt][8 * s2], sacc[tt][8 * s2 + 1]), pk2(sacc[tt][8 * s2 + 2], sacc[tt][8 * s2 + 3]), pk2(sacc[tt][8 * s2 + 4], sacc[tt][8 * s2 + 5]), pk2(sacc[tt][8 * s2 + 6], sacc[tt][8 * s2 + 7]));
#pragma unroll
                    for (int dt = 0; dt < 2; ++dt) { const LAS unsigned char* vp = VL + (32 * dt + r) * 520 + (32 * (qt + tt) + 16 * s2 + 4 * h) * 2;
                        const v2u lo = *(const LAS v2u*)vp, hi = *(const LAS v2u*)(vp + 16);
                        oacc[dt] = mfma32(mk8(lo.x, lo.y, hi.x, hi.y), pf, oacc[dt]); }
                }
            float so = 0.f;
#pragma unroll
            for (int dt = 0; dt < 2; ++dt)
#pragma unroll
                for (int i = 0; i < 16; ++i) { const float o = oacc[dt][i] * inv; oacc[dt][i] = o; so += o * o; }
            so += __shfl_xor(so, 32);
            const float rs2 = 1.0f / sqrtf(so * (1.0f / 64.0f) + EPS);
            bf16* orow = F.MIXIN + tok * DM + 2048 + hq * 64;
#pragma unroll
            for (int dt = 0; dt < 2; ++dt)
#pragma unroll
                for (int gq = 0; gq < 4; ++gq) { const int d0 = 32 * dt + 8 * gq + 4 * h; const f32x4 gn = *(const GAS f32x4*)(F.swa_out_norm + d0);
                    v2u o; o.x = pk2(oacc[dt][4 * gq] * rs2 * gn[0], oacc[dt][4 * gq + 1] * rs2 * gn[1]); o.y = pk2(oacc[dt][4 * gq + 2] * rs2 * gn[2], oacc[dt][4 * gq + 3] * rs2 * gn[3]);
                    *(GAS v2u*)(orow + d0) = o; }
        }
    }
    __syncthreads();
}

constexpr int GL_QT = 0, GL_KT = 9216, GL_KHT = 18432, GL_VT = 27648, GL_WG = 46336, GL_BG = 50432, GL_OB = 50688;
__device__ __forceinline__ void gla_g1_units(Frame& F, int u0, int nu) {
    const int bh = u0 >> 5, b = bh >> 4, h = bh & 15, tid = F.tid, lane = F.lane, w = F.wave;
    LAS unsigned char* QT = F.lds + GL_QT;
    LAS unsigned char* KT = F.lds + GL_KT;
    LAS unsigned char* KHT = F.lds + GL_KHT;
    LAS unsigned char* VT = F.lds + GL_VT;
    LAS float* WG = (LAS float*)(F.lds + GL_WG);
    LAS float* BG = (LAS float*)(F.lds + GL_BG);
    LAS float* OB = (LAS float*)(F.lds + GL_OB);
    __syncthreads();
    for (int i = tid; i < 1024; i += 512) WG[i] = F.w_gate_up[(i >> 6) * 1024 + h * 64 + (i & 63)];
    if (tid < 64) BG[tid] = F.b_gla_gate[h * 64 + tid];
    __syncthreads();
    const int r = lane & 15, g = lane >> 4;
    const int t2 = tid >> 3, seg = tid & 7;
    v4u qv, kv, g0, g1, vv0, vv1;
    { const size_t row0 = (size_t)b * SEQ + (u0 & 31) * 64; const bf16* pr = F.PROJ + (row0 + lane) * NPROJ;
      qv = *(const GAS v4u*)(pr + C_GQ + h * 64 + 8 * w); kv = *(const GAS v4u*)(pr + C_GK + h * 64 + 8 * w); g0 = *(const GAS v4u*)(pr + C_GA); g1 = *(const GAS v4u*)(pr + C_GA + 8);
      const GAS v4u* vr = (const GAS v4u*)(F.PROJ + (row0 + t2) * NPROJ + C_GV + h * 128 + 16 * seg); vv0 = vr[0]; vv1 = vr[1]; }
    for (int ui = 0; ui < nu; ++ui) {
        const int u = u0 + ui, chunk = u & 31;
        const size_t row0 = (size_t)b * SEQ + chunk * 64;
        {
            float ga[16];
#pragma unroll
            for (int e = 0; e < 4; ++e) { ga[2 * e] = bflo(g0[e]); ga[2 * e + 1] = bfhi(g0[e]); ga[8 + 2 * e] = bflo(g1[e]); ga[8 + 2 * e + 1] = bfhi(g1[e]); }
            float z[8];
            { const f32x4 b0 = *(const LAS f32x4*)(BG + 8 * w), b1 = *(const LAS f32x4*)(BG + 8 * w + 4);
#pragma unroll
              for (int i = 0; i < 4; ++i) { z[i] = b0[i]; z[4 + i] = b1[i]; } }
#pragma unroll
            for (int j = 0; j < 16; ++j) { const f32x4 w0 = *(const LAS f32x4*)(WG + j * 64 + 8 * w), w1 = *(const LAS f32x4*)(WG + j * 64 + 8 * w + 4);
#pragma unroll
                for (int i = 0; i < 4; ++i) { z[i] += ga[j] * w0[i]; z[4 + i] += ga[j] * w1[i]; } }
            float bb[8];
#pragma unroll
            for (int i = 0; i < 8; ++i) { const float zz = z[i]; bb[i] = (fminf(zz, 0.f) - __logf(1.0f + __expf(-fabsf(zz)))) * (1.0f / 16.0f); }
#pragma unroll
            for (int off = 1; off < 64; off <<= 1)
#pragma unroll
                for (int i = 0; i < 8; ++i) { const float v = __shfl_up(bb[i], off); if (lane >= off) bb[i] += v; }
            float qn[8], kn[8], kh[8];
#pragma unroll
            for (int e = 0; e < 4; ++e) { qn[2 * e] = bflo(qv[e]); qn[2 * e + 1] = bfhi(qv[e]); kn[2 * e] = bflo(kv[e]); kn[2 * e + 1] = bfhi(kv[e]); }
#pragma unroll
            for (int i = 0; i < 8; ++i) { const float bl = __shfl(bb[i], 63); const float eb = __expf(bb[i]);
                qn[i] = qn[i] * 0.125f * eb; kh[i] = kn[i] * __expf(bl - bb[i]); kn[i] = kn[i] * __expf(-bb[i]);
                if (lane == 0) F.GG[(size_t)u * 64 + 8 * w + i] = __expf(bl); }
            const v4u qpk = {pk2(qn[0], qn[1]), pk2(qn[2], qn[3]), pk2(qn[4], qn[5]), pk2(qn[6], qn[7])};
            *(LAS v4u*)(QT + lane * 144 + 16 * w) = qpk;
            *(GAS v4u*)(F.GQT + ((size_t)u * 64 + lane) * 64 + 8 * w) = qpk;
            *(LAS v4u*)(KT + lane * 144 + 16 * w) = (v4u){pk2(kn[0], kn[1]), pk2(kn[2], kn[3]), pk2(kn[4], kn[5]), pk2(kn[6], kn[7])};
#pragma unroll
            for (int i = 0; i < 8; ++i) *(LAS unsigned short*)(KHT + (8 * w + i) * 144 + lane * 2) = (unsigned short)f2bf(kh[i]);
#pragma unroll
            for (int e = 0; e < 4; ++e) {
                *(LAS unsigned short*)(VT + (16 * seg + 2 * e) * 144 + t2 * 2) = (unsigned short)(vv0[e] & 0xffffu);
                *(LAS unsigned short*)(VT + (16 * seg + 2 * e + 1) * 144 + t2 * 2) = (unsigned short)(vv0[e] >> 16);
                *(LAS unsigned short*)(VT + (16 * seg + 8 + 2 * e) * 144 + t2 * 2) = (unsigned short)(vv1[e] & 0xffffu);
                *(LAS unsigned short*)(VT + (16 * seg + 8 + 2 * e + 1) * 144 + t2 * 2) = (unsigned short)(vv1[e] >> 16); }
        }
        if (ui + 1 < nu) {
            const size_t rown = row0 + 64; const bf16* pr = F.PROJ + (rown + lane) * NPROJ;
            qv = *(const GAS v4u*)(pr + C_GQ + h * 64 + 8 * w); kv = *(const GAS v4u*)(pr + C_GK + h * 64 + 8 * w); g0 = *(const GAS v4u*)(pr + C_GA); g1 = *(const GAS v4u*)(pr + C_GA + 8);
            const GAS v4u* vr = (const GAS v4u*)(F.PROJ + (rown + t2) * NPROJ + C_GV + h * 128 + 16 * seg); vv0 = vr[0]; vv1 = vr[1]; }
        __syncthreads();
        {
            unsigned dp[4][4][2];
#pragma unroll
            for (int tt = 0; tt < 4; ++tt) {
                const bf16x8 bq0 = *(const LAS bf16x8*)(QT + (16 * tt + r) * 144 + (8 * g) * 2), bq1 = *(const LAS bf16x8*)(QT + (16 * tt + r) * 144 + (32 + 8 * g) * 2);
#pragma unroll
                for (int st = 0; st < 4; ++st) {
                    if (st <= tt) {
                        const bf16x8 ak0 = *(const LAS bf16x8*)(KT + (16 * st + r) * 144 + (8 * g) * 2), ak1 = *(const LAS bf16x8*)(KT + (16 * st + r) * 144 + (32 + 8 * g) * 2);
                        f32x4 d = {0.f, 0.f, 0.f, 0.f}; d = mfma16(ak0, bq0, d); d = mfma16(ak1, bq1, d);
                        if (st == tt) {
#pragma unroll
                            for (int i = 0; i < 4; ++i) if (4 * g + i > r) d[i] = 0.f; }
                        dp[st][tt][0] = pk2(d[0], d[1]); dp[st][tt][1] = pk2(d[2], d[3]);
                    } else { dp[st][tt][0] = 0u; dp[st][tt][1] = 0u; }
                }
            }
#pragma unroll
            for (int tt = 0; tt < 4; ++tt) {
                f32x4 o = {0.f, 0.f, 0.f, 0.f};
#pragma unroll
                for (int kk = 0; kk < 2; ++kk) {
                    if (2 * kk <= tt) {
                        const LAS unsigned char* vp = VT + (16 * w + r) * 144 + (32 * kk + 4 * g) * 2;
                        const v2u lo = *(const LAS v2u*)vp, hi = *(const LAS v2u*)(vp + 32);
                        o = mfma16(mk8(dp[2 * kk][tt][0], dp[2 * kk][tt][1], dp[2 * kk + 1][tt][0], dp[2 * kk + 1][tt][1]), mk8(lo.x, lo.y, hi.x, hi.y), o);
                    }
                }
#pragma unroll
                for (int i = 0; i < 4; ++i) OB[(16 * tt + 4 * g + i) * 132 + 16 * w + r] = o[i];
            }
#pragma unroll
            for (int dt = 0; dt < 4; ++dt) {
                f32x4 uacc = {0.f, 0.f, 0.f, 0.f};
#pragma unroll
                for (int kk = 0; kk < 2; ++kk) { const bf16x8 a = *(const LAS bf16x8*)(KHT + (16 * dt + r) * 144 + (32 * kk + 8 * g) * 2), bv = *(const LAS bf16x8*)(VT + (16 * w + r) * 144 + (32 * kk + 8 * g) * 2);
                    uacc = mfma16(a, bv, uacc); }
                *(GAS f32x4*)(F.GUT + ((size_t)u * 128 + 16 * w + r) * 64 + 16 * dt + 4 * g) = uacc;
            }
        }
        __syncthreads();
        {
            unsigned ow[8];
#pragma unroll
            for (int j = 0; j < 4; ++j) { const f32x4 v = *(const LAS f32x4*)(OB + t2 * 132 + 16 * seg + 4 * j); ow[2 * j] = pk2(v[0], v[1]); ow[2 * j + 1] = pk2(v[2], v[3]); }
            GAS v4u* op = (GAS v4u*)(F.MIXIN + (row0 + t2) * DM + h * 128 + 16 * seg);
            op[0] = (v4u){ow[0], ow[1], ow[2], ow[3]}; op[1] = (v4u){ow[4], ow[5], ow[6], ow[7]};
        }
    }
}
__device__ __forceinline__ void gla_scan(Frame& F) {
    const size_t gt = (size_t)F.vcu * 512 + F.tid, NT = (size_t)F.G * 512;
    for (size_t i = gt; i < (size_t)64 * 128 * 16; i += NT) {
        const int bh = (int)(i >> 11), v = (int)((i >> 4) & 127), d4 = (int)(i & 15);
        f32x4 S = {0.f, 0.f, 0.f, 0.f};
#pragma unroll 8
        for (int c = 0; c < 32; ++c) {
            const size_t u = (size_t)bh * 32 + c;
            const f32x4 U = *(const GAS f32x4*)(F.GUT + (u * 128 + v) * 64 + 4 * d4), gg = *(const GAS f32x4*)(F.GG + u * 64 + 4 * d4);
            *(GAS v2u*)(F.GST + (u * 128 + v) * 64 + 4 * d4) = (v2u){pk2(S[0], S[1]), pk2(S[2], S[3])};
            S = gg * S + U;
        }
    }
}
struct G3Ops { v4u oi0, oi1, gg0, gg1; v2u slo[2], shi[2], qlo[4][2], qhi[4][2]; };
__device__ __forceinline__ void gla_g3_load(Frame& F, G3Ops& P, int u, int b, int h, int w, int r, int g, int t2, int seg) {
    const size_t row0 = (size_t)b * SEQ + (u & 31) * 64;
    const GAS v4u* oip = (const GAS v4u*)(F.MIXIN + (row0 + t2) * DM + h * 128 + 16 * seg); P.oi0 = oip[0]; P.oi1 = oip[1];
    const GAS v4u* gr = (const GAS v4u*)(F.PROJ + (row0 + t2) * NPROJ + C_GG + h * 128 + 16 * seg); P.gg0 = gr[0]; P.gg1 = gr[1];
#pragma unroll
    for (int kk = 0; kk < 2; ++kk) { const bf16* sp = F.GST + ((size_t)u * 128 + 16 * w + r) * 64 + 32 * kk + 4 * g; P.slo[kk] = *(const GAS v2u*)sp; P.shi[kk] = *(const GAS v2u*)(sp + 16); }
#pragma unroll
    for (int tt = 0; tt < 4; ++tt)
#pragma unroll
        for (int kk = 0; kk < 2; ++kk) { const bf16* qp = F.GQT + ((size_t)u * 64 + 16 * tt + r) * 64 + 32 * kk + 4 * g; P.qlo[tt][kk] = *(const GAS v2u*)qp; P.qhi[tt][kk] = *(const GAS v2u*)(qp + 16); }
}
__device__ __forceinline__ void gla_g3_units(Frame& F, int u0, int nu) {
    const int bh = u0 >> 5, b = bh >> 4, h = bh & 15, tid = F.tid, lane = F.lane, w = F.wave;
    LAS float* OB = (LAS float*)(F.lds + GL_OB);
    const int r = lane & 15, g = lane >> 4, t2 = tid >> 3, seg = tid & 7;
    __syncthreads();
    G3Ops cur, nxt;
    gla_g3_load(F, cur, u0, b, h, w, r, g, t2, seg);
    for (int ui = 0; ui < nu; ++ui) {
        const int u = u0 + ui, chunk = u & 31;
        const size_t row0 = (size_t)b * SEQ + chunk * 64;
        {
            bf16x8 bs[2];
#pragma unroll
            for (int kk = 0; kk < 2; ++kk) bs[kk] = mk8(cur.slo[kk].x, cur.slo[kk].y, cur.shi[kk].x, cur.shi[kk].y);
#pragma unroll
            for (int tt = 0; tt < 4; ++tt) {
                f32x4 o = {0.f, 0.f, 0.f, 0.f};
#pragma unroll
                for (int kk = 0; kk < 2; ++kk) o = mfma16(mk8(cur.qlo[tt][kk].x, cur.qlo[tt][kk].y, cur.qhi[tt][kk].x, cur.qhi[tt][kk].y), bs[kk], o);
#pragma unroll
                for (int i = 0; i < 4; ++i) OB[(16 * tt + 4 * g + i) * 132 + 16 * w + r] = o[i];
            }
        }
        if (ui + 1 < nu) gla_g3_load(F, nxt, u + 1, b, h, w, r, g, t2, seg);
        __syncthreads();
        {
            float o[16]; float ss = 0.f;
#pragma unroll
            for (int j = 0; j < 4; ++j) { const f32x4 v = *(const LAS f32x4*)(OB + t2 * 132 + 16 * seg + 4 * j);
#pragma unroll
                for (int e = 0; e < 4; ++e) o[4 * j + e] = v[e]; }
#pragma unroll
            for (int e = 0; e < 4; ++e) { o[2 * e] += bflo(cur.oi0[e]); o[2 * e + 1] += bfhi(cur.oi0[e]); o[8 + 2 * e] += bflo(cur.oi1[e]); o[8 + 2 * e + 1] += bfhi(cur.oi1[e]); }
#pragma unroll
            for (int e = 0; e < 16; ++e) ss += o[e] * o[e];
            ss += __shfl_xor(ss, 1); ss += __shfl_xor(ss, 2); ss += __shfl_xor(ss, 4);
            const float rstd = 1.0f / sqrtf(ss * (1.0f / 128.0f) + EPS);
            float gg[16];
#pragma unroll
            for (int e = 0; e < 4; ++e) { gg[2 * e] = bflo(cur.gg0[e]); gg[2 * e + 1] = bfhi(cur.gg0[e]); gg[8 + 2 * e] = bflo(cur.gg1[e]); gg[8 + 2 * e + 1] = bfhi(cur.gg1[e]); }
            unsigned ow[8];
#pragma unroll
            for (int e = 0; e < 8; ++e) { const float a = o[2 * e] * rstd * F.gla_out_norm[16 * seg + 2 * e] * silu_f(gg[2 * e]), c = o[2 * e + 1] * rstd * F.gla_out_norm[16 * seg + 2 * e + 1] * silu_f(gg[2 * e + 1]);
                ow[e] = pk2(a, c); }
            GAS v4u* op = (GAS v4u*)(F.MIXIN + (row0 + t2) * DM + h * 128 + 16 * seg);
            op[0] = (v4u){ow[0], ow[1], ow[2], ow[3]}; op[1] = (v4u){ow[4], ow[5], ow[6], ow[7]};
        }
        __syncthreads();
        cur = nxt;
    }
}

__device__ __forceinline__ void p3a_mixer(Frame& F) {
    for (int u = F.vcu; u < 256; u += F.G) swa_unit(F, u);
    for (int q = F.vcu; q < 256; q += F.G) gla_g1_units(F, q * 8, 8);
}
__device__ __forceinline__ void p3c_mixer(Frame& F) {
    for (int q = F.vcu; q < 256; q += F.G) gla_g3_units(F, q * 8, 8);
}

__device__ __forceinline__ unsigned f2s(float f) { const unsigned u = __builtin_bit_cast(unsigned, f); return (u & 0x80000000u) ? ~u : (u | 0x80000000u); }
__device__ __forceinline__ float s2f(unsigned s) { const unsigned u = (s & 0x80000000u) ? (s & 0x7fffffffu) : ~s; return __builtin_bit_cast(float, u); }
#define TOPK_INSERT(list, xin) do { unsigned _x = (xin); _Pragma("unroll") for (int _p = 0; _p < 16; ++_p) { const unsigned _hi = list[_p] > _x ? list[_p] : _x; _x = list[_p] > _x ? _x : list[_p]; list[_p] = _hi; } } while (0)

__device__ __forceinline__ void p7_topk(Frame& F) {
    const int tid = F.tid, lane = F.lane, wave = F.wave;
    LAS unsigned char* KY = F.lds;
    LAS unsigned* SC = (LAS unsigned*)(F.lds + 69632 + wave * 4096);
    for (int i = tid; i < 2 * 128 * 64; i += 512) { const int hf = i >> 13, key = (i >> 6) & 127, dp2 = i & 63;
        const float* kp = (hf ? F.keys2 : F.keys1) + key * 128 + 2 * dp2;
        *(LAS unsigned*)(KY + hf * 34816 + key * 272 + dp2 * 4) = pk2(kp[0], kp[1]); }
    __syncthreads();
    const int gw = F.vcu * NWAVES + wave, NGW = F.G * NWAVES;
    const int r = lane & 31, h = lane >> 5;
    for (int task = gw; task < 256 * 8; task += NGW) {
        const int tile = task >> 3, hd = task & 7, tok = tile * 32 + r;
        for (int hf = 0; hf < 2; ++hf) {
            const GAS v4u* qr = (const GAS v4u*)(F.QPEER + (size_t)tok * PEER_N + hd * 256 + hf * 128);
            bf16x8 qf[8];
#pragma unroll
            for (int kk = 0; kk < 8; ++kk) qf[kk] = __builtin_bit_cast(bf16x8, qr[2 * kk + h]);
            unsigned list[16];
#pragma unroll
            for (int p = 0; p < 16; ++p) list[p] = 0u;
#pragma unroll
            for (int T = 0; T < 4; ++T) {
                f32x16 a = {0.f, 0.f, 0.f, 0.f, 0.f, 0.f, 0.f, 0.f, 0.f, 0.f, 0.f, 0.f, 0.f, 0.f, 0.f, 0.f};
#pragma unroll
                for (int kk = 0; kk < 8; ++kk) { const bf16x8 kf = *(const LAS bf16x8*)(KY + hf * 34816 + (32 * T + r) * 272 + (16 * kk + 8 * h) * 2); a = mfma32(kf, qf[kk], a); }
#pragma unroll
                for (int i = 0; i < 16; ++i) { const int key = 32 * T + (i & 3) + 8 * (i >> 2) + 4 * h; const unsigned pkd = (f2s(a[i]) & ~127u) | (unsigned)(127 - key); TOPK_INSERT(list, pkd); }
            }
            unsigned other[16];
#pragma unroll
            for (int p = 0; p < 16; ++p) other[p] = (unsigned)__shfl_xor((int)list[p], 32);
#pragma unroll
            for (int p = 0; p < 16; ++p) TOPK_INSERT(list, other[p]);
            if (h == 0) {
#pragma unroll
                for (int p = 0; p < 16; ++p) SC[(hf * 16 + p) * 32 + r] = list[p]; }
        }
        LDS_WAIT(); asm volatile("" ::: "memory");
        float v1[16], v2[16];
#pragma unroll
        for (int p = 0; p < 16; ++p) { v1[p] = s2f(SC[p * 32 + r] & ~127u); v2[p] = s2f(SC[(16 + p) * 32 + r] & ~127u); }
        unsigned cl[16];
#pragma unroll
        for (int p = 0; p < 16; ++p) cl[p] = 0u;
#pragma unroll
        for (int i = 0; i < 16; ++i)
#pragma unroll
            for (int j = 0; j < 16; ++j) if ((i + 1) * (j + 1) <= 16) { const unsigned pkd = (f2s(v1[i] + v2[j]) & ~255u) | (unsigned)(255 - (i * 16 + j)); TOPK_INSERT(cl, pkd); }
        float val[8]; int eidx[8]; float mx = -INFINITY;
#pragma unroll
        for (int p = 0; p < 16; ++p) { const int pos = 255 - (int)(cl[p] & 255u), i = pos >> 4, j = pos & 15;
            const unsigned a = SC[i * 32 + r], b2 = SC[(16 + j) * 32 + r];
            const float v = s2f(a & ~127u) + s2f(b2 & ~127u); mx = fmaxf(mx, v);
            if ((p >> 3) == h) { val[p & 7] = v; eidx[p & 7] = (127 - (int)(a & 127u)) * 128 + (127 - (int)(b2 & 127u)); } }
        float sum = 0.f, ex[8];
#pragma unroll
        for (int p = 0; p < 8; ++p) { ex[p] = __expf(val[p] - mx); sum += ex[p]; }
        sum += __shfl_xor(sum, 32);
        const float inv = 1.0f / sum;
        const int p4a = hd * 4 + 2 * h;
        GAS v4u* ip = (GAS v4u*)F.EIDX; GAS f32x4* gp = (GAS f32x4*)F.GATEQ;
        ip[(size_t)p4a * NTOK + tok] = (v4u){(unsigned)eidx[0], (unsigned)eidx[1], (unsigned)eidx[2], (unsigned)eidx[3]}; ip[(size_t)(p4a + 1) * NTOK + tok] = (v4u){(unsigned)eidx[4], (unsigned)eidx[5], (unsigned)eidx[6], (unsigned)eidx[7]};
        ((GAS v4u*)F.EIDX16)[(size_t)(hd * 2 + h) * NTOK + tok] = (v4u){(unsigned)eidx[0] | ((unsigned)eidx[1] << 16), (unsigned)eidx[2] | ((unsigned)eidx[3] << 16), (unsigned)eidx[4] | ((unsigned)eidx[5] << 16), (unsigned)eidx[6] | ((unsigned)eidx[7] << 16)};
        gp[(size_t)p4a * NTOK + tok] = (f32x4){ex[0] * inv, ex[1] * inv, ex[2] * inv, ex[3] * inv}; gp[(size_t)(p4a + 1) * NTOK + tok] = (f32x4){ex[4] * inv, ex[5] * inv, ex[6] * inv, ex[7] * inv};
        LDS_WAIT(); asm volatile("" ::: "memory");
    }
}

typedef int i32x4 __attribute__((ext_vector_type(4)));
__device__ __forceinline__ void lds_fill_128k(Frame& F, const unsigned char* src) {
#pragma unroll
    for (int i = 0; i < 16; ++i)
        __builtin_amdgcn_global_load_lds((const unsigned*)(src + (size_t)(i * 512 + F.tid) * 16), (LAS unsigned*)(F.lds + i * 8192 + F.wave * 1024), 16, 0, 0);
}
constexpr int P8_ZOFF = 139264;
constexpr int P8_YB = 132096;
constexpr int P8_DUMMY = 140288;
#define P8_WAITV0() asm volatile("s_waitcnt vmcnt(0)" ::: "memory")
#define P8_BAR() do { asm volatile("s_waitcnt lgkmcnt(0)" ::: "memory"); __builtin_amdgcn_s_barrier(); asm volatile("" ::: "memory"); } while (0)
__device__ __forceinline__ void p8a_sddmm(Frame& F) {
    const int wv = F.wave;
    for (int u = F.vcu; u < 256; u += F.G) {
        const int tg = u & 15, dr = u >> 4, t = tg * 512 + F.tid;
        unsigned id[64];
#pragma unroll
        for (int p8 = 0; p8 < 16; ++p8) { const v4u v = ((const GAS v4u*)F.EIDX16)[(size_t)p8 * NTOK + t]; id[4 * p8] = v.x; id[4 * p8 + 1] = v.y; id[4 * p8 + 2] = v.z; id[4 * p8 + 3] = v.w; }
        int acc[128];
#pragma unroll
        for (int p = 0; p < 128; ++p) acc[p] = 0;
        const unsigned char* tab = F.DC8 + (size_t)(dr * 32) * 131072;
        const unsigned char* ysrc = F.YC8 + ((size_t)(dr * 32) * NTOK + tg * 512) * 8 + (wv & 3) * 1024 + F.lane * 16;
        for (int sl = 0; sl < 32; ++sl) {
#pragma unroll
            for (int i = 0; i < 64; ++i) asm volatile("" : "+v"(id[i]));
            P8_WAITV0();
            P8_BAR();
            lds_fill_128k(F, tab + (size_t)sl * 131072);
            if (wv < 4) __builtin_amdgcn_global_load_lds((const unsigned*)(ysrc + (size_t)sl * NTOK * 8), (LAS unsigned*)(F.lds + P8_YB + wv * 1024), 16, 0, 0);
            P8_WAITV0();
            P8_BAR();
            if (sl + 1 < 32) __builtin_amdgcn_global_load_lds((const unsigned*)(tab + (size_t)(sl + 1) * 131072 + (size_t)tg * 8192 + wv * 1024 + F.lane * 16), (LAS unsigned*)(F.lds + P8_DUMMY + wv * 1024), 16, 0, 0);
            const v2u yv = *(const LAS v2u*)(F.lds + P8_YB + F.tid * 8);
#pragma unroll
            for (int p = 0; p < 128; ++p) {
                const unsigned off = (p & 1) ? ((id[p >> 1] >> 13) & 0x7fff8u) : ((id[p >> 1] << 3) & 0x7fff8u);
                const v2u d = *(const LAS v2u*)(F.lds + off);
                acc[p] = __builtin_amdgcn_sdot4((int)d.x, (int)yv.x, acc[p], false);
                acc[p] = __builtin_amdgcn_sdot4((int)d.y, (int)yv.y, acc[p], false);
                asm volatile("" : "+v"(acc[p]));
                if ((p & 7) == 7) __builtin_amdgcn_sched_barrier(0);
            }
        }
#pragma unroll
        for (int p4 = 0; p4 < 32; ++p4) ((GAS i32x4*)F.ZP)[((size_t)(dr * 32 + p4)) * NTOK + t] = (i32x4){acc[4 * p4], acc[4 * p4 + 1], acc[4 * p4 + 2], acc[4 * p4 + 3]};
    }
    P8_WAITV0();
    __syncthreads();
}
__device__ __forceinline__ void p8h_gate(Frame& F) {
    const size_t gt = (size_t)F.vcu * 512 + F.tid, NT = (size_t)F.G * 512;
    for (size_t i = gt; i < (size_t)32 * NTOK; i += NT) {
        const int p4 = (int)(i >> 13), t = (int)(i & (NTOK - 1));
        i32x4 z = {0, 0, 0, 0};
#pragma unroll
        for (int dr = 0; dr < 16; ++dr) z += ((const GAS i32x4*)F.ZP)[((size_t)(dr * 32 + p4)) * NTOK + t];
        const v4u e4 = ((const GAS v4u*)F.EIDX)[i]; const f32x4 g4 = ((const GAS f32x4*)F.GATEQ)[i]; const float ys = F.YSC[t];
        v4u he;
#pragma unroll
        for (int c = 0; c < 4; ++c) { const float zz = (float)z[c] * ys * F.DSC[e4[c]]; const float hv = 0.5f * zz * (1.0f + erff(zz * 0.70710678118654752f)) * g4[c]; he[c] = ((f2bf(hv) << 16) & 0xfffe0000u) | (e4[c] << 3); }
        ((GAS v4u*)F.HE)[i] = he;
    }
}
template <int MODE  > __device__ __forceinline__ void p8b_spmm(Frame& F, float* dst) {
    for (int u = F.vcu; u < 256; u += F.G) {
        const int tg = u & 15, sr = u >> 4, t = tg * 512 + F.tid, b = t >> 11;
        unsigned he[128];
#pragma unroll
        for (int p4 = 0; p4 < 32; ++p4) { const v4u v = ((const GAS v4u*)F.HE)[(size_t)p4 * NTOK + t]; he[4 * p4] = v.x; he[4 * p4 + 1] = v.y; he[4 * p4 + 2] = v.z; he[4 * p4 + 3] = v.w; }
        const bf16* xrow = F.X1 + (size_t)t * DM; float* orow = dst + (size_t)t * DM; const float* g2 = F.MOD + b * NMOD + 5 * DM;
        for (int sg = 0; sg < 8; ++sg) {
            f32x2 acc[4][4];
#pragma unroll
            for (int k = 0; k < 4; ++k) {
                const int s = sr * 32 + sg * 4 + k;
#pragma unroll
                for (int i = 0; i < 128; ++i) asm volatile("" : "+v"(he[i]));
                P8_WAITV0();
                P8_BAR();
                if (MODE != 1) lds_fill_128k(F, F.UC8 + (size_t)s * 131072);
                P8_WAITV0();
                P8_BAR();
                if (MODE != 1 && (sg * 4 + k) + 1 < 32) __builtin_amdgcn_global_load_lds((const unsigned*)(F.UC8 + (size_t)(s + 1) * 131072 + (size_t)tg * 8192 + F.wave * 1024 + F.lane * 16), (LAS unsigned*)(F.lds + P8_DUMMY + F.wave * 1024), 16, 0, 0);
#pragma unroll
                for (int q = 0; q < 4; ++q) acc[k][q] = (f32x2){0.f, 0.f};
#pragma unroll
                for (int p = 0; p < (MODE == 2 ? 8 : 128); ++p) {
                    const v2u w = *(const LAS v2u*)(F.lds + (he[p] & 0x1fff8u));
                    const float hv = __builtin_bit_cast(float, he[p] & 0xfffe0000u); const f32x2 h2 = {hv, hv};
                    acc[k][0] += __builtin_amdgcn_cvt_pk_f32_fp8((int)w.x, false) * h2; acc[k][1] += __builtin_amdgcn_cvt_pk_f32_fp8((int)w.x, true) * h2;
                    acc[k][2] += __builtin_amdgcn_cvt_pk_f32_fp8((int)w.y, false) * h2; acc[k][3] += __builtin_amdgcn_cvt_pk_f32_fp8((int)w.y, true) * h2;
                    if ((p & 7) == 7) { asm volatile("" : "+v"(acc[k][0]), "+v"(acc[k][1]), "+v"(acc[k][2]), "+v"(acc[k][3])); __builtin_amdgcn_sched_barrier(0); }
                }
            }
            const int c0 = (sr * 32 + sg * 4) * 8;
#pragma unroll
            for (int k = 0; k < 4; ++k) {
                const v4u xw = *(const GAS v4u*)(xrow + c0 + 8 * k); const f32x4 xa = {bflo(xw.x), bfhi(xw.x), bflo(xw.y), bfhi(xw.y)}, xb = {bflo(xw.z), bfhi(xw.z), bflo(xw.w), bfhi(xw.w)};
                const f32x4 ga = *(const GAS f32x4*)(g2 + c0 + 8 * k), gb = *(const GAS f32x4*)(g2 + c0 + 8 * k + 4);
                *(GAS f32x4*)(orow + c0 + 8 * k) = (f32x4){xa[0] + ga[0] * acc[k][0].x, xa[1] + ga[1] * acc[k][0].y, xa[2] + ga[2] * acc[k][1].x, xa[3] + ga[3] * acc[k][1].y};
                *(GAS f32x4*)(orow + c0 + 8 * k + 4) = (f32x4){xb[0] + gb[0] * acc[k][2].x, xb[1] + gb[1] * acc[k][2].y, xb[2] + gb[2] * acc[k][3].x, xb[3] + gb[3] * acc[k][3].y};
            }
        }
    }
    P8_WAITV0();
    __syncthreads();
}

struct Args { const float* in[18]; float* out; unsigned char* ws; int ph_lo, ph_hi; };
__global__ void __launch_bounds__(NWAVES * 64, 2) mega_fwd(Args args) {
    extern __shared__ __attribute__((aligned(16))) unsigned char lds[];
    Frame F;
    F.lds = (LAS unsigned char*)lds;
    F.MISC = (volatile LAS unsigned*)(F.lds + MISC_OFF);
    F.tid = threadIdx.x; F.lane = F.tid & 63; F.wave = __builtin_amdgcn_readfirstlane(F.tid >> 6);
    F.G = gridDim.x; { const int bx = blockIdx.x; F.vcu = (F.G % 8 == 0) ? (bx % 8) * (F.G / 8) + bx / 8 : bx; }
    unsigned char* ws = args.ws;
    F.ctl = (unsigned*)(ws + WS_CTL);
    F.x = args.in[0]; F.c = args.in[1]; F.w_ada = args.in[2]; F.b_ada = args.in[3]; F.w_in = args.in[4]; F.w_gate_up = args.in[5]; F.b_gla_gate = args.in[6]; F.gla_out_norm = args.in[7];
    F.swa_q_norm = args.in[8]; F.swa_k_norm = args.in[9]; F.swa_sinks = args.in[10]; F.swa_out_norm = args.in[11]; F.w_out = args.in[12]; F.w_peer_q = args.in[13];
    F.keys1 = args.in[14]; F.keys2 = args.in[15]; F.edown = args.in[16]; F.eup = args.in[17];
    F.out = args.out; F.ws = ws;
    F.MOD = (float*)(ws + WS_MOD); F.ROPE = (float*)(ws + WS_ROPE);
    F.BTIN = (bf16*)(ws + WS_BTIN); F.BTOUT = (bf16*)(ws + WS_BTOUT); F.BTQ = (bf16*)(ws + WS_BTQ); F.HBUF = (bf16*)(ws + WS_HBUF); F.PROJ = (bf16*)(ws + WS_PROJ);
    F.MIXIN = (bf16*)(ws + WS_MIXIN); F.QPEER = (bf16*)(ws + WS_QPEER);
    F.DC8 = ws + WS_DC8; F.UC8 = ws + WS_UC8; F.YC8 = ws + WS_YC8; F.ZP = (int*)(ws + WS_ZP); F.EIDX = (unsigned*)(ws + WS_EIDX); F.HE = (unsigned*)(ws + WS_HE);
    F.EIDX16 = (unsigned*)(ws + WS_EIDX16);
    F.GQT = (bf16*)(ws + WS_QPEER); F.GST = (bf16*)(ws + WS_YC8); F.GUT = (float*)(ws + WS_ZP); F.GG = (float*)(ws + WS_IDX); F.X1 = (bf16*)(ws + WS_PROJ);   F.GATEQ = (float*)(ws + WS_GATEQ); F.DSC = (float*)(ws + WS_DSC); F.YSC = (float*)(ws + WS_YSC);
    for (int u = F.tid; u < (LDS_BYTES - LDSCTL_OFF) / 4; u += NWAVES * 64) ((LAS unsigned*)(F.lds + LDSCTL_OFF))[u] = 0u;
    __syncthreads();
    XcdBarrier bar; bar.bar = F.ctl + CW_BAR; bar.x = 0; bar.st = nullptr;
    if (N_LAUNCHES == 1) bar = xcd_barrier_post(F.ctl + CW_BAR, F.MISC + 8);
#define GRID_BAR() do { if (N_LAUNCHES == 1) xcd_barrier(bar); } while (0)
    const int lo = args.ph_lo, hi = args.ph_hi;
#define IN(k) (lo <= (k) && (k) < hi)
#define BOTH(k) (IN(k) && IN((k) + 1))

    if (PROBE_REP_PHASE == 20 && IN(0)) { p0a_ada(F); GRID_BAR(); }
    if (PROBE_REP_PHASE == 21 && IN(0)) { p0b_weights(F); GRID_BAR(); }
    if (PROBE_REP_PHASE == 22 && IN(0)) { p0c_tables(F); GRID_BAR(); }
    for (int rep_ = 0; rep_ < (PROBE_REP_PHASE == 0 ? 2 : 1); ++rep_) if (IN(0)) { p0_prologue(F); if (BOTH(0)) GRID_BAR(); }
    for (int rep_ = 0; rep_ < (PROBE_REP_PHASE == 1 ? 2 : 1); ++rep_) if (IN(1)) { modulate_rows(F, F.x, F.HBUF, 0, DM); if (BOTH(1)) GRID_BAR(); }
    for (int rep_ = 0; rep_ < (PROBE_REP_PHASE == 2 ? 2 : 1); ++rep_) if (IN(2)) {
        pg8::Gemm g{F.HBUF, F.BTIN, NTOK, NPROJ, DM}; pg8::StaticOrder S; S.init(NTOK, NPROJ, F.G, (int)blockIdx.x);
        pg8::EpiBf16 E{F.PROJ, NPROJ};
        pg8::gemm_phase<pg8::EpiBf16, pg8::StaticOrder, true, true>(F.lds, g, S, E);
        {
            const int G = F.G, rem = GEMM1_UNITS % G, tg = tail_groups(G), nidle = G - rem;
            if (rem != 0 && (int)blockIdx.x >= rem) convert_expert_groups(F, (int)blockIdx.x - rem, tg, nidle);
        }
        if (BOTH(2)) GRID_BAR();
    }
    for (int rep_ = 0; rep_ < (PROBE_REP_PHASE == 3 ? 2 : 1); ++rep_) if (IN(3)) { p3a_mixer(F); GRID_BAR(); gla_scan(F); GRID_BAR(); p3c_mixer(F); if (BOTH(3)) GRID_BAR(); }
    for (int rep_ = 0; rep_ < (PROBE_REP_PHASE == 4 ? 2 : 1); ++rep_) if (IN(4)) {
        pg8::Gemm g{F.MIXIN, F.BTOUT, NTOK, DM, DM}; pg8::StaticOrder S; S.init(NTOK, DM, F.G, (int)blockIdx.x);
        pg8::EpiResid E{F.x, F.X1, DM, F.MOD + 2 * DM, NMOD, SEQ / 256};
        pg8::gemm_phase<pg8::EpiResid, pg8::StaticOrder, true, true>(F.lds, g, S, E);
        if (BOTH(4)) GRID_BAR();
    }
    for (int rep_ = 0; rep_ < (PROBE_REP_PHASE == 5 ? 2 : 1); ++rep_) if (IN(5)) { p5_modulate_quant(F); if (BOTH(5)) GRID_BAR(); }
    for (int rep_ = 0; rep_ < (PROBE_REP_PHASE == 6 ? 2 : 1); ++rep_) if (IN(6)) {
        pg8::Gemm g{F.HBUF, F.BTQ, NTOK, PEER_N, DM}; pg8::StaticOrder S; S.init(NTOK, PEER_N, F.G, (int)blockIdx.x);
        pg8::EpiBf16 E{F.QPEER, PEER_N};
        pg8::gemm_phase<pg8::EpiBf16, pg8::StaticOrder, true, true>(F.lds, g, S, E);
        if (BOTH(6)) GRID_BAR();
    }
    for (int rep_ = 0; rep_ < (PROBE_REP_PHASE == 7 ? 2 : 1); ++rep_) if (IN(7)) { p7_topk(F); if (BOTH(7)) GRID_BAR(); }
    for (int rep_ = 0; rep_ < (PROBE_REP_PHASE == 8 ? 2 : 1); ++rep_) if (IN(8)) { p8a_sddmm(F); if (BOTH(8)) GRID_BAR(); }
    for (int rep_ = 0; rep_ < (PROBE_REP_PHASE == 9 ? 2 : 1); ++rep_) if (IN(9)) { p8h_gate(F); if (BOTH(9)) GRID_BAR(); }
    if (PROBE_REP_PHASE == 10 && IN(10)) { p8b_spmm<0>(F, (float*)(F.ws + WS_BTIN)); GRID_BAR(); }
    if (PROBE_REP_PHASE == 11 && IN(10)) { p8b_spmm<1>(F, (float*)F.PROJ); GRID_BAR(); }
    if (PROBE_REP_PHASE == 12 && IN(10)) { p8b_spmm<2>(F, (float*)F.PROJ); GRID_BAR(); }
    if (IN(10)) { p8b_spmm<0>(F, F.out); }
#undef IN
#undef BOTH
}

extern "C" void kernel_launch(void* const* d_in, const int* in_sizes, int n_in, void* d_out, int out_size, void* d_ws, size_t ws_size, hipStream_t stream) {
    static int grid = 0;
    if (grid == 0) {
        if (n_in != 18 || out_size != NTOK * DM || ws_size < WS_END) { fprintf(stderr, "kernel_launch: unexpected shapes (n_in %d, out %d, ws %zu); nothing launched\n", n_in, out_size, ws_size); grid = -1; return; }
        int dev = 0, cus = 0, per_cu = 0;
        if (hipGetDevice(&dev) != hipSuccess || hipDeviceGetAttribute(&cus, hipDeviceAttributeMultiprocessorCount, dev) != hipSuccess) { grid = -1; return; }
        if (hipFuncSetAttribute((const void*)mega_fwd, hipFuncAttributeMaxDynamicSharedMemorySize, LDS_BYTES) != hipSuccess) { fprintf(stderr, "kernel_launch: hipFuncSetAttribute failed\n"); grid = -1; return; }
        if (hipOccupancyMaxActiveBlocksPerMultiprocessor(&per_cu, (const void*)mega_fwd, NWAVES * 64, LDS_BYTES) != hipSuccess || per_cu < 1)
            fprintf(stderr, "kernel_launch: note: occupancy query reports %d workgroups per CU\n", per_cu);
        (void)hipGetLastError();
        grid = cus;
    }
    if (grid < 0) return;
    (void)hipMemsetAsync((char*)d_ws + WS_CTL, 0, CTL_ZERO_BYTES, stream);
    Args a{};
    for (int i = 0; i < 18; ++i) a.in[i] = (const float*)d_in[i];
    a.out = (float*)d_out; a.ws = (unsigned char*)d_ws;
    if (N_LAUNCHES == 1) { a.ph_lo = 0; a.ph_hi = NPHASE; hipLaunchKernelGGL(mega_fwd, dim3(grid), dim3(NWAVES * 64), LDS_BYTES, stream, a); }
    else for (int p = 0; p < NPHASE; ++p) { a.ph_lo = p; a.ph_hi = p + 1; hipLaunchKernelGGL(mega_fwd, dim3(grid), dim3(NWAVES * 64), LDS_BYTES, stream, a); }
}
```

```cpp
#include <hip/hip_runtime.h>
#include <cstdio>
#include <cstdint>

#ifndef MK_N_LAUNCHES
#define MK_N_LAUNCHES 1
#endif
#ifndef PROBE_REP_PHASE
#define PROBE_REP_PHASE -1
#endif

#define GAS __attribute__((address_space(1)))
#define LAS __attribute__((address_space(3)))
typedef unsigned short bf16;
typedef unsigned v4u __attribute__((ext_vector_type(4)));
typedef unsigned v2u __attribute__((ext_vector_type(2)));
typedef float f32x4 __attribute__((ext_vector_type(4)));
typedef float f32x2 __attribute__((ext_vector_type(2)));
typedef float f32x16 __attribute__((ext_vector_type(16)));
typedef short bf16x8 __attribute__((ext_vector_type(8)));
using bf16x2 = __attribute__((ext_vector_type(2))) __bf16;

namespace pg8 {
#define PG8_LAS __attribute__((address_space(3)))
typedef unsigned short bf16_t;
typedef short bf16x8 __attribute__((ext_vector_type(8)));
typedef float f32x4 __attribute__((ext_vector_type(4)));
typedef unsigned u32x4 __attribute__((ext_vector_type(4)));
constexpr int BM = 256, BK = 64, HALF = 128, HTB = HALF * BK * 2, STAGE_BYTES = 8 * HTB, NXCD = 8, WGM = 8;

__host__ __device__ __forceinline__ int lds_byte(int r, int c) { const int st = (r >> 4) * 2 + (c >> 5), rr = r & 15, cc = c & 31, ob = rr * 64 + cc * 2; return st * 1024 + (ob ^ (((ob >> 9) & 1) << 5)); }
__host__ __device__ __forceinline__ void stage_rc(int b, int& R, int& C) { const int st = b / 1024, sb = b % 1024, swz = sb ^ (((sb >> 9) & 1) << 5); R = (st >> 1) * 16 + swz / 64; C = (st & 1) * 32 + (swz % 64) / 2; }
__host__ __device__ __forceinline__ int perm32(int rho) { const int n = rho >> 4, i = rho & 15; return 8 * (i >> 2) + 4 * n + (i & 3); }

struct Unit { int pm, pn; };
struct Gemm { const bf16_t* A; const bf16_t* Bt; int M, N, K; };

struct StaticOrder {
    int nM, nN, nwg, G, c;
    __host__ __device__ void init(int M, int N, int G_, int c_) { nM = M / BM; nN = N / BM; nwg = nM * nN; G = G_; c = c_; }
    __host__ __device__ bool next(int i, Unit& u) const {
        const long L = (long)i * G + c; if (L >= nwg) return false;
        int wgid = (int)L; { const int q = nwg / NXCD, r = nwg % NXCD, xcd = wgid % NXCD, off = wgid / NXCD; wgid = (xcd < r ? xcd * (q + 1) : r * (q + 1) + (xcd - r) * q) + off; }
        const int nig = WGM * nN, gid = wgid / nig, fm = gid * WGM, gsz = (nM - fm) < WGM ? (nM - fm) : WGM;
        u.pm = fm + ((wgid % nig) % gsz); u.pn = (wgid % nig) / gsz; return true;
    }
    __device__ __forceinline__ void a_ready(const Unit&) const {}
    __device__ __forceinline__ void done(const Unit&) const {}
};

__device__ __forceinline__ unsigned cvt_pk_bf16(float lo, float hi) { unsigned r; asm volatile("v_cvt_pk_bf16_f32 %0, %1, %2" : "=v"(r) : "v"(lo), "v"(hi)); return r; }

struct EpiBf16 {
    static constexpr bool PERM = true, AFTER_DRAIN = false;
    bf16_t* O; int ldc;
    __device__ __forceinline__ void operator()(const f32x4 (&acc)[2][2][4][2], const Unit& u, int wr, int wc, int fr, int fq) const {
        const int row0 = u.pm * BM + wr * 64 + fr; const int col0 = u.pn * BM + wc * 32 + 8 * fq;
#pragma unroll
        for (int ai = 0; ai < 2; ++ai)
#pragma unroll
            for (int m = 0; m < 4; ++m) { bf16_t* rowp = O + (size_t)(row0 + ai * HALF + m * 16) * ldc + col0;
#pragma unroll
                for (int bj = 0; bj < 2; ++bj) { const f32x4 v0 = acc[ai][bj][m][0], v1 = acc[ai][bj][m][1];
                    u32x4 w; w.x = cvt_pk_bf16(v0[0], v0[1]); w.y = cvt_pk_bf16(v0[2], v0[3]); w.z = cvt_pk_bf16(v1[0], v1[1]); w.w = cvt_pk_bf16(v1[2], v1[3]);
                    *(u32x4*)(rowp + bj * HALF) = w; } }
    }
};
struct EpiResid {
    static constexpr bool PERM = true, AFTER_DRAIN = false;
    const float* base; bf16_t* out; int ldc; const float* gate; int gate_stride; int tiles_per_batch;
    __device__ __forceinline__ void operator()(const f32x4 (&acc)[2][2][4][2], const Unit& u, int wr, int wc, int fr, int fq) const {
        const int row0 = u.pm * BM + wr * 64 + fr, col0 = u.pn * BM + wc * 32 + 8 * fq;
        const float* gp = gate + (size_t)(u.pm / tiles_per_batch) * gate_stride + col0;
        f32x4 gv[2][2];
#pragma unroll
        for (int bj = 0; bj < 2; ++bj)
#pragma unroll
            for (int n = 0; n < 2; ++n) gv[bj][n] = *(const f32x4*)(gp + bj * HALF + 4 * n);
#pragma unroll
        for (int ai = 0; ai < 2; ++ai)
#pragma unroll
            for (int m = 0; m < 4; ++m) { const size_t off = (size_t)(row0 + ai * HALF + m * 16) * ldc + col0;
#pragma unroll
                for (int bj = 0; bj < 2; ++bj) { const f32x4 b0 = *(const f32x4*)(base + off + bj * HALF), b1 = *(const f32x4*)(base + off + bj * HALF + 4);
                    const f32x4 v0 = b0 + gv[bj][0] * acc[ai][bj][m][0], v1 = b1 + gv[bj][1] * acc[ai][bj][m][1];
                    u32x4 w; w.x = cvt_pk_bf16(v0[0], v0[1]); w.y = cvt_pk_bf16(v0[2], v0[3]); w.z = cvt_pk_bf16(v1[0], v1[1]); w.w = cvt_pk_bf16(v1[2], v1[3]);
                    *(u32x4*)(out + off + bj * HALF) = w; } }
    }
};

template <class Epi, class Sched, bool ALIGN_EPI = false, bool SP2 = false>
__device__ __forceinline__ void gemm_phase(PG8_LAS unsigned char* lds, const Gemm g, const Sched& S, const Epi& E) {
    const int tid = threadIdx.x, wid = __builtin_amdgcn_readfirstlane(tid >> 6), lane = tid & 63, wr = wid >> 2, wc = wid & 3, fr = lane & 15, fq = lane >> 4;
    const int K = g.K, nt = K / BK;
    unsigned voffA[2], voffB[2];
#pragma unroll
    for (int i = 0; i < 2; ++i) { int R, C; stage_rc(tid * 16 + i * 8192, R, C); const int Rb = Epi::PERM ? ((R & ~31) + perm32(R & 31)) : R;
        voffA[i] = (unsigned)(R * K + C) * 2u; voffB[i] = (unsigned)(Rb * K + C) * 2u; }
    const size_t kstep = (size_t)(BK * 2);
    const size_t hstep = (size_t)HALF * K * 2;
    const size_t tstep = 2 * hstep;
    const unsigned ldsw = (unsigned)wid * 1024u;
    const int aoff = lds_byte(wr * 64 + fr, fq * 8), boff = lds_byte(wc * 32 + fr, fq * 8);
#define PG8_SA(b, h) (((b) * 2 + (h)) * HTB)
#define PG8_SB(b, h) ((4 + (b) * 2 + (h)) * HTB)
#define PG8_STAGE(bufoff, gbase, voff) do { const unsigned long long _g = (unsigned long long)(gbase); const unsigned _lo = __builtin_amdgcn_readfirstlane((unsigned)_g), _hi = __builtin_amdgcn_readfirstlane((unsigned)(_g >> 32)); \
        const char* _gb = (const char*)(((unsigned long long)_hi << 32) | _lo); _Pragma("unroll") for (int _i = 0; _i < 2; ++_i) \
        __builtin_amdgcn_global_load_lds((const unsigned*)(_gb + (size_t)_i * (size_t)(64 * K * 2) + (voff)[0]), (PG8_LAS unsigned*)(lds + (bufoff) + ldsw + _i * 8192), 16, 0, 0); } while (0)
#define PG8_LDA(dst, b, h) do { _Pragma("unroll") for (int m = 0; m < 4; ++m) _Pragma("unroll") for (int k = 0; k < 2; ++k) dst[m][k] = *(const PG8_LAS bf16x8*)(lds + PG8_SA(b, h) + aoff + m * 2048 + k * 1024); } while (0)
#define PG8_LDB(dst, b, h) do { _Pragma("unroll") for (int n = 0; n < 2; ++n) _Pragma("unroll") for (int k = 0; k < 2; ++k) dst[n][k] = *(const PG8_LAS bf16x8*)(lds + PG8_SB(b, h) + boff + n * 2048 + k * 1024); } while (0)
#define PG8_MMA(ai, bj, At, Bt) do { __builtin_amdgcn_s_setprio(1); _Pragma("unroll") for (int m = 0; m < 4; ++m) _Pragma("unroll") for (int n = 0; n < 2; ++n) _Pragma("unroll") for (int k = 0; k < 2; ++k) \
        acc[ai][bj][m][n] = __builtin_amdgcn_mfma_f32_16x16x32_bf16(Bt[n][k], At[m][k], acc[ai][bj][m][n], 0, 0, 0); __builtin_amdgcn_s_setprio(0); } while (0)
#define PG8_WAIT_V(n) asm volatile("s_waitcnt vmcnt(" #n ")" ::: "memory")
#define PG8_WAIT_L(n) asm volatile("s_waitcnt lgkmcnt(" #n ")" ::: "memory")
#define PG8_BAR __builtin_amdgcn_s_barrier()
#define PG8_SCHED __builtin_amdgcn_sched_barrier(0)
    Unit cur, nxt; int ui = 0;
    if (!S.next(0, cur)) return;
    f32x4 acc[2][2][4][2];
#pragma unroll
    for (int a = 0; a < 2; ++a)
#pragma unroll
        for (int b = 0; b < 2; ++b)
#pragma unroll
            for (int m = 0; m < 4; ++m)
#pragma unroll
                for (int n = 0; n < 2; ++n) acc[a][b][m][n] = (f32x4){0.f, 0.f, 0.f, 0.f};
    bf16x8 At[4][2], B0[2][2], B1[2][2];
    const char* cA = (const char*)g.A + (size_t)cur.pm * tstep; const char* cB = (const char*)g.Bt + (size_t)cur.pn * tstep;
    S.a_ready(cur);
    if constexpr (SP2) {
        PG8_STAGE(PG8_SB(0, 0), cB, voffB); PG8_STAGE(PG8_SB(0, 1), cB + hstep, voffB); PG8_STAGE(PG8_SA(0, 0), cA, voffA); PG8_STAGE(PG8_SA(0, 1), cA + hstep, voffA);
        if (wr == 1) PG8_BAR;
        PG8_WAIT_V(2); PG8_BAR;
        PG8_STAGE(PG8_SB(1, 0), cB + kstep, voffB); PG8_STAGE(PG8_SA(1, 0), cA + kstep, voffA); PG8_STAGE(PG8_SB(1, 1), cB + hstep + kstep, voffB);
        PG8_WAIT_V(6); PG8_BAR;
    } else {
        PG8_STAGE(PG8_SB(0, 0), cB, voffB); PG8_STAGE(PG8_SA(0, 0), cA, voffA); PG8_STAGE(PG8_SB(0, 1), cB + hstep, voffB); PG8_STAGE(PG8_SA(0, 1), cA + hstep, voffA);
        if (wr == 1) PG8_BAR;
        PG8_WAIT_V(4); PG8_BAR;
        PG8_STAGE(PG8_SB(1, 0), cB + kstep, voffB); PG8_STAGE(PG8_SA(1, 0), cA + kstep, voffA); PG8_STAGE(PG8_SB(1, 1), cB + hstep + kstep, voffB);
        PG8_WAIT_V(6); PG8_BAR;
    }
    for (;;) {
        const bool has_next = S.next(ui + 1, nxt);
        const char* nA = has_next ? (const char*)g.A + (size_t)nxt.pm * tstep : cA; const char* nB = has_next ? (const char*)g.Bt + (size_t)nxt.pn * tstep : cB;
        for (int t = 0; t < nt; t += 2) {
            const bool last = (t == nt - 2);
            const char* a1 = cA + (size_t)(t + 1) * kstep;
            const char* a2 = last ? nA : cA + (size_t)(t + 2) * kstep; const char* b2 = last ? nB : cB + (size_t)(t + 2) * kstep;
            const char* a3 = a2 + kstep; const char* b3 = b2 + kstep;
            if (last && has_next) S.a_ready(nxt);
            if constexpr (SP2) {
            PG8_LDB(B0, 0, 0); PG8_LDB(B1, 0, 1); PG8_SCHED; PG8_LDA(At, 0, 0); PG8_STAGE(PG8_SA(1, 1), a1 + hstep, voffA);
            PG8_WAIT_V(8); PG8_WAIT_L(0); PG8_BAR; PG8_MMA(0, 0, At, B0); PG8_MMA(0, 1, At, B1); PG8_BAR; PG8_SCHED;
            PG8_LDA(At, 0, 1); PG8_STAGE(PG8_SB(0, 0), b2, voffB); PG8_STAGE(PG8_SB(0, 1), b2 + hstep, voffB); PG8_STAGE(PG8_SA(0, 0), a2, voffA);
            PG8_WAIT_V(8); PG8_WAIT_L(0); PG8_BAR; PG8_MMA(1, 0, At, B0); PG8_MMA(1, 1, At, B1); PG8_BAR; PG8_SCHED;
            PG8_LDB(B0, 1, 0); PG8_LDB(B1, 1, 1); PG8_SCHED; PG8_LDA(At, 1, 0); PG8_STAGE(PG8_SA(0, 1), a2 + hstep, voffA);
            PG8_WAIT_V(8); PG8_WAIT_L(0); PG8_BAR; PG8_MMA(0, 0, At, B0); PG8_MMA(0, 1, At, B1); PG8_BAR; PG8_SCHED;
            PG8_LDA(At, 1, 1); PG8_STAGE(PG8_SB(1, 0), b3, voffB); PG8_STAGE(PG8_SB(1, 1), b3 + hstep, voffB); PG8_STAGE(PG8_SA(1, 0), a3, voffA);
            PG8_WAIT_V(8); PG8_WAIT_L(0); PG8_BAR; PG8_MMA(1, 0, At, B0); PG8_MMA(1, 1, At, B1); PG8_BAR; PG8_SCHED;
            } else {
            PG8_LDB(B0, 0, 0); PG8_SCHED; PG8_LDA(At, 0, 0); PG8_STAGE(PG8_SA(1, 1), a1 + hstep, voffA);
            PG8_WAIT_L(8); PG8_BAR; PG8_WAIT_L(0); PG8_MMA(0, 0, At, B0); PG8_BAR; PG8_SCHED;
            PG8_LDB(B1, 0, 1); PG8_STAGE(PG8_SB(0, 0), b2, voffB);
            PG8_BAR; PG8_WAIT_L(0); PG8_MMA(0, 1, At, B1); PG8_BAR;
            PG8_LDA(At, 0, 1); PG8_STAGE(PG8_SA(0, 0), a2, voffA);
            PG8_BAR; PG8_WAIT_L(0); PG8_MMA(1, 0, At, B0); PG8_BAR; PG8_SCHED;
            PG8_STAGE(PG8_SB(0, 1), b2 + hstep, voffB);
            PG8_WAIT_V(6); PG8_BAR; PG8_MMA(1, 1, At, B1); PG8_BAR;
            PG8_LDB(B0, 1, 0); PG8_SCHED; PG8_LDA(At, 1, 0); PG8_STAGE(PG8_SA(0, 1), a2 + hstep, voffA);
            PG8_WAIT_L(8); PG8_BAR; PG8_WAIT_L(0); PG8_MMA(0, 0, At, B0); PG8_BAR; PG8_SCHED;
            PG8_LDB(B1, 1, 1); PG8_STAGE(PG8_SB(1, 0), b3, voffB);
            PG8_BAR; PG8_WAIT_L(0); PG8_MMA(0, 1, At, B1); PG8_BAR;
            PG8_LDA(At, 1, 1); PG8_STAGE(PG8_SA(1, 0), a3, voffA);
            PG8_BAR; PG8_WAIT_L(0); PG8_MMA(1, 0, At, B0); PG8_BAR; PG8_SCHED;
            PG8_STAGE(PG8_SB(1, 1), b3 + hstep, voffB);
            PG8_WAIT_V(6); PG8_BAR; PG8_MMA(1, 1, At, B1); PG8_BAR;
            }
        }
        if constexpr (ALIGN_EPI) { if (wr == 0) PG8_BAR; }
        if constexpr (!Epi::AFTER_DRAIN) { E(acc, cur, wr, wc, fr, fq); S.done(cur); }
        if (!has_next) break;
#pragma unroll
        for (int a = 0; a < 2; ++a)
#pragma unroll
            for (int b = 0; b < 2; ++b)
#pragma unroll
                for (int m = 0; m < 4; ++m)
#pragma unroll
                    for (int n = 0; n < 2; ++n) acc[a][b][m][n] = (f32x4){0.f, 0.f, 0.f, 0.f};
        cur = nxt; cA = nA; cB = nB; ++ui;
        if constexpr (ALIGN_EPI) { if (wr == 1) PG8_BAR; }
    }
    PG8_WAIT_V(0);
    if constexpr (!ALIGN_EPI) { if (wr == 0) PG8_BAR; }
    PG8_BAR;
#undef PG8_SA
#undef PG8_SB
#undef PG8_STAGE
#undef PG8_LDA
#undef PG8_LDB
#undef PG8_MMA
#undef PG8_WAIT_V
#undef PG8_WAIT_L
#undef PG8_BAR
#undef PG8_SCHED
}
}

constexpr int NWAVES = 8;
constexpr int NPHASE = 11;
constexpr int N_LAUNCHES = MK_N_LAUNCHES;
constexpr int BATCH = 4, SEQ = 2048, DM = 4096, NTOK = BATCH * SEQ;
constexpr int NMOD = 6 * DM;
constexpr int IN_WIDTH = 8720;
constexpr int NPROJ = 8960;
constexpr int C_GQ = 0, C_GK = 1024, C_GV = 2048, C_GG = 4096, C_SQ = 6144, C_SK = 8192, C_SV = 8448, C_GA = 8704;
constexpr int NEXP = 16384, PEER_N = 2048;
constexpr float EPS = 1e-6f;

constexpr size_t MiB = 1u << 20;
constexpr size_t WS_CTL = 0, CTL_ZERO_BYTES = 1 * MiB;
constexpr size_t WS_MOD = 1 * MiB;
constexpr size_t WS_ROPE = 2 * MiB;
constexpr size_t WS_BTIN = 4 * MiB;
constexpr size_t WS_BTOUT = 74 * MiB;
constexpr size_t WS_BTQ = 106 * MiB;
constexpr size_t WS_HBUF = 122 * MiB;
constexpr size_t WS_PROJ = 186 * MiB;
constexpr size_t WS_MIXIN = 326 * MiB;
constexpr size_t WS_QPEER = 390 * MiB;
constexpr size_t WS_IDX = 422 * MiB;
constexpr size_t WS_GATE = 426 * MiB;
constexpr size_t WS_DC8 = 430 * MiB;
constexpr size_t WS_UC8 = 494 * MiB;
constexpr size_t WS_YC8 = 558 * MiB;
constexpr size_t WS_ZP = 590 * MiB;
constexpr size_t WS_EIDX = 654 * MiB;
constexpr size_t WS_GATEQ = 658 * MiB;
constexpr size_t WS_HE = 662 * MiB;
constexpr size_t WS_DSC = 666 * MiB;
constexpr size_t WS_YSC = 667 * MiB;
constexpr size_t WS_EIDX16 = 668 * MiB;
constexpr size_t WS_END = 670 * MiB;
constexpr int CW_BAR = 4096;

constexpr int RING_BYTES = 131072;
constexpr int LDSCTL_OFF = RING_BYTES, MISC_OFF = LDSCTL_OFF + 320;
constexpr int LDS_BYTES = 155648;

#define LDS_WAIT() asm volatile("s_waitcnt lgkmcnt(0)" ::: "memory")
#define VM_WAIT() asm volatile("s_waitcnt vmcnt(0)" ::: "memory")
__device__ __forceinline__ unsigned f2bf(float f) { unsigned u = __builtin_bit_cast(unsigned, f); return (u + 0x7fffu + ((u >> 16) & 1u)) >> 16; }
typedef __bf16 bf16x2_t __attribute__((ext_vector_type(2)));
__device__ __forceinline__ unsigned pk2(float lo, float hi) { const bf16x2_t v = {(__bf16)lo, (__bf16)hi}; return __builtin_bit_cast(unsigned, v); }
__device__ __forceinline__ float bflo(unsigned w) { return __builtin_bit_cast(float, w << 16); }
__device__ __forceinline__ float bfhi(unsigned w) { return __builtin_bit_cast(float, w & 0xffff0000u); }
__device__ __forceinline__ float dot2_bf16(unsigned w, unsigned x, float acc) { return __builtin_amdgcn_fdot2_f32_bf16(__builtin_bit_cast(bf16x2, w), __builtin_bit_cast(bf16x2, x), acc, false); }
__device__ __forceinline__ f32x16 mfma32(bf16x8 a, bf16x8 b, f32x16 c) { return __builtin_amdgcn_mfma_f32_32x32x16_bf16(a, b, c, 0, 0, 0); }
__device__ __forceinline__ f32x4 mfma16(bf16x8 a, bf16x8 b, f32x4 c) { return __builtin_amdgcn_mfma_f32_16x16x32_bf16(a, b, c, 0, 0, 0); }
__device__ __forceinline__ bf16x8 mk8(unsigned a, unsigned b, unsigned c, unsigned d) { v4u t = {a, b, c, d}; return __builtin_bit_cast(bf16x8, t); }
__device__ __forceinline__ float silu_f(float x) { return x / (1.0f + __expf(-x)); }

#define XB_TMO      128
#define XB_XCNT(j)  (256  + 64 * (j))
#define XB_XSUB(j)  (1280 + 64 * (j))
#define XB_XGEN(j)  (2304 + 64 * (j))
#define XB_TOP      3328
#define XB_TOPGEN   3392
#define XCD_BAR_WORDS 3456
#define XB_SPIN_CAP (1u << 18)
__device__ __forceinline__ unsigned xb_ld(unsigned* p)              { return __hip_atomic_load(p, __ATOMIC_RELAXED, __HIP_MEMORY_SCOPE_AGENT); }
__device__ __forceinline__ unsigned xb_add(unsigned* p, unsigned v) { return __hip_atomic_fetch_add(p, v, __ATOMIC_RELAXED, __HIP_MEMORY_SCOPE_AGENT); }
__device__ __forceinline__ unsigned xb_xcc_id() { return (unsigned)__builtin_amdgcn_s_getreg((3 << 11) | 20) & 0xFu; }
#define XB_SPIN(cond, bar) do { unsigned _sp = 0; while (cond) { __builtin_amdgcn_s_sleep(1); \
    if ((++_sp & 255u) == 0u) { if (xb_ld(&(bar)[XB_TMO])) break; if (_sp > XB_SPIN_CAP) { atomicAdd(&(bar)[XB_TMO], 1u); break; } } } } while (0)
struct XcdBarrier { unsigned* bar; unsigned x; volatile LAS unsigned* st; };
__device__ __forceinline__ XcdBarrier xcd_barrier_post(unsigned* bar, volatile LAS unsigned* st) {
    XcdBarrier b; b.bar = bar; b.x = xb_xcc_id(); b.st = st;
    if (threadIdx.x == 0) (void)xb_add(&bar[XB_XCNT(b.x)], 1u);
    return b;
}
__device__ __forceinline__ void xcd_barrier_complete(unsigned* bar, unsigned x, unsigned& nloc, unsigned& nx) {
    const unsigned G = gridDim.x * gridDim.y * gridDim.z;
    unsigned sum, cnt, mine, sp = 0u;
    for (;;) {
        sum = 0u; cnt = 0u; mine = 0u;
#pragma unroll
        for (unsigned j = 0; j < 16; ++j) { const unsigned c = xb_ld(&bar[XB_XCNT(j)]); sum += c; cnt += (c > 0u) ? 1u : 0u; mine = (j == x) ? c : mine; }
        if (sum == G) break;
        __builtin_amdgcn_s_sleep(1);
        if ((++sp & 255u) == 0u) { if (xb_ld(&bar[XB_TMO])) break; if (sp > XB_SPIN_CAP) { atomicAdd(&bar[XB_TMO], 1u); break; } }
    }
    nloc = mine > 0u ? mine : 1u; nx = cnt > 0u ? cnt : 1u;
}
__device__ __forceinline__ void xcd_barrier(const XcdBarrier& b) {
    asm volatile("s_waitcnt vmcnt(0)" ::: "memory");
    __syncthreads();
    if (threadIdx.x == 0) {
        unsigned* bar = b.bar;
        __builtin_amdgcn_s_waitcnt(0);
        unsigned nloc = b.st[0], nx = b.st[1];
        if (nloc == 0u) { xcd_barrier_complete(bar, b.x, nloc, nx); b.st[0] = nloc; b.st[1] = nx; }
        const unsigned old = xb_add(&bar[XB_XSUB(b.x)], 1u);
        const unsigned gen = old / nloc;
        if (old + 1u == (gen + 1u) * nloc) {
            __builtin_amdgcn_fence(__ATOMIC_RELEASE, "agent");
            asm volatile("s_waitcnt vmcnt(0)" ::: "memory");
            const unsigned og = xb_add(&bar[XB_TOP], 1u);
            const unsigned tg = og / nx;
            if (og + 1u == (tg + 1u) * nx) xb_add(&bar[XB_TOPGEN], 1u);
            else XB_SPIN(xb_ld(&bar[XB_TOPGEN]) == tg, bar);
            __builtin_amdgcn_fence(__ATOMIC_ACQUIRE, "agent");
            xb_add(&bar[XB_XGEN(b.x)], 1u);
            asm volatile("s_waitcnt vmcnt(0)" ::: "memory");
        } else {
            XB_SPIN(xb_ld(&bar[XB_XGEN(b.x)]) == gen, bar);
            __builtin_amdgcn_fence(__ATOMIC_ACQUIRE, "agent");
            asm volatile("s_waitcnt vmcnt(0)" ::: "memory");
        }
    }
    __syncthreads();
}

struct Frame {
    LAS unsigned char* lds;
    volatile LAS unsigned* MISC;
    unsigned* ctl;
    int tid, lane, wave, vcu, G;
    const float *x, *c, *w_ada, *b_ada, *w_in, *w_gate_up, *b_gla_gate, *gla_out_norm, *swa_q_norm, *swa_k_norm, *swa_sinks, *swa_out_norm, *w_out, *w_peer_q, *keys1, *keys2, *edown, *eup;
    float* out;
    unsigned char* ws;
    float *MOD, *ROPE;
    bf16 *BTIN, *BTOUT, *BTQ, *HBUF, *PROJ, *MIXIN, *QPEER;
    unsigned char *DC8, *UC8, *YC8;
    int* ZP; unsigned *EIDX, *HE, *EIDX16; float *GATEQ, *DSC, *YSC;
    bf16 *GQT, *GST, *X1; float *GUT, *GG;
};

__device__ __forceinline__ float wave_sum(float v) {
#pragma unroll
    for (int o = 1; o < 64; o <<= 1) v += __shfl_xor(v, o);
    return v;
}
__device__ __forceinline__ float wave_max(float v) {
#pragma unroll
    for (int o = 1; o < 64; o <<= 1) v = fmaxf(v, __shfl_xor(v, o));
    return v;
}
__device__ __forceinline__ unsigned pack4i(float a, float b, float c, float d) {
    const int q0 = (int)__builtin_rintf(a), q1 = (int)__builtin_rintf(b), q2 = (int)__builtin_rintf(c), q3 = (int)__builtin_rintf(d);
    return (unsigned)(q0 & 255) | ((unsigned)(q1 & 255) << 8) | ((unsigned)(q2 & 255) << 16) | ((unsigned)q3 << 24);
}

__device__ __forceinline__ void p0_tr_item(const float* W, int ldw, int sc0, int ncols, bf16* WT, int dr0, int k0, LAS float* scr, int lane) {
    const int c4 = (lane & 7) * 4, kr = lane >> 3;
    f32x4 v[8];
#pragma unroll
    for (int i = 0; i < 8; ++i) v[i] = (c4 < ncols) ? *(const GAS f32x4*)(W + (size_t)(k0 + kr + 8 * i) * ldw + sc0 + c4) : (f32x4){0.f, 0.f, 0.f, 0.f};
#pragma unroll
    for (int i = 0; i < 8; ++i) { LAS float* d = scr + (kr + 8 * i) * 33 + c4; d[0] = v[i][0]; d[1] = v[i][1]; d[2] = v[i][2]; d[3] = v[i][3]; }
    LDS_WAIT(); asm volatile("" ::: "memory");
    const int c8 = lane & 7;
#pragma unroll
    for (int j = 0; j < 4; ++j) { const int n = (lane >> 3) + 8 * j; const LAS float* s = scr + (8 * c8) * 33 + n;
        v4u o; o.x = pk2(s[0 * 33], s[1 * 33]); o.y = pk2(s[2 * 33], s[3 * 33]); o.z = pk2(s[4 * 33], s[5 * 33]); o.w = pk2(s[6 * 33], s[7 * 33]);
        if (n < ncols) *(GAS v4u*)(WT + (size_t)(dr0 + n) * DM + k0 + 8 * c8) = o; }
    LDS_WAIT(); asm volatile("" ::: "memory");
}

__device__ __forceinline__ void p0a_ada(Frame& F) {
    const int tid = F.tid, lane = F.lane, wave = F.wave;
    {
        LAS f32x4* cact = (LAS f32x4*)F.lds;
        LAS float* red = (LAS float*)(F.lds + 65536);
        for (int k = tid; k < DM; k += 512) { f32x4 v;
#pragma unroll
            for (int b = 0; b < 4; ++b) { const float cv = F.c[b * DM + k]; v[b] = cv / (1.0f + expf(-cv)); }
            cact[k] = v; }
        __syncthreads();
        for (int slice = F.vcu; slice < 256; slice += F.G) {
            const int col0 = slice * 96, sub = lane / 24, cl = lane - sub * 24;
            f32x4 acc[4];
#pragma unroll
            for (int b = 0; b < 4; ++b) acc[b] = (f32x4){0.f, 0.f, 0.f, 0.f};
            if (lane < 48) {
                const float* wp = F.w_ada + col0 + 4 * cl;
#pragma unroll 16
                for (int k = wave * 2 + sub; k < DM; k += 16) {
                    const f32x4 w = *(const GAS f32x4*)(wp + (size_t)k * NMOD); const f32x4 cv = cact[k];
#pragma unroll
                    for (int b = 0; b < 4; ++b) acc[b] += w * cv[b];
                }
#pragma unroll
                for (int b = 0; b < 4; ++b) *(LAS f32x4*)(red + (wave * 48 + lane) * 16 + 4 * b) = acc[b];
            }
            __syncthreads();
            if (tid < 384) { const int b = tid / 96, col = tid - b * 96, cl2 = col >> 2, e = col & 3; float s = 0.f;
#pragma unroll
                for (int w = 0; w < 8; ++w) { s += red[(w * 48 + cl2) * 16 + 4 * b + e]; s += red[(w * 48 + 24 + cl2) * 16 + 4 * b + e]; }
                F.MOD[b * NMOD + col0 + col] = s + F.b_ada[col0 + col]; }
            __syncthreads();
        }
    }
}
__device__ __forceinline__ void p0b_weights(Frame& F) {
    const int tid = F.tid, lane = F.lane, wave = F.wave;
    const int gw = F.vcu * NWAVES + wave, NGW = F.G * NWAVES;
    {
        LAS float* scr = (LAS float*)(F.lds + wave * 16384);
        constexpr int NB0 = 192, NB1 = 80, NB2 = 1, NB3 = 128, NB4 = 64, NBT = NB0 + NB1 + NB2 + NB3 + NB4;
        for (int it = gw; it < NBT * 64; it += NGW) {
            int nb = it >> 6; const int k0 = (it & 63) * 64;
            if (nb < NB0) { p0_tr_item(F.w_in, IN_WIDTH, 32 * nb, 32, F.BTIN, 32 * nb, k0, scr, lane); continue; } nb -= NB0;
            if (nb < NB1) { p0_tr_item(F.w_in, IN_WIDTH, 6160 + 32 * nb, 32, F.BTIN, 6144 + 32 * nb, k0, scr, lane); continue; } nb -= NB1;
            if (nb < NB2) { p0_tr_item(F.w_in, IN_WIDTH, 6144, 16, F.BTIN, C_GA, k0, scr, lane); continue; } nb -= NB2;
            if (nb < NB3) { p0_tr_item(F.w_out, DM, 32 * nb, 32, F.BTOUT, 32 * nb, k0, scr, lane); continue; } nb -= NB3;
            p0_tr_item(F.w_peer_q, PEER_N, 32 * nb, 32, F.BTQ, 32 * nb, k0, scr, lane);
        }
        const size_t gt = (size_t)F.vcu * 512 + tid, NT = (size_t)F.G * 512;
        GAS v4u* z = (GAS v4u*)(F.BTIN + (size_t)(C_GA + 16) * DM);
        for (size_t i = gt; i < (size_t)240 * DM / 8; i += NT) z[i] = (v4u){0u, 0u, 0u, 0u};
        for (size_t e = gt; e < (size_t)SEQ * 32; e += NT) { const int pos = (int)(e >> 5), i = (int)(e & 31);
            const float inv = exp2f(-(float)i * (13.287712379549449f / 32.0f));
            const float ang = (float)pos * inv;
            const double rev = (double)ang * 0.15915494309189535; const float fr = (float)(rev - floor(rev));
            F.ROPE[e] = __builtin_amdgcn_cosf(fr); F.ROPE[SEQ * 32 + e] = __builtin_amdgcn_sinf(fr); }
    }
}
__device__ __forceinline__ void convert_expert_groups(Frame& F, int g_lo, int g_hi, int g_step) {
    const int tid = F.tid, lane = F.lane, wave = F.wave;
    __syncthreads();
    for (int tb = 0; tb < 2; ++tb) {
        const float* srcT = tb ? F.eup : F.edown; unsigned char* dstT = tb ? F.UC8 : F.DC8;
        for (int grp = g_lo; grp < g_hi; grp += g_step) {
            const int e0 = grp * 32;
#pragma unroll 1
            for (int r = 0; r < 4; ++r) {
                const int el = wave * 4 + r, e = e0 + el;
                const GAS f32x4* src = (const GAS f32x4*)(srcT + (size_t)e * DM);
                f32x4 a[8], b[8];
#pragma unroll
                for (int j = 0; j < 8; ++j) { a[j] = src[2 * (lane + 64 * j)]; b[j] = src[2 * (lane + 64 * j) + 1]; }
                if (tb == 0) {
                    float m = 0.f;
#pragma unroll
                    for (int j = 0; j < 8; ++j)
#pragma unroll
                        for (int q = 0; q < 4; ++q) m = fmaxf(m, fmaxf(fabsf(a[j][q]), fabsf(b[j][q])));
                    m = wave_max(m);
                    const float inv = m > 0.f ? 127.0f / m : 0.f;
                    if (lane == 0) F.DSC[e] = m * (1.0f / 127.0f);
#pragma unroll
                    for (int j = 0; j < 8; ++j) { v2u o; o.x = pack4i(a[j][0] * inv, a[j][1] * inv, a[j][2] * inv, a[j][3] * inv); o.y = pack4i(b[j][0] * inv, b[j][1] * inv, b[j][2] * inv, b[j][3] * inv);
                        *(LAS v2u*)(F.lds + el * 4096 + ((lane + 64 * j + el) & 511) * 8) = o; }
                } else {
#pragma unroll
                    for (int j = 0; j < 8; ++j) { int w0 = __builtin_amdgcn_cvt_pk_fp8_f32(a[j][0], a[j][1], 0, false); w0 = __builtin_amdgcn_cvt_pk_fp8_f32(a[j][2], a[j][3], w0, true);
                        int w1 = __builtin_amdgcn_cvt_pk_fp8_f32(b[j][0], b[j][1], 0, false); w1 = __builtin_amdgcn_cvt_pk_fp8_f32(b[j][2], b[j][3], w1, true);
                        v2u o; o.x = (unsigned)w0; o.y = (unsigned)w1;
                        *(LAS v2u*)(F.lds + el * 4096 + ((lane + 64 * j + el) & 511) * 8) = o; }
                }
            }
            __syncthreads();
            { const int el = tid & 31;
#pragma unroll 4
              for (int it = 0; it < 32; ++it) { const int sc = it * 16 + (tid >> 5);
                  const v2u o = *(const LAS v2u*)(F.lds + el * 4096 + ((sc + el) & 511) * 8);
                  *(GAS v2u*)(dstT + ((size_t)sc * NEXP + e0 + el) * 8) = o; } }
            __syncthreads();
        }
    }
}
constexpr int GEMM1_UNITS = (NTOK / 256) * (NPROJ / 256);
__host__ __device__ constexpr int tail_groups(int G) { return (GEMM1_UNITS % G) ? (512 - G > 0 ? 512 - G : 0) : 0; }
__device__ __forceinline__ void p0c_tables(Frame& F) {
    convert_expert_groups(F, tail_groups(F.G) + F.vcu, 512, F.G);
}
__device__ __forceinline__ void p0_prologue(Frame& F) { p0a_ada(F); p0b_weights(F); p0c_tables(F); }

__device__ __forceinline__ void modulate_rows(Frame& F, const float* src, bf16* dst, int sh_off, int sc_off) {
    const int gw = F.vcu * NWAVES + F.wave, NGW = F.G * NWAVES, lane = F.lane;
    for (int m = gw; m < NTOK; m += NGW) {
        const int b = m >> 11;
        const GAS f32x4* xr = (const GAS f32x4*)(src + (size_t)m * DM) + lane;
        f32x4 v[16]; float s = 0.f;
#pragma unroll
        for (int j = 0; j < 16; ++j) { v[j] = xr[64 * j]; s += (v[j].x * v[j].x + v[j].y * v[j].y) + (v[j].z * v[j].z + v[j].w * v[j].w); }
        const float rstd = 1.0f / sqrtf(wave_sum(s) * (1.0f / DM) + EPS);
        const GAS f32x4* shp = (const GAS f32x4*)(F.MOD + b * NMOD + sh_off) + lane;
        const GAS f32x4* scp = (const GAS f32x4*)(F.MOD + b * NMOD + sc_off) + lane;
        GAS v2u* o8 = (GAS v2u*)(dst + (size_t)m * DM) + lane;
#pragma unroll
        for (int j = 0; j < 16; ++j) { const f32x4 sh = shp[64 * j], sc = scp[64 * j]; const f32x4 y = v[j] * rstd * (sc + 1.0f) + sh;
            v2u o; o.x = pk2(y.x, y.y); o.y = pk2(y.z, y.w); o8[64 * j] = o; }
    }
}


__device__ __forceinline__ void p5_modulate_quant(Frame& F) {
    const int gw = F.vcu * NWAVES + F.wave, NGW = F.G * NWAVES, lane = F.lane;
    for (int m = gw; m < NTOK; m += NGW) {
        const int b = m >> 11;
        const GAS v4u* xr = (const GAS v4u*)(F.X1 + (size_t)m * DM);
        f32x4 a[8], c[8]; float s = 0.f;
#pragma unroll
        for (int j = 0; j < 8; ++j) { const v4u w = xr[lane + 64 * j]; a[j] = (f32x4){bflo(w.x), bfhi(w.x), bflo(w.y), bfhi(w.y)}; c[j] = (f32x4){bflo(w.z), bfhi(w.z), bflo(w.w), bfhi(w.w)};
            s += (a[j].x * a[j].x + a[j].y * a[j].y) + (a[j].z * a[j].z + a[j].w * a[j].w) + (c[j].x * c[j].x + c[j].y * c[j].y) + (c[j].z * c[j].z + c[j].w * c[j].w); }
        const float rstd = 1.0f / sqrtf(wave_sum(s) * (1.0f / DM) + EPS);
        const GAS f32x4* shp = (const GAS f32x4*)(F.MOD + b * NMOD + 3 * DM);
        const GAS f32x4* scp = (const GAS f32x4*)(F.MOD + b * NMOD + 4 * DM);
        float mx = 0.f;
#pragma unroll
        for (int j = 0; j < 8; ++j) { const int i0 = 2 * (lane + 64 * j);
            a[j] = a[j] * rstd * (scp[i0] + 1.0f) + shp[i0]; c[j] = c[j] * rstd * (scp[i0 + 1] + 1.0f) + shp[i0 + 1];
#pragma unroll
            for (int q = 0; q < 4; ++q) mx = fmaxf(mx, fmaxf(fabsf(a[j][q]), fabsf(c[j][q])));
            *(GAS v4u*)(F.HBUF + (size_t)m * DM + 8 * (lane + 64 * j)) = (v4u){pk2(a[j].x, a[j].y), pk2(a[j].z, a[j].w), pk2(c[j].x, c[j].y), pk2(c[j].z, c[j].w)}; }
        mx = wave_max(mx);
        const float inv = mx > 0.f ? 127.0f / mx : 0.f;
        if (lane == 0) F.YSC[m] = mx * (1.0f / 127.0f);
#pragma unroll
        for (int j = 0; j < 8; ++j) { v2u o; o.x = pack4i(a[j].x * inv, a[j].y * inv, a[j].z * inv, a[j].w * inv); o.y = pack4i(c[j].x * inv, c[j].y * inv, c[j].z * inv, c[j].w * inv);
            *(GAS v2u*)(F.YC8 + ((size_t)(lane + 64 * j) * NTOK + m) * 8) = o; }
    }
}

__device__ __forceinline__ void swa_unit(Frame& F, int u) {
    const int b = u >> 6, kvh = (u >> 4) & 3, n = u & 15, t0 = n * 128;
    LAS unsigned char* KL = F.lds;
    LAS unsigned char* VL = F.lds + 36864;
    const float* COS = F.ROPE; const float* SIN = F.ROPE + SEQ * 32;
    {
        const int key = F.tid >> 1, p = F.tid & 1, kpos = t0 - 128 + key;
        v4u ka[2] = {{0u, 0u, 0u, 0u}, {0u, 0u, 0u, 0u}}, kb[2] = {{0u, 0u, 0u, 0u}, {0u, 0u, 0u, 0u}}, vv[4] = {{0u, 0u, 0u, 0u}, {0u, 0u, 0u, 0u}, {0u, 0u, 0u, 0u}, {0u, 0u, 0u, 0u}};
        float cs[16], sn[16];
#pragma unroll
        for (int i = 0; i < 16; ++i) { cs[i] = 1.f; sn[i] = 0.f; }
        if (kpos >= 0) {
            const bf16* pr = F.PROJ + (size_t)(b * SEQ + kpos) * NPROJ;
            const GAS v4u* kr = (const GAS v4u*)(pr + C_SK + kvh * 64);
            ka[0] = kr[2 * p]; ka[1] = kr[2 * p + 1]; kb[0] = kr[4 + 2 * p]; kb[1] = kr[4 + 2 * p + 1];
            const GAS v4u* vr = (const GAS v4u*)(pr + C_SV + kvh * 64 + 32 * p);
#pragma unroll
            for (int j = 0; j < 4; ++j) vv[j] = vr[j];
            const GAS f32x4* cp = (const GAS f32x4*)(COS + kpos * 32 + 16 * p); const GAS f32x4* sp = (const GAS f32x4*)(SIN + kpos * 32 + 16 * p);
#pragma unroll
            for (int j = 0; j < 4; ++j) { const f32x4 c4 = cp[j], s4 = sp[j];
#pragma unroll
                for (int e = 0; e < 4; ++e) { cs[4 * j + e] = c4[e]; sn[4 * j + e] = s4[e]; } }
        }
        float x1[16], x2[16]; float ss = 0.f;
#pragma unroll
        for (int j = 0; j < 2; ++j)
#pragma unroll
            for (int e = 0; e < 4; ++e) { x1[8 * j + 2 * e] = bflo(ka[j][e]); x1[8 * j + 2 * e + 1] = bfhi(ka[j][e]); x2[8 * j + 2 * e] = bflo(kb[j][e]); x2[8 * j + 2 * e + 1] = bfhi(kb[j][e]); }
#pragma unroll
        for (int i = 0; i < 16; ++i) ss += x1[i] * x1[i] + x2[i] * x2[i];
        ss += __shfl_xor(ss, 1);
        const float rstd = 1.0f / sqrtf(ss * (1.0f / 64.0f) + EPS);
        unsigned o1[8], o2[8];
#pragma unroll
        for (int i = 0; i < 8; ++i) {
            float y1[2], y2[2];
#pragma unroll
            for (int e = 0; e < 2; ++e) { const int d = 2 * i + e; const float a = x1[d] * rstd * F.swa_k_norm[16 * p + d], c = x2[d] * rstd * F.swa_k_norm[32 + 16 * p + d];
                y1[e] = a * cs[d] - c * sn[d]; y2[e] = c * cs[d] + a * sn[d]; }
            o1[i] = pk2(y1[0], y1[1]); o2[i] = pk2(y2[0], y2[1]);
        }
        LAS v4u* kd = (LAS v4u*)(KL + key * 144 + 32 * p);
        kd[0] = (v4u){o1[0], o1[1], o1[2], o1[3]}; kd[1] = (v4u){o1[4], o1[5], o1[6], o1[7]};
        LAS v4u* kd2 = (LAS v4u*)(KL + key * 144 + 64 + 32 * p);
        kd2[0] = (v4u){o2[0], o2[1], o2[2], o2[3]}; kd2[1] = (v4u){o2[4], o2[5], o2[6], o2[7]};
#pragma unroll
        for (int j = 0; j < 4; ++j)
#pragma unroll
            for (int e = 0; e < 4; ++e) { const int d = 32 * p + 8 * j + 2 * e; const unsigned w = vv[j][e];
                *(LAS unsigned short*)(VL + d * 520 + key * 2) = (unsigned short)(w & 0xffffu);
                *(LAS unsigned short*)(VL + (d + 1) * 520 + key * 2) = (unsigned short)(w >> 16); }
    }
    __syncthreads();
    {
        const int g = F.wave, hq = kvh * 8 + g, r = F.lane & 31, h = F.lane >> 5;
        const float sink = F.swa_sinks[hq];
        for (int qt = 0; qt < 4; ++qt) {
            const int qpos = t0 + 32 * qt + r;
            const size_t tok = (size_t)(b * SEQ + qpos);
            const GAS v4u* qr = (const GAS v4u*)(F.PROJ + tok * NPROJ + C_SQ + hq * 64);
            v4u qraw[4];
#pragma unroll
            for (int kk = 0; kk < 4; ++kk) qraw[kk] = qr[2 * kk + h];
            float qf[4][8]; float ss = 0.f;
#pragma unroll
            for (int kk = 0; kk < 4; ++kk)
#pragma unroll
                for (int e = 0; e < 4; ++e) { qf[kk][2 * e] = bflo(qraw[kk][e]); qf[kk][2 * e + 1] = bfhi(qraw[kk][e]); }
#pragma unroll
            for (int kk = 0; kk < 4; ++kk)
#pragma unroll
                for (int j = 0; j < 8; ++j) ss += qf[kk][j] * qf[kk][j];
            ss += __shfl_xor(ss, 32);
            const float rstd = 0.125f / sqrtf(ss * (1.0f / 64.0f) + EPS);
            bf16x8 qfrag[4];
#pragma unroll
            for (int kk = 0; kk < 2; ++kk) {
                float y1[8], y2[8];
                const GAS f32x4* cp = (const GAS f32x4*)(COS + qpos * 32 + 16 * kk + 8 * h); const GAS f32x4* sp = (const GAS f32x4*)(SIN + qpos * 32 + 16 * kk + 8 * h);
                const f32x4 c0 = cp[0], c1 = cp[1], s0 = sp[0], s1 = sp[1];
#pragma unroll
                for (int j = 0; j < 8; ++j) { const int d = 16 * kk + 8 * h + j; const float cc = j < 4 ? c0[j & 3] : c1[j & 3], sv = j < 4 ? s0[j & 3] : s1[j & 3];
                    const float a = qf[kk][j] * rstd * F.swa_q_norm[d], c = qf[kk + 2][j] * rstd * F.swa_q_norm[d + 32];
                    y1[j] = a * cc - c * sv; y2[j] = c * cc + a * sv; }
                qfrag[kk] = mk8(pk2(y1[0], y1[1]), pk2(y1[2], y1[3]), pk2(y1[4], y1[5]), pk2(y1[6], y1[7]));
                qfrag[kk + 2] = mk8(pk2(y2[0], y2[1]), pk2(y2[2], y2[3]), pk2(y2[4], y2[5]), pk2(y2[6], y2[7]));
            }
            f32x16 sacc[5];
#pragma unroll
            for (int tt = 0; tt < 5; ++tt) { f32x16 a = {0.f, 0.f, 0.f, 0.f, 0.f, 0.f, 0.f, 0.f, 0.f, 0.f, 0.f, 0.f, 0.f, 0.f, 0.f, 0.f};
#pragma unroll
                for (int kk = 0; kk < 4; ++kk) { const bf16x8 kf = *(const LAS bf16x8*)(KL + (32 * (qt + tt) + r) * 144 + (16 * kk + 8 * h) * 2); a = mfma32(kf, qfrag[kk], a); }
                sacc[tt] = a; }
            float mx = sink;
#pragma unroll
            for (int tt = 0; tt < 5; ++tt)
#pragma unroll
                for (int i = 0; i < 16; ++i) { const int koff = (i & 3) + 8 * (i >> 2) + 4 * h; const int rel = r + 128 - 32 * tt - koff; const int kidx = 32 * (qt + tt) + koff;
                    const bool valid = (rel >= 0) && (rel < 128) && (t0 - 128 + kidx >= 0);
                    const float s = valid ? sacc[tt][i] : -INFINITY; sacc[tt][i] = s; mx = fmaxf(mx, s); }
            mx = fmaxf(mx, __shfl_xor(mx, 32));
            float sum = 0.f;
#pragma unroll
            for (int tt = 0; tt < 5; ++tt)
#pragma unroll
                for (int i = 0; i < 16; ++i) { const float pv = __expf(sacc[tt][i] - mx); sacc[tt][i] = pv; sum += pv; }
            sum += __shfl_xor(sum, 32);
            const float inv = 1.0f / (sum + __expf(sink - mx));
            f32x16 oacc[2];
#pragma unroll
            for (int dt = 0; dt < 2; ++dt) oacc[dt] = (f32x16){0.f, 0.f, 0.f, 0.f, 0.f, 0.f, 0.f, 0.f, 0.f, 0.f, 0.f, 0.f, 0.f, 0.f, 0.f, 0.f};
#pragma unroll
            for (int tt = 0; tt < 5; ++tt)
#pragma unroll
                for (int s2 = 0; s2 < 2; ++s2) {
                    const bf16x8 pf = mk8(pk2(sacc[tt][8 * s2], sacc[tt][8 * s2 + 1]), pk2(sacc[tt][8 * s2 + 2], sacc[tt][8 * s2 + 3]), pk2(sacc[tt][8 * s2 + 4], sacc[tt][8 * s2 + 5]), pk2(sacc[tt][8 * s2 + 6], sacc[tt][8 * s2 + 7]));
#pragma unroll
                    for (int dt = 0; dt < 2; ++dt) { const LAS unsigned char* vp = VL + (32 * dt + r) * 520 + (32 * (qt + tt) + 16 * s2 + 4 * h) * 2;
                        const v2u lo = *(const LAS v2u*)vp, hi = *(const LAS v2u*)(vp + 16);
                        oacc[dt] = mfma32(mk8(lo.x, lo.y, hi.x, hi.y), pf, oacc[dt]); }
                }
            float so = 0.f;
#pragma unroll
            for (int dt = 0; dt < 2; ++dt)
#pragma unroll
                for (int i = 0; i < 16; ++i) { const float o = oacc[dt][i] * inv; oacc[dt][i] = o; so += o * o; }
            so += __shfl_xor(so, 32);
            const float rs2 = 1.0f / sqrtf(so * (1.0f / 64.0f) + EPS);
            bf16* orow = F.MIXIN + tok * DM + 2048 + hq * 64;
#pragma unroll
            for (int dt = 0; dt < 2; ++dt)
#pragma unroll
                for (int gq = 0; gq < 4; ++gq) { const int d0 = 32 * dt + 8 * gq + 4 * h; const f32x4 gn = *(const GAS f32x4*)(F.swa_out_norm + d0);
                    v2u o; o.x = pk2(oacc[dt][4 * gq] * rs2 * gn[0], oacc[dt][4 * gq + 1] * rs2 * gn[1]); o.y = pk2(oacc[dt][4 * gq + 2] * rs2 * gn[2], oacc[dt][4 * gq + 3] * rs2 * gn[3]);
                    *(GAS v2u*)(orow + d0) = o; }
        }
    }
    __syncthreads();
}

constexpr int GL_QT = 0, GL_KT = 9216, GL_KHT = 18432, GL_VT = 27648, GL_WG = 46336, GL_BG = 50432, GL_OB = 50688;
__device__ __forceinline__ void gla_g1_units(Frame& F, int u0, int nu) {
    const int bh = u0 >> 5, b = bh >> 4, h = bh & 15, tid = F.tid, lane = F.lane, w = F.wave;
    LAS unsigned char* QT = F.lds + GL_QT;
    LAS unsigned char* KT = F.lds + GL_KT;
    LAS unsigned char* KHT = F.lds + GL_KHT;
    LAS unsigned char* VT = F.lds + GL_VT;
    LAS float* WG = (LAS float*)(F.lds + GL_WG);
    LAS float* BG = (LAS float*)(F.lds + GL_BG);
    LAS float* OB = (LAS float*)(F.lds + GL_OB);
    __syncthreads();
    for (int i = tid; i < 1024; i += 512) WG[i] = F.w_gate_up[(i >> 6) * 1024 + h * 64 + (i & 63)];
    if (tid < 64) BG[tid] = F.b_gla_gate[h * 64 + tid];
    __syncthreads();
    const int r = lane & 15, g = lane >> 4;
    const int t2 = tid >> 3, seg = tid & 7;
    v4u qv, kv, g0, g1, vv0, vv1;
    { const size_t row0 = (size_t)b * SEQ + (u0 & 31) * 64; const bf16* pr = F.PROJ + (row0 + lane) * NPROJ;
      qv = *(const GAS v4u*)(pr + C_GQ + h * 64 + 8 * w); kv = *(const GAS v4u*)(pr + C_GK + h * 64 + 8 * w); g0 = *(const GAS v4u*)(pr + C_GA); g1 = *(const GAS v4u*)(pr + C_GA + 8);
      const GAS v4u* vr = (const GAS v4u*)(F.PROJ + (row0 + t2) * NPROJ + C_GV + h * 128 + 16 * seg); vv0 = vr[0]; vv1 = vr[1]; }
    for (int ui = 0; ui < nu; ++ui) {
        const int u = u0 + ui, chunk = u & 31;
        const size_t row0 = (size_t)b * SEQ + chunk * 64;
        v4u nqv = qv, nkv = kv, ng0 = g0, ng1 = g1, nvv0 = vv0, nvv1 = vv1;
        if (ui + 1 < nu) {
            const size_t rown = row0 + 64; const bf16* pr = F.PROJ + (rown + lane) * NPROJ;
            nqv = *(const GAS v4u*)(pr + C_GQ + h * 64 + 8 * w); nkv = *(const GAS v4u*)(pr + C_GK + h * 64 + 8 * w); ng0 = *(const GAS v4u*)(pr + C_GA); ng1 = *(const GAS v4u*)(pr + C_GA + 8);
            const GAS v4u* vr = (const GAS v4u*)(F.PROJ + (rown + t2) * NPROJ + C_GV + h * 128 + 16 * seg); nvv0 = vr[0]; nvv1 = vr[1]; }
        {
            float ga[16];
#pragma unroll
            for (int e = 0; e < 4; ++e) { ga[2 * e] = bflo(g0[e]); ga[2 * e + 1] = bfhi(g0[e]); ga[8 + 2 * e] = bflo(g1[e]); ga[8 + 2 * e + 1] = bfhi(g1[e]); }
            float z[8];
            { const f32x4 b0 = *(const LAS f32x4*)(BG + 8 * w), b1 = *(const LAS f32x4*)(BG + 8 * w + 4);
#pragma unroll
              for (int i = 0; i < 4; ++i) { z[i] = b0[i]; z[4 + i] = b1[i]; } }
#pragma unroll
            for (int j = 0; j < 16; ++j) { const f32x4 w0 = *(const LAS f32x4*)(WG + j * 64 + 8 * w), w1 = *(const LAS f32x4*)(WG + j * 64 + 8 * w + 4);
#pragma unroll
                for (int i = 0; i < 4; ++i) { z[i] += ga[j] * w0[i]; z[4 + i] += ga[j] * w1[i]; } }
            float bb[8];
#pragma unroll
            for (int i = 0; i < 8; ++i) { const float zz = z[i]; bb[i] = (fminf(zz, 0.f) - __logf(1.0f + __expf(-fabsf(zz)))) * (1.0f / 16.0f); }
#pragma unroll
            for (int off = 1; off < 64; off <<= 1)
#pragma unroll
                for (int i = 0; i < 8; ++i) { const float v = __shfl_up(bb[i], off); if (lane >= off) bb[i] += v; }
            float qn[8], kn[8], kh[8];
#pragma unroll
            for (int e = 0; e < 4; ++e) { qn[2 * e] = bflo(qv[e]); qn[2 * e + 1] = bfhi(qv[e]); kn[2 * e] = bflo(kv[e]); kn[2 * e + 1] = bfhi(kv[e]); }
#pragma unroll
            for (int i = 0; i < 8; ++i) { const float bl = __shfl(bb[i], 63); const float eb = __expf(bb[i]);
                qn[i] = qn[i] * 0.125f * eb; kh[i] = kn[i] * __expf(bl - bb[i]); kn[i] = kn[i] * __expf(-bb[i]);
                if (lane == 0) F.GG[(size_t)u * 64 + 8 * w + i] = __expf(bl); }
            const v4u qpk = {pk2(qn[0], qn[1]), pk2(qn[2], qn[3]), pk2(qn[4], qn[5]), pk2(qn[6], qn[7])};
            *(LAS v4u*)(QT + lane * 144 + 16 * w) = qpk;
            *(GAS v4u*)(F.GQT + ((size_t)u * 64 + lane) * 64 + 8 * w) = qpk;
            *(LAS v4u*)(KT + lane * 144 + 16 * w) = (v4u){pk2(kn[0], kn[1]), pk2(kn[2], kn[3]), pk2(kn[4], kn[5]), pk2(kn[6], kn[7])};
#pragma unroll
            for (int i = 0; i < 8; ++i) *(LAS unsigned short*)(KHT + (8 * w + i) * 144 + lane * 2) = (unsigned short)f2bf(kh[i]);
#pragma unroll
            for (int e = 0; e < 4; ++e) {
                *(LAS unsigned short*)(VT + (16 * seg + 2 * e) * 144 + t2 * 2) = (unsigned short)(vv0[e] & 0xffffu);
                *(LAS unsigned short*)(VT + (16 * seg + 2 * e + 1) * 144 + t2 * 2) = (unsigned short)(vv0[e] >> 16);
                *(LAS unsigned short*)(VT + (16 * seg + 8 + 2 * e) * 144 + t2 * 2) = (unsigned short)(vv1[e] & 0xffffu);
                *(LAS unsigned short*)(VT + (16 * seg + 8 + 2 * e + 1) * 144 + t2 * 2) = (unsigned short)(vv1[e] >> 16); }
        }
        __syncthreads();
        {
            unsigned dp[4][4][2];
#pragma unroll
            for (int tt = 0; tt < 4; ++tt) {
                const bf16x8 bq0 = *(const LAS bf16x8*)(QT + (16 * tt + r) * 144 + (8 * g) * 2), bq1 = *(const LAS bf16x8*)(QT + (16 * tt + r) * 144 + (32 + 8 * g) * 2);
#pragma unroll
                for (int st = 0; st < 4; ++st) {
                    if (st <= tt) {
                        const bf16x8 ak0 = *(const LAS bf16x8*)(KT + (16 * st + r) * 144 + (8 * g) * 2), ak1 = *(const LAS bf16x8*)(KT + (16 * st + r) * 144 + (32 + 8 * g) * 2);
                        f32x4 d = {0.f, 0.f, 0.f, 0.f}; d = mfma16(ak0, bq0, d); d = mfma16(ak1, bq1, d);
                        if (st == tt) {
#pragma unroll
                            for (int i = 0; i < 4; ++i) if (4 * g + i > r) d[i] = 0.f; }
                        dp[st][tt][0] = pk2(d[0], d[1]); dp[st][tt][1] = pk2(d[2], d[3]);
                    } else { dp[st][tt][0] = 0u; dp[st][tt][1] = 0u; }
                }
            }
#pragma unroll
            for (int tt = 0; tt < 4; ++tt) {
                f32x4 o = {0.f, 0.f, 0.f, 0.f};
#pragma unroll
                for (int kk = 0; kk < 2; ++kk) {
                    if (2 * kk <= tt) {
                        const LAS unsigned char* vp = VT + (16 * w + r) * 144 + (32 * kk + 4 * g) * 2;
                        const v2u lo = *(const LAS v2u*)vp, hi = *(const LAS v2u*)(vp + 32);
                        o = mfma16(mk8(dp[2 * kk][tt][0], dp[2 * kk][tt][1], dp[2 * kk + 1][tt][0], dp[2 * kk + 1][tt][1]), mk8(lo.x, lo.y, hi.x, hi.y), o);
                    }
                }
#pragma unroll
                for (int i = 0; i < 4; ++i) OB[(16 * tt + 4 * g + i) * 132 + 16 * w + r] = o[i];
            }
#pragma unroll
            for (int dt = 0; dt < 4; ++dt) {
                f32x4 uacc = {0.f, 0.f, 0.f, 0.f};
#pragma unroll
                for (int kk = 0; kk < 2; ++kk) { const bf16x8 a = *(const LAS bf16x8*)(KHT + (16 * dt + r) * 144 + (32 * kk + 8 * g) * 2), bv = *(const LAS bf16x8*)(VT + (16 * w + r) * 144 + (32 * kk + 8 * g) * 2);
                    uacc = mfma16(a, bv, uacc); }
                *(GAS f32x4*)(F.GUT + ((size_t)u * 128 + 16 * w + r) * 64 + 16 * dt + 4 * g) = uacc;
            }
        }
        __syncthreads();
        {
            unsigned ow[8];
#pragma unroll
            for (int j = 0; j < 4; ++j) { const f32x4 v = *(const LAS f32x4*)(OB + t2 * 132 + 16 * seg + 4 * j); ow[2 * j] = pk2(v[0], v[1]); ow[2 * j + 1] = pk2(v[2], v[3]); }
            GAS v4u* op = (GAS v4u*)(F.MIXIN + (row0 + t2) * DM + h * 128 + 16 * seg);
            op[0] = (v4u){ow[0], ow[1], ow[2], ow[3]}; op[1] = (v4u){ow[4], ow[5], ow[6], ow[7]};
        }
        qv = nqv; kv = nkv; g0 = ng0; g1 = ng1; vv0 = nvv0; vv1 = nvv1;
    }
}
__device__ __forceinline__ void gla_scan(Frame& F) {
    const size_t gt = (size_t)F.vcu * 512 + F.tid, NT = (size_t)F.G * 512;
    for (size_t i = gt; i < (size_t)64 * 128 * 16; i += NT) {
        const int bh = (int)(i >> 11), v = (int)((i >> 4) & 127), d4 = (int)(i & 15);
        f32x4 S = {0.f, 0.f, 0.f, 0.f};
#pragma unroll 8
        for (int c = 0; c < 32; ++c) {
            const size_t u = (size_t)bh * 32 + c;
            const f32x4 U = *(const GAS f32x4*)(F.GUT + (u * 128 + v) * 64 + 4 * d4), gg = *(const GAS f32x4*)(F.GG + u * 64 + 4 * d4);
            *(GAS v2u*)(F.GST + (u * 128 + v) * 64 + 4 * d4) = (v2u){pk2(S[0], S[1]), pk2(S[2], S[3])};
            S = gg * S + U;
        }
    }
}
struct G3Ops { v4u oi0, oi1, gg0, gg1; v2u slo[2], shi[2], qlo[4][2], qhi[4][2]; };
__device__ __forceinline__ void gla_g3_load(Frame& F, G3Ops& P, int u, int b, int h, int w, int r, int g, int t2, int seg) {
    const size_t row0 = (size_t)b * SEQ + (u & 31) * 64;
    const GAS v4u* oip = (const GAS v4u*)(F.MIXIN + (row0 + t2) * DM + h * 128 + 16 * seg); P.oi0 = oip[0]; P.oi1 = oip[1];
    const GAS v4u* gr = (const GAS v4u*)(F.PROJ + (row0 + t2) * NPROJ + C_GG + h * 128 + 16 * seg); P.gg0 = gr[0]; P.gg1 = gr[1];
#pragma unroll
    for (int kk = 0; kk < 2; ++kk) { const bf16* sp = F.GST + ((size_t)u * 128 + 16 * w + r) * 64 + 32 * kk + 4 * g; P.slo[kk] = *(const GAS v2u*)sp; P.shi[kk] = *(const GAS v2u*)(sp + 16); }
#pragma unroll
    for (int tt = 0; tt < 4; ++tt)
#pragma unroll
        for (int kk = 0; kk < 2; ++kk) { const bf16* qp = F.GQT + ((size_t)u * 64 + 16 * tt + r) * 64 + 32 * kk + 4 * g; P.qlo[tt][kk] = *(const GAS v2u*)qp; P.qhi[tt][kk] = *(const GAS v2u*)(qp + 16); }
}
__device__ __forceinline__ void gla_g3_units(Frame& F, int u0, int nu) {
    const int bh = u0 >> 5, b = bh >> 4, h = bh & 15, tid = F.tid, lane = F.lane, w = F.wave;
    LAS float* OB = (LAS float*)(F.lds + GL_OB);
    const int r = lane & 15, g = lane >> 4, t2 = tid >> 3, seg = tid & 7;
    __syncthreads();
    G3Ops cur, nxt;
    gla_g3_load(F, cur, u0, b, h, w, r, g, t2, seg);
    for (int ui = 0; ui < nu; ++ui) {
        const int u = u0 + ui, chunk = u & 31;
        const size_t row0 = (size_t)b * SEQ + chunk * 64;
        {
            bf16x8 bs[2];
#pragma unroll
            for (int kk = 0; kk < 2; ++kk) bs[kk] = mk8(cur.slo[kk].x, cur.slo[kk].y, cur.shi[kk].x, cur.shi[kk].y);
#pragma unroll
            for (int tt = 0; tt < 4; ++tt) {
                f32x4 o = {0.f, 0.f, 0.f, 0.f};
#pragma unroll
                for (int kk = 0; kk < 2; ++kk) o = mfma16(mk8(cur.qlo[tt][kk].x, cur.qlo[tt][kk].y, cur.qhi[tt][kk].x, cur.qhi[tt][kk].y), bs[kk], o);
#pragma unroll
                for (int i = 0; i < 4; ++i) OB[(16 * tt + 4 * g + i) * 132 + 16 * w + r] = o[i];
            }
        }
        if (ui + 1 < nu) gla_g3_load(F, nxt, u + 1, b, h, w, r, g, t2, seg);
        __syncthreads();
        {
            float o[16]; float ss = 0.f;
#pragma unroll
            for (int j = 0; j < 4; ++j) { const f32x4 v = *(const LAS f32x4*)(OB + t2 * 132 + 16 * seg + 4 * j);
#pragma unroll
                for (int e = 0; e < 4; ++e) o[4 * j + e] = v[e]; }
#pragma unroll
            for (int e = 0; e < 4; ++e) { o[2 * e] += bflo(cur.oi0[e]); o[2 * e + 1] += bfhi(cur.oi0[e]); o[8 + 2 * e] += bflo(cur.oi1[e]); o[8 + 2 * e + 1] += bfhi(cur.oi1[e]); }
#pragma unroll
            for (int e = 0; e < 16; ++e) ss += o[e] * o[e];
            ss += __shfl_xor(ss, 1); ss += __shfl_xor(ss, 2); ss += __shfl_xor(ss, 4);
            const float rstd = 1.0f / sqrtf(ss * (1.0f / 128.0f) + EPS);
            float gg[16];
#pragma unroll
            for (int e = 0; e < 4; ++e) { gg[2 * e] = bflo(cur.gg0[e]); gg[2 * e + 1] = bfhi(cur.gg0[e]); gg[8 + 2 * e] = bflo(cur.gg1[e]); gg[8 + 2 * e + 1] = bfhi(cur.gg1[e]); }
            unsigned ow[8];
#pragma unroll
            for (int e = 0; e < 8; ++e) { const float a = o[2 * e] * rstd * F.gla_out_norm[16 * seg + 2 * e] * silu_f(gg[2 * e]), c = o[2 * e + 1] * rstd * F.gla_out_norm[16 * seg + 2 * e + 1] * silu_f(gg[2 * e + 1]);
                ow[e] = pk2(a, c); }
            GAS v4u* op = (GAS v4u*)(F.MIXIN + (row0 + t2) * DM + h * 128 + 16 * seg);
            op[0] = (v4u){ow[0], ow[1], ow[2], ow[3]}; op[1] = (v4u){ow[4], ow[5], ow[6], ow[7]};
        }
        __syncthreads();
        cur = nxt;
    }
}

__device__ __forceinline__ void p3a_mixer(Frame& F) {
    for (int u = F.vcu; u < 256; u += F.G) swa_unit(F, u);
    for (int q = F.vcu; q < 256; q += F.G) gla_g1_units(F, q * 8, 8);
}
__device__ __forceinline__ void p3c_mixer(Frame& F) {
    for (int q = F.vcu; q < 256; q += F.G) gla_g3_units(F, q * 8, 8);
}

__device__ __forceinline__ unsigned f2s(float f) { const unsigned u = __builtin_bit_cast(unsigned, f); return (u & 0x80000000u) ? ~u : (u | 0x80000000u); }
__device__ __forceinline__ float s2f(unsigned s) { const unsigned u = (s & 0x80000000u) ? (s & 0x7fffffffu) : ~s; return __builtin_bit_cast(float, u); }
#define TOPK_INSERT(list, xin) do { unsigned _x = (xin); _Pragma("unroll") for (int _p = 0; _p < 16; ++_p) { const unsigned _hi = list[_p] > _x ? list[_p] : _x; _x = list[_p] > _x ? _x : list[_p]; list[_p] = _hi; } } while (0)

template <int MODE  > __device__ __forceinline__ void p7_topk(Frame& F) {
    const int tid = F.tid, lane = F.lane, wave = F.wave;
    LAS unsigned char* KY = F.lds;
    LAS unsigned* SC = (LAS unsigned*)(F.lds + 69632 + wave * 4096);
#pragma unroll
    for (int j = 0; j < 16; ++j) { const int i4 = j * 512 + tid, hf = i4 >> 12, key = (i4 >> 5) & 127, q4 = i4 & 31;
        const f32x4 v = *(const GAS f32x4*)((hf ? F.keys2 : F.keys1) + key * 128 + 4 * q4);
        *(LAS v2u*)(KY + hf * 34816 + key * 272 + q4 * 8) = (v2u){pk2(v[0], v[1]), pk2(v[2], v[3])}; }
    __syncthreads();
    const int gw = F.vcu * NWAVES + wave, NGW = F.G * NWAVES;
    const int r = lane & 31, h = lane >> 5;
    for (int task = gw; task < 256 * 8; task += NGW) {
        const int tile = task >> 3, hd = task & 7, tok = tile * 32 + r;
        for (int hf = 0; hf < 2; ++hf) {
            const GAS v4u* qr = (const GAS v4u*)(F.QPEER + (size_t)tok * PEER_N + hd * 256 + hf * 128);
            bf16x8 qf[8];
#pragma unroll
            for (int kk = 0; kk < 8; ++kk) qf[kk] = __builtin_bit_cast(bf16x8, qr[2 * kk + h]);
            unsigned list[16];
#pragma unroll
            for (int p = 0; p < 16; ++p) list[p] = 0u;
#pragma unroll
            for (int T = 0; T < 4; ++T) {
                f32x16 a = {0.f, 0.f, 0.f, 0.f, 0.f, 0.f, 0.f, 0.f, 0.f, 0.f, 0.f, 0.f, 0.f, 0.f, 0.f, 0.f};
#pragma unroll
                for (int kk = 0; kk < 8; ++kk) { const bf16x8 kf = *(const LAS bf16x8*)(KY + hf * 34816 + (32 * T + r) * 272 + (16 * kk + 8 * h) * 2); a = mfma32(kf, qf[kk], a); }
#pragma unroll
                for (int i = 0; i < 16; ++i) { const int key = 32 * T + (i & 3) + 8 * (i >> 2) + 4 * h; const unsigned pkd = (f2s(a[i]) & ~127u) | (unsigned)(127 - key); if (MODE == 0 || i < 4) TOPK_INSERT(list, pkd); }
            }
            unsigned other[16];
#pragma unroll
            for (int p = 0; p < 16; ++p) other[p] = (unsigned)__shfl_xor((int)list[p], 32);
#pragma unroll
            for (int p = 0; p < 16; ++p) TOPK_INSERT(list, other[p]);
            if (h == 0) {
#pragma unroll
                for (int p = 0; p < 16; ++p) SC[(hf * 16 + p) * 32 + r] = list[p]; }
        }
        LDS_WAIT(); asm volatile("" ::: "memory");
        float v1[16], v2[16];
#pragma unroll
        for (int p = 0; p < 16; ++p) { v1[p] = s2f(SC[p * 32 + r] & ~127u); v2[p] = s2f(SC[(16 + p) * 32 + r] & ~127u); }
        unsigned cl[16];
#pragma unroll
        for (int p = 0; p < 16; ++p) cl[p] = 0u;
#pragma unroll
        for (int i = 0; i < 16; ++i)
#pragma unroll
            for (int j = 0; j < 16; ++j) if ((i + 1) * (j + 1) <= 16 && (MODE != 2 || i + j < 6)) { const unsigned pkd = (f2s(v1[i] + v2[j]) & ~255u) | (unsigned)(255 - (i * 16 + j)); TOPK_INSERT(cl, pkd); }
        float val[8]; int eidx[8]; float mx = -INFINITY;
#pragma unroll
        for (int p = 0; p < 16; ++p) { const int pos = 255 - (int)(cl[p] & 255u), i = pos >> 4, j = pos & 15;
            const unsigned a = SC[i * 32 + r], b2 = SC[(16 + j) * 32 + r];
            const float v = s2f(a & ~127u) + s2f(b2 & ~127u); mx = fmaxf(mx, v);
            if ((p >> 3) == h) { val[p & 7] = v; eidx[p & 7] = (127 - (int)(a & 127u)) * 128 + (127 - (int)(b2 & 127u)); } }
        float sum = 0.f, ex[8];
#pragma unroll
        for (int p = 0; p < 8; ++p) { ex[p] = __expf(val[p] - mx); sum += ex[p]; }
        sum += __shfl_xor(sum, 32);
        const float inv = 1.0f / sum;
        const int p4a = hd * 4 + 2 * h;
        GAS v4u* ip = (GAS v4u*)F.EIDX; GAS f32x4* gp = (GAS f32x4*)F.GATEQ;
        ip[(size_t)p4a * NTOK + tok] = (v4u){(unsigned)eidx[0], (unsigned)eidx[1], (unsigned)eidx[2], (unsigned)eidx[3]}; ip[(size_t)(p4a + 1) * NTOK + tok] = (v4u){(unsigned)eidx[4], (unsigned)eidx[5], (unsigned)eidx[6], (unsigned)eidx[7]};
        ((GAS v4u*)F.EIDX16)[(size_t)(hd * 2 + h) * NTOK + tok] = (v4u){(unsigned)eidx[0] | ((unsigned)eidx[1] << 16), (unsigned)eidx[2] | ((unsigned)eidx[3] << 16), (unsigned)eidx[4] | ((unsigned)eidx[5] << 16), (unsigned)eidx[6] | ((unsigned)eidx[7] << 16)};
        gp[(size_t)p4a * NTOK + tok] = (f32x4){ex[0] * inv, ex[1] * inv, ex[2] * inv, ex[3] * inv}; gp[(size_t)(p4a + 1) * NTOK + tok] = (f32x4){ex[4] * inv, ex[5] * inv, ex[6] * inv, ex[7] * inv};
        LDS_WAIT(); asm volatile("" ::: "memory");
    }
}

typedef int i32x4 __attribute__((ext_vector_type(4)));
__device__ __forceinline__ void lds_fill_128k(Frame& F, const unsigned char* src, int rot) {
    const unsigned long long g = (unsigned long long)src; const unsigned lo = __builtin_amdgcn_readfirstlane((unsigned)g), hi = __builtin_amdgcn_readfirstlane((unsigned)(g >> 32));
    const unsigned char* sb = (const unsigned char*)(((unsigned long long)hi << 32) | lo);
    const unsigned voff = (unsigned)F.tid * 16u; const int r8 = __builtin_amdgcn_readfirstlane(rot) & 15;
#pragma unroll
    for (int i = 0; i < 16; ++i) { const int ii = (i + r8) & 15;
        __builtin_amdgcn_global_load_lds((const unsigned*)(sb + (size_t)ii * 8192 + voff), (LAS unsigned*)(F.lds + ii * 8192 + F.wave * 1024), 16, 0, 0); }
}
constexpr int P8_YB = 132096;
constexpr int P8_DUMMY = 140288;
#define P8_WAITV0() asm volatile("s_waitcnt vmcnt(0)" ::: "memory")
#define P8_BAR() do { asm volatile("s_waitcnt lgkmcnt(0)" ::: "memory"); __builtin_amdgcn_s_barrier(); asm volatile("" ::: "memory"); } while (0)
__device__ __forceinline__ void p8a_sddmm(Frame& F) {
    const int wv = F.wave;
    for (int u = F.vcu; u < 256; u += F.G) {
        const int tg = u & 15, dr = u >> 4, t = tg * 512 + F.tid;
        unsigned id[64];
#pragma unroll
        for (int p8 = 0; p8 < 16; ++p8) { const v4u v = ((const GAS v4u*)F.EIDX16)[(size_t)p8 * NTOK + t]; id[4 * p8] = v.x; id[4 * p8 + 1] = v.y; id[4 * p8 + 2] = v.z; id[4 * p8 + 3] = v.w; }
        int acc[128];
#pragma unroll
        for (int p = 0; p < 128; ++p) acc[p] = 0;
        const unsigned char* tab = F.DC8 + (size_t)(dr * 32) * 131072;
        const unsigned char* ysrc = F.YC8 + ((size_t)(dr * 32) * NTOK + tg * 512) * 8 + (wv & 3) * 1024 + F.lane * 16;
        for (int sl = 0; sl < 32; ++sl) {
#pragma unroll
            for (int i = 0; i < 64; ++i) asm volatile("" : "+v"(id[i]));
            P8_WAITV0();
            P8_BAR();
            lds_fill_128k(F, tab + (size_t)sl * 131072, tg);
            if (wv < 4) __builtin_amdgcn_global_load_lds((const unsigned*)(ysrc + (size_t)sl * NTOK * 8), (LAS unsigned*)(F.lds + P8_YB + wv * 1024), 16, 0, 0);
            P8_WAITV0();
            P8_BAR();
            if (sl + 1 < 32) __builtin_amdgcn_global_load_lds((const unsigned*)(tab + (size_t)(sl + 1) * 131072 + (size_t)tg * 8192 + wv * 1024 + F.lane * 16), (LAS unsigned*)(F.lds + P8_DUMMY + wv * 1024), 16, 0, 0);
            const v2u yv = *(const LAS v2u*)(F.lds + P8_YB + F.tid * 8);
#pragma unroll
            for (int p = 0; p < 128; ++p) {
                const unsigned off = (p & 1) ? ((id[p >> 1] >> 13) & 0x7fff8u) : ((id[p >> 1] << 3) & 0x7fff8u);
                const v2u d = *(const LAS v2u*)(F.lds + off);
                acc[p] = __builtin_amdgcn_sdot4((int)d.x, (int)yv.x, acc[p], false);
                acc[p] = __builtin_amdgcn_sdot4((int)d.y, (int)yv.y, acc[p], false);
                asm volatile("" : "+v"(acc[p]));
                if ((p & 7) == 7) __builtin_amdgcn_sched_barrier(0);
            }
        }
#pragma unroll
        for (int p4 = 0; p4 < 32; ++p4) ((GAS i32x4*)F.ZP)[((size_t)(dr * 32 + p4)) * NTOK + t] = (i32x4){acc[4 * p4], acc[4 * p4 + 1], acc[4 * p4 + 2], acc[4 * p4 + 3]};
    }
    P8_WAITV0();
    __syncthreads();
}
__device__ __forceinline__ void p8h_gate(Frame& F) {
    const size_t gt = (size_t)F.vcu * 512 + F.tid, NT = (size_t)F.G * 512;
    for (size_t i = gt; i < (size_t)32 * NTOK; i += NT) {
        const int p4 = (int)(i >> 13), t = (int)(i & (NTOK - 1));
        i32x4 z = {0, 0, 0, 0};
#pragma unroll
        for (int dr = 0; dr < 16; ++dr) z += ((const GAS i32x4*)F.ZP)[((size_t)(dr * 32 + p4)) * NTOK + t];
        const v4u e4 = ((const GAS v4u*)F.EIDX)[i]; const f32x4 g4 = ((const GAS f32x4*)F.GATEQ)[i]; const float ys = F.YSC[t];
        v4u he;
#pragma unroll
        for (int c = 0; c < 4; ++c) { const float zz = (float)z[c] * ys * F.DSC[e4[c]]; const float hv = 0.5f * zz * (1.0f + erff(zz * 0.70710678118654752f)) * g4[c]; he[c] = ((f2bf(hv) << 16) & 0xfffe0000u) | (e4[c] << 3); }
        ((GAS v4u*)F.HE)[i] = he;
    }
}
template <int MODE  > __device__ __forceinline__ void p8b_spmm(Frame& F, float* dst) {
    for (int u = F.vcu; u < 256; u += F.G) {
        const int tg = u & 15, sr = u >> 4, t = tg * 512 + F.tid, b = t >> 11;
        unsigned he[128];
#pragma unroll
        for (int p4 = 0; p4 < 32; ++p4) { const v4u v = ((const GAS v4u*)F.HE)[(size_t)p4 * NTOK + t]; he[4 * p4] = v.x; he[4 * p4 + 1] = v.y; he[4 * p4 + 2] = v.z; he[4 * p4 + 3] = v.w; }
        const bf16* xrow = F.X1 + (size_t)t * DM; float* orow = dst + (size_t)t * DM; const float* g2 = F.MOD + b * NMOD + 5 * DM;
        for (int sg = 0; sg < 8; ++sg) {
            f32x2 acc[4][4];
#pragma unroll
            for (int k = 0; k < 4; ++k) {
                const int s = sr * 32 + sg * 4 + k;
#pragma unroll
                for (int i = 0; i < 128; ++i) asm volatile("" : "+v"(he[i]));
                P8_WAITV0();
                P8_BAR();
                if (MODE != 1) lds_fill_128k(F, F.UC8 + (size_t)s * 131072, tg);
                P8_WAITV0();
                P8_BAR();
                if (MODE != 1 && (sg * 4 + k) + 1 < 32) __builtin_amdgcn_global_load_lds((const unsigned*)(F.UC8 + (size_t)(s + 1) * 131072 + (size_t)tg * 8192 + F.wave * 1024 + F.lane * 16), (LAS unsigned*)(F.lds + P8_DUMMY + F.wave * 1024), 16, 0, 0);
#pragma unroll
                for (int q = 0; q < 4; ++q) acc[k][q] = (f32x2){0.f, 0.f};
#pragma unroll
                for (int p = 0; p < (MODE == 2 ? 8 : 128); ++p) {
                    const v2u w = *(const LAS v2u*)(F.lds + (he[p] & 0x1fff8u));
                    const float hv = __builtin_bit_cast(float, he[p] & 0xfffe0000u); const f32x2 h2 = {hv, hv};
                    acc[k][0] += __builtin_amdgcn_cvt_pk_f32_fp8((int)w.x, false) * h2; acc[k][1] += __builtin_amdgcn_cvt_pk_f32_fp8((int)w.x, true) * h2;
                    acc[k][2] += __builtin_amdgcn_cvt_pk_f32_fp8((int)w.y, false) * h2; acc[k][3] += __builtin_amdgcn_cvt_pk_f32_fp8((int)w.y, true) * h2;
                    if ((p & 7) == 7) { asm volatile("" : "+v"(acc[k][0]), "+v"(acc[k][1]), "+v"(acc[k][2]), "+v"(acc[k][3])); __builtin_amdgcn_sched_barrier(0); }
                }
            }
            const int c0 = (sr * 32 + sg * 4) * 8;
#pragma unroll
            for (int k = 0; k < 4; ++k) {
                const v4u xw = *(const GAS v4u*)(xrow + c0 + 8 * k); const f32x4 xa = {bflo(xw.x), bfhi(xw.x), bflo(xw.y), bfhi(xw.y)}, xb = {bflo(xw.z), bfhi(xw.z), bflo(xw.w), bfhi(xw.w)};
                const f32x4 ga = *(const GAS f32x4*)(g2 + c0 + 8 * k), gb = *(const GAS f32x4*)(g2 + c0 + 8 * k + 4);
                *(GAS f32x4*)(orow + c0 + 8 * k) = (f32x4){xa[0] + ga[0] * acc[k][0].x, xa[1] + ga[1] * acc[k][0].y, xa[2] + ga[2] * acc[k][1].x, xa[3] + ga[3] * acc[k][1].y};
                *(GAS f32x4*)(orow + c0 + 8 * k + 4) = (f32x4){xb[0] + gb[0] * acc[k][2].x, xb[1] + gb[1] * acc[k][2].y, xb[2] + gb[2] * acc[k][3].x, xb[3] + gb[3] * acc[k][3].y};
            }
        }
    }
    P8_WAITV0();
    __syncthreads();
}

struct Args { const float* in[18]; float* out; unsigned char* ws; int ph_lo, ph_hi; };
__global__ void __launch_bounds__(NWAVES * 64, 2) mega_fwd(Args args) {
    extern __shared__ __attribute__((aligned(16))) unsigned char lds[];
    Frame F;
    F.lds = (LAS unsigned char*)lds;
    F.MISC = (volatile LAS unsigned*)(F.lds + MISC_OFF);
    F.tid = threadIdx.x; F.lane = F.tid & 63; F.wave = __builtin_amdgcn_readfirstlane(F.tid >> 6);
    F.G = gridDim.x; { const int bx = blockIdx.x; F.vcu = (F.G % 8 == 0) ? (bx % 8) * (F.G / 8) + bx / 8 : bx; }
    unsigned char* ws = args.ws;
    F.ctl = (unsigned*)(ws + WS_CTL);
    F.x = args.in[0]; F.c = args.in[1]; F.w_ada = args.in[2]; F.b_ada = args.in[3]; F.w_in = args.in[4]; F.w_gate_up = args.in[5]; F.b_gla_gate = args.in[6]; F.gla_out_norm = args.in[7];
    F.swa_q_norm = args.in[8]; F.swa_k_norm = args.in[9]; F.swa_sinks = args.in[10]; F.swa_out_norm = args.in[11]; F.w_out = args.in[12]; F.w_peer_q = args.in[13];
    F.keys1 = args.in[14]; F.keys2 = args.in[15]; F.edown = args.in[16]; F.eup = args.in[17];
    F.out = args.out; F.ws = ws;
    F.MOD = (float*)(ws + WS_MOD); F.ROPE = (float*)(ws + WS_ROPE);
    F.BTIN = (bf16*)(ws + WS_BTIN); F.BTOUT = (bf16*)(ws + WS_BTOUT); F.BTQ = (bf16*)(ws + WS_BTQ); F.HBUF = (bf16*)(ws + WS_HBUF); F.PROJ = (bf16*)(ws + WS_PROJ);
    F.MIXIN = (bf16*)(ws + WS_MIXIN); F.QPEER = (bf16*)(ws + WS_QPEER);
    F.DC8 = ws + WS_DC8; F.UC8 = ws + WS_UC8; F.YC8 = ws + WS_YC8; F.ZP = (int*)(ws + WS_ZP); F.EIDX = (unsigned*)(ws + WS_EIDX); F.HE = (unsigned*)(ws + WS_HE);
    F.EIDX16 = (unsigned*)(ws + WS_EIDX16);
    F.GQT = (bf16*)(ws + WS_QPEER); F.GST = (bf16*)(ws + WS_YC8); F.GUT = (float*)(ws + WS_ZP); F.GG = (float*)(ws + WS_IDX); F.X1 = (bf16*)(ws + WS_PROJ);   F.GATEQ = (float*)(ws + WS_GATEQ); F.DSC = (float*)(ws + WS_DSC); F.YSC = (float*)(ws + WS_YSC);
    for (int u = F.tid; u < (LDS_BYTES - LDSCTL_OFF) / 4; u += NWAVES * 64) ((LAS unsigned*)(F.lds + LDSCTL_OFF))[u] = 0u;
    __syncthreads();
    XcdBarrier bar; bar.bar = F.ctl + CW_BAR; bar.x = 0; bar.st = nullptr;
    if (N_LAUNCHES == 1) bar = xcd_barrier_post(F.ctl + CW_BAR, F.MISC + 8);
#define GRID_BAR() do { if (N_LAUNCHES == 1) xcd_barrier(bar); } while (0)
    const int lo = args.ph_lo, hi = args.ph_hi;
#define IN(k) (lo <= (k) && (k) < hi)
#define BOTH(k) (IN(k) && IN((k) + 1))

    if (PROBE_REP_PHASE == 20 && IN(0)) { p0a_ada(F); GRID_BAR(); }
    if (PROBE_REP_PHASE == 21 && IN(0)) { p0b_weights(F); GRID_BAR(); }
    if (PROBE_REP_PHASE == 22 && IN(0)) { p0c_tables(F); GRID_BAR(); }
    for (int rep_ = 0; rep_ < (PROBE_REP_PHASE == 0 ? 2 : 1); ++rep_) if (IN(0)) { p0_prologue(F); if (BOTH(0)) GRID_BAR(); }
    for (int rep_ = 0; rep_ < (PROBE_REP_PHASE == 1 ? 2 : 1); ++rep_) if (IN(1)) { modulate_rows(F, F.x, F.HBUF, 0, DM); if (BOTH(1)) GRID_BAR(); }
    for (int rep_ = 0; rep_ < (PROBE_REP_PHASE == 2 ? 2 : 1); ++rep_) if (IN(2)) {
        pg8::Gemm g{F.HBUF, F.BTIN, NTOK, NPROJ, DM}; pg8::StaticOrder S; S.init(NTOK, NPROJ, F.G, (int)blockIdx.x);
        pg8::EpiBf16 E{F.PROJ, NPROJ};
        pg8::gemm_phase<pg8::EpiBf16, pg8::StaticOrder, true, true>(F.lds, g, S, E);
        {
            const int G = F.G, rem = GEMM1_UNITS % G, tg = tail_groups(G), nidle = G - rem;
            if (rem != 0 && (int)blockIdx.x >= rem) convert_expert_groups(F, (int)blockIdx.x - rem, tg, nidle);
        }
        if (BOTH(2)) GRID_BAR();
    }
    for (int rep_ = 0; rep_ < (PROBE_REP_PHASE == 3 ? 2 : 1); ++rep_) if (IN(3)) { p3a_mixer(F); GRID_BAR(); gla_scan(F); GRID_BAR(); p3c_mixer(F); if (BOTH(3)) GRID_BAR(); }
    for (int rep_ = 0; rep_ < (PROBE_REP_PHASE == 4 ? 2 : 1); ++rep_) if (IN(4)) {
        pg8::Gemm g{F.MIXIN, F.BTOUT, NTOK, DM, DM}; pg8::StaticOrder S; S.init(NTOK, DM, F.G, (int)blockIdx.x);
        pg8::EpiResid E{F.x, F.X1, DM, F.MOD + 2 * DM, NMOD, SEQ / 256};
        pg8::gemm_phase<pg8::EpiResid, pg8::StaticOrder, true, true>(F.lds, g, S, E);
        if (BOTH(4)) GRID_BAR();
    }
    for (int rep_ = 0; rep_ < (PROBE_REP_PHASE == 5 ? 2 : 1); ++rep_) if (IN(5)) { p5_modulate_quant(F); if (BOTH(5)) GRID_BAR(); }
    for (int rep_ = 0; rep_ < (PROBE_REP_PHASE == 6 ? 2 : 1); ++rep_) if (IN(6)) {
        pg8::Gemm g{F.HBUF, F.BTQ, NTOK, PEER_N, DM}; pg8::StaticOrder S; S.init(NTOK, PEER_N, F.G, (int)blockIdx.x);
        pg8::EpiBf16 E{F.QPEER, PEER_N};
        pg8::gemm_phase<pg8::EpiBf16, pg8::StaticOrder, true, true>(F.lds, g, S, E);
        if (BOTH(6)) GRID_BAR();
    }
    if (PROBE_REP_PHASE == 41 && IN(7)) { p7_topk<1>(F); GRID_BAR(); }
    if (PROBE_REP_PHASE == 42 && IN(7)) { p7_topk<2>(F); GRID_BAR(); }
    for (int rep_ = 0; rep_ < (PROBE_REP_PHASE == 7 ? 2 : 1); ++rep_) if (IN(7)) { p7_topk<0>(F); if (BOTH(7)) GRID_BAR(); }
    for (int rep_ = 0; rep_ < (PROBE_REP_PHASE == 8 ? 2 : 1); ++rep_) if (IN(8)) { p8a_sddmm(F); if (BOTH(8)) GRID_BAR(); }
    for (int rep_ = 0; rep_ < (PROBE_REP_PHASE == 9 ? 2 : 1); ++rep_) if (IN(9)) { p8h_gate(F); if (BOTH(9)) GRID_BAR(); }
    if (PROBE_REP_PHASE == 10 && IN(10)) { p8b_spmm<0>(F, (float*)(F.ws + WS_BTIN)); GRID_BAR(); }
    if (PROBE_REP_PHASE == 11 && IN(10)) { p8b_spmm<1>(F, (float*)F.PROJ); GRID_BAR(); }
    if (PROBE_REP_PHASE == 12 && IN(10)) { p8b_spmm<2>(F, (float*)F.PROJ); GRID_BAR(); }
    if (IN(10)) { p8b_spmm<0>(F, F.out); }
#undef IN
#undef BOTH
}

extern "C" void kernel_launch(void* const* d_in, const int* in_sizes, int n_in, void* d_out, int out_size, void* d_ws, size_t ws_size, hipStream_t stream) {
    static int grid = 0;
    if (grid == 0) {
        if (n_in != 18 || out_size != NTOK * DM || ws_size < WS_END) { fprintf(stderr, "kernel_launch: unexpected shapes (n_in %d, out %d, ws %zu); nothing launched\n", n_in, out_size, ws_size); grid = -1; return; }
        int dev = 0, cus = 0, per_cu = 0;
        if (hipGetDevice(&dev) != hipSuccess || hipDeviceGetAttribute(&cus, hipDeviceAttributeMultiprocessorCount, dev) != hipSuccess) { grid = -1; return; }
        if (hipFuncSetAttribute((const void*)mega_fwd, hipFuncAttributeMaxDynamicSharedMemorySize, LDS_BYTES) != hipSuccess) { fprintf(stderr, "kernel_launch: hipFuncSetAttribute failed\n"); grid = -1; return; }
        if (hipOccupancyMaxActiveBlocksPerMultiprocessor(&per_cu, (const void*)mega_fwd, NWAVES * 64, LDS_BYTES) != hipSuccess || per_cu < 1)
            fprintf(stderr, "kernel_launch: note: occupancy query reports %d workgroups per CU\n", per_cu);
        (void)hipGetLastError();
        grid = cus;
    }
    if (grid < 0) return;
    (void)hipMemsetAsync((char*)d_ws + WS_CTL, 0, CTL_ZERO_BYTES, stream);
    Args a{};
    for (int i = 0; i < 18; ++i) a.in[i] = (const float*)d_in[i];
    a.out = (float*)d_out; a.ws = (unsigned char*)d_ws;
    if (N_LAUNCHES == 1) { a.ph_lo = 0; a.ph_hi = NPHASE; hipLaunchKernelGGL(mega_fwd, dim3(grid), dim3(NWAVES * 64), LDS_BYTES, stream, a); }
    else for (int p = 0; p < NPHASE; ++p) { a.ph_lo = p; a.ph_hi = p + 1; hipLaunchKernelGGL(mega_fwd, dim3(grid), dim3(NWAVES * 64), LDS_BYTES, stream, a); }
}
```

```cpp
#include <hip/hip_runtime.h>
#include <cstdio>
#include <cstdint>

#ifndef MK_N_LAUNCHES
#define MK_N_LAUNCHES 1
#endif
#ifndef PROBE_REP_PHASE
#define PROBE_REP_PHASE -1
#endif

#define GAS __attribute__((address_space(1)))
#define LAS __attribute__((address_space(3)))
typedef unsigned short bf16;
typedef unsigned v4u __attribute__((ext_vector_type(4)));
typedef unsigned v2u __attribute__((ext_vector_type(2)));
typedef float f32x4 __attribute__((ext_vector_type(4)));
typedef float f32x2 __attribute__((ext_vector_type(2)));
typedef float f32x16 __attribute__((ext_vector_type(16)));
typedef short bf16x8 __attribute__((ext_vector_type(8)));
using bf16x2 = __attribute__((ext_vector_type(2))) __bf16;

namespace pg8 {
#define PG8_LAS __attribute__((address_space(3)))
typedef unsigned short bf16_t;
typedef short bf16x8 __attribute__((ext_vector_type(8)));
typedef float f32x4 __attribute__((ext_vector_type(4)));
typedef unsigned u32x4 __attribute__((ext_vector_type(4)));
constexpr int BM = 256, BK = 64, HALF = 128, HTB = HALF * BK * 2, STAGE_BYTES = 8 * HTB, NXCD = 8, WGM = 8;

__host__ __device__ __forceinline__ int lds_byte(int r, int c) { const int st = (r >> 4) * 2 + (c >> 5), rr = r & 15, cc = c & 31, ob = rr * 64 + cc * 2; return st * 1024 + (ob ^ (((ob >> 9) & 1) << 5)); }
__host__ __device__ __forceinline__ void stage_rc(int b, int& R, int& C) { const int st = b / 1024, sb = b % 1024, swz = sb ^ (((sb >> 9) & 1) << 5); R = (st >> 1) * 16 + swz / 64; C = (st & 1) * 32 + (swz % 64) / 2; }
__host__ __device__ __forceinline__ int perm32(int rho) { const int n = rho >> 4, i = rho & 15; return 8 * (i >> 2) + 4 * n + (i & 3); }

struct Unit { int pm, pn; };
struct Gemm { const bf16_t* A; const bf16_t* Bt; int M, N, K; };

struct StaticOrder {
    int nM, nN, nwg, G, c;
    __host__ __device__ void init(int M, int N, int G_, int c_) { nM = M / BM; nN = N / BM; nwg = nM * nN; G = G_; c = c_; }
    __host__ __device__ bool next(int i, Unit& u) const {
        const long L = (long)i * G + c; if (L >= nwg) return false;
        int wgid = (int)L; { const int q = nwg / NXCD, r = nwg % NXCD, xcd = wgid % NXCD, off = wgid / NXCD; wgid = (xcd < r ? xcd * (q + 1) : r * (q + 1) + (xcd - r) * q) + off; }
        const int nig = WGM * nN, gid = wgid / nig, fm = gid * WGM, gsz = (nM - fm) < WGM ? (nM - fm) : WGM;
        u.pm = fm + ((wgid % nig) % gsz); u.pn = (wgid % nig) / gsz; return true;
    }
    __device__ __forceinline__ void a_ready(const Unit&) const {}
    __device__ __forceinline__ void done(const Unit&) const {}
};

__device__ __forceinline__ unsigned cvt_pk_bf16(float lo, float hi) { unsigned r; asm volatile("v_cvt_pk_bf16_f32 %0, %1, %2" : "=v"(r) : "v"(lo), "v"(hi)); return r; }

struct EpiBf16 {
    static constexpr bool PERM = true, AFTER_DRAIN = false;
    bf16_t* O; int ldc;
    __device__ __forceinline__ void operator()(const f32x4 (&acc)[2][2][4][2], const Unit& u, int wr, int wc, int fr, int fq) const {
        const int row0 = u.pm * BM + wr * 64 + fr; const int col0 = u.pn * BM + wc * 32 + 8 * fq;
#pragma unroll
        for (int ai = 0; ai < 2; ++ai)
#pragma unroll
            for (int m = 0; m < 4; ++m) { bf16_t* rowp = O + (size_t)(row0 + ai * HALF + m * 16) * ldc + col0;
#pragma unroll
                for (int bj = 0; bj < 2; ++bj) { const f32x4 v0 = acc[ai][bj][m][0], v1 = acc[ai][bj][m][1];
                    u32x4 w; w.x = cvt_pk_bf16(v0[0], v0[1]); w.y = cvt_pk_bf16(v0[2], v0[3]); w.z = cvt_pk_bf16(v1[0], v1[1]); w.w = cvt_pk_bf16(v1[2], v1[3]);
                    *(u32x4*)(rowp + bj * HALF) = w; } }
    }
};
struct EpiResid {
    static constexpr bool PERM = true, AFTER_DRAIN = false;
    const float* base; bf16_t* out; int ldc; const float* gate; int gate_stride; int tiles_per_batch;
    __device__ __forceinline__ void operator()(const f32x4 (&acc)[2][2][4][2], const Unit& u, int wr, int wc, int fr, int fq) const {
        const int row0 = u.pm * BM + wr * 64 + fr, col0 = u.pn * BM + wc * 32 + 8 * fq;
        const float* gp = gate + (size_t)(u.pm / tiles_per_batch) * gate_stride + col0;
        f32x4 gv[2][2];
#pragma unroll
        for (int bj = 0; bj < 2; ++bj)
#pragma unroll
            for (int n = 0; n < 2; ++n) gv[bj][n] = *(const f32x4*)(gp + bj * HALF + 4 * n);
#pragma unroll
        for (int ai = 0; ai < 2; ++ai)
#pragma unroll
            for (int m = 0; m < 4; ++m) { const size_t off = (size_t)(row0 + ai * HALF + m * 16) * ldc + col0;
#pragma unroll
                for (int bj = 0; bj < 2; ++bj) { const f32x4 b0 = *(const f32x4*)(base + off + bj * HALF), b1 = *(const f32x4*)(base + off + bj * HALF + 4);
                    const f32x4 v0 = b0 + gv[bj][0] * acc[ai][bj][m][0], v1 = b1 + gv[bj][1] * acc[ai][bj][m][1];
                    u32x4 w; w.x = cvt_pk_bf16(v0[0], v0[1]); w.y = cvt_pk_bf16(v0[2], v0[3]); w.z = cvt_pk_bf16(v1[0], v1[1]); w.w = cvt_pk_bf16(v1[2], v1[3]);
                    *(u32x4*)(out + off + bj * HALF) = w; } }
    }
};

template <class Epi, class Sched, bool ALIGN_EPI = false, bool SP2 = false>
__device__ __forceinline__ void gemm_phase(PG8_LAS unsigned char* lds, const Gemm g, const Sched& S, const Epi& E) {
    const int tid = threadIdx.x, wid = __builtin_amdgcn_readfirstlane(tid >> 6), lane = tid & 63, wr = wid >> 2, wc = wid & 3, fr = lane & 15, fq = lane >> 4;
    const int K = g.K, nt = K / BK;
    unsigned voffA[2], voffB[2];
#pragma unroll
    for (int i = 0; i < 2; ++i) { int R, C; stage_rc(tid * 16 + i * 8192, R, C); const int Rb = Epi::PERM ? ((R & ~31) + perm32(R & 31)) : R;
        voffA[i] = (unsigned)(R * K + C) * 2u; voffB[i] = (unsigned)(Rb * K + C) * 2u; }
    const size_t kstep = (size_t)(BK * 2);
    const size_t hstep = (size_t)HALF * K * 2;
    const size_t tstep = 2 * hstep;
    const unsigned ldsw = (unsigned)wid * 1024u;
    const int aoff = lds_byte(wr * 64 + fr, fq * 8), boff = lds_byte(wc * 32 + fr, fq * 8);
#define PG8_SA(b, h) (((b) * 2 + (h)) * HTB)
#define PG8_SB(b, h) ((4 + (b) * 2 + (h)) * HTB)
#define PG8_STAGE(bufoff, gbase, voff) do { const unsigned long long _g = (unsigned long long)(gbase); const unsigned _lo = __builtin_amdgcn_readfirstlane((unsigned)_g), _hi = __builtin_amdgcn_readfirstlane((unsigned)(_g >> 32)); \
        const char* _gb = (const char*)(((unsigned long long)_hi << 32) | _lo); _Pragma("unroll") for (int _i = 0; _i < 2; ++_i) \
        __builtin_amdgcn_global_load_lds((const unsigned*)(_gb + (size_t)_i * (size_t)(64 * K * 2) + (voff)[0]), (PG8_LAS unsigned*)(lds + (bufoff) + ldsw + _i * 8192), 16, 0, 0); } while (0)
#define PG8_LDA(dst, b, h) do { _Pragma("unroll") for (int m = 0; m < 4; ++m) _Pragma("unroll") for (int k = 0; k < 2; ++k) dst[m][k] = *(const PG8_LAS bf16x8*)(lds + PG8_SA(b, h) + aoff + m * 2048 + k * 1024); } while (0)
#define PG8_LDB(dst, b, h) do { _Pragma("unroll") for (int n = 0; n < 2; ++n) _Pragma("unroll") for (int k = 0; k < 2; ++k) dst[n][k] = *(const PG8_LAS bf16x8*)(lds + PG8_SB(b, h) + boff + n * 2048 + k * 1024); } while (0)
#define PG8_MMA(ai, bj, At, Bt) do { __builtin_amdgcn_s_setprio(1); _Pragma("unroll") for (int m = 0; m < 4; ++m) _Pragma("unroll") for (int n = 0; n < 2; ++n) _Pragma("unroll") for (int k = 0; k < 2; ++k) \
        acc[ai][bj][m][n] = __builtin_amdgcn_mfma_f32_16x16x32_bf16(Bt[n][k], At[m][k], acc[ai][bj][m][n], 0, 0, 0); __builtin_amdgcn_s_setprio(0); } while (0)
#define PG8_WAIT_V(n) asm volatile("s_waitcnt vmcnt(" #n ")" ::: "memory")
#define PG8_WAIT_L(n) asm volatile("s_waitcnt lgkmcnt(" #n ")" ::: "memory")
#define PG8_BAR __builtin_amdgcn_s_barrier()
#define PG8_SCHED __builtin_amdgcn_sched_barrier(0)
    Unit cur, nxt; int ui = 0;
    if (!S.next(0, cur)) return;
    f32x4 acc[2][2][4][2];
#pragma unroll
    for (int a = 0; a < 2; ++a)
#pragma unroll
        for (int b = 0; b < 2; ++b)
#pragma unroll
            for (int m = 0; m < 4; ++m)
#pragma unroll
                for (int n = 0; n < 2; ++n) acc[a][b][m][n] = (f32x4){0.f, 0.f, 0.f, 0.f};
    bf16x8 At[4][2], B0[2][2], B1[2][2];
    const char* cA = (const char*)g.A + (size_t)cur.pm * tstep; const char* cB = (const char*)g.Bt + (size_t)cur.pn * tstep;
    S.a_ready(cur);
    if constexpr (SP2) {
        PG8_STAGE(PG8_SB(0, 0), cB, voffB); PG8_STAGE(PG8_SB(0, 1), cB + hstep, voffB); PG8_STAGE(PG8_SA(0, 0), cA, voffA); PG8_STAGE(PG8_SA(0, 1), cA + hstep, voffA);
        if (wr == 1) PG8_BAR;
        PG8_WAIT_V(2); PG8_BAR;
        PG8_STAGE(PG8_SB(1, 0), cB + kstep, voffB); PG8_STAGE(PG8_SA(1, 0), cA + kstep, voffA); PG8_STAGE(PG8_SB(1, 1), cB + hstep + kstep, voffB);
        PG8_WAIT_V(6); PG8_BAR;
    } else {
        PG8_STAGE(PG8_SB(0, 0), cB, voffB); PG8_STAGE(PG8_SA(0, 0), cA, voffA); PG8_STAGE(PG8_SB(0, 1), cB + hstep, voffB); PG8_STAGE(PG8_SA(0, 1), cA + hstep, voffA);
        if (wr == 1) PG8_BAR;
        PG8_WAIT_V(4); PG8_BAR;
        PG8_STAGE(PG8_SB(1, 0), cB + kstep, voffB); PG8_STAGE(PG8_SA(1, 0), cA + kstep, voffA); PG8_STAGE(PG8_SB(1, 1), cB + hstep + kstep, voffB);
        PG8_WAIT_V(6); PG8_BAR;
    }
    for (;;) {
        const bool has_next = S.next(ui + 1, nxt);
        const char* nA = has_next ? (const char*)g.A + (size_t)nxt.pm * tstep : cA; const char* nB = has_next ? (const char*)g.Bt + (size_t)nxt.pn * tstep : cB;
        for (int t = 0; t < nt; t += 2) {
            const bool last = (t == nt - 2);
            const char* a1 = cA + (size_t)(t + 1) * kstep;
            const char* a2 = last ? nA : cA + (size_t)(t + 2) * kstep; const char* b2 = last ? nB : cB + (size_t)(t + 2) * kstep;
            const char* a3 = a2 + kstep; const char* b3 = b2 + kstep;
            if (last && has_next) S.a_ready(nxt);
            if constexpr (SP2) {
            PG8_LDB(B0, 0, 0); PG8_LDB(B1, 0, 1); PG8_SCHED; PG8_LDA(At, 0, 0); PG8_STAGE(PG8_SA(1, 1), a1 + hstep, voffA);
            PG8_WAIT_V(8); PG8_WAIT_L(0); PG8_BAR; PG8_MMA(0, 0, At, B0); PG8_MMA(0, 1, At, B1); PG8_BAR; PG8_SCHED;
            PG8_LDA(At, 0, 1); PG8_STAGE(PG8_SB(0, 0), b2, voffB); PG8_STAGE(PG8_SB(0, 1), b2 + hstep, voffB); PG8_STAGE(PG8_SA(0, 0), a2, voffA);
            PG8_WAIT_V(8); PG8_WAIT_L(0); PG8_BAR; PG8_MMA(1, 0, At, B0); PG8_MMA(1, 1, At, B1); PG8_BAR; PG8_SCHED;
            PG8_LDB(B0, 1, 0); PG8_LDB(B1, 1, 1); PG8_SCHED; PG8_LDA(At, 1, 0); PG8_STAGE(PG8_SA(0, 1), a2 + hstep, voffA);
            PG8_WAIT_V(8); PG8_WAIT_L(0); PG8_BAR; PG8_MMA(0, 0, At, B0); PG8_MMA(0, 1, At, B1); PG8_BAR; PG8_SCHED;
            PG8_LDA(At, 1, 1); PG8_STAGE(PG8_SB(1, 0), b3, voffB); PG8_STAGE(PG8_SB(1, 1), b3 + hstep, voffB); PG8_STAGE(PG8_SA(1, 0), a3, voffA);
            PG8_WAIT_V(8); PG8_WAIT_L(0); PG8_BAR; PG8_MMA(1, 0, At, B0); PG8_MMA(1, 1, At, B1); PG8_BAR; PG8_SCHED;
            } else {
            PG8_LDB(B0, 0, 0); PG8_SCHED; PG8_LDA(At, 0, 0); PG8_STAGE(PG8_SA(1, 1), a1 + hstep, voffA);
            PG8_WAIT_L(8); PG8_BAR; PG8_WAIT_L(0); PG8_MMA(0, 0, At, B0); PG8_BAR; PG8_SCHED;
            PG8_LDB(B1, 0, 1); PG8_STAGE(PG8_SB(0, 0), b2, voffB);
            PG8_BAR; PG8_WAIT_L(0); PG8_MMA(0, 1, At, B1); PG8_BAR;
            PG8_LDA(At, 0, 1); PG8_STAGE(PG8_SA(0, 0), a2, voffA);
            PG8_BAR; PG8_WAIT_L(0); PG8_MMA(1, 0, At, B0); PG8_BAR; PG8_SCHED;
            PG8_STAGE(PG8_SB(0, 1), b2 + hstep, voffB);
            PG8_WAIT_V(6); PG8_BAR; PG8_MMA(1, 1, At, B1); PG8_BAR;
            PG8_LDB(B0, 1, 0); PG8_SCHED; PG8_LDA(At, 1, 0); PG8_STAGE(PG8_SA(0, 1), a2 + hstep, voffA);
            PG8_WAIT_L(8); PG8_BAR; PG8_WAIT_L(0); PG8_MMA(0, 0, At, B0); PG8_BAR; PG8_SCHED;
            PG8_LDB(B1, 1, 1); PG8_STAGE(PG8_SB(1, 0), b3, voffB);
            PG8_BAR; PG8_WAIT_L(0); PG8_MMA(0, 1, At, B1); PG8_BAR;
            PG8_LDA(At, 1, 1); PG8_STAGE(PG8_SA(1, 0), a3, voffA);
            PG8_BAR; PG8_WAIT_L(0); PG8_MMA(1, 0, At, B0); PG8_BAR; PG8_SCHED;
            PG8_STAGE(PG8_SB(1, 1), b3 + hstep, voffB);
            PG8_WAIT_V(6); PG8_BAR; PG8_MMA(1, 1, At, B1); PG8_BAR;
            }
        }
        if constexpr (ALIGN_EPI) { if (wr == 0) PG8_BAR; }
        if constexpr (!Epi::AFTER_DRAIN) { E(acc, cur, wr, wc, fr, fq); S.done(cur); }
        if (!has_next) break;
#pragma unroll
        for (int a = 0; a < 2; ++a)
#pragma unroll
            for (int b = 0; b < 2; ++b)
#pragma unroll
                for (int m = 0; m < 4; ++m)
#pragma unroll
                    for (int n = 0; n < 2; ++n) acc[a][b][m][n] = (f32x4){0.f, 0.f, 0.f, 0.f};
        cur = nxt; cA = nA; cB = nB; ++ui;
        if constexpr (ALIGN_EPI) { if (wr == 1) PG8_BAR; }
    }
    PG8_WAIT_V(0);
    if constexpr (!ALIGN_EPI) { if (wr == 0) PG8_BAR; }
    PG8_BAR;
#undef PG8_SA
#undef PG8_SB
#undef PG8_STAGE
#undef PG8_LDA
#undef PG8_LDB
#undef PG8_MMA
#undef PG8_WAIT_V
#undef PG8_WAIT_L
#undef PG8_BAR
#undef PG8_SCHED
}
}

constexpr int NWAVES = 8;
constexpr int NPHASE = 11;
constexpr int N_LAUNCHES = MK_N_LAUNCHES;
constexpr int BATCH = 4, SEQ = 2048, DM = 4096, NTOK = BATCH * SEQ;
constexpr int NMOD = 6 * DM;
constexpr int IN_WIDTH = 8720;
constexpr int NPROJ = 8960;
constexpr int C_GQ = 0, C_GK = 1024, C_GV = 2048, C_GG = 4096, C_SQ = 6144, C_SK = 8192, C_SV = 8448, C_GA = 8704;
constexpr int NEXP = 16384, PEER_N = 2048;
constexpr float EPS = 1e-6f;

constexpr size_t MiB = 1u << 20;
constexpr size_t WS_CTL = 0, CTL_ZERO_BYTES = 1 * MiB;
constexpr size_t WS_MOD = 1 * MiB;
constexpr size_t WS_ROPE = 2 * MiB;
constexpr size_t WS_BTIN = 4 * MiB;
constexpr size_t WS_BTOUT = 74 * MiB;
constexpr size_t WS_BTQ = 106 * MiB;
constexpr size_t WS_HBUF = 122 * MiB;
constexpr size_t WS_PROJ = 186 * MiB;
constexpr size_t WS_MIXIN = 326 * MiB;
constexpr size_t WS_QPEER = 390 * MiB;
constexpr size_t WS_IDX = 422 * MiB;
constexpr size_t WS_GATE = 426 * MiB;
constexpr size_t WS_DC8 = 430 * MiB;
constexpr size_t WS_UC8 = 494 * MiB;
constexpr size_t WS_YC8 = 558 * MiB;
constexpr size_t WS_ZP = 590 * MiB;
constexpr size_t WS_EIDX = 654 * MiB;
constexpr size_t WS_GATEQ = 658 * MiB;
constexpr size_t WS_HE = 662 * MiB;
constexpr size_t WS_DSC = 666 * MiB;
constexpr size_t WS_YSC = 667 * MiB;
constexpr size_t WS_EIDX16 = 668 * MiB;
constexpr size_t WS_END = 670 * MiB;
constexpr int CW_BAR = 4096;

constexpr int RING_BYTES = 131072;
constexpr int LDSCTL_OFF = RING_BYTES, MISC_OFF = LDSCTL_OFF + 320;
constexpr int LDS_BYTES = 155648;

#define LDS_WAIT() asm volatile("s_waitcnt lgkmcnt(0)" ::: "memory")
#define VM_WAIT() asm volatile("s_waitcnt vmcnt(0)" ::: "memory")
__device__ __forceinline__ unsigned f2bf(float f) { unsigned u = __builtin_bit_cast(unsigned, f); return (u + 0x7fffu + ((u >> 16) & 1u)) >> 16; }
typedef __bf16 bf16x2_t __attribute__((ext_vector_type(2)));
__device__ __forceinline__ unsigned pk2(float lo, float hi) { const bf16x2_t v = {(__bf16)lo, (__bf16)hi}; return __builtin_bit_cast(unsigned, v); }
__device__ __forceinline__ float bflo(unsigned w) { return __builtin_bit_cast(float, w << 16); }
__device__ __forceinline__ float bfhi(unsigned w) { return __builtin_bit_cast(float, w & 0xffff0000u); }
__device__ __forceinline__ float dot2_bf16(unsigned w, unsigned x, float acc) { return __builtin_amdgcn_fdot2_f32_bf16(__builtin_bit_cast(bf16x2, w), __builtin_bit_cast(bf16x2, x), acc, false); }
__device__ __forceinline__ f32x16 mfma32(bf16x8 a, bf16x8 b, f32x16 c) { return __builtin_amdgcn_mfma_f32_32x32x16_bf16(a, b, c, 0, 0, 0); }
__device__ __forceinline__ f32x4 mfma16(bf16x8 a, bf16x8 b, f32x4 c) { return __builtin_amdgcn_mfma_f32_16x16x32_bf16(a, b, c, 0, 0, 0); }
__device__ __forceinline__ bf16x8 mk8(unsigned a, unsigned b, unsigned c, unsigned d) { v4u t = {a, b, c, d}; return __builtin_bit_cast(bf16x8, t); }
__device__ __forceinline__ float silu_f(float x) { return x / (1.0f + __expf(-x)); }

#define XB_TMO      128
#define XB_XCNT(j)  (256  + 64 * (j))
#define XB_XSUB(j)  (1280 + 64 * (j))
#define XB_XGEN(j)  (2304 + 64 * (j))
#define XB_TOP      3328
#define XB_TOPGEN   3392
#define XCD_BAR_WORDS 3456
#define XB_SPIN_CAP (1u << 18)
__device__ __forceinline__ unsigned xb_ld(unsigned* p)              { return __hip_atomic_load(p, __ATOMIC_RELAXED, __HIP_MEMORY_SCOPE_AGENT); }
__device__ __forceinline__ unsigned xb_add(unsigned* p, unsigned v) { return __hip_atomic_fetch_add(p, v, __ATOMIC_RELAXED, __HIP_MEMORY_SCOPE_AGENT); }
__device__ __forceinline__ unsigned xb_xcc_id() { return (unsigned)__builtin_amdgcn_s_getreg((3 << 11) | 20) & 0xFu; }
#define XB_SPIN(cond, bar) do { unsigned _sp = 0; while (cond) { __builtin_amdgcn_s_sleep(1); \
    if ((++_sp & 255u) == 0u) { if (xb_ld(&(bar)[XB_TMO])) break; if (_sp > XB_SPIN_CAP) { atomicAdd(&(bar)[XB_TMO], 1u); break; } } } } while (0)
struct XcdBarrier { unsigned* bar; unsigned x; volatile LAS unsigned* st; };
__device__ __forceinline__ XcdBarrier xcd_barrier_post(unsigned* bar, volatile LAS unsigned* st) {
    XcdBarrier b; b.bar = bar; b.x = xb_xcc_id(); b.st = st;
    if (threadIdx.x == 0) (void)xb_add(&bar[XB_XCNT(b.x)], 1u);
    return b;
}
__device__ __forceinline__ void xcd_barrier_complete(unsigned* bar, unsigned x, unsigned& nloc, unsigned& nx) {
    const unsigned G = gridDim.x * gridDim.y * gridDim.z;
    unsigned sum, cnt, mine, sp = 0u;
    for (;;) {
        sum = 0u; cnt = 0u; mine = 0u;
#pragma unroll
        for (unsigned j = 0; j < 16; ++j) { const unsigned c = xb_ld(&bar[XB_XCNT(j)]); sum += c; cnt += (c > 0u) ? 1u : 0u; mine = (j == x) ? c : mine; }
        if (sum == G) break;
        __builtin_amdgcn_s_sleep(1);
        if ((++sp & 255u) == 0u) { if (xb_ld(&bar[XB_TMO])) break; if (sp > XB_SPIN_CAP) { atomicAdd(&bar[XB_TMO], 1u); break; } }
    }
    nloc = mine > 0u ? mine : 1u; nx = cnt > 0u ? cnt : 1u;
}
__device__ __forceinline__ void xcd_barrier(const XcdBarrier& b) {
    asm volatile("s_waitcnt vmcnt(0)" ::: "memory");
    __syncthreads();
    if (threadIdx.x == 0) {
        unsigned* bar = b.bar;
        __builtin_amdgcn_s_waitcnt(0);
        unsigned nloc = b.st[0], nx = b.st[1];
        if (nloc == 0u) { xcd_barrier_complete(bar, b.x, nloc, nx); b.st[0] = nloc; b.st[1] = nx; }
        const unsigned old = xb_add(&bar[XB_XSUB(b.x)], 1u);
        const unsigned gen = old / nloc;
        if (old + 1u == (gen + 1u) * nloc) {
            __builtin_amdgcn_fence(__ATOMIC_RELEASE, "agent");
            asm volatile("s_waitcnt vmcnt(0)" ::: "memory");
            const unsigned og = xb_add(&bar[XB_TOP], 1u);
            const unsigned tg = og / nx;
            if (og + 1u == (tg + 1u) * nx) xb_add(&bar[XB_TOPGEN], 1u);
            else XB_SPIN(xb_ld(&bar[XB_TOPGEN]) == tg, bar);
            __builtin_amdgcn_fence(__ATOMIC_ACQUIRE, "agent");
            xb_add(&bar[XB_XGEN(b.x)], 1u);
            asm volatile("s_waitcnt vmcnt(0)" ::: "memory");
        } else {
            XB_SPIN(xb_ld(&bar[XB_XGEN(b.x)]) == gen, bar);
            __builtin_amdgcn_fence(__ATOMIC_ACQUIRE, "agent");
            asm volatile("s_waitcnt vmcnt(0)" ::: "memory");
        }
    }
    __syncthreads();
}

struct Frame {
    LAS unsigned char* lds;
    volatile LAS unsigned* MISC;
    unsigned* ctl;
    int tid, lane, wave, vcu, G;
    const float *x, *c, *w_ada, *b_ada, *w_in, *w_gate_up, *b_gla_gate, *gla_out_norm, *swa_q_norm, *swa_k_norm, *swa_sinks, *swa_out_norm, *w_out, *w_peer_q, *keys1, *keys2, *edown, *eup;
    float* out;
    unsigned char* ws;
    float *MOD, *ROPE;
    bf16 *BTIN, *BTOUT, *BTQ, *HBUF, *PROJ, *MIXIN, *QPEER;
    unsigned char *DC8, *UC8, *YC8;
    int* ZP; unsigned *EIDX, *HE, *EIDX16; float *GATEQ, *DSC, *YSC;
    bf16 *GQT, *GST, *X1; float *GUT, *GG;
};

__device__ __forceinline__ float wave_sum(float v) {
#pragma unroll
    for (int o = 1; o < 64; o <<= 1) v += __shfl_xor(v, o);
    return v;
}
__device__ __forceinline__ float wave_max(float v) {
#pragma unroll
    for (int o = 1; o < 64; o <<= 1) v = fmaxf(v, __shfl_xor(v, o));
    return v;
}
__device__ __forceinline__ unsigned pack4i(float a, float b, float c, float d) {
    const int q0 = (int)__builtin_rintf(a), q1 = (int)__builtin_rintf(b), q2 = (int)__builtin_rintf(c), q3 = (int)__builtin_rintf(d);
    return (unsigned)(q0 & 255) | ((unsigned)(q1 & 255) << 8) | ((unsigned)(q2 & 255) << 16) | ((unsigned)q3 << 24);
}

__device__ __forceinline__ void p0_tr_item(const float* W, int ldw, int sc0, int ncols, bf16* WT, int dr0, int k0, LAS float* scr, int lane) {
    const int c4 = (lane & 7) * 4, kr = lane >> 3;
    f32x4 v[8];
#pragma unroll
    for (int i = 0; i < 8; ++i) v[i] = (c4 < ncols) ? *(const GAS f32x4*)(W + (size_t)(k0 + kr + 8 * i) * ldw + sc0 + c4) : (f32x4){0.f, 0.f, 0.f, 0.f};
#pragma unroll
    for (int i = 0; i < 8; ++i) { LAS float* d = scr + (kr + 8 * i) * 33 + c4; d[0] = v[i][0]; d[1] = v[i][1]; d[2] = v[i][2]; d[3] = v[i][3]; }
    LDS_WAIT(); asm volatile("" ::: "memory");
    const int c8 = lane & 7;
#pragma unroll
    for (int j = 0; j < 4; ++j) { const int n = (lane >> 3) + 8 * j; const LAS float* s = scr + (8 * c8) * 33 + n;
        v4u o; o.x = pk2(s[0 * 33], s[1 * 33]); o.y = pk2(s[2 * 33], s[3 * 33]); o.z = pk2(s[4 * 33], s[5 * 33]); o.w = pk2(s[6 * 33], s[7 * 33]);
        if (n < ncols) *(GAS v4u*)(WT + (size_t)(dr0 + n) * DM + k0 + 8 * c8) = o; }
    LDS_WAIT(); asm volatile("" ::: "memory");
}

__device__ __forceinline__ void p0a_ada(Frame& F) {
    const int tid = F.tid, lane = F.lane, wave = F.wave;
    {
        LAS f32x4* cact = (LAS f32x4*)F.lds;
        LAS float* red = (LAS float*)(F.lds + 65536);
        for (int k = tid; k < DM; k += 512) { f32x4 v;
#pragma unroll
            for (int b = 0; b < 4; ++b) { const float cv = F.c[b * DM + k]; v[b] = cv / (1.0f + expf(-cv)); }
            cact[k] = v; }
        __syncthreads();
        for (int slice = F.vcu; slice < 256; slice += F.G) {
            const int col0 = slice * 96, sub = lane / 24, cl = lane - sub * 24;
            f32x4 acc[4];
#pragma unroll
            for (int b = 0; b < 4; ++b) acc[b] = (f32x4){0.f, 0.f, 0.f, 0.f};
            if (lane < 48) {
                const float* wp = F.w_ada + col0 + 4 * cl;
#pragma unroll 16
                for (int k = wave * 2 + sub; k < DM; k += 16) {
                    const f32x4 w = *(const GAS f32x4*)(wp + (size_t)k * NMOD); const f32x4 cv = cact[k];
#pragma unroll
                    for (int b = 0; b < 4; ++b) acc[b] += w * cv[b];
                }
#pragma unroll
                for (int b = 0; b < 4; ++b) *(LAS f32x4*)(red + (wave * 48 + lane) * 16 + 4 * b) = acc[b];
            }
            __syncthreads();
            if (tid < 384) { const int b = tid / 96, col = tid - b * 96, cl2 = col >> 2, e = col & 3; float s = 0.f;
#pragma unroll
                for (int w = 0; w < 8; ++w) { s += red[(w * 48 + cl2) * 16 + 4 * b + e]; s += red[(w * 48 + 24 + cl2) * 16 + 4 * b + e]; }
                F.MOD[b * NMOD + col0 + col] = s + F.b_ada[col0 + col]; }
            __syncthreads();
        }
    }
}
__device__ __forceinline__ void p0b_weights(Frame& F) {
    const int tid = F.tid, lane = F.lane, wave = F.wave;
    const int gw = F.vcu * NWAVES + wave, NGW = F.G * NWAVES;
    {
        LAS float* scr = (LAS float*)(F.lds + wave * 16384);
        constexpr int NB0 = 192, NB1 = 80, NB2 = 1, NB3 = 128, NB4 = 64, NBT = NB0 + NB1 + NB2 + NB3 + NB4;
        for (int it = gw; it < NBT * 64; it += NGW) {
            int nb = it >> 6; const int k0 = (it & 63) * 64;
            if (nb < NB0) { p0_tr_item(F.w_in, IN_WIDTH, 32 * nb, 32, F.BTIN, 32 * nb, k0, scr, lane); continue; } nb -= NB0;
            if (nb < NB1) { p0_tr_item(F.w_in, IN_WIDTH, 6160 + 32 * nb, 32, F.BTIN, 6144 + 32 * nb, k0, scr, lane); continue; } nb -= NB1;
            if (nb < NB2) { p0_tr_item(F.w_in, IN_WIDTH, 6144, 16, F.BTIN, C_GA, k0, scr, lane); continue; } nb -= NB2;
            if (nb < NB3) { p0_tr_item(F.w_out, DM, 32 * nb, 32, F.BTOUT, 32 * nb, k0, scr, lane); continue; } nb -= NB3;
            p0_tr_item(F.w_peer_q, PEER_N, 32 * nb, 32, F.BTQ, 32 * nb, k0, scr, lane);
        }
        const size_t gt = (size_t)F.vcu * 512 + tid, NT = (size_t)F.G * 512;
        GAS v4u* z = (GAS v4u*)(F.BTIN + (size_t)(C_GA + 16) * DM);
        for (size_t i = gt; i < (size_t)240 * DM / 8; i += NT) z[i] = (v4u){0u, 0u, 0u, 0u};
        for (size_t e = gt; e < (size_t)SEQ * 32; e += NT) { const int pos = (int)(e >> 5), i = (int)(e & 31);
            const float inv = exp2f(-(float)i * (13.287712379549449f / 32.0f));
            const float ang = (float)pos * inv;
            const double rev = (double)ang * 0.15915494309189535; const float fr = (float)(rev - floor(rev));
            F.ROPE[e] = __builtin_amdgcn_cosf(fr); F.ROPE[SEQ * 32 + e] = __builtin_amdgcn_sinf(fr); }
    }
}
__device__ __forceinline__ void convert_expert_groups(Frame& F, int g_lo, int g_hi, int g_step) {
    const int tid = F.tid, lane = F.lane, wave = F.wave;
    __syncthreads();
    for (int tb = 0; tb < 2; ++tb) {
        const float* srcT = tb ? F.eup : F.edown; unsigned char* dstT = tb ? F.UC8 : F.DC8;
        for (int grp = g_lo; grp < g_hi; grp += g_step) {
            const int e0 = grp * 32;
#pragma unroll 1
            for (int r = 0; r < 4; ++r) {
                const int el = wave * 4 + r, e = e0 + el;
                const GAS f32x4* src = (const GAS f32x4*)(srcT + (size_t)e * DM);
                f32x4 a[8], b[8];
#pragma unroll
                for (int j = 0; j < 8; ++j) { a[j] = src[2 * (lane + 64 * j)]; b[j] = src[2 * (lane + 64 * j) + 1]; }
                if (tb == 0) {
                    float m = 0.f;
#pragma unroll
                    for (int j = 0; j < 8; ++j)
#pragma unroll
                        for (int q = 0; q < 4; ++q) m = fmaxf(m, fmaxf(fabsf(a[j][q]), fabsf(b[j][q])));
                    m = wave_max(m);
                    const float inv = m > 0.f ? 127.0f / m : 0.f;
                    if (lane == 0) F.DSC[e] = m * (1.0f / 127.0f);
#pragma unroll
                    for (int j = 0; j < 8; ++j) { v2u o; o.x = pack4i(a[j][0] * inv, a[j][1] * inv, a[j][2] * inv, a[j][3] * inv); o.y = pack4i(b[j][0] * inv, b[j][1] * inv, b[j][2] * inv, b[j][3] * inv);
                        *(LAS v2u*)(F.lds + el * 4096 + ((lane + 64 * j + el) & 511) * 8) = o; }
                } else {
#pragma unroll
                    for (int j = 0; j < 8; ++j) { int w0 = __builtin_amdgcn_cvt_pk_fp8_f32(a[j][0], a[j][1], 0, false); w0 = __builtin_amdgcn_cvt_pk_fp8_f32(a[j][2], a[j][3], w0, true);
                        int w1 = __builtin_amdgcn_cvt_pk_fp8_f32(b[j][0], b[j][1], 0, false); w1 = __builtin_amdgcn_cvt_pk_fp8_f32(b[j][2], b[j][3], w1, true);
                        v2u o; o.x = (unsigned)w0; o.y = (unsigned)w1;
                        *(LAS v2u*)(F.lds + el * 4096 + ((lane + 64 * j + el) & 511) * 8) = o; }
                }
            }
            __syncthreads();
            { const int el = tid & 31;
#pragma unroll 4
              for (int it = 0; it < 32; ++it) { const int sc = it * 16 + (tid >> 5);
                  const v2u o = *(const LAS v2u*)(F.lds + el * 4096 + ((sc + el) & 511) * 8);
                  *(GAS v2u*)(dstT + ((size_t)sc * NEXP + e0 + el) * 8) = o; } }
            __syncthreads();
        }
    }
}
constexpr int GEMM1_UNITS = (NTOK / 256) * (NPROJ / 256);
__host__ __device__ constexpr int tail_groups(int G) { return (GEMM1_UNITS % G) ? (512 - G > 0 ? 512 - G : 0) : 0; }
__device__ __forceinline__ void p0c_tables(Frame& F) {
    convert_expert_groups(F, tail_groups(F.G) + F.vcu, 512, F.G);
}
__device__ __forceinline__ void p0_prologue(Frame& F) { p0a_ada(F); p0b_weights(F); p0c_tables(F); }

__device__ __forceinline__ void modulate_rows(Frame& F, const float* src, bf16* dst, int sh_off, int sc_off) {
    const int gw = F.vcu * NWAVES + F.wave, NGW = F.G * NWAVES, lane = F.lane;
    for (int m = gw; m < NTOK; m += NGW) {
        const int b = m >> 11;
        const GAS f32x4* xr = (const GAS f32x4*)(src + (size_t)m * DM) + lane;
        f32x4 v[16]; float s = 0.f;
#pragma unroll
        for (int j = 0; j < 16; ++j) { v[j] = xr[64 * j]; s += (v[j].x * v[j].x + v[j].y * v[j].y) + (v[j].z * v[j].z + v[j].w * v[j].w); }
        const float rstd = 1.0f / sqrtf(wave_sum(s) * (1.0f / DM) + EPS);
        const GAS f32x4* shp = (const GAS f32x4*)(F.MOD + b * NMOD + sh_off) + lane;
        const GAS f32x4* scp = (const GAS f32x4*)(F.MOD + b * NMOD + sc_off) + lane;
        GAS v2u* o8 = (GAS v2u*)(dst + (size_t)m * DM) + lane;
#pragma unroll
        for (int j = 0; j < 16; ++j) { const f32x4 sh = shp[64 * j], sc = scp[64 * j]; const f32x4 y = v[j] * rstd * (sc + 1.0f) + sh;
            v2u o; o.x = pk2(y.x, y.y); o.y = pk2(y.z, y.w); o8[64 * j] = o; }
    }
}


__device__ __forceinline__ void p5_modulate_quant(Frame& F) {
    const int gw = F.vcu * NWAVES + F.wave, NGW = F.G * NWAVES, lane = F.lane;
    for (int m = gw; m < NTOK; m += NGW) {
        const int b = m >> 11;
        const GAS v4u* xr = (const GAS v4u*)(F.X1 + (size_t)m * DM);
        f32x4 a[8], c[8]; float s = 0.f;
#pragma unroll
        for (int j = 0; j < 8; ++j) { const v4u w = xr[lane + 64 * j]; a[j] = (f32x4){bflo(w.x), bfhi(w.x), bflo(w.y), bfhi(w.y)}; c[j] = (f32x4){bflo(w.z), bfhi(w.z), bflo(w.w), bfhi(w.w)};
            s += (a[j].x * a[j].x + a[j].y * a[j].y) + (a[j].z * a[j].z + a[j].w * a[j].w) + (c[j].x * c[j].x + c[j].y * c[j].y) + (c[j].z * c[j].z + c[j].w * c[j].w); }
        const float rstd = 1.0f / sqrtf(wave_sum(s) * (1.0f / DM) + EPS);
        const GAS f32x4* shp = (const GAS f32x4*)(F.MOD + b * NMOD + 3 * DM);
        const GAS f32x4* scp = (const GAS f32x4*)(F.MOD + b * NMOD + 4 * DM);
        float mx = 0.f;
#pragma unroll
        for (int j = 0; j < 8; ++j) { const int i0 = 2 * (lane + 64 * j);
            a[j] = a[j] * rstd * (scp[i0] + 1.0f) + shp[i0]; c[j] = c[j] * rstd * (scp[i0 + 1] + 1.0f) + shp[i0 + 1];
#pragma unroll
            for (int q = 0; q < 4; ++q) mx = fmaxf(mx, fmaxf(fabsf(a[j][q]), fabsf(c[j][q])));
            *(GAS v4u*)(F.HBUF + (size_t)m * DM + 8 * (lane + 64 * j)) = (v4u){pk2(a[j].x, a[j].y), pk2(a[j].z, a[j].w), pk2(c[j].x, c[j].y), pk2(c[j].z, c[j].w)}; }
        mx = wave_max(mx);
        const float inv = mx > 0.f ? 127.0f / mx : 0.f;
        if (lane == 0) F.YSC[m] = mx * (1.0f / 127.0f);
#pragma unroll
        for (int j = 0; j < 8; ++j) { v2u o; o.x = pack4i(a[j].x * inv, a[j].y * inv, a[j].z * inv, a[j].w * inv); o.y = pack4i(c[j].x * inv, c[j].y * inv, c[j].z * inv, c[j].w * inv);
            *(GAS v2u*)(F.YC8 + ((size_t)(lane + 64 * j) * NTOK + m) * 8) = o; }
    }
}

__device__ __forceinline__ void swa_unit(Frame& F, int u) {
    const int b = u >> 6, kvh = (u >> 4) & 3, n = u & 15, t0 = n * 128;
    LAS unsigned char* KL = F.lds;
    LAS unsigned char* VL = F.lds + 36864;
    const float* COS = F.ROPE; const float* SIN = F.ROPE + SEQ * 32;
    {
        const int key = F.tid >> 1, p = F.tid & 1, kpos = t0 - 128 + key;
        v4u ka[2] = {{0u, 0u, 0u, 0u}, {0u, 0u, 0u, 0u}}, kb[2] = {{0u, 0u, 0u, 0u}, {0u, 0u, 0u, 0u}}, vv[4] = {{0u, 0u, 0u, 0u}, {0u, 0u, 0u, 0u}, {0u, 0u, 0u, 0u}, {0u, 0u, 0u, 0u}};
        float cs[16], sn[16];
#pragma unroll
        for (int i = 0; i < 16; ++i) { cs[i] = 1.f; sn[i] = 0.f; }
        if (kpos >= 0) {
            const bf16* pr = F.PROJ + (size_t)(b * SEQ + kpos) * NPROJ;
            const GAS v4u* kr = (const GAS v4u*)(pr + C_SK + kvh * 64);
            ka[0] = kr[2 * p]; ka[1] = kr[2 * p + 1]; kb[0] = kr[4 + 2 * p]; kb[1] = kr[4 + 2 * p + 1];
            const GAS v4u* vr = (const GAS v4u*)(pr + C_SV + kvh * 64 + 32 * p);
#pragma unroll
            for (int j = 0; j < 4; ++j) vv[j] = vr[j];
            const GAS f32x4* cp = (const GAS f32x4*)(COS + kpos * 32 + 16 * p); const GAS f32x4* sp = (const GAS f32x4*)(SIN + kpos * 32 + 16 * p);
#pragma unroll
            for (int j = 0; j < 4; ++j) { const f32x4 c4 = cp[j], s4 = sp[j];
#pragma unroll
                for (int e = 0; e < 4; ++e) { cs[4 * j + e] = c4[e]; sn[4 * j + e] = s4[e]; } }
        }
        float x1[16], x2[16]; float ss = 0.f;
#pragma unroll
        for (int j = 0; j < 2; ++j)
#pragma unroll
            for (int e = 0; e < 4; ++e) { x1[8 * j + 2 * e] = bflo(ka[j][e]); x1[8 * j + 2 * e + 1] = bfhi(ka[j][e]); x2[8 * j + 2 * e] = bflo(kb[j][e]); x2[8 * j + 2 * e + 1] = bfhi(kb[j][e]); }
#pragma unroll
        for (int i = 0; i < 16; ++i) ss += x1[i] * x1[i] + x2[i] * x2[i];
        ss += __shfl_xor(ss, 1);
        const float rstd = 1.0f / sqrtf(ss * (1.0f / 64.0f) + EPS);
        unsigned o1[8], o2[8];
#pragma unroll
        for (int i = 0; i < 8; ++i) {
            float y1[2], y2[2];
#pragma unroll
            for (int e = 0; e < 2; ++e) { const int d = 2 * i + e; const float a = x1[d] * rstd * F.swa_k_norm[16 * p + d], c = x2[d] * rstd * F.swa_k_norm[32 + 16 * p + d];
                y1[e] = a * cs[d] - c * sn[d]; y2[e] = c * cs[d] + a * sn[d]; }
            o1[i] = pk2(y1[0], y1[1]); o2[i] = pk2(y2[0], y2[1]);
        }
        LAS v4u* kd = (LAS v4u*)(KL + key * 144 + 32 * p);
        kd[0] = (v4u){o1[0], o1[1], o1[2], o1[3]}; kd[1] = (v4u){o1[4], o1[5], o1[6], o1[7]};
        LAS v4u* kd2 = (LAS v4u*)(KL + key * 144 + 64 + 32 * p);
        kd2[0] = (v4u){o2[0], o2[1], o2[2], o2[3]}; kd2[1] = (v4u){o2[4], o2[5], o2[6], o2[7]};
#pragma unroll
        for (int j = 0; j < 4; ++j)
#pragma unroll
            for (int e = 0; e < 4; ++e) { const int d = 32 * p + 8 * j + 2 * e; const unsigned w = vv[j][e];
                *(LAS unsigned short*)(VL + d * 520 + key * 2) = (unsigned short)(w & 0xffffu);
                *(LAS unsigned short*)(VL + (d + 1) * 520 + key * 2) = (unsigned short)(w >> 16); }
    }
    __syncthreads();
    {
        const int g = F.wave, hq = kvh * 8 + g, r = F.lane & 31, h = F.lane >> 5;
        const float sink = F.swa_sinks[hq];
        for (int qt = 0; qt < 4; ++qt) {
            const int qpos = t0 + 32 * qt + r;
            const size_t tok = (size_t)(b * SEQ + qpos);
            const GAS v4u* qr = (const GAS v4u*)(F.PROJ + tok * NPROJ + C_SQ + hq * 64);
            v4u qraw[4];
#pragma unroll
            for (int kk = 0; kk < 4; ++kk) qraw[kk] = qr[2 * kk + h];
            float qf[4][8]; float ss = 0.f;
#pragma unroll
            for (int kk = 0; kk < 4; ++kk)
#pragma unroll
                for (int e = 0; e < 4; ++e) { qf[kk][2 * e] = bflo(qraw[kk][e]); qf[kk][2 * e + 1] = bfhi(qraw[kk][e]); }
#pragma unroll
            for (int kk = 0; kk < 4; ++kk)
#pragma unroll
                for (int j = 0; j < 8; ++j) ss += qf[kk][j] * qf[kk][j];
            ss += __shfl_xor(ss, 32);
            const float rstd = 0.125f / sqrtf(ss * (1.0f / 64.0f) + EPS);
            bf16x8 qfrag[4];
#pragma unroll
            for (int kk = 0; kk < 2; ++kk) {
                float y1[8], y2[8];
                const GAS f32x4* cp = (const GAS f32x4*)(COS + qpos * 32 + 16 * kk + 8 * h); const GAS f32x4* sp = (const GAS f32x4*)(SIN + qpos * 32 + 16 * kk + 8 * h);
                const f32x4 c0 = cp[0], c1 = cp[1], s0 = sp[0], s1 = sp[1];
#pragma unroll
                for (int j = 0; j < 8; ++j) { const int d = 16 * kk + 8 * h + j; const float cc = j < 4 ? c0[j & 3] : c1[j & 3], sv = j < 4 ? s0[j & 3] : s1[j & 3];
                    const float a = qf[kk][j] * rstd * F.swa_q_norm[d], c = qf[kk + 2][j] * rstd * F.swa_q_norm[d + 32];
                    y1[j] = a * cc - c * sv; y2[j] = c * cc + a * sv; }
                qfrag[kk] = mk8(pk2(y1[0], y1[1]), pk2(y1[2], y1[3]), pk2(y1[4], y1[5]), pk2(y1[6], y1[7]));
                qfrag[kk + 2] = mk8(pk2(y2[0], y2[1]), pk2(y2[2], y2[3]), pk2(y2[4], y2[5]), pk2(y2[6], y2[7]));
            }
            f32x16 sacc[5];
#pragma unroll
            for (int tt = 0; tt < 5; ++tt) { f32x16 a = {0.f, 0.f, 0.f, 0.f, 0.f, 0.f, 0.f, 0.f, 0.f, 0.f, 0.f, 0.f, 0.f, 0.f, 0.f, 0.f};
#pragma unroll
                for (int kk = 0; kk < 4; ++kk) { const bf16x8 kf = *(const LAS bf16x8*)(KL + (32 * (qt + tt) + r) * 144 + (16 * kk + 8 * h) * 2); a = mfma32(kf, qfrag[kk], a); }
                sacc[tt] = a; }
            float mx = sink;
#pragma unroll
            for (int tt = 0; tt < 5; ++tt)
#pragma unroll
                for (int i = 0; i < 16; ++i) { const int koff = (i & 3) + 8 * (i >> 2) + 4 * h; const int rel = r + 128 - 32 * tt - koff; const int kidx = 32 * (qt + tt) + koff;
                    const bool valid = (rel >= 0) && (rel < 128) && (t0 - 128 + kidx >= 0);
                    const float s = valid ? sacc[tt][i] : -INFINITY; sacc[tt][i] = s; mx = fmaxf(mx, s); }
            mx = fmaxf(mx, __shfl_xor(mx, 32));
            float sum = 0.f;
#pragma unroll
            for (int tt = 0; tt < 5; ++tt)
#pragma unroll
                for (int i = 0; i < 16; ++i) { const float pv = __expf(sacc[tt][i] - mx); sacc[tt][i] = pv; sum += pv; }
            sum += __shfl_xor(sum, 32);
            const float inv = 1.0f / (sum + __expf(sink - mx));
            f32x16 oacc[2];
#pragma unroll
            for (int dt = 0; dt < 2; ++dt) oacc[dt] = (f32x16){0.f, 0.f, 0.f, 0.f, 0.f, 0.f, 0.f, 0.f, 0.f, 0.f, 0.f, 0.f, 0.f, 0.f, 0.f, 0.f};
#pragma unroll
            for (int tt = 0; tt < 5; ++tt)
#pragma unroll
                for (int s2 = 0; s2 < 2; ++s2) {
                    const bf16x8 pf = mk8(pk2(sacc[tt][8 * s2], sacc[tt][8 * s2 + 1]), pk2(sacc[tt][8 * s2 + 2], sacc[tt][8 * s2 + 3]), pk2(sacc[tt][8 * s2 + 4], sacc[tt][8 * s2 + 5]), pk2(sacc[tt][8 * s2 + 6], sacc[tt][8 * s2 + 7]));
#pragma unroll
                    for (int dt = 0; dt < 2; ++dt) { const LAS unsigned char* vp = VL + (32 * dt + r) * 520 + (32 * (qt + tt) + 16 * s2 + 4 * h) * 2;
                        const v2u lo = *(const LAS v2u*)vp, hi = *(const LAS v2u*)(vp + 16);
                        oacc[dt] = mfma32(mk8(lo.x, lo.y, hi.x, hi.y), pf, oacc[dt]); }
                }
            float so = 0.f;
#pragma unroll
            for (int dt = 0; dt < 2; ++dt)
#pragma unroll
                for (int i = 0; i < 16; ++i) { const float o = oacc[dt][i] * inv; oacc[dt][i] = o; so += o * o; }
            so += __shfl_xor(so, 32);
            const float rs2 = 1.0f / sqrtf(so * (1.0f / 64.0f) + EPS);
            bf16* orow = F.MIXIN + tok * DM + 2048 + hq * 64;
#pragma unroll
            for (int dt = 0; dt < 2; ++dt)
#pragma unroll
                for (int gq = 0; gq < 4; ++gq) { const int d0 = 32 * dt + 8 * gq + 4 * h; const f32x4 gn = *(const GAS f32x4*)(F.swa_out_norm + d0);
                    v2u o; o.x = pk2(oacc[dt][4 * gq] * rs2 * gn[0], oacc[dt][4 * gq + 1] * rs2 * gn[1]); o.y = pk2(oacc[dt][4 * gq + 2] * rs2 * gn[2], oacc[dt][4 * gq + 3] * rs2 * gn[3]);
                    *(GAS v2u*)(orow + d0) = o; }
        }
    }
    __syncthreads();
}

constexpr int GL_QT = 0, GL_KT = 9216, GL_KHT = 18432, GL_VT = 27648, GL_WG = 46336, GL_BG = 50432, GL_OB = 50688;
__device__ __forceinline__ void gla_g1_units(Frame& F, int u0, int nu) {
    const int bh = u0 >> 5, b = bh >> 4, h = bh & 15, tid = F.tid, lane = F.lane, w = F.wave;
    LAS unsigned char* QT = F.lds + GL_QT;
    LAS unsigned char* KT = F.lds + GL_KT;
    LAS unsigned char* KHT = F.lds + GL_KHT;
    LAS unsigned char* VT = F.lds + GL_VT;
    LAS float* WG = (LAS float*)(F.lds + GL_WG);
    LAS float* BG = (LAS float*)(F.lds + GL_BG);
    LAS float* OB = (LAS float*)(F.lds + GL_OB);
    __syncthreads();
    for (int i = tid; i < 1024; i += 512) WG[i] = F.w_gate_up[(i >> 6) * 1024 + h * 64 + (i & 63)];
    if (tid < 64) BG[tid] = F.b_gla_gate[h * 64 + tid];
    __syncthreads();
    const int r = lane & 15, g = lane >> 4;
    const int t2 = tid >> 3, seg = tid & 7;
    v4u qv, kv, g0, g1, vv0, vv1;
    { const size_t row0 = (size_t)b * SEQ + (u0 & 31) * 64; const bf16* pr = F.PROJ + (row0 + lane) * NPROJ;
      qv = *(const GAS v4u*)(pr + C_GQ + h * 64 + 8 * w); kv = *(const GAS v4u*)(pr + C_GK + h * 64 + 8 * w); g0 = *(const GAS v4u*)(pr + C_GA); g1 = *(const GAS v4u*)(pr + C_GA + 8);
      const GAS v4u* vr = (const GAS v4u*)(F.PROJ + (row0 + t2) * NPROJ + C_GV + h * 128 + 16 * seg); vv0 = vr[0]; vv1 = vr[1]; }
    for (int ui = 0; ui < nu; ++ui) {
        const int u = u0 + ui, chunk = u & 31;
        const size_t row0 = (size_t)b * SEQ + chunk * 64;
        v4u nqv = qv, nkv = kv, ng0 = g0, ng1 = g1, nvv0 = vv0, nvv1 = vv1;
        if (ui + 1 < nu) {
            const size_t rown = row0 + 64; const bf16* pr = F.PROJ + (rown + lane) * NPROJ;
            nqv = *(const GAS v4u*)(pr + C_GQ + h * 64 + 8 * w); nkv = *(const GAS v4u*)(pr + C_GK + h * 64 + 8 * w); ng0 = *(const GAS v4u*)(pr + C_GA); ng1 = *(const GAS v4u*)(pr + C_GA + 8);
            const GAS v4u* vr = (const GAS v4u*)(F.PROJ + (rown + t2) * NPROJ + C_GV + h * 128 + 16 * seg); nvv0 = vr[0]; nvv1 = vr[1]; }
        {
            float ga[16];
#pragma unroll
            for (int e = 0; e < 4; ++e) { ga[2 * e] = bflo(g0[e]); ga[2 * e + 1] = bfhi(g0[e]); ga[8 + 2 * e] = bflo(g1[e]); ga[8 + 2 * e + 1] = bfhi(g1[e]); }
            float z[8];
            { const f32x4 b0 = *(const LAS f32x4*)(BG + 8 * w), b1 = *(const LAS f32x4*)(BG + 8 * w + 4);
#pragma unroll
              for (int i = 0; i < 4; ++i) { z[i] = b0[i]; z[4 + i] = b1[i]; } }
#pragma unroll
            for (int j = 0; j < 16; ++j) { const f32x4 w0 = *(const LAS f32x4*)(WG + j * 64 + 8 * w), w1 = *(const LAS f32x4*)(WG + j * 64 + 8 * w + 4);
#pragma unroll
                for (int i = 0; i < 4; ++i) { z[i] += ga[j] * w0[i]; z[4 + i] += ga[j] * w1[i]; } }
            float bb[8];
#pragma unroll
            for (int i = 0; i < 8; ++i) { const float zz = z[i]; bb[i] = (fminf(zz, 0.f) - __logf(1.0f + __expf(-fabsf(zz)))) * (1.0f / 16.0f); }
#pragma unroll
            for (int off = 1; off < 64; off <<= 1)
#pragma unroll
                for (int i = 0; i < 8; ++i) { const float v = __shfl_up(bb[i], off); if (lane >= off) bb[i] += v; }
            float qn[8], kn[8], kh[8];
#pragma unroll
            for (int e = 0; e < 4; ++e) { qn[2 * e] = bflo(qv[e]); qn[2 * e + 1] = bfhi(qv[e]); kn[2 * e] = bflo(kv[e]); kn[2 * e + 1] = bfhi(kv[e]); }
#pragma unroll
            for (int i = 0; i < 8; ++i) { const float bl = __shfl(bb[i], 63); const float eb = __expf(bb[i]);
                qn[i] = qn[i] * 0.125f * eb; kh[i] = kn[i] * __expf(bl - bb[i]); kn[i] = kn[i] * __expf(-bb[i]);
                if (lane == 0) F.GG[(size_t)u * 64 + 8 * w + i] = __expf(bl); }
            const v4u qpk = {pk2(qn[0], qn[1]), pk2(qn[2], qn[3]), pk2(qn[4], qn[5]), pk2(qn[6], qn[7])};
            *(LAS v4u*)(QT + lane * 144 + 16 * w) = qpk;
            *(GAS v4u*)(F.GQT + ((size_t)u * 64 + lane) * 64 + 8 * w) = qpk;
            *(LAS v4u*)(KT + lane * 144 + 16 * w) = (v4u){pk2(kn[0], kn[1]), pk2(kn[2], kn[3]), pk2(kn[4], kn[5]), pk2(kn[6], kn[7])};
#pragma unroll
            for (int i = 0; i < 8; ++i) *(LAS unsigned short*)(KHT + (8 * w + i) * 144 + lane * 2) = (unsigned short)f2bf(kh[i]);
#pragma unroll
            for (int e = 0; e < 4; ++e) {
                *(LAS unsigned short*)(VT + (16 * seg + 2 * e) * 144 + t2 * 2) = (unsigned short)(vv0[e] & 0xffffu);
                *(LAS unsigned short*)(VT + (16 * seg + 2 * e + 1) * 144 + t2 * 2) = (unsigned short)(vv0[e] >> 16);
                *(LAS unsigned short*)(VT + (16 * seg + 8 + 2 * e) * 144 + t2 * 2) = (unsigned short)(vv1[e] & 0xffffu);
                *(LAS unsigned short*)(VT + (16 * seg + 8 + 2 * e + 1) * 144 + t2 * 2) = (unsigned short)(vv1[e] >> 16); }
        }
        __syncthreads();
        {
            unsigned dp[4][4][2];
#pragma unroll
            for (int tt = 0; tt < 4; ++tt) {
                const bf16x8 bq0 = *(const LAS bf16x8*)(QT + (16 * tt + r) * 144 + (8 * g) * 2), bq1 = *(const LAS bf16x8*)(QT + (16 * tt + r) * 144 + (32 + 8 * g) * 2);
#pragma unroll
                for (int st = 0; st < 4; ++st) {
                    if (st <= tt) {
                        const bf16x8 ak0 = *(const LAS bf16x8*)(KT + (16 * st + r) * 144 + (8 * g) * 2), ak1 = *(const LAS bf16x8*)(KT + (16 * st + r) * 144 + (32 + 8 * g) * 2);
                        f32x4 d = {0.f, 0.f, 0.f, 0.f}; d = mfma16(ak0, bq0, d); d = mfma16(ak1, bq1, d);
                        if (st == tt) {
#pragma unroll
                            for (int i = 0; i < 4; ++i) if (4 * g + i > r) d[i] = 0.f; }
                        dp[st][tt][0] = pk2(d[0], d[1]); dp[st][tt][1] = pk2(d[2], d[3]);
                    } else { dp[st][tt][0] = 0u; dp[st][tt][1] = 0u; }
                }
            }
#pragma unroll
            for (int tt = 0; tt < 4; ++tt) {
                f32x4 o = {0.f, 0.f, 0.f, 0.f};
#pragma unroll
                for (int kk = 0; kk < 2; ++kk) {
                    if (2 * kk <= tt) {
                        const LAS unsigned char* vp = VT + (16 * w + r) * 144 + (32 * kk + 4 * g) * 2;
                        const v2u lo = *(const LAS v2u*)vp, hi = *(const LAS v2u*)(vp + 32);
                        o = mfma16(mk8(dp[2 * kk][tt][0], dp[2 * kk][tt][1], dp[2 * kk + 1][tt][0], dp[2 * kk + 1][tt][1]), mk8(lo.x, lo.y, hi.x, hi.y), o);
                    }
                }
#pragma unroll
                for (int i = 0; i < 4; ++i) OB[(16 * tt + 4 * g + i) * 132 + 16 * w + r] = o[i];
            }
#pragma unroll
            for (int dt = 0; dt < 4; ++dt) {
                f32x4 uacc = {0.f, 0.f, 0.f, 0.f};
#pragma unroll
                for (int kk = 0; kk < 2; ++kk) { const bf16x8 a = *(const LAS bf16x8*)(KHT + (16 * dt + r) * 144 + (32 * kk + 8 * g) * 2), bv = *(const LAS bf16x8*)(VT + (16 * w + r) * 144 + (32 * kk + 8 * g) * 2);
                    uacc = mfma16(a, bv, uacc); }
                *(GAS f32x4*)(F.GUT + ((size_t)u * 128 + 16 * w + r) * 64 + 16 * dt + 4 * g) = uacc;
            }
        }
        __syncthreads();
        {
            unsigned ow[8];
#pragma unroll
            for (int j = 0; j < 4; ++j) { const f32x4 v = *(const LAS f32x4*)(OB + t2 * 132 + 16 * seg + 4 * j); ow[2 * j] = pk2(v[0], v[1]); ow[2 * j + 1] = pk2(v[2], v[3]); }
            GAS v4u* op = (GAS v4u*)(F.MIXIN + (row0 + t2) * DM + h * 128 + 16 * seg);
            op[0] = (v4u){ow[0], ow[1], ow[2], ow[3]}; op[1] = (v4u){ow[4], ow[5], ow[6], ow[7]};
        }
        qv = nqv; kv = nkv; g0 = ng0; g1 = ng1; vv0 = nvv0; vv1 = nvv1;
    }
}
__device__ __forceinline__ void gla_scan(Frame& F) {
    const size_t gt = (size_t)F.vcu * 512 + F.tid, NT = (size_t)F.G * 512;
    for (size_t i = gt; i < (size_t)64 * 128 * 16; i += NT) {
        const int bh = (int)(i >> 11), v = (int)((i >> 4) & 127), d4 = (int)(i & 15);
        f32x4 S = {0.f, 0.f, 0.f, 0.f};
#pragma unroll 8
        for (int c = 0; c < 32; ++c) {
            const size_t u = (size_t)bh * 32 + c;
            const f32x4 U = *(const GAS f32x4*)(F.GUT + (u * 128 + v) * 64 + 4 * d4), gg = *(const GAS f32x4*)(F.GG + u * 64 + 4 * d4);
            *(GAS v2u*)(F.GST + (u * 128 + v) * 64 + 4 * d4) = (v2u){pk2(S[0], S[1]), pk2(S[2], S[3])};
            S = gg * S + U;
        }
    }
}
struct G3Ops { v4u oi0, oi1, gg0, gg1; v2u slo[2], shi[2], qlo[4][2], qhi[4][2]; };
__device__ __forceinline__ void gla_g3_load(Frame& F, G3Ops& P, int u, int b, int h, int w, int r, int g, int t2, int seg) {
    const size_t row0 = (size_t)b * SEQ + (u & 31) * 64;
    const GAS v4u* oip = (const GAS v4u*)(F.MIXIN + (row0 + t2) * DM + h * 128 + 16 * seg); P.oi0 = oip[0]; P.oi1 = oip[1];
    const GAS v4u* gr = (const GAS v4u*)(F.PROJ + (row0 + t2) * NPROJ + C_GG + h * 128 + 16 * seg); P.gg0 = gr[0]; P.gg1 = gr[1];
#pragma unroll
    for (int kk = 0; kk < 2; ++kk) { const bf16* sp = F.GST + ((size_t)u * 128 + 16 * w + r) * 64 + 32 * kk + 4 * g; P.slo[kk] = *(const GAS v2u*)sp; P.shi[kk] = *(const GAS v2u*)(sp + 16); }
#pragma unroll
    for (int tt = 0; tt < 4; ++tt)
#pragma unroll
        for (int kk = 0; kk < 2; ++kk) { const bf16* qp = F.GQT + ((size_t)u * 64 + 16 * tt + r) * 64 + 32 * kk + 4 * g; P.qlo[tt][kk] = *(const GAS v2u*)qp; P.qhi[tt][kk] = *(const GAS v2u*)(qp + 16); }
}
__device__ __forceinline__ void gla_g3_units(Frame& F, int u0, int nu) {
    const int bh = u0 >> 5, b = bh >> 4, h = bh & 15, tid = F.tid, lane = F.lane, w = F.wave;
    LAS float* OB = (LAS float*)(F.lds + GL_OB);
    const int r = lane & 15, g = lane >> 4, t2 = tid >> 3, seg = tid & 7;
    __syncthreads();
    G3Ops cur, nxt;
    gla_g3_load(F, cur, u0, b, h, w, r, g, t2, seg);
    for (int ui = 0; ui < nu; ++ui) {
        const int u = u0 + ui, chunk = u & 31;
        const size_t row0 = (size_t)b * SEQ + chunk * 64;
        {
            bf16x8 bs[2];
#pragma unroll
            for (int kk = 0; kk < 2; ++kk) bs[kk] = mk8(cur.slo[kk].x, cur.slo[kk].y, cur.shi[kk].x, cur.shi[kk].y);
#pragma unroll
            for (int tt = 0; tt < 4; ++tt) {
                f32x4 o = {0.f, 0.f, 0.f, 0.f};
#pragma unroll
                for (int kk = 0; kk < 2; ++kk) o = mfma16(mk8(cur.qlo[tt][kk].x, cur.qlo[tt][kk].y, cur.qhi[tt][kk].x, cur.qhi[tt][kk].y), bs[kk], o);
#pragma unroll
                for (int i = 0; i < 4; ++i) OB[(16 * tt + 4 * g + i) * 132 + 16 * w + r] = o[i];
            }
        }
        if (ui + 1 < nu) gla_g3_load(F, nxt, u + 1, b, h, w, r, g, t2, seg);
        __syncthreads();
        {
            float o[16]; float ss = 0.f;
#pragma unroll
            for (int j = 0; j < 4; ++j) { const f32x4 v = *(const LAS f32x4*)(OB + t2 * 132 + 16 * seg + 4 * j);
#pragma unroll
                for (int e = 0; e < 4; ++e) o[4 * j + e] = v[e]; }
#pragma unroll
            for (int e = 0; e < 4; ++e) { o[2 * e] += bflo(cur.oi0[e]); o[2 * e + 1] += bfhi(cur.oi0[e]); o[8 + 2 * e] += bflo(cur.oi1[e]); o[8 + 2 * e + 1] += bfhi(cur.oi1[e]); }
#pragma unroll
            for (int e = 0; e < 16; ++e) ss += o[e] * o[e];
            ss += __shfl_xor(ss, 1); ss += __shfl_xor(ss, 2); ss += __shfl_xor(ss, 4);
            const float rstd = 1.0f / sqrtf(ss * (1.0f / 128.0f) + EPS);
            float gg[16];
#pragma unroll
            for (int e = 0; e < 4; ++e) { gg[2 * e] = bflo(cur.gg0[e]); gg[2 * e + 1] = bfhi(cur.gg0[e]); gg[8 + 2 * e] = bflo(cur.gg1[e]); gg[8 + 2 * e + 1] = bfhi(cur.gg1[e]); }
            unsigned ow[8];
#pragma unroll
            for (int e = 0; e < 8; ++e) { const float a = o[2 * e] * rstd * F.gla_out_norm[16 * seg + 2 * e] * silu_f(gg[2 * e]), c = o[2 * e + 1] * rstd * F.gla_out_norm[16 * seg + 2 * e + 1] * silu_f(gg[2 * e + 1]);
                ow[e] = pk2(a, c); }
            GAS v4u* op = (GAS v4u*)(F.MIXIN + (row0 + t2) * DM + h * 128 + 16 * seg);
            op[0] = (v4u){ow[0], ow[1], ow[2], ow[3]}; op[1] = (v4u){ow[4], ow[5], ow[6], ow[7]};
        }
        __syncthreads();
        cur = nxt;
    }
}

__device__ __forceinline__ void p3a_mixer(Frame& F) {
    for (int u = F.vcu; u < 256; u += F.G) swa_unit(F, u);
    for (int q = F.vcu; q < 256; q += F.G) gla_g1_units(F, q * 8, 8);
}
__device__ __forceinline__ void p3c_mixer(Frame& F) {
    for (int q = F.vcu; q < 256; q += F.G) gla_g3_units(F, q * 8, 8);
}

__device__ __forceinline__ unsigned f2s(float f) { const unsigned u = __builtin_bit_cast(unsigned, f); return (u & 0x80000000u) ? ~u : (u | 0x80000000u); }
__device__ __forceinline__ float s2f(unsigned s) { const unsigned u = (s & 0x80000000u) ? (s & 0x7fffffffu) : ~s; return __builtin_bit_cast(float, u); }
#define TOPK_INSERT(list, xin) do { unsigned _x = (xin); _Pragma("unroll") for (int _p = 0; _p < 16; ++_p) { const unsigned _hi = list[_p] > _x ? list[_p] : _x; _x = list[_p] > _x ? _x : list[_p]; list[_p] = _hi; } } while (0)

template <int MODE  > __device__ __forceinline__ void p7_topk(Frame& F) {
    const int tid = F.tid, lane = F.lane, wave = F.wave;
    LAS unsigned char* KY = F.lds;
    LAS unsigned* SC = (LAS unsigned*)(F.lds + 69632 + wave * 4096);
#pragma unroll
    for (int j = 0; j < 16; ++j) { const int i4 = j * 512 + tid, hf = i4 >> 12, key = (i4 >> 5) & 127, q4 = i4 & 31;
        const f32x4 v = *(const GAS f32x4*)((hf ? F.keys2 : F.keys1) + key * 128 + 4 * q4);
        *(LAS v2u*)(KY + hf * 34816 + key * 272 + q4 * 8) = (v2u){pk2(v[0], v[1]), pk2(v[2], v[3])}; }
    __syncthreads();
    const int gw = F.vcu * NWAVES + wave, NGW = F.G * NWAVES;
    const int r = lane & 31, h = lane >> 5;
    for (int task = gw; task < 256 * 8; task += NGW) {
        const int tile = task >> 3, hd = task & 7, tok = tile * 32 + r;
        for (int hf = 0; hf < 2; ++hf) {
            const GAS v4u* qr = (const GAS v4u*)(F.QPEER + (size_t)tok * PEER_N + hd * 256 + hf * 128);
            bf16x8 qf[8];
#pragma unroll
            for (int kk = 0; kk < 8; ++kk) qf[kk] = __builtin_bit_cast(bf16x8, qr[2 * kk + h]);
            unsigned list[16];
#pragma unroll
            for (int p = 0; p < 16; ++p) list[p] = 0u;
#pragma unroll
            for (int T = 0; T < 4; ++T) {
                f32x16 a = {0.f, 0.f, 0.f, 0.f, 0.f, 0.f, 0.f, 0.f, 0.f, 0.f, 0.f, 0.f, 0.f, 0.f, 0.f, 0.f};
#pragma unroll
                for (int kk = 0; kk < 8; ++kk) { const bf16x8 kf = *(const LAS bf16x8*)(KY + hf * 34816 + (32 * T + r) * 272 + (16 * kk + 8 * h) * 2); a = mfma32(kf, qf[kk], a); }
#pragma unroll
                for (int i = 0; i < 16; ++i) { const int key = 32 * T + (i & 3) + 8 * (i >> 2) + 4 * h; const unsigned pkd = (f2s(a[i]) & ~127u) | (unsigned)(127 - key); if (MODE == 0 || i < 4) TOPK_INSERT(list, pkd); }
            }
            unsigned other[16];
#pragma unroll
            for (int p = 0; p < 16; ++p) other[p] = (unsigned)__shfl_xor((int)list[p], 32);
#pragma unroll
            for (int p = 0; p < 16; ++p) TOPK_INSERT(list, other[p]);
            if (h == 0) {
#pragma unroll
                for (int p = 0; p < 16; ++p) SC[(hf * 16 + p) * 32 + r] = list[p]; }
        }
        LDS_WAIT(); asm volatile("" ::: "memory");
        float v1[16], v2[16];
#pragma unroll
        for (int p = 0; p < 16; ++p) { v1[p] = s2f(SC[p * 32 + r] & ~127u); v2[p] = s2f(SC[(16 + p) * 32 + r] & ~127u); }
        unsigned cl[16];
#pragma unroll
        for (int p = 0; p < 16; ++p) cl[p] = 0u;
#pragma unroll
        for (int i = 0; i < 16; ++i)
#pragma unroll
            for (int j = 0; j < 16; ++j) if ((i + 1) * (j + 1) <= 16 && (MODE != 2 || i + j < 6)) { const unsigned pkd = (f2s(v1[i] + v2[j]) & ~255u) | (unsigned)(255 - (i * 16 + j)); TOPK_INSERT(cl, pkd); }
        float val[8]; int eidx[8]; float mx = -INFINITY;
#pragma unroll
        for (int p = 0; p < 16; ++p) { const int pos = 255 - (int)(cl[p] & 255u), i = pos >> 4, j = pos & 15;
            const unsigned a = SC[i * 32 + r], b2 = SC[(16 + j) * 32 + r];
            const float v = s2f(a & ~127u) + s2f(b2 & ~127u); mx = fmaxf(mx, v);
            if ((p >> 3) == h) { val[p & 7] = v; eidx[p & 7] = (127 - (int)(a & 127u)) * 128 + (127 - (int)(b2 & 127u)); } }
        float sum = 0.f, ex[8];
#pragma unroll
        for (int p = 0; p < 8; ++p) { ex[p] = __expf(val[p] - mx); sum += ex[p]; }
        sum += __shfl_xor(sum, 32);
        const float inv = 1.0f / sum;
        const int p4a = hd * 4 + 2 * h;
        GAS v4u* ip = (GAS v4u*)F.EIDX; GAS f32x4* gp = (GAS f32x4*)F.GATEQ;
        ip[(size_t)p4a * NTOK + tok] = (v4u){(unsigned)eidx[0], (unsigned)eidx[1], (unsigned)eidx[2], (unsigned)eidx[3]}; ip[(size_t)(p4a + 1) * NTOK + tok] = (v4u){(unsigned)eidx[4], (unsigned)eidx[5], (unsigned)eidx[6], (unsigned)eidx[7]};
        ((GAS v4u*)F.EIDX16)[(size_t)(hd * 2 + h) * NTOK + tok] = (v4u){(unsigned)eidx[0] | ((unsigned)eidx[1] << 16), (unsigned)eidx[2] | ((unsigned)eidx[3] << 16), (unsigned)eidx[4] | ((unsigned)eidx[5] << 16), (unsigned)eidx[6] | ((unsigned)eidx[7] << 16)};
        gp[(size_t)p4a * NTOK + tok] = (f32x4){ex[0] * inv, ex[1] * inv, ex[2] * inv, ex[3] * inv}; gp[(size_t)(p4a + 1) * NTOK + tok] = (f32x4){ex[4] * inv, ex[5] * inv, ex[6] * inv, ex[7] * inv};
        LDS_WAIT(); asm volatile("" ::: "memory");
    }
}

typedef int i32x4 __attribute__((ext_vector_type(4)));
__device__ __forceinline__ void lds_fill_128k(Frame& F, const unsigned char* src, int rot) {
    const unsigned long long g = (unsigned long long)src; const unsigned lo = __builtin_amdgcn_readfirstlane((unsigned)g), hi = __builtin_amdgcn_readfirstlane((unsigned)(g >> 32));
    const unsigned char* sb = (const unsigned char*)(((unsigned long long)hi << 32) | lo);
    const unsigned voff = (unsigned)F.tid * 16u; const int r8 = __builtin_amdgcn_readfirstlane(rot) & 15;
#pragma unroll
    for (int i = 0; i < 16; ++i) { const int ii = (i + r8) & 15;
        __builtin_amdgcn_global_load_lds((const unsigned*)(sb + (size_t)ii * 8192 + voff), (LAS unsigned*)(F.lds + ii * 8192 + F.wave * 1024), 16, 0, 0); }
}
constexpr int P8_YB = 132096;
constexpr int P8_DUMMY = 140288;
#define P8_WAITV0() asm volatile("s_waitcnt vmcnt(0)" ::: "memory")
#define P8_BAR() do { asm volatile("s_waitcnt lgkmcnt(0)" ::: "memory"); __builtin_amdgcn_s_barrier(); asm volatile("" ::: "memory"); } while (0)
__device__ __forceinline__ void p8a_sddmm(Frame& F) {
    const int wv = F.wave;
    for (int u = F.vcu; u < 256; u += F.G) {
        const int tg = u & 15, dr = u >> 4, t = tg * 512 + F.tid;
        unsigned id[64];
#pragma unroll
        for (int p8 = 0; p8 < 16; ++p8) { const v4u v = ((const GAS v4u*)F.EIDX16)[(size_t)p8 * NTOK + t]; id[4 * p8] = v.x; id[4 * p8 + 1] = v.y; id[4 * p8 + 2] = v.z; id[4 * p8 + 3] = v.w; }
        int acc[128];
#pragma unroll
        for (int p = 0; p < 128; ++p) acc[p] = 0;
        const unsigned char* tab = F.DC8 + (size_t)(dr * 32) * 131072;
        const unsigned char* ysrc = F.YC8 + ((size_t)(dr * 32) * NTOK + tg * 512) * 8 + (wv & 3) * 1024 + F.lane * 16;
        for (int sl = 0; sl < 32; ++sl) {
#pragma unroll
            for (int i = 0; i < 64; ++i) asm volatile("" : "+v"(id[i]));
            P8_WAITV0();
            P8_BAR();
            lds_fill_128k(F, tab + (size_t)sl * 131072, tg);
            if (wv < 4) __builtin_amdgcn_global_load_lds((const unsigned*)(ysrc + (size_t)sl * NTOK * 8), (LAS unsigned*)(F.lds + P8_YB + wv * 1024), 16, 0, 0);
            P8_WAITV0();
            P8_BAR();
            if (sl + 1 < 32) __builtin_amdgcn_global_load_lds((const unsigned*)(tab + (size_t)(sl + 1) * 131072 + (size_t)tg * 8192 + wv * 1024 + F.lane * 16), (LAS unsigned*)(F.lds + P8_DUMMY + wv * 1024), 16, 0, 0);
            const v2u yv = *(const LAS v2u*)(F.lds + P8_YB + F.tid * 8);
            v2u dA[8], dB[8];
#define P8A_OFF(p) (((p) & 1) ? ((id[(p) >> 1] >> 13) & 0x7fff8u) : ((id[(p) >> 1] << 3) & 0x7fff8u))
#define P8A_LOAD(dst, pb) do { _Pragma("unroll") for (int j_ = 0; j_ < 8; ++j_) asm volatile("ds_read_b64 %0, %1" : "=v"(dst[j_]) : "v"(ldsb + P8A_OFF((pb) + j_))); } while (0)
#define P8A_DOT(src, pb) do { _Pragma("unroll") for (int j_ = 0; j_ < 8; ++j_) { acc[(pb) + j_] = __builtin_amdgcn_sdot4((int)src[j_].x, (int)yv.x, acc[(pb) + j_], false); acc[(pb) + j_] = __builtin_amdgcn_sdot4((int)src[j_].y, (int)yv.y, acc[(pb) + j_], false); } \
                _Pragma("unroll") for (int j_ = 0; j_ < 8; ++j_) asm volatile("" : "+v"(acc[(pb) + j_])); } while (0)
            const unsigned ldsb = (unsigned)(unsigned long long)F.lds;
            asm volatile("s_waitcnt lgkmcnt(0)" ::: "memory"); __builtin_amdgcn_sched_barrier(0);
            P8A_LOAD(dA, 0);
#pragma unroll
            for (int pb = 0; pb < 128; pb += 16) {
                P8A_LOAD(dB, pb + 8);
                asm volatile("s_waitcnt lgkmcnt(8)" ::: "memory"); __builtin_amdgcn_sched_barrier(0);
                P8A_DOT(dA, pb);
                __builtin_amdgcn_sched_barrier(0);
                if (pb + 16 < 128) { P8A_LOAD(dA, pb + 16); asm volatile("s_waitcnt lgkmcnt(8)" ::: "memory"); } else asm volatile("s_waitcnt lgkmcnt(0)" ::: "memory");
                __builtin_amdgcn_sched_barrier(0);
                P8A_DOT(dB, pb + 8);
                __builtin_amdgcn_sched_barrier(0);
            }
#undef P8A_OFF
#undef P8A_LOAD
#undef P8A_DOT
        }
#pragma unroll
        for (int p4 = 0; p4 < 32; ++p4) ((GAS i32x4*)F.ZP)[((size_t)(dr * 32 + p4)) * NTOK + t] = (i32x4){acc[4 * p4], acc[4 * p4 + 1], acc[4 * p4 + 2], acc[4 * p4 + 3]};
    }
    P8_WAITV0();
    __syncthreads();
}
__device__ __forceinline__ void p8h_gate(Frame& F) {
    const size_t gt = (size_t)F.vcu * 512 + F.tid, NT = (size_t)F.G * 512;
    for (size_t i = gt; i < (size_t)32 * NTOK; i += NT) {
        const int p4 = (int)(i >> 13), t = (int)(i & (NTOK - 1));
        i32x4 z = {0, 0, 0, 0};
#pragma unroll
        for (int dr = 0; dr < 16; ++dr) z += ((const GAS i32x4*)F.ZP)[((size_t)(dr * 32 + p4)) * NTOK + t];
        const v4u e4 = ((const GAS v4u*)F.EIDX)[i]; const f32x4 g4 = ((const GAS f32x4*)F.GATEQ)[i]; const float ys = F.YSC[t];
        v4u he;
#pragma unroll
        for (int c = 0; c < 4; ++c) { const float zz = (float)z[c] * ys * F.DSC[e4[c]]; const float hv = 0.5f * zz * (1.0f + erff(zz * 0.70710678118654752f)) * g4[c]; he[c] = ((f2bf(hv) << 16) & 0xfffe0000u) | (e4[c] << 3); }
        ((GAS v4u*)F.HE)[i] = he;
    }
}
template <int MODE  > __device__ __forceinline__ void p8b_spmm(Frame& F, float* dst) {
    for (int u = F.vcu; u < 256; u += F.G) {
        const int tg = u & 15, sr = u >> 4, t = tg * 512 + F.tid, b = t >> 11;
        unsigned he[128];
#pragma unroll
        for (int p4 = 0; p4 < 32; ++p4) { const v4u v = ((const GAS v4u*)F.HE)[(size_t)p4 * NTOK + t]; he[4 * p4] = v.x; he[4 * p4 + 1] = v.y; he[4 * p4 + 2] = v.z; he[4 * p4 + 3] = v.w; }
        const bf16* xrow = F.X1 + (size_t)t * DM; float* orow = dst + (size_t)t * DM; const float* g2 = F.MOD + b * NMOD + 5 * DM;
        for (int sg = 0; sg < 8; ++sg) {
            f32x2 acc[4][4];
#pragma unroll
            for (int k = 0; k < 4; ++k) {
                const int s = sr * 32 + sg * 4 + k;
#pragma unroll
                for (int i = 0; i < 128; ++i) asm volatile("" : "+v"(he[i]));
                P8_WAITV0();
                P8_BAR();
                if (MODE != 1) lds_fill_128k(F, F.UC8 + (size_t)s * 131072, tg);
                P8_WAITV0();
                P8_BAR();
                if (MODE != 1 && (sg * 4 + k) + 1 < 32) __builtin_amdgcn_global_load_lds((const unsigned*)(F.UC8 + (size_t)(s + 1) * 131072 + (size_t)tg * 8192 + F.wave * 1024 + F.lane * 16), (LAS unsigned*)(F.lds + P8_DUMMY + F.wave * 1024), 16, 0, 0);
#pragma unroll
                for (int q = 0; q < 4; ++q) acc[k][q] = (f32x2){0.f, 0.f};
                v2u wA[8], wB[8];
#define P8B_LOAD(dst, pb) do { _Pragma("unroll") for (int j_ = 0; j_ < 8; ++j_) asm volatile("ds_read_b64 %0, %1" : "=v"(dst[j_]) : "v"(ldsb + (he[(pb) + j_] & 0x1fff8u))); } while (0)
#define P8B_FMA(src, pb) do { _Pragma("unroll") for (int j_ = 0; j_ < 8; ++j_) { const float hv_ = __builtin_bit_cast(float, he[(pb) + j_] & 0xfffe0000u); const f32x2 h2_ = {hv_, hv_}; \
                    acc[k][0] += __builtin_amdgcn_cvt_pk_f32_fp8((int)src[j_].x, false) * h2_; acc[k][1] += __builtin_amdgcn_cvt_pk_f32_fp8((int)src[j_].x, true) * h2_; \
                    acc[k][2] += __builtin_amdgcn_cvt_pk_f32_fp8((int)src[j_].y, false) * h2_; acc[k][3] += __builtin_amdgcn_cvt_pk_f32_fp8((int)src[j_].y, true) * h2_; } \
                    asm volatile("" : "+v"(acc[k][0]), "+v"(acc[k][1]), "+v"(acc[k][2]), "+v"(acc[k][3])); } while (0)
                constexpr int NP = (MODE == 2 ? 16 : 128);
                const unsigned ldsb = (unsigned)(unsigned long long)F.lds;
                asm volatile("s_waitcnt lgkmcnt(0)" ::: "memory"); __builtin_amdgcn_sched_barrier(0);
                P8B_LOAD(wA, 0);
#pragma unroll
                for (int pb = 0; pb < NP; pb += 16) {
                    P8B_LOAD(wB, pb + 8);
                    asm volatile("s_waitcnt lgkmcnt(8)" ::: "memory"); __builtin_amdgcn_sched_barrier(0);
                    P8B_FMA(wA, pb);
                    __builtin_amdgcn_sched_barrier(0);
                    if (pb + 16 < NP) { P8B_LOAD(wA, pb + 16); asm volatile("s_waitcnt lgkmcnt(8)" ::: "memory"); } else asm volatile("s_waitcnt lgkmcnt(0)" ::: "memory");
                    __builtin_amdgcn_sched_barrier(0);
                    P8B_FMA(wB, pb + 8);
                    __builtin_amdgcn_sched_barrier(0);
                }
#undef P8B_LOAD
#undef P8B_FMA
            }
            const int c0 = (sr * 32 + sg * 4) * 8;
#pragma unroll
            for (int k = 0; k < 4; ++k) {
                const v4u xw = *(const GAS v4u*)(xrow + c0 + 8 * k); const f32x4 xa = {bflo(xw.x), bfhi(xw.x), bflo(xw.y), bfhi(xw.y)}, xb = {bflo(xw.z), bfhi(xw.z), bflo(xw.w), bfhi(xw.w)};
                const f32x4 ga = *(const GAS f32x4*)(g2 + c0 + 8 * k), gb = *(const GAS f32x4*)(g2 + c0 + 8 * k + 4);
                *(GAS f32x4*)(orow + c0 + 8 * k) = (f32x4){xa[0] + ga[0] * acc[k][0].x, xa[1] + ga[1] * acc[k][0].y, xa[2] + ga[2] * acc[k][1].x, xa[3] + ga[3] * acc[k][1].y};
                *(GAS f32x4*)(orow + c0 + 8 * k + 4) = (f32x4){xb[0] + gb[0] * acc[k][2].x, xb[1] + gb[1] * acc[k][2].y, xb[2] + gb[2] * acc[k][3].x, xb[3] + gb[3] * acc[k][3].y};
            }
        }
    }
    P8_WAITV0();
    __syncthreads();
}

struct Args { const float* in[18]; float* out; unsigned char* ws; int ph_lo, ph_hi; };
__global__ void __launch_bounds__(NWAVES * 64, 2) mega_fwd(Args args) {
    extern __shared__ __attribute__((aligned(16))) unsigned char lds[];
    Frame F;
    F.lds = (LAS unsigned char*)lds;
    F.MISC = (volatile LAS unsigned*)(F.lds + MISC_OFF);
    F.tid = threadIdx.x; F.lane = F.tid & 63; F.wave = __builtin_amdgcn_readfirstlane(F.tid >> 6);
    F.G = gridDim.x; { const int bx = blockIdx.x; F.vcu = (F.G % 8 == 0) ? (bx % 8) * (F.G / 8) + bx / 8 : bx; }
    unsigned char* ws = args.ws;
    F.ctl = (unsigned*)(ws + WS_CTL);
    F.x = args.in[0]; F.c = args.in[1]; F.w_ada = args.in[2]; F.b_ada = args.in[3]; F.w_in = args.in[4]; F.w_gate_up = args.in[5]; F.b_gla_gate = args.in[6]; F.gla_out_norm = args.in[7];
    F.swa_q_norm = args.in[8]; F.swa_k_norm = args.in[9]; F.swa_sinks = args.in[10]; F.swa_out_norm = args.in[11]; F.w_out = args.in[12]; F.w_peer_q = args.in[13];
    F.keys1 = args.in[14]; F.keys2 = args.in[15]; F.edown = args.in[16]; F.eup = args.in[17];
    F.out = args.out; F.ws = ws;
    F.MOD = (float*)(ws + WS_MOD); F.ROPE = (float*)(ws + WS_ROPE);
    F.BTIN = (bf16*)(ws + WS_BTIN); F.BTOUT = (bf16*)(ws + WS_BTOUT); F.BTQ = (bf16*)(ws + WS_BTQ); F.HBUF = (bf16*)(ws + WS_HBUF); F.PROJ = (bf16*)(ws + WS_PROJ);
    F.MIXIN = (bf16*)(ws + WS_MIXIN); F.QPEER = (bf16*)(ws + WS_QPEER);
    F.DC8 = ws + WS_DC8; F.UC8 = ws + WS_UC8; F.YC8 = ws + WS_YC8; F.ZP = (int*)(ws + WS_ZP); F.EIDX = (unsigned*)(ws + WS_EIDX); F.HE = (unsigned*)(ws + WS_HE);
    F.EIDX16 = (unsigned*)(ws + WS_EIDX16);
    F.GQT = (bf16*)(ws + WS_QPEER); F.GST = (bf16*)(ws + WS_YC8); F.GUT = (float*)(ws + WS_ZP); F.GG = (float*)(ws + WS_IDX); F.X1 = (bf16*)(ws + WS_PROJ);   F.GATEQ = (float*)(ws + WS_GATEQ); F.DSC = (float*)(ws + WS_DSC); F.YSC = (float*)(ws + WS_YSC);
    for (int u = F.tid; u < (LDS_BYTES - LDSCTL_OFF) / 4; u += NWAVES * 64) ((LAS unsigned*)(F.lds + LDSCTL_OFF))[u] = 0u;
    __syncthreads();
    XcdBarrier bar; bar.bar = F.ctl + CW_BAR; bar.x = 0; bar.st = nullptr;
    if (N_LAUNCHES == 1) bar = xcd_barrier_post(F.ctl + CW_BAR, F.MISC + 8);
#define GRID_BAR() do { if (N_LAUNCHES == 1) xcd_barrier(bar); } while (0)
    const int lo = args.ph_lo, hi = args.ph_hi;
#define IN(k) (lo <= (k) && (k) < hi)
#define BOTH(k) (IN(k) && IN((k) + 1))

    if (PROBE_REP_PHASE == 20 && IN(0)) { p0a_ada(F); GRID_BAR(); }
    if (PROBE_REP_PHASE == 21 && IN(0)) { p0b_weights(F); GRID_BAR(); }
    if (PROBE_REP_PHASE == 22 && IN(0)) { p0c_tables(F); GRID_BAR(); }
    for (int rep_ = 0; rep_ < (PROBE_REP_PHASE == 0 ? 2 : 1); ++rep_) if (IN(0)) { p0_prologue(F); if (BOTH(0)) GRID_BAR(); }
    for (int rep_ = 0; rep_ < (PROBE_REP_PHASE == 1 ? 2 : 1); ++rep_) if (IN(1)) { modulate_rows(F, F.x, F.HBUF, 0, DM); if (BOTH(1)) GRID_BAR(); }
    for (int rep_ = 0; rep_ < (PROBE_REP_PHASE == 2 ? 2 : 1); ++rep_) if (IN(2)) {
        pg8::Gemm g{F.HBUF, F.BTIN, NTOK, NPROJ, DM}; pg8::StaticOrder S; S.init(NTOK, NPROJ, F.G, (int)blockIdx.x);
        pg8::EpiBf16 E{F.PROJ, NPROJ};
        pg8::gemm_phase<pg8::EpiBf16, pg8::StaticOrder, true, true>(F.lds, g, S, E);
        {
            const int G = F.G, rem = GEMM1_UNITS % G, tg = tail_groups(G), nidle = G - rem;
            if (rem != 0 && (int)blockIdx.x >= rem) convert_expert_groups(F, (int)blockIdx.x - rem, tg, nidle);
        }
        if (BOTH(2)) GRID_BAR();
    }
    for (int rep_ = 0; rep_ < (PROBE_REP_PHASE == 3 ? 2 : 1); ++rep_) if (IN(3)) { p3a_mixer(F); GRID_BAR(); gla_scan(F); GRID_BAR(); p3c_mixer(F); if (BOTH(3)) GRID_BAR(); }
    for (int rep_ = 0; rep_ < (PROBE_REP_PHASE == 4 ? 2 : 1); ++rep_) if (IN(4)) {
        pg8::Gemm g{F.MIXIN, F.BTOUT, NTOK, DM, DM}; pg8::StaticOrder S; S.init(NTOK, DM, F.G, (int)blockIdx.x);
        pg8::EpiResid E{F.x, F.X1, DM, F.MOD + 2 * DM, NMOD, SEQ / 256};
        pg8::gemm_phase<pg8::EpiResid, pg8::StaticOrder, true, true>(F.lds, g, S, E);
        if (BOTH(4)) GRID_BAR();
    }
    for (int rep_ = 0; rep_ < (PROBE_REP_PHASE == 5 ? 2 : 1); ++rep_) if (IN(5)) { p5_modulate_quant(F); if (BOTH(5)) GRID_BAR(); }
    for (int rep_ = 0; rep_ < (PROBE_REP_PHASE == 6 ? 2 : 1); ++rep_) if (IN(6)) {
        pg8::Gemm g{F.HBUF, F.BTQ, NTOK, PEER_N, DM}; pg8::StaticOrder S; S.init(NTOK, PEER_N, F.G, (int)blockIdx.x);
        pg8::EpiBf16 E{F.QPEER, PEER_N};
        pg8::gemm_phase<pg8::EpiBf16, pg8::StaticOrder, true, true>(F.lds, g, S, E);
        if (BOTH(6)) GRID_BAR();
    }
    if (PROBE_REP_PHASE == 41 && IN(7)) { p7_topk<1>(F); GRID_BAR(); }
    if (PROBE_REP_PHASE == 42 && IN(7)) { p7_topk<2>(F); GRID_BAR(); }
    for (int rep_ = 0; rep_ < (PROBE_REP_PHASE == 7 ? 2 : 1); ++rep_) if (IN(7)) { p7_topk<0>(F); if (BOTH(7)) GRID_BAR(); }
    for (int rep_ = 0; rep_ < (PROBE_REP_PHASE == 8 ? 2 : 1); ++rep_) if (IN(8)) { p8a_sddmm(F); if (BOTH(8)) GRID_BAR(); }
    for (int rep_ = 0; rep_ < (PROBE_REP_PHASE == 9 ? 2 : 1); ++rep_) if (IN(9)) { p8h_gate(F); if (BOTH(9)) GRID_BAR(); }
    if (PROBE_REP_PHASE == 10 && IN(10)) { p8b_spmm<0>(F, (float*)(F.ws + WS_BTIN)); GRID_BAR(); }
    if (PROBE_REP_PHASE == 11 && IN(10)) { p8b_spmm<1>(F, (float*)F.PROJ); GRID_BAR(); }
    if (PROBE_REP_PHASE == 12 && IN(10)) { p8b_spmm<2>(F, (float*)F.PROJ); GRID_BAR(); }
    if (IN(10)) { p8b_spmm<0>(F, F.out); }
#undef IN
#undef BOTH
}

extern "C" void kernel_launch(void* const* d_in, const int* in_sizes, int n_in, void* d_out, int out_size, void* d_ws, size_t ws_size, hipStream_t stream) {
    static int grid = 0;
    if (grid == 0) {
        if (n_in != 18 || out_size != NTOK * DM || ws_size < WS_END) { fprintf(stderr, "kernel_launch: unexpected shapes (n_in %d, out %d, ws %zu); nothing launched\n", n_in, out_size, ws_size); grid = -1; return; }
        int dev = 0, cus = 0, per_cu = 0;
        if (hipGetDevice(&dev) != hipSuccess || hipDeviceGetAttribute(&cus, hipDeviceAttributeMultiprocessorCount, dev) != hipSuccess) { grid = -1; return; }
        if (hipFuncSetAttribute((const void*)mega_fwd, hipFuncAttributeMaxDynamicSharedMemorySize, LDS_BYTES) != hipSuccess) { fprintf(stderr, "kernel_launch: hipFuncSetAttribute failed\n"); grid = -1; return; }
        if (hipOccupancyMaxActiveBlocksPerMultiprocessor(&per_cu, (const void*)mega_fwd, NWAVES * 64, LDS_BYTES) != hipSuccess || per_cu < 1)
            fprintf(stderr, "kernel_launch: note: occupancy query reports %d workgroups per CU\n", per_cu);
        (void)hipGetLastError();
        grid = cus;
    }
    if (grid < 0) return;
    (void)hipMemsetAsync((char*)d_ws + WS_CTL, 0, CTL_ZERO_BYTES, stream);
    Args a{};
    for (int i = 0; i < 18; ++i) a.in[i] = (const float*)d_in[i];
    a.out = (float*)d_out; a.ws = (unsigned char*)d_ws;
    if (N_LAUNCHES == 1) { a.ph_lo = 0; a.ph_hi = NPHASE; hipLaunchKernelGGL(mega_fwd, dim3(grid), dim3(NWAVES * 64), LDS_BYTES, stream, a); }
    else for (int p = 0; p < NPHASE; ++p) { a.ph_lo = p; a.ph_hi = p + 1; hipLaunchKernelGGL(mega_fwd, dim3(grid), dim3(NWAVES * 64), LDS_BYTES, stream, a); }
}
```

```cpp
#include <hip/hip_runtime.h>
#include <cstdio>
#include <cstdint>

#ifndef MK_N_LAUNCHES
#define MK_N_LAUNCHES 1
#endif
#ifndef PROBE_REP_PHASE
#define PROBE_REP_PHASE -1
#endif

#define GAS __attribute__((address_space(1)))
#define LAS __attribute__((address_space(3)))
typedef unsigned short bf16;
typedef unsigned v4u __attribute__((ext_vector_type(4)));
typedef unsigned v2u __attribute__((ext_vector_type(2)));
typedef float f32x4 __attribute__((ext_vector_type(4)));
typedef float f32x2 __attribute__((ext_vector_type(2)));
typedef float f32x16 __attribute__((ext_vector_type(16)));
typedef short bf16x8 __attribute__((ext_vector_type(8)));
using bf16x2 = __attribute__((ext_vector_type(2))) __bf16;

namespace pg8 {
#define PG8_LAS __attribute__((address_space(3)))
typedef unsigned short bf16_t;
typedef short bf16x8 __attribute__((ext_vector_type(8)));
typedef float f32x4 __attribute__((ext_vector_type(4)));
typedef unsigned u32x4 __attribute__((ext_vector_type(4)));
constexpr int BM = 256, BK = 64, HALF = 128, HTB = HALF * BK * 2, STAGE_BYTES = 8 * HTB, NXCD = 8, WGM = 8;

__host__ __device__ __forceinline__ int lds_byte(int r, int c) { const int st = (r >> 4) * 2 + (c >> 5), rr = r & 15, cc = c & 31, ob = rr * 64 + cc * 2; return st * 1024 + (ob ^ (((ob >> 9) & 1) << 5)); }
__host__ __device__ __forceinline__ void stage_rc(int b, int& R, int& C) { const int st = b / 1024, sb = b % 1024, swz = sb ^ (((sb >> 9) & 1) << 5); R = (st >> 1) * 16 + swz / 64; C = (st & 1) * 32 + (swz % 64) / 2; }
__host__ __device__ __forceinline__ int perm32(int rho) { const int n = rho >> 4, i = rho & 15; return 8 * (i >> 2) + 4 * n + (i & 3); }

struct Unit { int pm, pn; };
struct Gemm { const bf16_t* A; const bf16_t* Bt; int M, N, K; };

struct StaticOrder {
    int nM, nN, nwg, G, c;
    __host__ __device__ void init(int M, int N, int G_, int c_) { nM = M / BM; nN = N / BM; nwg = nM * nN; G = G_; c = c_; }
    __host__ __device__ bool next(int i, Unit& u) const {
        const long L = (long)i * G + c; if (L >= nwg) return false;
        int wgid = (int)L; { const int q = nwg / NXCD, r = nwg % NXCD, xcd = wgid % NXCD, off = wgid / NXCD; wgid = (xcd < r ? xcd * (q + 1) : r * (q + 1) + (xcd - r) * q) + off; }
        const int nig = WGM * nN, gid = wgid / nig, fm = gid * WGM, gsz = (nM - fm) < WGM ? (nM - fm) : WGM;
        u.pm = fm + ((wgid % nig) % gsz); u.pn = (wgid % nig) / gsz; return true;
    }
    __device__ __forceinline__ void a_ready(const Unit&) const {}
    __device__ __forceinline__ void done(const Unit&) const {}
};

__device__ __forceinline__ unsigned cvt_pk_bf16(float lo, float hi) { unsigned r; asm volatile("v_cvt_pk_bf16_f32 %0, %1, %2" : "=v"(r) : "v"(lo), "v"(hi)); return r; }

struct EpiBf16 {
    static constexpr bool PERM = true, AFTER_DRAIN = false;
    bf16_t* O; int ldc;
    __device__ __forceinline__ void operator()(const f32x4 (&acc)[2][2][4][2], const Unit& u, int wr, int wc, int fr, int fq) const {
        const int row0 = u.pm * BM + wr * 64 + fr; const int col0 = u.pn * BM + wc * 32 + 8 * fq;
#pragma unroll
        for (int ai = 0; ai < 2; ++ai)
#pragma unroll
            for (int m = 0; m < 4; ++m) { bf16_t* rowp = O + (size_t)(row0 + ai * HALF + m * 16) * ldc + col0;
#pragma unroll
                for (int bj = 0; bj < 2; ++bj) { const f32x4 v0 = acc[ai][bj][m][0], v1 = acc[ai][bj][m][1];
                    u32x4 w; w.x = cvt_pk_bf16(v0[0], v0[1]); w.y = cvt_pk_bf16(v0[2], v0[3]); w.z = cvt_pk_bf16(v1[0], v1[1]); w.w = cvt_pk_bf16(v1[2], v1[3]);
                    *(u32x4*)(rowp + bj * HALF) = w; } }
    }
};
struct EpiResid {
    static constexpr bool PERM = true, AFTER_DRAIN = false;
    const float* base; bf16_t* out; int ldc; const float* gate; int gate_stride; int tiles_per_batch;
    __device__ __forceinline__ void operator()(const f32x4 (&acc)[2][2][4][2], const Unit& u, int wr, int wc, int fr, int fq) const {
        const int row0 = u.pm * BM + wr * 64 + fr, col0 = u.pn * BM + wc * 32 + 8 * fq;
        const float* gp = gate + (size_t)(u.pm / tiles_per_batch) * gate_stride + col0;
        f32x4 gv[2][2];
#pragma unroll
        for (int bj = 0; bj < 2; ++bj)
#pragma unroll
            for (int n = 0; n < 2; ++n) gv[bj][n] = *(const f32x4*)(gp + bj * HALF + 4 * n);
#pragma unroll
        for (int ai = 0; ai < 2; ++ai)
#pragma unroll
            for (int m = 0; m < 4; ++m) { const size_t off = (size_t)(row0 + ai * HALF + m * 16) * ldc + col0;
#pragma unroll
                for (int bj = 0; bj < 2; ++bj) { const f32x4 b0 = *(const f32x4*)(base + off + bj * HALF), b1 = *(const f32x4*)(base + off + bj * HALF + 4);
                    const f32x4 v0 = b0 + gv[bj][0] * acc[ai][bj][m][0], v1 = b1 + gv[bj][1] * acc[ai][bj][m][1];
                    u32x4 w; w.x = cvt_pk_bf16(v0[0], v0[1]); w.y = cvt_pk_bf16(v0[2], v0[3]); w.z = cvt_pk_bf16(v1[0], v1[1]); w.w = cvt_pk_bf16(v1[2], v1[3]);
                    *(u32x4*)(out + off + bj * HALF) = w; } }
    }
};

template <class Epi, class Sched, bool ALIGN_EPI = false, bool SP2 = false>
__device__ __forceinline__ void gemm_phase(PG8_LAS unsigned char* lds, const Gemm g, const Sched& S, const Epi& E) {
    const int tid = threadIdx.x, wid = __builtin_amdgcn_readfirstlane(tid >> 6), lane = tid & 63, wr = wid >> 2, wc = wid & 3, fr = lane & 15, fq = lane >> 4;
    const int K = g.K, nt = K / BK;
    unsigned voffA[2], voffB[2];
#pragma unroll
    for (int i = 0; i < 2; ++i) { int R, C; stage_rc(tid * 16 + i * 8192, R, C); const int Rb = Epi::PERM ? ((R & ~31) + perm32(R & 31)) : R;
        voffA[i] = (unsigned)(R * K + C) * 2u; voffB[i] = (unsigned)(Rb * K + C) * 2u; }
    const size_t kstep = (size_t)(BK * 2);
    const size_t hstep = (size_t)HALF * K * 2;
    const size_t tstep = 2 * hstep;
    const unsigned ldsw = (unsigned)wid * 1024u;
    const int aoff = lds_byte(wr * 64 + fr, fq * 8), boff = lds_byte(wc * 32 + fr, fq * 8);
#define PG8_SA(b, h) (((b) * 2 + (h)) * HTB)
#define PG8_SB(b, h) ((4 + (b) * 2 + (h)) * HTB)
#define PG8_STAGE(bufoff, gbase, voff) do { const unsigned long long _g = (unsigned long long)(gbase); const unsigned _lo = __builtin_amdgcn_readfirstlane((unsigned)_g), _hi = __builtin_amdgcn_readfirstlane((unsigned)(_g >> 32)); \
        const char* _gb = (const char*)(((unsigned long long)_hi << 32) | _lo); _Pragma("unroll") for (int _i = 0; _i < 2; ++_i) \
        __builtin_amdgcn_global_load_lds((const unsigned*)(_gb + (size_t)_i * (size_t)(64 * K * 2) + (voff)[0]), (PG8_LAS unsigned*)(lds + (bufoff) + ldsw + _i * 8192), 16, 0, 0); } while (0)
#define PG8_LDA(dst, b, h) do { _Pragma("unroll") for (int m = 0; m < 4; ++m) _Pragma("unroll") for (int k = 0; k < 2; ++k) dst[m][k] = *(const PG8_LAS bf16x8*)(lds + PG8_SA(b, h) + aoff + m * 2048 + k * 1024); } while (0)
#define PG8_LDB(dst, b, h) do { _Pragma("unroll") for (int n = 0; n < 2; ++n) _Pragma("unroll") for (int k = 0; k < 2; ++k) dst[n][k] = *(const PG8_LAS bf16x8*)(lds + PG8_SB(b, h) + boff + n * 2048 + k * 1024); } while (0)
#define PG8_MMA(ai, bj, At, Bt) do { __builtin_amdgcn_s_setprio(1); _Pragma("unroll") for (int m = 0; m < 4; ++m) _Pragma("unroll") for (int n = 0; n < 2; ++n) _Pragma("unroll") for (int k = 0; k < 2; ++k) \
        acc[ai][bj][m][n] = __builtin_amdgcn_mfma_f32_16x16x32_bf16(Bt[n][k], At[m][k], acc[ai][bj][m][n], 0, 0, 0); __builtin_amdgcn_s_setprio(0); } while (0)
#define PG8_WAIT_V(n) asm volatile("s_waitcnt vmcnt(" #n ")" ::: "memory")
#define PG8_WAIT_L(n) asm volatile("s_waitcnt lgkmcnt(" #n ")" ::: "memory")
#define PG8_BAR __builtin_amdgcn_s_barrier()
#define PG8_SCHED __builtin_amdgcn_sched_barrier(0)
    Unit cur, nxt; int ui = 0;
    if (!S.next(0, cur)) return;
    f32x4 acc[2][2][4][2];
#pragma unroll
    for (int a = 0; a < 2; ++a)
#pragma unroll
        for (int b = 0; b < 2; ++b)
#pragma unroll
            for (int m = 0; m < 4; ++m)
#pragma unroll
                for (int n = 0; n < 2; ++n) acc[a][b][m][n] = (f32x4){0.f, 0.f, 0.f, 0.f};
    bf16x8 At[4][2], B0[2][2], B1[2][2];
    const char* cA = (const char*)g.A + (size_t)cur.pm * tstep; const char* cB = (const char*)g.Bt + (size_t)cur.pn * tstep;
    S.a_ready(cur);
    if constexpr (SP2) {
        PG8_STAGE(PG8_SB(0, 0), cB, voffB); PG8_STAGE(PG8_SB(0, 1), cB + hstep, voffB); PG8_STAGE(PG8_SA(0, 0), cA, voffA); PG8_STAGE(PG8_SA(0, 1), cA + hstep, voffA);
        if (wr == 1) PG8_BAR;
        PG8_WAIT_V(2); PG8_BAR;
        PG8_STAGE(PG8_SB(1, 0), cB + kstep, voffB); PG8_STAGE(PG8_SA(1, 0), cA + kstep, voffA); PG8_STAGE(PG8_SB(1, 1), cB + hstep + kstep, voffB);
        PG8_WAIT_V(6); PG8_BAR;
    } else {
        PG8_STAGE(PG8_SB(0, 0), cB, voffB); PG8_STAGE(PG8_SA(0, 0), cA, voffA); PG8_STAGE(PG8_SB(0, 1), cB + hstep, voffB); PG8_STAGE(PG8_SA(0, 1), cA + hstep, voffA);
        if (wr == 1) PG8_BAR;
        PG8_WAIT_V(4); PG8_BAR;
        PG8_STAGE(PG8_SB(1, 0), cB + kstep, voffB); PG8_STAGE(PG8_SA(1, 0), cA + kstep, voffA); PG8_STAGE(PG8_SB(1, 1), cB + hstep + kstep, voffB);
        PG8_WAIT_V(6); PG8_BAR;
    }
    for (;;) {
        const bool has_next = S.next(ui + 1, nxt);
        const char* nA = has_next ? (const char*)g.A + (size_t)nxt.pm * tstep : cA; const char* nB = has_next ? (const char*)g.Bt + (size_t)nxt.pn * tstep : cB;
        for (int t = 0; t < nt; t += 2) {
            const bool last = (t == nt - 2);
            const char* a1 = cA + (size_t)(t + 1) * kstep;
            const char* a2 = last ? nA : cA + (size_t)(t + 2) * kstep; const char* b2 = last ? nB : cB + (size_t)(t + 2) * kstep;
            const char* a3 = a2 + kstep; const char* b3 = b2 + kstep;
            if (last && has_next) S.a_ready(nxt);
            if constexpr (SP2) {
            PG8_LDB(B0, 0, 0); PG8_LDB(B1, 0, 1); PG8_SCHED; PG8_LDA(At, 0, 0); PG8_STAGE(PG8_SA(1, 1), a1 + hstep, voffA);
            PG8_WAIT_V(8); PG8_WAIT_L(0); PG8_BAR; PG8_MMA(0, 0, At, B0); PG8_MMA(0, 1, At, B1); PG8_BAR; PG8_SCHED;
            PG8_LDA(At, 0, 1); PG8_STAGE(PG8_SB(0, 0), b2, voffB); PG8_STAGE(PG8_SB(0, 1), b2 + hstep, voffB); PG8_STAGE(PG8_SA(0, 0), a2, voffA);
            PG8_WAIT_V(8); PG8_WAIT_L(0); PG8_BAR; PG8_MMA(1, 0, At, B0); PG8_MMA(1, 1, At, B1); PG8_BAR; PG8_SCHED;
            PG8_LDB(B0, 1, 0); PG8_LDB(B1, 1, 1); PG8_SCHED; PG8_LDA(At, 1, 0); PG8_STAGE(PG8_SA(0, 1), a2 + hstep, voffA);
            PG8_WAIT_V(8); PG8_WAIT_L(0); PG8_BAR; PG8_MMA(0, 0, At, B0); PG8_MMA(0, 1, At, B1); PG8_BAR; PG8_SCHED;
            PG8_LDA(At, 1, 1); PG8_STAGE(PG8_SB(1, 0), b3, voffB); PG8_STAGE(PG8_SB(1, 1), b3 + hstep, voffB); PG8_STAGE(PG8_SA(1, 0), a3, voffA);
            PG8_WAIT_V(8); PG8_WAIT_L(0); PG8_BAR; PG8_MMA(1, 0, At, B0); PG8_MMA(1, 1, At, B1); PG8_BAR; PG8_SCHED;
            } else {
            PG8_LDB(B0, 0, 0); PG8_SCHED; PG8_LDA(At, 0, 0); PG8_STAGE(PG8_SA(1, 1), a1 + hstep, voffA);
            PG8_WAIT_L(8); PG8_BAR; PG8_WAIT_L(0); PG8_MMA(0, 0, At, B0); PG8_BAR; PG8_SCHED;
            PG8_LDB(B1, 0, 1); PG8_STAGE(PG8_SB(0, 0), b2, voffB);
            PG8_BAR; PG8_WAIT_L(0); PG8_MMA(0, 1, At, B1); PG8_BAR;
            PG8_LDA(At, 0, 1); PG8_STAGE(PG8_SA(0, 0), a2, voffA);
            PG8_BAR; PG8_WAIT_L(0); PG8_MMA(1, 0, At, B0); PG8_BAR; PG8_SCHED;
            PG8_STAGE(PG8_SB(0, 1), b2 + hstep, voffB);
            PG8_WAIT_V(6); PG8_BAR; PG8_MMA(1, 1, At, B1); PG8_BAR;
            PG8_LDB(B0, 1, 0); PG8_SCHED; PG8_LDA(At, 1, 0); PG8_STAGE(PG8_SA(0, 1), a2 + hstep, voffA);
            PG8_WAIT_L(8); PG8_BAR; PG8_WAIT_L(0); PG8_MMA(0, 0, At, B0); PG8_BAR; PG8_SCHED;
            PG8_LDB(B1, 1, 1); PG8_STAGE(PG8_SB(1, 0), b3, voffB);
            PG8_BAR; PG8_WAIT_L(0); PG8_MMA(0, 1, At, B1); PG8_BAR;
            PG8_LDA(At, 1, 1); PG8_STAGE(PG8_SA(1, 0), a3, voffA);
            PG8_BAR; PG8_WAIT_L(0); PG8_MMA(1, 0, At, B0); PG8_BAR; PG8_SCHED;
            PG8_STAGE(PG8_SB(1, 1), b3 + hstep, voffB);
            PG8_WAIT_V(6); PG8_BAR; PG8_MMA(1, 1, At, B1); PG8_BAR;
            }
        }
        if constexpr (ALIGN_EPI) { if (wr == 0) PG8_BAR; }
        if constexpr (!Epi::AFTER_DRAIN) { E(acc, cur, wr, wc, fr, fq); S.done(cur); }
        if (!has_next) break;
#pragma unroll
        for (int a = 0; a < 2; ++a)
#pragma unroll
            for (int b = 0; b < 2; ++b)
#pragma unroll
                for (int m = 0; m < 4; ++m)
#pragma unroll
                    for (int n = 0; n < 2; ++n) acc[a][b][m][n] = (f32x4){0.f, 0.f, 0.f, 0.f};
        cur = nxt; cA = nA; cB = nB; ++ui;
        if constexpr (ALIGN_EPI) { if (wr == 1) PG8_BAR; }
    }
    PG8_WAIT_V(0);
    if constexpr (!ALIGN_EPI) { if (wr == 0) PG8_BAR; }
    PG8_BAR;
#undef PG8_SA
#undef PG8_SB
#undef PG8_STAGE
#undef PG8_LDA
#undef PG8_LDB
#undef PG8_MMA
#undef PG8_WAIT_V
#undef PG8_WAIT_L
#undef PG8_BAR
#undef PG8_SCHED
}
}

constexpr int NWAVES = 8;
constexpr int NPHASE = 11;
constexpr int N_LAUNCHES = MK_N_LAUNCHES;
constexpr int BATCH = 4, SEQ = 2048, DM = 4096, NTOK = BATCH * SEQ;
constexpr int NMOD = 6 * DM;
constexpr int IN_WIDTH = 8720;
constexpr int NPROJ = 8960;
constexpr int C_GQ = 0, C_GK = 1024, C_GV = 2048, C_GG = 4096, C_SQ = 6144, C_SK = 8192, C_SV = 8448, C_GA = 8704;
constexpr int NEXP = 16384, PEER_N = 2048;
constexpr float EPS = 1e-6f;

constexpr size_t MiB = 1u << 20;
constexpr size_t WS_CTL = 0, CTL_ZERO_BYTES = 1 * MiB;
constexpr size_t WS_MOD = 1 * MiB;
constexpr size_t WS_ROPE = 2 * MiB;
constexpr size_t WS_BTIN = 4 * MiB;
constexpr size_t WS_BTOUT = 74 * MiB;
constexpr size_t WS_BTQ = 106 * MiB;
constexpr size_t WS_HBUF = 122 * MiB;
constexpr size_t WS_PROJ = 186 * MiB;
constexpr size_t WS_MIXIN = 326 * MiB;
constexpr size_t WS_QPEER = 390 * MiB;
constexpr size_t WS_IDX = 422 * MiB;
constexpr size_t WS_GATE = 426 * MiB;
constexpr size_t WS_DC8 = 430 * MiB;
constexpr size_t WS_UC8 = 494 * MiB;
constexpr size_t WS_YC8 = 558 * MiB;
constexpr size_t WS_ZP = 590 * MiB;
constexpr size_t WS_EIDX = 654 * MiB;
constexpr size_t WS_GATEQ = 658 * MiB;
constexpr size_t WS_HE = 662 * MiB;
constexpr size_t WS_DSC = 666 * MiB;
constexpr size_t WS_YSC = 667 * MiB;
constexpr size_t WS_EIDX16 = 668 * MiB;
constexpr size_t WS_END = 670 * MiB;
constexpr int CW_BAR = 4096;

constexpr int RING_BYTES = 131072;
constexpr int LDSCTL_OFF = RING_BYTES, MISC_OFF = LDSCTL_OFF + 320;
constexpr int LDS_BYTES = 155648;

#define LDS_WAIT() asm volatile("s_waitcnt lgkmcnt(0)" ::: "memory")
#define VM_WAIT() asm volatile("s_waitcnt vmcnt(0)" ::: "memory")
__device__ __forceinline__ unsigned f2bf(float f) { unsigned u = __builtin_bit_cast(unsigned, f); return (u + 0x7fffu + ((u >> 16) & 1u)) >> 16; }
typedef __bf16 bf16x2_t __attribute__((ext_vector_type(2)));
__device__ __forceinline__ unsigned pk2(float lo, float hi) { const bf16x2_t v = {(__bf16)lo, (__bf16)hi}; return __builtin_bit_cast(unsigned, v); }
__device__ __forceinline__ float bflo(unsigned w) { return __builtin_bit_cast(float, w << 16); }
__device__ __forceinline__ float bfhi(unsigned w) { return __builtin_bit_cast(float, w & 0xffff0000u); }
__device__ __forceinline__ float dot2_bf16(unsigned w, unsigned x, float acc) { return __builtin_amdgcn_fdot2_f32_bf16(__builtin_bit_cast(bf16x2, w), __builtin_bit_cast(bf16x2, x), acc, false); }
__device__ __forceinline__ f32x16 mfma32(bf16x8 a, bf16x8 b, f32x16 c) { return __builtin_amdgcn_mfma_f32_32x32x16_bf16(a, b, c, 0, 0, 0); }
__device__ __forceinline__ f32x4 mfma16(bf16x8 a, bf16x8 b, f32x4 c) { return __builtin_amdgcn_mfma_f32_16x16x32_bf16(a, b, c, 0, 0, 0); }
__device__ __forceinline__ bf16x8 mk8(unsigned a, unsigned b, unsigned c, unsigned d) { v4u t = {a, b, c, d}; return __builtin_bit_cast(bf16x8, t); }
__device__ __forceinline__ float silu_f(float x) { return x / (1.0f + __expf(-x)); }

#define XB_TMO      128
#define XB_XCNT(j)  (256  + 64 * (j))
#define XB_XSUB(j)  (1280 + 64 * (j))
#define XB_XGEN(j)  (2304 + 64 * (j))
#define XB_TOP      3328
#define XB_TOPGEN   3392
#define XCD_BAR_WORDS 3456
#define XB_SPIN_CAP (1u << 18)
__device__ __forceinline__ unsigned xb_ld(unsigned* p)              { return __hip_atomic_load(p, __ATOMIC_RELAXED, __HIP_MEMORY_SCOPE_AGENT); }
__device__ __forceinline__ unsigned xb_add(unsigned* p, unsigned v) { return __hip_atomic_fetch_add(p, v, __ATOMIC_RELAXED, __HIP_MEMORY_SCOPE_AGENT); }
__device__ __forceinline__ unsigned xb_xcc_id() { return (unsigned)__builtin_amdgcn_s_getreg((3 << 11) | 20) & 0xFu; }
#define XB_SPIN(cond, bar) do { unsigned _sp = 0; while (cond) { __builtin_amdgcn_s_sleep(1); \
    if ((++_sp & 255u) == 0u) { if (xb_ld(&(bar)[XB_TMO])) break; if (_sp > XB_SPIN_CAP) { atomicAdd(&(bar)[XB_TMO], 1u); break; } } } } while (0)
struct XcdBarrier { unsigned* bar; unsigned x; volatile LAS unsigned* st; };
__device__ __forceinline__ XcdBarrier xcd_barrier_post(unsigned* bar, volatile LAS unsigned* st) {
    XcdBarrier b; b.bar = bar; b.x = xb_xcc_id(); b.st = st;
    if (threadIdx.x == 0) (void)xb_add(&bar[XB_XCNT(b.x)], 1u);
    return b;
}
__device__ __forceinline__ void xcd_barrier_complete(unsigned* bar, unsigned x, unsigned& nloc, unsigned& nx) {
    const unsigned G = gridDim.x * gridDim.y * gridDim.z;
    unsigned sum, cnt, mine, sp = 0u;
    for (;;) {
        sum = 0u; cnt = 0u; mine = 0u;
#pragma unroll
        for (unsigned j = 0; j < 16; ++j) { const unsigned c = xb_ld(&bar[XB_XCNT(j)]); sum += c; cnt += (c > 0u) ? 1u : 0u; mine = (j == x) ? c : mine; }
        if (sum == G) break;
        __builtin_amdgcn_s_sleep(1);
        if ((++sp & 255u) == 0u) { if (xb_ld(&bar[XB_TMO])) break; if (sp > XB_SPIN_CAP) { atomicAdd(&bar[XB_TMO], 1u); break; } }
    }
    nloc = mine > 0u ? mine : 1u; nx = cnt > 0u ? cnt : 1u;
}
__device__ __forceinline__ void xcd_barrier(const XcdBarrier& b) {
    asm volatile("s_waitcnt vmcnt(0)" ::: "memory");
    __syncthreads();
    if (threadIdx.x == 0) {
        unsigned* bar = b.bar;
        __builtin_amdgcn_s_waitcnt(0);
        unsigned nloc = b.st[0], nx = b.st[1];
        if (nloc == 0u) { xcd_barrier_complete(bar, b.x, nloc, nx); b.st[0] = nloc; b.st[1] = nx; }
        const unsigned old = xb_add(&bar[XB_XSUB(b.x)], 1u);
        const unsigned gen = old / nloc;
        if (old + 1u == (gen + 1u) * nloc) {
            __builtin_amdgcn_fence(__ATOMIC_RELEASE, "agent");
            asm volatile("s_waitcnt vmcnt(0)" ::: "memory");
            const unsigned og = xb_add(&bar[XB_TOP], 1u);
            const unsigned tg = og / nx;
            if (og + 1u == (tg + 1u) * nx) xb_add(&bar[XB_TOPGEN], 1u);
            else XB_SPIN(xb_ld(&bar[XB_TOPGEN]) == tg, bar);
            __builtin_amdgcn_fence(__ATOMIC_ACQUIRE, "agent");
            xb_add(&bar[XB_XGEN(b.x)], 1u);
            asm volatile("s_waitcnt vmcnt(0)" ::: "memory");
        } else {
            XB_SPIN(xb_ld(&bar[XB_XGEN(b.x)]) == gen, bar);
            __builtin_amdgcn_fence(__ATOMIC_ACQUIRE, "agent");
            asm volatile("s_waitcnt vmcnt(0)" ::: "memory");
        }
    }
    __syncthreads();
}

struct Frame {
    LAS unsigned char* lds;
    volatile LAS unsigned* MISC;
    unsigned* ctl;
    int tid, lane, wave, vcu, G;
    const float *x, *c, *w_ada, *b_ada, *w_in, *w_gate_up, *b_gla_gate, *gla_out_norm, *swa_q_norm, *swa_k_norm, *swa_sinks, *swa_out_norm, *w_out, *w_peer_q, *keys1, *keys2, *edown, *eup;
    float* out;
    unsigned char* ws;
    float *MOD, *ROPE;
    bf16 *BTIN, *BTOUT, *BTQ, *HBUF, *PROJ, *MIXIN, *QPEER;
    unsigned char *DC8, *UC8, *YC8;
    int* ZP; unsigned *EIDX, *HE, *EIDX16; float *GATEQ, *DSC, *YSC;
    bf16 *GQT, *GST, *X1; float *GUT, *GG;
};

__device__ __forceinline__ float wave_sum(float v) {
#pragma unroll
    for (int o = 1; o < 64; o <<= 1) v += __shfl_xor(v, o);
    return v;
}
__device__ __forceinline__ float wave_max(float v) {
#pragma unroll
    for (int o = 1; o < 64; o <<= 1) v = fmaxf(v, __shfl_xor(v, o));
    return v;
}
__device__ __forceinline__ unsigned pack4i(float a, float b, float c, float d) {
    const int q0 = (int)__builtin_rintf(a), q1 = (int)__builtin_rintf(b), q2 = (int)__builtin_rintf(c), q3 = (int)__builtin_rintf(d);
    return (unsigned)(q0 & 255) | ((unsigned)(q1 & 255) << 8) | ((unsigned)(q2 & 255) << 16) | ((unsigned)q3 << 24);
}

__device__ __forceinline__ void p0_tr_item(const float* W, int ldw, int sc0, int ncols, bf16* WT, int dr0, int k0, LAS float* scr, int lane) {
    const int c4 = (lane & 7) * 4, kr = lane >> 3;
    f32x4 v[8];
#pragma unroll
    for (int i = 0; i < 8; ++i) v[i] = (c4 < ncols) ? *(const GAS f32x4*)(W + (size_t)(k0 + kr + 8 * i) * ldw + sc0 + c4) : (f32x4){0.f, 0.f, 0.f, 0.f};
#pragma unroll
    for (int i = 0; i < 8; ++i) { LAS float* d = scr + (kr + 8 * i) * 33 + c4; d[0] = v[i][0]; d[1] = v[i][1]; d[2] = v[i][2]; d[3] = v[i][3]; }
    LDS_WAIT(); asm volatile("" ::: "memory");
    const int c8 = lane & 7;
#pragma unroll
    for (int j = 0; j < 4; ++j) { const int n = (lane >> 3) + 8 * j; const LAS float* s = scr + (8 * c8) * 33 + n;
        v4u o; o.x = pk2(s[0 * 33], s[1 * 33]); o.y = pk2(s[2 * 33], s[3 * 33]); o.z = pk2(s[4 * 33], s[5 * 33]); o.w = pk2(s[6 * 33], s[7 * 33]);
        if (n < ncols) *(GAS v4u*)(WT + (size_t)(dr0 + n) * DM + k0 + 8 * c8) = o; }
    LDS_WAIT(); asm volatile("" ::: "memory");
}

__device__ __forceinline__ void p0a_ada(Frame& F) {
    const int tid = F.tid, lane = F.lane, wave = F.wave;
    {
        LAS f32x4* cact = (LAS f32x4*)F.lds;
        LAS float* red = (LAS float*)(F.lds + 65536);
        for (int k = tid; k < DM; k += 512) { f32x4 v;
#pragma unroll
            for (int b = 0; b < 4; ++b) { const float cv = F.c[b * DM + k]; v[b] = cv / (1.0f + expf(-cv)); }
            cact[k] = v; }
        __syncthreads();
        for (int slice = F.vcu; slice < 256; slice += F.G) {
            const int col0 = slice * 96, sub = lane / 24, cl = lane - sub * 24;
            f32x4 acc[4];
#pragma unroll
            for (int b = 0; b < 4; ++b) acc[b] = (f32x4){0.f, 0.f, 0.f, 0.f};
            if (lane < 48) {
                const float* wp = F.w_ada + col0 + 4 * cl;
#pragma unroll 16
                for (int k = wave * 2 + sub; k < DM; k += 16) {
                    const f32x4 w = *(const GAS f32x4*)(wp + (size_t)k * NMOD); const f32x4 cv = cact[k];
#pragma unroll
                    for (int b = 0; b < 4; ++b) acc[b] += w * cv[b];
                }
#pragma unroll
                for (int b = 0; b < 4; ++b) *(LAS f32x4*)(red + (wave * 48 + lane) * 16 + 4 * b) = acc[b];
            }
            __syncthreads();
            if (tid < 384) { const int b = tid / 96, col = tid - b * 96, cl2 = col >> 2, e = col & 3; float s = 0.f;
#pragma unroll
                for (int w = 0; w < 8; ++w) { s += red[(w * 48 + cl2) * 16 + 4 * b + e]; s += red[(w * 48 + 24 + cl2) * 16 + 4 * b + e]; }
                F.MOD[b * NMOD + col0 + col] = s + F.b_ada[col0 + col]; }
            __syncthreads();
        }
    }
}
__device__ __forceinline__ void p0b_weights(Frame& F) {
    const int tid = F.tid, lane = F.lane, wave = F.wave;
    const int gw = F.vcu * NWAVES + wave, NGW = F.G * NWAVES;
    {
        LAS float* scr = (LAS float*)(F.lds + wave * 16384);
        constexpr int NB0 = 192, NB1 = 80, NB2 = 1, NB3 = 128, NB4 = 64, NBT = NB0 + NB1 + NB2 + NB3 + NB4;
        for (int it = gw; it < NBT * 64; it += NGW) {
            int nb = it >> 6; const int k0 = (it & 63) * 64;
            if (nb < NB0) { p0_tr_item(F.w_in, IN_WIDTH, 32 * nb, 32, F.BTIN, 32 * nb, k0, scr, lane); continue; } nb -= NB0;
            if (nb < NB1) { p0_tr_item(F.w_in, IN_WIDTH, 6160 + 32 * nb, 32, F.BTIN, 6144 + 32 * nb, k0, scr, lane); continue; } nb -= NB1;
            if (nb < NB2) { p0_tr_item(F.w_in, IN_WIDTH, 6144, 16, F.BTIN, C_GA, k0, scr, lane); continue; } nb -= NB2;
            if (nb < NB3) { p0_tr_item(F.w_out, DM, 32 * nb, 32, F.BTOUT, 32 * nb, k0, scr, lane); continue; } nb -= NB3;
            p0_tr_item(F.w_peer_q, PEER_N, 32 * nb, 32, F.BTQ, 32 * nb, k0, scr, lane);
        }
        const size_t gt = (size_t)F.vcu * 512 + tid, NT = (size_t)F.G * 512;
        GAS v4u* z = (GAS v4u*)(F.BTIN + (size_t)(C_GA + 16) * DM);
        for (size_t i = gt; i < (size_t)240 * DM / 8; i += NT) z[i] = (v4u){0u, 0u, 0u, 0u};
        for (size_t e = gt; e < (size_t)SEQ * 32; e += NT) { const int pos = (int)(e >> 5), i = (int)(e & 31);
            const float inv = exp2f(-(float)i * (13.287712379549449f / 32.0f));
            const float ang = (float)pos * inv;
            const double rev = (double)ang * 0.15915494309189535; const float fr = (float)(rev - floor(rev));
            F.ROPE[e] = __builtin_amdgcn_cosf(fr); F.ROPE[SEQ * 32 + e] = __builtin_amdgcn_sinf(fr); }
    }
}
__device__ __forceinline__ void convert_expert_groups(Frame& F, int g_lo, int g_hi, int g_step) {
    const int tid = F.tid, lane = F.lane, wave = F.wave;
    __syncthreads();
    for (int tb = 0; tb < 2; ++tb) {
        const float* srcT = tb ? F.eup : F.edown; unsigned char* dstT = tb ? F.UC8 : F.DC8;
        for (int grp = g_lo; grp < g_hi; grp += g_step) {
            const int e0 = grp * 32;
#pragma unroll 1
            for (int r = 0; r < 4; ++r) {
                const int el = wave * 4 + r, e = e0 + el;
                const GAS f32x4* src = (const GAS f32x4*)(srcT + (size_t)e * DM);
                f32x4 a[8], b[8];
#pragma unroll
                for (int j = 0; j < 8; ++j) { a[j] = src[2 * (lane + 64 * j)]; b[j] = src[2 * (lane + 64 * j) + 1]; }
                if (tb == 0) {
                    float m = 0.f;
#pragma unroll
                    for (int j = 0; j < 8; ++j)
#pragma unroll
                        for (int q = 0; q < 4; ++q) m = fmaxf(m, fmaxf(fabsf(a[j][q]), fabsf(b[j][q])));
                    m = wave_max(m);
                    const float inv = m > 0.f ? 127.0f / m : 0.f;
                    if (lane == 0) F.DSC[e] = m * (1.0f / 127.0f);
#pragma unroll
                    for (int j = 0; j < 8; ++j) { v2u o; o.x = pack4i(a[j][0] * inv, a[j][1] * inv, a[j][2] * inv, a[j][3] * inv); o.y = pack4i(b[j][0] * inv, b[j][1] * inv, b[j][2] * inv, b[j][3] * inv);
                        *(LAS v2u*)(F.lds + el * 4096 + ((lane + 64 * j + el) & 511) * 8) = o; }
                } else {
#pragma unroll
                    for (int j = 0; j < 8; ++j) { int w0 = __builtin_amdgcn_cvt_pk_fp8_f32(a[j][0], a[j][1], 0, false); w0 = __builtin_amdgcn_cvt_pk_fp8_f32(a[j][2], a[j][3], w0, true);
                        int w1 = __builtin_amdgcn_cvt_pk_fp8_f32(b[j][0], b[j][1], 0, false); w1 = __builtin_amdgcn_cvt_pk_fp8_f32(b[j][2], b[j][3], w1, true);
                        v2u o; o.x = (unsigned)w0; o.y = (unsigned)w1;
                        *(LAS v2u*)(F.lds + el * 4096 + ((lane + 64 * j + el) & 511) * 8) = o; }
                }
            }
            __syncthreads();
            { const int el = tid & 31;
#pragma unroll 4
              for (int it = 0; it < 32; ++it) { const int sc = it * 16 + (tid >> 5);
                  const v2u o = *(const LAS v2u*)(F.lds + el * 4096 + ((sc + el) & 511) * 8);
                  *(GAS v2u*)(dstT + ((size_t)sc * NEXP + e0 + el) * 8) = o; } }
            __syncthreads();
        }
    }
}
constexpr int GEMM1_UNITS = (NTOK / 256) * (NPROJ / 256);
__host__ __device__ constexpr int tail_groups(int G) { return (GEMM1_UNITS % G) ? (512 - G > 0 ? 512 - G : 0) : 0; }
__device__ __forceinline__ void p0c_tables(Frame& F) {
    convert_expert_groups(F, tail_groups(F.G) + F.vcu, 512, F.G);
}
__device__ __forceinline__ void p0_prologue(Frame& F) { p0a_ada(F); p0b_weights(F); p0c_tables(F); }

__device__ __forceinline__ void modulate_rows(Frame& F, const float* src, bf16* dst, int sh_off, int sc_off) {
    const int gw = F.vcu * NWAVES + F.wave, NGW = F.G * NWAVES, lane = F.lane;
    for (int m = gw; m < NTOK; m += NGW) {
        const int b = m >> 11;
        const GAS f32x4* xr = (const GAS f32x4*)(src + (size_t)m * DM) + lane;
        f32x4 v[16]; float s = 0.f;
#pragma unroll
        for (int j = 0; j < 16; ++j) { v[j] = xr[64 * j]; s += (v[j].x * v[j].x + v[j].y * v[j].y) + (v[j].z * v[j].z + v[j].w * v[j].w); }
        const float rstd = 1.0f / sqrtf(wave_sum(s) * (1.0f / DM) + EPS);
        const GAS f32x4* shp = (const GAS f32x4*)(F.MOD + b * NMOD + sh_off) + lane;
        const GAS f32x4* scp = (const GAS f32x4*)(F.MOD + b * NMOD + sc_off) + lane;
        GAS v2u* o8 = (GAS v2u*)(dst + (size_t)m * DM) + lane;
#pragma unroll
        for (int j = 0; j < 16; ++j) { const f32x4 sh = shp[64 * j], sc = scp[64 * j]; const f32x4 y = v[j] * rstd * (sc + 1.0f) + sh;
            v2u o; o.x = pk2(y.x, y.y); o.y = pk2(y.z, y.w); o8[64 * j] = o; }
    }
}


__device__ __forceinline__ void p5_modulate_quant(Frame& F) {
    const int gw = F.vcu * NWAVES + F.wave, NGW = F.G * NWAVES, lane = F.lane;
    for (int m = gw; m < NTOK; m += NGW) {
        const int b = m >> 11;
        const GAS v4u* xr = (const GAS v4u*)(F.X1 + (size_t)m * DM);
        f32x4 a[8], c[8]; float s = 0.f;
#pragma unroll
        for (int j = 0; j < 8; ++j) { const v4u w = xr[lane + 64 * j]; a[j] = (f32x4){bflo(w.x), bfhi(w.x), bflo(w.y), bfhi(w.y)}; c[j] = (f32x4){bflo(w.z), bfhi(w.z), bflo(w.w), bfhi(w.w)};
            s += (a[j].x * a[j].x + a[j].y * a[j].y) + (a[j].z * a[j].z + a[j].w * a[j].w) + (c[j].x * c[j].x + c[j].y * c[j].y) + (c[j].z * c[j].z + c[j].w * c[j].w); }
        const float rstd = 1.0f / sqrtf(wave_sum(s) * (1.0f / DM) + EPS);
        const GAS f32x4* shp = (const GAS f32x4*)(F.MOD + b * NMOD + 3 * DM);
        const GAS f32x4* scp = (const GAS f32x4*)(F.MOD + b * NMOD + 4 * DM);
        float mx = 0.f;
#pragma unroll
        for (int j = 0; j < 8; ++j) { const int i0 = 2 * (lane + 64 * j);
            a[j] = a[j] * rstd * (scp[i0] + 1.0f) + shp[i0]; c[j] = c[j] * rstd * (scp[i0 + 1] + 1.0f) + shp[i0 + 1];
#pragma unroll
            for (int q = 0; q < 4; ++q) mx = fmaxf(mx, fmaxf(fabsf(a[j][q]), fabsf(c[j][q])));
            *(GAS v4u*)(F.HBUF + (size_t)m * DM + 8 * (lane + 64 * j)) = (v4u){pk2(a[j].x, a[j].y), pk2(a[j].z, a[j].w), pk2(c[j].x, c[j].y), pk2(c[j].z, c[j].w)}; }
        mx = wave_max(mx);
        const float inv = mx > 0.f ? 127.0f / mx : 0.f;
        if (lane == 0) F.YSC[m] = mx * (1.0f / 127.0f);
#pragma unroll
        for (int j = 0; j < 8; ++j) { v2u o; o.x = pack4i(a[j].x * inv, a[j].y * inv, a[j].z * inv, a[j].w * inv); o.y = pack4i(c[j].x * inv, c[j].y * inv, c[j].z * inv, c[j].w * inv);
            *(GAS v2u*)(F.YC8 + ((size_t)(lane + 64 * j) * NTOK + m) * 8) = o; }
    }
}

__device__ __forceinline__ void swa_unit(Frame& F, int u) {
    const int b = u >> 6, kvh = (u >> 4) & 3, n = u & 15, t0 = n * 128;
    LAS unsigned char* KL = F.lds;
    LAS unsigned char* VL = F.lds + 36864;
    const float* COS = F.ROPE; const float* SIN = F.ROPE + SEQ * 32;
    {
        const int key = F.tid >> 1, p = F.tid & 1, kpos = t0 - 128 + key;
        v4u ka[2] = {{0u, 0u, 0u, 0u}, {0u, 0u, 0u, 0u}}, kb[2] = {{0u, 0u, 0u, 0u}, {0u, 0u, 0u, 0u}}, vv[4] = {{0u, 0u, 0u, 0u}, {0u, 0u, 0u, 0u}, {0u, 0u, 0u, 0u}, {0u, 0u, 0u, 0u}};
        float cs[16], sn[16];
#pragma unroll
        for (int i = 0; i < 16; ++i) { cs[i] = 1.f; sn[i] = 0.f; }
        if (kpos >= 0) {
            const bf16* pr = F.PROJ + (size_t)(b * SEQ + kpos) * NPROJ;
            const GAS v4u* kr = (const GAS v4u*)(pr + C_SK + kvh * 64);
            ka[0] = kr[2 * p]; ka[1] = kr[2 * p + 1]; kb[0] = kr[4 + 2 * p]; kb[1] = kr[4 + 2 * p + 1];
            const GAS v4u* vr = (const GAS v4u*)(pr + C_SV + kvh * 64 + 32 * p);
#pragma unroll
            for (int j = 0; j < 4; ++j) vv[j] = vr[j];
            const GAS f32x4* cp = (const GAS f32x4*)(COS + kpos * 32 + 16 * p); const GAS f32x4* sp = (const GAS f32x4*)(SIN + kpos * 32 + 16 * p);
#pragma unroll
            for (int j = 0; j < 4; ++j) { const f32x4 c4 = cp[j], s4 = sp[j];
#pragma unroll
                for (int e = 0; e < 4; ++e) { cs[4 * j + e] = c4[e]; sn[4 * j + e] = s4[e]; } }
        }
        float x1[16], x2[16]; float ss = 0.f;
#pragma unroll
        for (int j = 0; j < 2; ++j)
#pragma unroll
            for (int e = 0; e < 4; ++e) { x1[8 * j + 2 * e] = bflo(ka[j][e]); x1[8 * j + 2 * e + 1] = bfhi(ka[j][e]); x2[8 * j + 2 * e] = bflo(kb[j][e]); x2[8 * j + 2 * e + 1] = bfhi(kb[j][e]); }
#pragma unroll
        for (int i = 0; i < 16; ++i) ss += x1[i] * x1[i] + x2[i] * x2[i];
        ss += __shfl_xor(ss, 1);
        const float rstd = 1.0f / sqrtf(ss * (1.0f / 64.0f) + EPS);
        unsigned o1[8], o2[8];
#pragma unroll
        for (int i = 0; i < 8; ++i) {
            float y1[2], y2[2];
#pragma unroll
            for (int e = 0; e < 2; ++e) { const int d = 2 * i + e; const float a = x1[d] * rstd * F.swa_k_norm[16 * p + d], c = x2[d] * rstd * F.swa_k_norm[32 + 16 * p + d];
                y1[e] = a * cs[d] - c * sn[d]; y2[e] = c * cs[d] + a * sn[d]; }
            o1[i] = pk2(y1[0], y1[1]); o2[i] = pk2(y2[0], y2[1]);
        }
        LAS v4u* kd = (LAS v4u*)(KL + key * 144 + 32 * p);
        kd[0] = (v4u){o1[0], o1[1], o1[2], o1[3]}; kd[1] = (v4u){o1[4], o1[5], o1[6], o1[7]};
        LAS v4u* kd2 = (LAS v4u*)(KL + key * 144 + 64 + 32 * p);
        kd2[0] = (v4u){o2[0], o2[1], o2[2], o2[3]}; kd2[1] = (v4u){o2[4], o2[5], o2[6], o2[7]};
#pragma unroll
        for (int j = 0; j < 4; ++j)
#pragma unroll
            for (int e = 0; e < 4; ++e) { const int d = 32 * p + 8 * j + 2 * e; const unsigned w = vv[j][e];
                *(LAS unsigned short*)(VL + d * 520 + key * 2) = (unsigned short)(w & 0xffffu);
                *(LAS unsigned short*)(VL + (d + 1) * 520 + key * 2) = (unsigned short)(w >> 16); }
    }
    __syncthreads();
    {
        const int g = F.wave, hq = kvh * 8 + g, r = F.lane & 31, h = F.lane >> 5;
        const float sink = F.swa_sinks[hq];
        for (int qt = 0; qt < 4; ++qt) {
            const int qpos = t0 + 32 * qt + r;
            const size_t tok = (size_t)(b * SEQ + qpos);
            const GAS v4u* qr = (const GAS v4u*)(F.PROJ + tok * NPROJ + C_SQ + hq * 64);
            v4u qraw[4];
#pragma unroll
            for (int kk = 0; kk < 4; ++kk) qraw[kk] = qr[2 * kk + h];
            float qf[4][8]; float ss = 0.f;
#pragma unroll
            for (int kk = 0; kk < 4; ++kk)
#pragma unroll
                for (int e = 0; e < 4; ++e) { qf[kk][2 * e] = bflo(qraw[kk][e]); qf[kk][2 * e + 1] = bfhi(qraw[kk][e]); }
#pragma unroll
            for (int kk = 0; kk < 4; ++kk)
#pragma unroll
                for (int j = 0; j < 8; ++j) ss += qf[kk][j] * qf[kk][j];
            ss += __shfl_xor(ss, 32);
            const float rstd = 0.125f / sqrtf(ss * (1.0f / 64.0f) + EPS);
            bf16x8 qfrag[4];
#pragma unroll
            for (int kk = 0; kk < 2; ++kk) {
                float y1[8], y2[8];
                const GAS f32x4* cp = (const GAS f32x4*)(COS + qpos * 32 + 16 * kk + 8 * h); const GAS f32x4* sp = (const GAS f32x4*)(SIN + qpos * 32 + 16 * kk + 8 * h);
                const f32x4 c0 = cp[0], c1 = cp[1], s0 = sp[0], s1 = sp[1];
#pragma unroll
                for (int j = 0; j < 8; ++j) { const int d = 16 * kk + 8 * h + j; const float cc = j < 4 ? c0[j & 3] : c1[j & 3], sv = j < 4 ? s0[j & 3] : s1[j & 3];
                    const float a = qf[kk][j] * rstd * F.swa_q_norm[d], c = qf[kk + 2][j] * rstd * F.swa_q_norm[d + 32];
                    y1[j] = a * cc - c * sv; y2[j] = c * cc + a * sv; }
                qfrag[kk] = mk8(pk2(y1[0], y1[1]), pk2(y1[2], y1[3]), pk2(y1[4], y1[5]), pk2(y1[6], y1[7]));
                qfrag[kk + 2] = mk8(pk2(y2[0], y2[1]), pk2(y2[2], y2[3]), pk2(y2[4], y2[5]), pk2(y2[6], y2[7]));
            }
            f32x16 sacc[5];
#pragma unroll
            for (int tt = 0; tt < 5; ++tt) { f32x16 a = {0.f, 0.f, 0.f, 0.f, 0.f, 0.f, 0.f, 0.f, 0.f, 0.f, 0.f, 0.f, 0.f, 0.f, 0.f, 0.f};
#pragma unroll
                for (int kk = 0; kk < 4; ++kk) { const bf16x8 kf = *(const LAS bf16x8*)(KL + (32 * (qt + tt) + r) * 144 + (16 * kk + 8 * h) * 2); a = mfma32(kf, qfrag[kk], a); }
                sacc[tt] = a; }
            float mx = sink;
#pragma unroll
            for (int tt = 0; tt < 5; ++tt)
#pragma unroll
                for (int i = 0; i < 16; ++i) { const int koff = (i & 3) + 8 * (i >> 2) + 4 * h; const int rel = r + 128 - 32 * tt - koff; const int kidx = 32 * (qt + tt) + koff;
                    const bool valid = (rel >= 0) && (rel < 128) && (t0 - 128 + kidx >= 0);
                    const float s = valid ? sacc[tt][i] : -INFINITY; sacc[tt][i] = s; mx = fmaxf(mx, s); }
            mx = fmaxf(mx, __shfl_xor(mx, 32));
            float sum = 0.f;
#pragma unroll
            for (int tt = 0; tt < 5; ++tt)
#pragma unroll
                for (int i = 0; i < 16; ++i) { const float pv = __expf(sacc[tt][i] - mx); sacc[tt][i] = pv; sum += pv; }
            sum += __shfl_xor(sum, 32);
            const float inv = 1.0f / (sum + __expf(sink - mx));
            f32x16 oacc[2];
#pragma unroll
            for (int dt = 0; dt < 2; ++dt) oacc[dt] = (f32x16){0.f, 0.f, 0.f, 0.f, 0.f, 0.f, 0.f, 0.f, 0.f, 0.f, 0.f, 0.f, 0.f, 0.f, 0.f, 0.f};
#pragma unroll
            for (int tt = 0; tt < 5; ++tt)
#pragma unroll
                for (int s2 = 0; s2 < 2; ++s2) {
                    const bf16x8 pf = mk8(pk2(sacc[tt][8 * s2], sacc[tt][8 * s2 + 1]), pk2(sacc[tt][8 * s2 + 2], sacc[tt][8 * s2 + 3]), pk2(sacc[tt][8 * s2 + 4], sacc[tt][8 * s2 + 5]), pk2(sacc[tt][8 * s2 + 6], sacc[tt][8 * s2 + 7]));
#pragma unroll
                    for (int dt = 0; dt < 2; ++dt) { const LAS unsigned char* vp = VL + (32 * dt + r) * 520 + (32 * (qt + tt) + 16 * s2 + 4 * h) * 2;
                        const v2u lo = *(const LAS v2u*)vp, hi = *(const LAS v2u*)(vp + 16);
                        oacc[dt] = mfma32(mk8(lo.x, lo.y, hi.x, hi.y), pf, oacc[dt]); }
                }
            float so = 0.f;
#pragma unroll
            for (int dt = 0; dt < 2; ++dt)
#pragma unroll
                for (int i = 0; i < 16; ++i) { const float o = oacc[dt][i] * inv; oacc[dt][i] = o; so += o * o; }
            so += __shfl_xor(so, 32);
            const float rs2 = 1.0f / sqrtf(so * (1.0f / 64.0f) + EPS);
            bf16* orow = F.MIXIN + tok * DM + 2048 + hq * 64;
#pragma unroll
            for (int dt = 0; dt < 2; ++dt)
#pragma unroll
                for (int gq = 0; gq < 4; ++gq) { const int d0 = 32 * dt + 8 * gq + 4 * h; const f32x4 gn = *(const GAS f32x4*)(F.swa_out_norm + d0);
                    v2u o; o.x = pk2(oacc[dt][4 * gq] * rs2 * gn[0], oacc[dt][4 * gq + 1] * rs2 * gn[1]); o.y = pk2(oacc[dt][4 * gq + 2] * rs2 * gn[2], oacc[dt][4 * gq + 3] * rs2 * gn[3]);
                    *(GAS v2u*)(orow + d0) = o; }
        }
    }
    __syncthreads();
}

constexpr int GL_QT = 0, GL_KT = 9216, GL_KHT = 18432, GL_VT = 27648, GL_WG = 46336, GL_BG = 50432, GL_OB = 50688;
__device__ __forceinline__ void gla_g1_units(Frame& F, int u0, int nu) {
    const int bh = u0 >> 5, b = bh >> 4, h = bh & 15, tid = F.tid, lane = F.lane, w = F.wave;
    LAS unsigned char* QT = F.lds + GL_QT;
    LAS unsigned char* KT = F.lds + GL_KT;
    LAS unsigned char* KHT = F.lds + GL_KHT;
    LAS unsigned char* VT = F.lds + GL_VT;
    LAS float* WG = (LAS float*)(F.lds + GL_WG);
    LAS float* BG = (LAS float*)(F.lds + GL_BG);
    LAS float* OB = (LAS float*)(F.lds + GL_OB);
    __syncthreads();
    for (int i = tid; i < 1024; i += 512) WG[i] = F.w_gate_up[(i >> 6) * 1024 + h * 64 + (i & 63)];
    if (tid < 64) BG[tid] = F.b_gla_gate[h * 64 + tid];
    __syncthreads();
    const int r = lane & 15, g = lane >> 4;
    const int t2 = tid >> 3, seg = tid & 7;
    v4u qv, kv, g0, g1, vv0, vv1;
    { const size_t row0 = (size_t)b * SEQ + (u0 & 31) * 64; const bf16* pr = F.PROJ + (row0 + lane) * NPROJ;
      qv = *(const GAS v4u*)(pr + C_GQ + h * 64 + 8 * w); kv = *(const GAS v4u*)(pr + C_GK + h * 64 + 8 * w); g0 = *(const GAS v4u*)(pr + C_GA); g1 = *(const GAS v4u*)(pr + C_GA + 8);
      const GAS v4u* vr = (const GAS v4u*)(F.PROJ + (row0 + t2) * NPROJ + C_GV + h * 128 + 16 * seg); vv0 = vr[0]; vv1 = vr[1]; }
    for (int ui = 0; ui < nu; ++ui) {
        const int u = u0 + ui, chunk = u & 31;
        const size_t row0 = (size_t)b * SEQ + chunk * 64;
        v4u nqv = qv, nkv = kv, ng0 = g0, ng1 = g1, nvv0 = vv0, nvv1 = vv1;
        if (ui + 1 < nu) {
            const size_t rown = row0 + 64; const bf16* pr = F.PROJ + (rown + lane) * NPROJ;
            nqv = *(const GAS v4u*)(pr + C_GQ + h * 64 + 8 * w); nkv = *(const GAS v4u*)(pr + C_GK + h * 64 + 8 * w); ng0 = *(const GAS v4u*)(pr + C_GA); ng1 = *(const GAS v4u*)(pr + C_GA + 8);
            const GAS v4u* vr = (const GAS v4u*)(F.PROJ + (rown + t2) * NPROJ + C_GV + h * 128 + 16 * seg); nvv0 = vr[0]; nvv1 = vr[1]; }
        {
            float ga[16];
#pragma unroll
            for (int e = 0; e < 4; ++e) { ga[2 * e] = bflo(g0[e]); ga[2 * e + 1] = bfhi(g0[e]); ga[8 + 2 * e] = bflo(g1[e]); ga[8 + 2 * e + 1] = bfhi(g1[e]); }
            float z[8];
            { const f32x4 b0 = *(const LAS f32x4*)(BG + 8 * w), b1 = *(const LAS f32x4*)(BG + 8 * w + 4);
#pragma unroll
              for (int i = 0; i < 4; ++i) { z[i] = b0[i]; z[4 + i] = b1[i]; } }
#pragma unroll
            for (int j = 0; j < 16; ++j) { const f32x4 w0 = *(const LAS f32x4*)(WG + j * 64 + 8 * w), w1 = *(const LAS f32x4*)(WG + j * 64 + 8 * w + 4);
#pragma unroll
                for (int i = 0; i < 4; ++i) { z[i] += ga[j] * w0[i]; z[4 + i] += ga[j] * w1[i]; } }
            float bb[8];
#pragma unroll
            for (int i = 0; i < 8; ++i) { const float zz = z[i]; bb[i] = (fminf(zz, 0.f) - __logf(1.0f + __expf(-fabsf(zz)))) * (1.0f / 16.0f); }
#pragma unroll
            for (int off = 1; off < 64; off <<= 1)
#pragma unroll
                for (int i = 0; i < 8; ++i) { const float v = __shfl_up(bb[i], off); if (lane >= off) bb[i] += v; }
            float qn[8], kn[8], kh[8];
#pragma unroll
            for (int e = 0; e < 4; ++e) { qn[2 * e] = bflo(qv[e]); qn[2 * e + 1] = bfhi(qv[e]); kn[2 * e] = bflo(kv[e]); kn[2 * e + 1] = bfhi(kv[e]); }
#pragma unroll
            for (int i = 0; i < 8; ++i) { const float bl = __shfl(bb[i], 63); const float eb = __expf(bb[i]);
                qn[i] = qn[i] * 0.125f * eb; kh[i] = kn[i] * __expf(bl - bb[i]); kn[i] = kn[i] * __expf(-bb[i]);
                if (lane == 0) F.GG[(size_t)u * 64 + 8 * w + i] = __expf(bl); }
            const v4u qpk = {pk2(qn[0], qn[1]), pk2(qn[2], qn[3]), pk2(qn[4], qn[5]), pk2(qn[6], qn[7])};
            *(LAS v4u*)(QT + lane * 144 + 16 * w) = qpk;
            *(GAS v4u*)(F.GQT + ((size_t)u * 64 + lane) * 64 + 8 * w) = qpk;
            *(LAS v4u*)(KT + lane * 144 + 16 * w) = (v4u){pk2(kn[0], kn[1]), pk2(kn[2], kn[3]), pk2(kn[4], kn[5]), pk2(kn[6], kn[7])};
#pragma unroll
            for (int i = 0; i < 8; ++i) *(LAS unsigned short*)(KHT + (8 * w + i) * 144 + lane * 2) = (unsigned short)f2bf(kh[i]);
#pragma unroll
            for (int e = 0; e < 4; ++e) {
                *(LAS unsigned short*)(VT + (16 * seg + 2 * e) * 144 + t2 * 2) = (unsigned short)(vv0[e] & 0xffffu);
                *(LAS unsigned short*)(VT + (16 * seg + 2 * e + 1) * 144 + t2 * 2) = (unsigned short)(vv0[e] >> 16);
                *(LAS unsigned short*)(VT + (16 * seg + 8 + 2 * e) * 144 + t2 * 2) = (unsigned short)(vv1[e] & 0xffffu);
                *(LAS unsigned short*)(VT + (16 * seg + 8 + 2 * e + 1) * 144 + t2 * 2) = (unsigned short)(vv1[e] >> 16); }
        }
        __syncthreads();
        {
            unsigned dp[4][4][2];
#pragma unroll
            for (int tt = 0; tt < 4; ++tt) {
                const bf16x8 bq0 = *(const LAS bf16x8*)(QT + (16 * tt + r) * 144 + (8 * g) * 2), bq1 = *(const LAS bf16x8*)(QT + (16 * tt + r) * 144 + (32 + 8 * g) * 2);
#pragma unroll
                for (int st = 0; st < 4; ++st) {
                    if (st <= tt) {
                        const bf16x8 ak0 = *(const LAS bf16x8*)(KT + (16 * st + r) * 144 + (8 * g) * 2), ak1 = *(const LAS bf16x8*)(KT + (16 * st + r) * 144 + (32 + 8 * g) * 2);
                        f32x4 d = {0.f, 0.f, 0.f, 0.f}; d = mfma16(ak0, bq0, d); d = mfma16(ak1, bq1, d);
                        if (st == tt) {
#pragma unroll
                            for (int i = 0; i < 4; ++i) if (4 * g + i > r) d[i] = 0.f; }
                        dp[st][tt][0] = pk2(d[0], d[1]); dp[st][tt][1] = pk2(d[2], d[3]);
                    } else { dp[st][tt][0] = 0u; dp[st][tt][1] = 0u; }
                }
            }
#pragma unroll
            for (int tt = 0; tt < 4; ++tt) {
                f32x4 o = {0.f, 0.f, 0.f, 0.f};
#pragma unroll
                for (int kk = 0; kk < 2; ++kk) {
                    if (2 * kk <= tt) {
                        const LAS unsigned char* vp = VT + (16 * w + r) * 144 + (32 * kk + 4 * g) * 2;
                        const v2u lo = *(const LAS v2u*)vp, hi = *(const LAS v2u*)(vp + 32);
                        o = mfma16(mk8(dp[2 * kk][tt][0], dp[2 * kk][tt][1], dp[2 * kk + 1][tt][0], dp[2 * kk + 1][tt][1]), mk8(lo.x, lo.y, hi.x, hi.y), o);
                    }
                }
#pragma unroll
                for (int i = 0; i < 4; ++i) OB[(16 * tt + 4 * g + i) * 132 + 16 * w + r] = o[i];
            }
#pragma unroll
            for (int dt = 0; dt < 4; ++dt) {
                f32x4 uacc = {0.f, 0.f, 0.f, 0.f};
#pragma unroll
                for (int kk = 0; kk < 2; ++kk) { const bf16x8 a = *(const LAS bf16x8*)(KHT + (16 * dt + r) * 144 + (32 * kk + 8 * g) * 2), bv = *(const LAS bf16x8*)(VT + (16 * w + r) * 144 + (32 * kk + 8 * g) * 2);
                    uacc = mfma16(a, bv, uacc); }
                *(GAS f32x4*)(F.GUT + ((size_t)u * 128 + 16 * w + r) * 64 + 16 * dt + 4 * g) = uacc;
            }
        }
        __syncthreads();
        {
            unsigned ow[8];
#pragma unroll
            for (int j = 0; j < 4; ++j) { const f32x4 v = *(const LAS f32x4*)(OB + t2 * 132 + 16 * seg + 4 * j); ow[2 * j] = pk2(v[0], v[1]); ow[2 * j + 1] = pk2(v[2], v[3]); }
            GAS v4u* op = (GAS v4u*)(F.MIXIN + (row0 + t2) * DM + h * 128 + 16 * seg);
            op[0] = (v4u){ow[0], ow[1], ow[2], ow[3]}; op[1] = (v4u){ow[4], ow[5], ow[6], ow[7]};
        }
        qv = nqv; kv = nkv; g0 = ng0; g1 = ng1; vv0 = nvv0; vv1 = nvv1;
    }
}
__device__ __forceinline__ void gla_scan(Frame& F) {
    const size_t gt = (size_t)F.vcu * 512 + F.tid, NT = (size_t)F.G * 512;
    for (size_t i = gt; i < (size_t)64 * 128 * 16; i += NT) {
        const int bh = (int)(i >> 11), v = (int)((i >> 4) & 127), d4 = (int)(i & 15);
        f32x4 S = {0.f, 0.f, 0.f, 0.f};
#pragma unroll 8
        for (int c = 0; c < 32; ++c) {
            const size_t u = (size_t)bh * 32 + c;
            const f32x4 U = *(const GAS f32x4*)(F.GUT + (u * 128 + v) * 64 + 4 * d4), gg = *(const GAS f32x4*)(F.GG + u * 64 + 4 * d4);
            *(GAS v2u*)(F.GST + (u * 128 + v) * 64 + 4 * d4) = (v2u){pk2(S[0], S[1]), pk2(S[2], S[3])};
            S = gg * S + U;
        }
    }
}
struct G3Ops { v4u oi0, oi1, gg0, gg1; v2u slo[2], shi[2], qlo[4][2], qhi[4][2]; };
__device__ __forceinline__ void gla_g3_load(Frame& F, G3Ops& P, int u, int b, int h, int w, int r, int g, int t2, int seg) {
    const size_t row0 = (size_t)b * SEQ + (u & 31) * 64;
    const GAS v4u* oip = (const GAS v4u*)(F.MIXIN + (row0 + t2) * DM + h * 128 + 16 * seg); P.oi0 = oip[0]; P.oi1 = oip[1];
    const GAS v4u* gr = (const GAS v4u*)(F.PROJ + (row0 + t2) * NPROJ + C_GG + h * 128 + 16 * seg); P.gg0 = gr[0]; P.gg1 = gr[1];
#pragma unroll
    for (int kk = 0; kk < 2; ++kk) { const bf16* sp = F.GST + ((size_t)u * 128 + 16 * w + r) * 64 + 32 * kk + 4 * g; P.slo[kk] = *(const GAS v2u*)sp; P.shi[kk] = *(const GAS v2u*)(sp + 16); }
#pragma unroll
    for (int tt = 0; tt < 4; ++tt)
#pragma unroll
        for (int kk = 0; kk < 2; ++kk) { const bf16* qp = F.GQT + ((size_t)u * 64 + 16 * tt + r) * 64 + 32 * kk + 4 * g; P.qlo[tt][kk] = *(const GAS v2u*)qp; P.qhi[tt][kk] = *(const GAS v2u*)(qp + 16); }
}
__device__ __forceinline__ void gla_g3_units(Frame& F, int u0, int nu) {
    const int bh = u0 >> 5, b = bh >> 4, h = bh & 15, tid = F.tid, lane = F.lane, w = F.wave;
    LAS float* OB = (LAS float*)(F.lds + GL_OB);
    const int r = lane & 15, g = lane >> 4, t2 = tid >> 3, seg = tid & 7;
    __syncthreads();
    G3Ops cur, nxt;
    gla_g3_load(F, cur, u0, b, h, w, r, g, t2, seg);
    for (int ui = 0; ui < nu; ++ui) {
        const int u = u0 + ui, chunk = u & 31;
        const size_t row0 = (size_t)b * SEQ + chunk * 64;
        {
            bf16x8 bs[2];
#pragma unroll
            for (int kk = 0; kk < 2; ++kk) bs[kk] = mk8(cur.slo[kk].x, cur.slo[kk].y, cur.shi[kk].x, cur.shi[kk].y);
#pragma unroll
            for (int tt = 0; tt < 4; ++tt) {
                f32x4 o = {0.f, 0.f, 0.f, 0.f};
#pragma unroll
                for (int kk = 0; kk < 2; ++kk) o = mfma16(mk8(cur.qlo[tt][kk].x, cur.qlo[tt][kk].y, cur.qhi[tt][kk].x, cur.qhi[tt][kk].y), bs[kk], o);
#pragma unroll
                for (int i = 0; i < 4; ++i) OB[(16 * tt + 4 * g + i) * 132 + 16 * w + r] = o[i];
            }
        }
        if (ui + 1 < nu) gla_g3_load(F, nxt, u + 1, b, h, w, r, g, t2, seg);
        __syncthreads();
        {
            float o[16]; float ss = 0.f;
#pragma unroll
            for (int j = 0; j < 4; ++j) { const f32x4 v = *(const LAS f32x4*)(OB + t2 * 132 + 16 * seg + 4 * j);
#pragma unroll
                for (int e = 0; e < 4; ++e) o[4 * j + e] = v[e]; }
#pragma unroll
            for (int e = 0; e < 4; ++e) { o[2 * e] += bflo(cur.oi0[e]); o[2 * e + 1] += bfhi(cur.oi0[e]); o[8 + 2 * e] += bflo(cur.oi1[e]); o[8 + 2 * e + 1] += bfhi(cur.oi1[e]); }
#pragma unroll
            for (int e = 0; e < 16; ++e) ss += o[e] * o[e];
            ss += __shfl_xor(ss, 1); ss += __shfl_xor(ss, 2); ss += __shfl_xor(ss, 4);
            const float rstd = 1.0f / sqrtf(ss * (1.0f / 128.0f) + EPS);
            float gg[16];
#pragma unroll
            for (int e = 0; e < 4; ++e) { gg[2 * e] = bflo(cur.gg0[e]); gg[2 * e + 1] = bfhi(cur.gg0[e]); gg[8 + 2 * e] = bflo(cur.gg1[e]); gg[8 + 2 * e + 1] = bfhi(cur.gg1[e]); }
            unsigned ow[8];
#pragma unroll
            for (int e = 0; e < 8; ++e) { const float a = o[2 * e] * rstd * F.gla_out_norm[16 * seg + 2 * e] * silu_f(gg[2 * e]), c = o[2 * e + 1] * rstd * F.gla_out_norm[16 * seg + 2 * e + 1] * silu_f(gg[2 * e + 1]);
                ow[e] = pk2(a, c); }
            GAS v4u* op = (GAS v4u*)(F.MIXIN + (row0 + t2) * DM + h * 128 + 16 * seg);
            op[0] = (v4u){ow[0], ow[1], ow[2], ow[3]}; op[1] = (v4u){ow[4], ow[5], ow[6], ow[7]};
        }
        __syncthreads();
        cur = nxt;
    }
}

__device__ __forceinline__ void p3a_mixer(Frame& F) {
    for (int u = F.vcu; u < 256; u += F.G) swa_unit(F, u);
    for (int q = F.vcu; q < 256; q += F.G) gla_g1_units(F, q * 8, 8);
}
__device__ __forceinline__ void p3c_mixer(Frame& F) {
    for (int q = F.vcu; q < 256; q += F.G) gla_g3_units(F, q * 8, 8);
}

__device__ __forceinline__ unsigned f2s(float f) { const unsigned u = __builtin_bit_cast(unsigned, f); return (u & 0x80000000u) ? ~u : (u | 0x80000000u); }
__device__ __forceinline__ float s2f(unsigned s) { const unsigned u = (s & 0x80000000u) ? (s & 0x7fffffffu) : ~s; return __builtin_bit_cast(float, u); }
#define TOPK_INSERT(list, xin) do { unsigned _x = (xin); _Pragma("unroll") for (int _p = 0; _p < 16; ++_p) { const unsigned _hi = list[_p] > _x ? list[_p] : _x; _x = list[_p] > _x ? _x : list[_p]; list[_p] = _hi; } } while (0)

template <int MODE  > __device__ __forceinline__ void p7_topk(Frame& F) {
    const int tid = F.tid, lane = F.lane, wave = F.wave;
    LAS unsigned char* KY = F.lds;
    LAS unsigned* SC = (LAS unsigned*)(F.lds + 69632 + wave * 4096);
#pragma unroll
    for (int j = 0; j < 16; ++j) { const int i4 = j * 512 + tid, hf = i4 >> 12, key = (i4 >> 5) & 127, q4 = i4 & 31;
        const f32x4 v = *(const GAS f32x4*)((hf ? F.keys2 : F.keys1) + key * 128 + 4 * q4);
        *(LAS v2u*)(KY + hf * 34816 + key * 272 + q4 * 8) = (v2u){pk2(v[0], v[1]), pk2(v[2], v[3])}; }
    __syncthreads();
    const int gw = F.vcu * NWAVES + wave, NGW = F.G * NWAVES;
    const int r = lane & 31, h = lane >> 5;
    for (int task = gw; task < 256 * 8; task += NGW) {
        const int tile = task >> 3, hd = task & 7, tok = tile * 32 + r;
        for (int hf = 0; hf < 2; ++hf) {
            const GAS v4u* qr = (const GAS v4u*)(F.QPEER + (size_t)tok * PEER_N + hd * 256 + hf * 128);
            bf16x8 qf[8];
#pragma unroll
            for (int kk = 0; kk < 8; ++kk) qf[kk] = __builtin_bit_cast(bf16x8, qr[2 * kk + h]);
            unsigned list[16];
#pragma unroll
            for (int p = 0; p < 16; ++p) list[p] = 0u;
#pragma unroll
            for (int T = 0; T < 4; ++T) {
                f32x16 a = {0.f, 0.f, 0.f, 0.f, 0.f, 0.f, 0.f, 0.f, 0.f, 0.f, 0.f, 0.f, 0.f, 0.f, 0.f, 0.f};
#pragma unroll
                for (int kk = 0; kk < 8; ++kk) { const bf16x8 kf = *(const LAS bf16x8*)(KY + hf * 34816 + (32 * T + r) * 272 + (16 * kk + 8 * h) * 2); a = mfma32(kf, qf[kk], a); }
#pragma unroll
                for (int i = 0; i < 16; ++i) { const int key = 32 * T + (i & 3) + 8 * (i >> 2) + 4 * h; const unsigned pkd = (f2s(a[i]) & ~127u) | (unsigned)(127 - key); if (MODE == 0 || i < 4) TOPK_INSERT(list, pkd); }
            }
            unsigned other[16];
#pragma unroll
            for (int p = 0; p < 16; ++p) other[p] = (unsigned)__shfl_xor((int)list[p], 32);
#pragma unroll
            for (int p = 0; p < 16; ++p) TOPK_INSERT(list, other[p]);
            if (h == 0) {
#pragma unroll
                for (int p = 0; p < 16; ++p) SC[(hf * 16 + p) * 32 + r] = list[p]; }
        }
        LDS_WAIT(); asm volatile("" ::: "memory");
        float v1[16], v2[16];
#pragma unroll
        for (int p = 0; p < 16; ++p) { v1[p] = s2f(SC[p * 32 + r] & ~127u); v2[p] = s2f(SC[(16 + p) * 32 + r] & ~127u); }
        unsigned cl[16];
#pragma unroll
        for (int p = 0; p < 16; ++p) cl[p] = 0u;
#pragma unroll
        for (int i = 0; i < 16; ++i)
#pragma unroll
            for (int j = 0; j < 16; ++j) if ((i + 1) * (j + 1) <= 16 && (MODE != 2 || i + j < 6)) { const unsigned pkd = (f2s(v1[i] + v2[j]) & ~255u) | (unsigned)(255 - (i * 16 + j)); TOPK_INSERT(cl, pkd); }
        float val[8]; int eidx[8]; float mx = -INFINITY;
#pragma unroll
        for (int p = 0; p < 16; ++p) { const int pos = 255 - (int)(cl[p] & 255u), i = pos >> 4, j = pos & 15;
            const unsigned a = SC[i * 32 + r], b2 = SC[(16 + j) * 32 + r];
            const float v = s2f(a & ~127u) + s2f(b2 & ~127u); mx = fmaxf(mx, v);
            if ((p >> 3) == h) { val[p & 7] = v; eidx[p & 7] = (127 - (int)(a & 127u)) * 128 + (127 - (int)(b2 & 127u)); } }
        float sum = 0.f, ex[8];
#pragma unroll
        for (int p = 0; p < 8; ++p) { ex[p] = __expf(val[p] - mx); sum += ex[p]; }
        sum += __shfl_xor(sum, 32);
        const float inv = 1.0f / sum;
        const int p4a = hd * 4 + 2 * h;
        GAS v4u* ip = (GAS v4u*)F.EIDX; GAS f32x4* gp = (GAS f32x4*)F.GATEQ;
        ip[(size_t)p4a * NTOK + tok] = (v4u){(unsigned)eidx[0], (unsigned)eidx[1], (unsigned)eidx[2], (unsigned)eidx[3]}; ip[(size_t)(p4a + 1) * NTOK + tok] = (v4u){(unsigned)eidx[4], (unsigned)eidx[5], (unsigned)eidx[6], (unsigned)eidx[7]};
        ((GAS v4u*)F.EIDX16)[(size_t)(hd * 2 + h) * NTOK + tok] = (v4u){(unsigned)eidx[0] | ((unsigned)eidx[1] << 16), (unsigned)eidx[2] | ((unsigned)eidx[3] << 16), (unsigned)eidx[4] | ((unsigned)eidx[5] << 16), (unsigned)eidx[6] | ((unsigned)eidx[7] << 16)};
        gp[(size_t)p4a * NTOK + tok] = (f32x4){ex[0] * inv, ex[1] * inv, ex[2] * inv, ex[3] * inv}; gp[(size_t)(p4a + 1) * NTOK + tok] = (f32x4){ex[4] * inv, ex[5] * inv, ex[6] * inv, ex[7] * inv};
        LDS_WAIT(); asm volatile("" ::: "memory");
    }
}

typedef int i32x4 __attribute__((ext_vector_type(4)));
__device__ __forceinline__ void lds_fill_128k(Frame& F, const unsigned char* src, int rot) {
    const unsigned long long g = (unsigned long long)src; const unsigned lo = __builtin_amdgcn_readfirstlane((unsigned)g), hi = __builtin_amdgcn_readfirstlane((unsigned)(g >> 32));
    const unsigned char* sb = (const unsigned char*)(((unsigned long long)hi << 32) | lo);
    const unsigned voff = (unsigned)F.tid * 16u; const int r8 = __builtin_amdgcn_readfirstlane(rot) & 15;
#pragma unroll
    for (int i = 0; i < 16; ++i) { const int ii = (i + r8) & 15;
        __builtin_amdgcn_global_load_lds((const unsigned*)(sb + (size_t)ii * 8192 + voff), (LAS unsigned*)(F.lds + ii * 8192 + F.wave * 1024), 16, 0, 0); }
}
constexpr int P8_YB = 132096;
constexpr int P8_DUMMY = 140288;
#define P8_WAITV0() asm volatile("s_waitcnt vmcnt(0)" ::: "memory")
#define P8_BAR() do { asm volatile("s_waitcnt lgkmcnt(0)" ::: "memory"); __builtin_amdgcn_s_barrier(); asm volatile("" ::: "memory"); } while (0)
__device__ __forceinline__ void p8a_sddmm(Frame& F) {
    const int wv = F.wave;
    for (int u = F.vcu; u < 256; u += F.G) {
        const int tg = u & 15, dr = u >> 4, t = tg * 512 + F.tid;
        unsigned id[64];
#pragma unroll
        for (int p8 = 0; p8 < 16; ++p8) { const v4u v = ((const GAS v4u*)F.EIDX16)[(size_t)p8 * NTOK + t]; id[4 * p8] = v.x; id[4 * p8 + 1] = v.y; id[4 * p8 + 2] = v.z; id[4 * p8 + 3] = v.w; }
        int acc[128];
#pragma unroll
        for (int p = 0; p < 128; ++p) acc[p] = 0;
        const unsigned char* tab = F.DC8 + (size_t)(dr * 32) * 131072;
        const unsigned char* ysrc = F.YC8 + ((size_t)(dr * 32) * NTOK + tg * 512) * 8 + (wv & 3) * 1024 + F.lane * 16;
        for (int sl = 0; sl < 32; ++sl) {
#pragma unroll
            for (int i = 0; i < 64; ++i) asm volatile("" : "+v"(id[i]));
            P8_WAITV0();
            P8_BAR();
            lds_fill_128k(F, tab + (size_t)sl * 131072, tg);
            if (wv < 4) __builtin_amdgcn_global_load_lds((const unsigned*)(ysrc + (size_t)sl * NTOK * 8), (LAS unsigned*)(F.lds + P8_YB + wv * 1024), 16, 0, 0);
            P8_WAITV0();
            P8_BAR();
            if (sl + 1 < 32) __builtin_amdgcn_global_load_lds((const unsigned*)(tab + (size_t)(sl + 1) * 131072 + (size_t)tg * 8192 + wv * 1024 + F.lane * 16), (LAS unsigned*)(F.lds + P8_DUMMY + wv * 1024), 16, 0, 0);
            const v2u yv = *(const LAS v2u*)(F.lds + P8_YB + F.tid * 8);
            v2u dA[8], dB[8];
#define P8A_OFF(p) (((p) & 1) ? ((id[(p) >> 1] >> 13) & 0x7fff8u) : ((id[(p) >> 1] << 3) & 0x7fff8u))
#define P8A_LOAD(dst, pb) do { _Pragma("unroll") for (int j_ = 0; j_ < 8; ++j_) asm volatile("ds_read_b64 %0, %1" : "=v"(dst[j_]) : "v"(P8A_OFF((pb) + j_))); } while (0)
#define P8A_DOT(src, pb) do { _Pragma("unroll") for (int j_ = 0; j_ < 8; ++j_) { acc[(pb) + j_] = __builtin_amdgcn_sdot4((int)src[j_].x, (int)yv.x, acc[(pb) + j_], false); acc[(pb) + j_] = __builtin_amdgcn_sdot4((int)src[j_].y, (int)yv.y, acc[(pb) + j_], false); } \
                _Pragma("unroll") for (int j_ = 0; j_ < 8; ++j_) asm volatile("" : "+v"(acc[(pb) + j_])); } while (0)
            asm volatile("s_waitcnt lgkmcnt(0)" ::: "memory"); __builtin_amdgcn_sched_barrier(0);
            P8A_LOAD(dA, 0);
#pragma unroll
            for (int pb = 0; pb < 128; pb += 16) {
                P8A_LOAD(dB, pb + 8);
                asm volatile("s_waitcnt lgkmcnt(8)" ::: "memory"); __builtin_amdgcn_sched_barrier(0);
                P8A_DOT(dA, pb);
                __builtin_amdgcn_sched_barrier(0);
                if (pb + 16 < 128) { P8A_LOAD(dA, pb + 16); asm volatile("s_waitcnt lgkmcnt(8)" ::: "memory"); } else asm volatile("s_waitcnt lgkmcnt(0)" ::: "memory");
                __builtin_amdgcn_sched_barrier(0);
                P8A_DOT(dB, pb + 8);
                __builtin_amdgcn_sched_barrier(0);
            }
#undef P8A_OFF
#undef P8A_LOAD
#undef P8A_DOT
        }
#pragma unroll
        for (int p4 = 0; p4 < 32; ++p4) ((GAS i32x4*)F.ZP)[((size_t)(dr * 32 + p4)) * NTOK + t] = (i32x4){acc[4 * p4], acc[4 * p4 + 1], acc[4 * p4 + 2], acc[4 * p4 + 3]};
    }
    P8_WAITV0();
    __syncthreads();
}
__device__ __forceinline__ void p8h_gate(Frame& F) {
    const size_t gt = (size_t)F.vcu * 512 + F.tid, NT = (size_t)F.G * 512;
    for (size_t i = gt; i < (size_t)32 * NTOK; i += NT) {
        const int p4 = (int)(i >> 13), t = (int)(i & (NTOK - 1));
        i32x4 z = {0, 0, 0, 0};
#pragma unroll
        for (int dr = 0; dr < 16; ++dr) z += ((const GAS i32x4*)F.ZP)[((size_t)(dr * 32 + p4)) * NTOK + t];
        const v4u e4 = ((const GAS v4u*)F.EIDX)[i]; const f32x4 g4 = ((const GAS f32x4*)F.GATEQ)[i]; const float ys = F.YSC[t];
        v4u he;
#pragma unroll
        for (int c = 0; c < 4; ++c) { const float zz = (float)z[c] * ys * F.DSC[e4[c]]; const float hv = 0.5f * zz * (1.0f + erff(zz * 0.70710678118654752f)) * g4[c]; he[c] = ((f2bf(hv) << 16) & 0xfffe0000u) | (e4[c] << 3); }
        ((GAS v4u*)F.HE)[i] = he;
    }
}
template <int MODE  > __device__ __forceinline__ void p8b_spmm(Frame& F, float* dst) {
    for (int u = F.vcu; u < 256; u += F.G) {
        const int tg = u & 15, sr = u >> 4, t = tg * 512 + F.tid, b = t >> 11;
        unsigned he[128];
#pragma unroll
        for (int p4 = 0; p4 < 32; ++p4) { const v4u v = ((const GAS v4u*)F.HE)[(size_t)p4 * NTOK + t]; he[4 * p4] = v.x; he[4 * p4 + 1] = v.y; he[4 * p4 + 2] = v.z; he[4 * p4 + 3] = v.w; }
        const bf16* xrow = F.X1 + (size_t)t * DM; float* orow = dst + (size_t)t * DM; const float* g2 = F.MOD + b * NMOD + 5 * DM;
        for (int sg = 0; sg < 8; ++sg) {
            f32x2 acc[4][4];
#pragma unroll
            for (int k = 0; k < 4; ++k) {
                const int s = sr * 32 + sg * 4 + k;
#pragma unroll
                for (int i = 0; i < 128; ++i) asm volatile("" : "+v"(he[i]));
                P8_WAITV0();
                P8_BAR();
                if (MODE != 1) lds_fill_128k(F, F.UC8 + (size_t)s * 131072, tg);
                P8_WAITV0();
                P8_BAR();
                if (MODE != 1 && (sg * 4 + k) + 1 < 32) __builtin_amdgcn_global_load_lds((const unsigned*)(F.UC8 + (size_t)(s + 1) * 131072 + (size_t)tg * 8192 + F.wave * 1024 + F.lane * 16), (LAS unsigned*)(F.lds + P8_DUMMY + F.wave * 1024), 16, 0, 0);
#pragma unroll
                for (int q = 0; q < 4; ++q) acc[k][q] = (f32x2){0.f, 0.f};
                v2u wA[8], wB[8];
#define P8B_LOAD(dst, pb) do { _Pragma("unroll") for (int j_ = 0; j_ < 8; ++j_) asm volatile("ds_read_b64 %0, %1" : "=v"(dst[j_]) : "v"(he[(pb) + j_] & 0x1fff8u)); } while (0)
#define P8B_FMA(src, pb) do { _Pragma("unroll") for (int j_ = 0; j_ < 8; ++j_) { const float hv_ = __builtin_bit_cast(float, he[(pb) + j_] & 0xfffe0000u); const f32x2 h2_ = {hv_, hv_}; \
                    acc[k][0] += __builtin_amdgcn_cvt_pk_f32_fp8((int)src[j_].x, false) * h2_; acc[k][1] += __builtin_amdgcn_cvt_pk_f32_fp8((int)src[j_].x, true) * h2_; \
                    acc[k][2] += __builtin_amdgcn_cvt_pk_f32_fp8((int)src[j_].y, false) * h2_; acc[k][3] += __builtin_amdgcn_cvt_pk_f32_fp8((int)src[j_].y, true) * h2_; } \
                    asm volatile("" : "+v"(acc[k][0]), "+v"(acc[k][1]), "+v"(acc[k][2]), "+v"(acc[k][3])); } while (0)
                constexpr int NP = (MODE == 2 ? 16 : 128);
                asm volatile("s_waitcnt lgkmcnt(0)" ::: "memory"); __builtin_amdgcn_sched_barrier(0);
                P8B_LOAD(wA, 0);
#pragma unroll
                for (int pb = 0; pb < NP; pb += 16) {
                    P8B_LOAD(wB, pb + 8);
                    asm volatile("s_waitcnt lgkmcnt(8)" ::: "memory"); __builtin_amdgcn_sched_barrier(0);
                    P8B_FMA(wA, pb);
                    __builtin_amdgcn_sched_barrier(0);
                    if (pb + 16 < NP) { P8B_LOAD(wA, pb + 16); asm volatile("s_waitcnt lgkmcnt(8)" ::: "memory"); } else asm volatile("s_waitcnt lgkmcnt(0)" ::: "memory");
                    __builtin_amdgcn_sched_barrier(0);
                    P8B_FMA(wB, pb + 8);
                    __builtin_amdgcn_sched_barrier(0);
                }
#undef P8B_LOAD
#undef P8B_FMA
            }
            const int c0 = (sr * 32 + sg * 4) * 8;
#pragma unroll
            for (int k = 0; k < 4; ++k) {
                const v4u xw = *(const GAS v4u*)(xrow + c0 + 8 * k); const f32x4 xa = {bflo(xw.x), bfhi(xw.x), bflo(xw.y), bfhi(xw.y)}, xb = {bflo(xw.z), bfhi(xw.z), bflo(xw.w), bfhi(xw.w)};
                const f32x4 ga = *(const GAS f32x4*)(g2 + c0 + 8 * k), gb = *(const GAS f32x4*)(g2 + c0 + 8 * k + 4);
                *(GAS f32x4*)(orow + c0 + 8 * k) = (f32x4){xa[0] + ga[0] * acc[k][0].x, xa[1] + ga[1] * acc[k][0].y, xa[2] + ga[2] * acc[k][1].x, xa[3] + ga[3] * acc[k][1].y};
                *(GAS f32x4*)(orow + c0 + 8 * k + 4) = (f32x4){xb[0] + gb[0] * acc[k][2].x, xb[1] + gb[1] * acc[k][2].y, xb[2] + gb[2] * acc[k][3].x, xb[3] + gb[3] * acc[k][3].y};
            }
        }
    }
    P8_WAITV0();
    __syncthreads();
}

struct Args { const float* in[18]; float* out; unsigned char* ws; int ph_lo, ph_hi; };
__global__ void __launch_bounds__(NWAVES * 64, 2) mega_fwd(Args args) {
    extern __shared__ __attribute__((aligned(16))) unsigned char lds[];
    Frame F;
    F.lds = (LAS unsigned char*)lds;
    F.MISC = (volatile LAS unsigned*)(F.lds + MISC_OFF);
    F.tid = threadIdx.x; F.lane = F.tid & 63; F.wave = __builtin_amdgcn_readfirstlane(F.tid >> 6);
    F.G = gridDim.x; { const int bx = blockIdx.x; F.vcu = (F.G % 8 == 0) ? (bx % 8) * (F.G / 8) + bx / 8 : bx; }
    unsigned char* ws = args.ws;
    F.ctl = (unsigned*)(ws + WS_CTL);
    F.x = args.in[0]; F.c = args.in[1]; F.w_ada = args.in[2]; F.b_ada = args.in[3]; F.w_in = args.in[4]; F.w_gate_up = args.in[5]; F.b_gla_gate = args.in[6]; F.gla_out_norm = args.in[7];
    F.swa_q_norm = args.in[8]; F.swa_k_norm = args.in[9]; F.swa_sinks = args.in[10]; F.swa_out_norm = args.in[11]; F.w_out = args.in[12]; F.w_peer_q = args.in[13];
    F.keys1 = args.in[14]; F.keys2 = args.in[15]; F.edown = args.in[16]; F.eup = args.in[17];
    F.out = args.out; F.ws = ws;
    F.MOD = (float*)(ws + WS_MOD); F.ROPE = (float*)(ws + WS_ROPE);
    F.BTIN = (bf16*)(ws + WS_BTIN); F.BTOUT = (bf16*)(ws + WS_BTOUT); F.BTQ = (bf16*)(ws + WS_BTQ); F.HBUF = (bf16*)(ws + WS_HBUF); F.PROJ = (bf16*)(ws + WS_PROJ);
    F.MIXIN = (bf16*)(ws + WS_MIXIN); F.QPEER = (bf16*)(ws + WS_QPEER);
    F.DC8 = ws + WS_DC8; F.UC8 = ws + WS_UC8; F.YC8 = ws + WS_YC8; F.ZP = (int*)(ws + WS_ZP); F.EIDX = (unsigned*)(ws + WS_EIDX); F.HE = (unsigned*)(ws + WS_HE);
    F.EIDX16 = (unsigned*)(ws + WS_EIDX16);
    F.GQT = (bf16*)(ws + WS_QPEER); F.GST = (bf16*)(ws + WS_YC8); F.GUT = (float*)(ws + WS_ZP); F.GG = (float*)(ws + WS_IDX); F.X1 = (bf16*)(ws + WS_PROJ);   F.GATEQ = (float*)(ws + WS_GATEQ); F.DSC = (float*)(ws + WS_DSC); F.YSC = (float*)(ws + WS_YSC);
    for (int u = F.tid; u < (LDS_BYTES - LDSCTL_OFF) / 4; u += NWAVES * 64) ((LAS unsigned*)(F.lds + LDSCTL_OFF))[u] = 0u;
    __syncthreads();
    XcdBarrier bar; bar.bar = F.ctl + CW_BAR; bar.x = 0; bar.st = nullptr;
    if (N_LAUNCHES == 1) bar = xcd_barrier_post(F.ctl + CW_BAR, F.MISC + 8);
#define GRID_BAR() do { if (N_LAUNCHES == 1) xcd_barrier(bar); } while (0)
    const int lo = args.ph_lo, hi = args.ph_hi;
#define IN(k) (lo <= (k) && (k) < hi)
#define BOTH(k) (IN(k) && IN((k) + 1))

    if (PROBE_REP_PHASE == 20 && IN(0)) { p0a_ada(F); GRID_BAR(); }
    if (PROBE_REP_PHASE == 21 && IN(0)) { p0b_weights(F); GRID_BAR(); }
    if (PROBE_REP_PHASE == 22 && IN(0)) { p0c_tables(F); GRID_BAR(); }
    for (int rep_ = 0; rep_ < (PROBE_REP_PHASE == 0 ? 2 : 1); ++rep_) if (IN(0)) { p0_prologue(F); if (BOTH(0)) GRID_BAR(); }
    for (int rep_ = 0; rep_ < (PROBE_REP_PHASE == 1 ? 2 : 1); ++rep_) if (IN(1)) { modulate_rows(F, F.x, F.HBUF, 0, DM); if (BOTH(1)) GRID_BAR(); }
    for (int rep_ = 0; rep_ < (PROBE_REP_PHASE == 2 ? 2 : 1); ++rep_) if (IN(2)) {
        pg8::Gemm g{F.HBUF, F.BTIN, NTOK, NPROJ, DM}; pg8::StaticOrder S; S.init(NTOK, NPROJ, F.G, (int)blockIdx.x);
        pg8::EpiBf16 E{F.PROJ, NPROJ};
        pg8::gemm_phase<pg8::EpiBf16, pg8::StaticOrder, true, true>(F.lds, g, S, E);
        {
            const int G = F.G, rem = GEMM1_UNITS % G, tg = tail_groups(G), nidle = G - rem;
            if (rem != 0 && (int)blockIdx.x >= rem) convert_expert_groups(F, (int)blockIdx.x - rem, tg, nidle);
        }
        if (BOTH(2)) GRID_BAR();
    }
    for (int rep_ = 0; rep_ < (PROBE_REP_PHASE == 3 ? 2 : 1); ++rep_) if (IN(3)) { p3a_mixer(F); GRID_BAR(); gla_scan(F); GRID_BAR(); p3c_mixer(F); if (BOTH(3)) GRID_BAR(); }
    for (int rep_ = 0; rep_ < (PROBE_REP_PHASE == 4 ? 2 : 1); ++rep_) if (IN(4)) {
        pg8::Gemm g{F.MIXIN, F.BTOUT, NTOK, DM, DM}; pg8::StaticOrder S; S.init(NTOK, DM, F.G, (int)blockIdx.x);
        pg8::EpiResid E{F.x, F.X1, DM, F.MOD + 2 * DM, NMOD, SEQ / 256};
        pg8::gemm_phase<pg8::EpiResid, pg8::StaticOrder, true, true>(F.lds, g, S, E);
        if (BOTH(4)) GRID_BAR();
    }
    for (int rep_ = 0; rep_ < (PROBE_REP_PHASE == 5 ? 2 : 1); ++rep_) if (IN(5)) { p5_modulate_quant(F); if (BOTH(5)) GRID_BAR(); }
    for (int rep_ = 0; rep_ < (PROBE_REP_PHASE == 6 ? 2 : 1); ++rep_) if (IN(6)) {
        pg8::Gemm g{F.HBUF, F.BTQ, NTOK, PEER_N, DM}; pg8::StaticOrder S; S.init(NTOK, PEER_N, F.G, (int)blockIdx.x);
        pg8::EpiBf16 E{F.QPEER, PEER_N};
        pg8::gemm_phase<pg8::EpiBf16, pg8::StaticOrder, true, true>(F.lds, g, S, E);
        if (BOTH(6)) GRID_BAR();
    }
    if (PROBE_REP_PHASE == 41 && IN(7)) { p7_topk<1>(F); GRID_BAR(); }
    if (PROBE_REP_PHASE == 42 && IN(7)) { p7_topk<2>(F); GRID_BAR(); }
    for (int rep_ = 0; rep_ < (PROBE_REP_PHASE == 7 ? 2 : 1); ++rep_) if (IN(7)) { p7_topk<0>(F); if (BOTH(7)) GRID_BAR(); }
    for (int rep_ = 0; rep_ < (PROBE_REP_PHASE == 8 ? 2 : 1); ++rep_) if (IN(8)) { p8a_sddmm(F); if (BOTH(8)) GRID_BAR(); }
    for (int rep_ = 0; rep_ < (PROBE_REP_PHASE == 9 ? 2 : 1); ++rep_) if (IN(9)) { p8h_gate(F); if (BOTH(9)) GRID_BAR(); }
    if (PROBE_REP_PHASE == 10 && IN(10)) { p8b_spmm<0>(F, (float*)(F.ws + WS_BTIN)); GRID_BAR(); }
    if (PROBE_REP_PHASE == 11 && IN(10)) { p8b_spmm<1>(F, (float*)F.PROJ); GRID_BAR(); }
    if (PROBE_REP_PHASE == 12 && IN(10)) { p8b_spmm<2>(F, (float*)F.PROJ); GRID_BAR(); }
    if (IN(10)) { p8b_spmm<0>(F, F.out); }
#undef IN
#undef BOTH
}

extern "C" void kernel_launch(void* const* d_in, const int* in_sizes, int n_in, void* d_out, int out_size, void* d_ws, size_t ws_size, hipStream_t stream) {
    static int grid = 0;
    if (grid == 0) {
        if (n_in != 18 || out_size != NTOK * DM || ws_size < WS_END) { fprintf(stderr, "kernel_launch: unexpected shapes (n_in %d, out %d, ws %zu); nothing launched\n", n_in, out_size, ws_size); grid = -1; return; }
        int dev = 0, cus = 0, per_cu = 0;
        if (hipGetDevice(&dev) != hipSuccess || hipDeviceGetAttribute(&cus, hipDeviceAttributeMultiprocessorCount, dev) != hipSuccess) { grid = -1; return; }
        if (hipFuncSetAttribute((const void*)mega_fwd, hipFuncAttributeMaxDynamicSharedMemorySize, LDS_BYTES) != hipSuccess) { fprintf(stderr, "kernel_launch: hipFuncSetAttribute failed\n"); grid = -1; return; }
        if (hipOccupancyMaxActiveBlocksPerMultiprocessor(&per_cu, (const void*)mega_fwd, NWAVES * 64, LDS_BYTES) != hipSuccess || per_cu < 1)
            fprintf(stderr, "kernel_launch: note: occupancy query reports %d workgroups per CU\n", per_cu);
        (void)hipGetLastError();
        grid = cus;
    }
    if (grid < 0) return;
    (void)hipMemsetAsync((char*)d_ws + WS_CTL, 0, CTL_ZERO_BYTES, stream);
    Args a{};
    for (int i = 0; i < 18; ++i) a.in[i] = (const float*)d_in[i];
    a.out = (float*)d_out; a.ws = (unsigned char*)d_ws;
    if (N_LAUNCHES == 1) { a.ph_lo = 0; a.ph_hi = NPHASE; hipLaunchKernelGGL(mega_fwd, dim3(grid), dim3(NWAVES * 64), LDS_BYTES, stream, a); }
    else for (int p = 0; p < NPHASE; ++p) { a.ph_lo = p; a.ph_hi = p + 1; hipLaunchKernelGGL(mega_fwd, dim3(grid), dim3(NWAVES * 64), LDS_BYTES, stream, a); }
}
```

```cpp
#include <hip/hip_runtime.h>
#include <cstdio>
#include <cstdint>

#ifndef MK_N_LAUNCHES
#define MK_N_LAUNCHES 1
#endif
#ifndef PROBE_REP_PHASE
#define PROBE_REP_PHASE -1
#endif

#define GAS __attribute__((address_space(1)))
#define LAS __attribute__((address_space(3)))
typedef unsigned short bf16;
typedef unsigned v4u __attribute__((ext_vector_type(4)));
typedef unsigned v2u __attribute__((ext_vector_type(2)));
typedef float f32x4 __attribute__((ext_vector_type(4)));
typedef float f32x2 __attribute__((ext_vector_type(2)));
typedef float f32x16 __attribute__((ext_vector_type(16)));
typedef short bf16x8 __attribute__((ext_vector_type(8)));
using bf16x2 = __attribute__((ext_vector_type(2))) __bf16;

namespace pg8 {
#define PG8_LAS __attribute__((address_space(3)))
typedef unsigned short bf16_t;
typedef short bf16x8 __attribute__((ext_vector_type(8)));
typedef float f32x4 __attribute__((ext_vector_type(4)));
typedef unsigned u32x4 __attribute__((ext_vector_type(4)));
constexpr int BM = 256, BK = 64, HALF = 128, HTB = HALF * BK * 2, STAGE_BYTES = 8 * HTB, NXCD = 8, WGM = 8;

__host__ __device__ __forceinline__ int lds_byte(int r, int c) { const int st = (r >> 4) * 2 + (c >> 5), rr = r & 15, cc = c & 31, ob = rr * 64 + cc * 2; return st * 1024 + (ob ^ (((ob >> 9) & 1) << 5)); }
__host__ __device__ __forceinline__ void stage_rc(int b, int& R, int& C) { const int st = b / 1024, sb = b % 1024, swz = sb ^ (((sb >> 9) & 1) << 5); R = (st >> 1) * 16 + swz / 64; C = (st & 1) * 32 + (swz % 64) / 2; }
__host__ __device__ __forceinline__ int perm32(int rho) { const int n = rho >> 4, i = rho & 15; return 8 * (i >> 2) + 4 * n + (i & 3); }

struct Unit { int pm, pn; };
struct Gemm { const bf16_t* A; const bf16_t* Bt; int M, N, K; };

struct StaticOrder {
    int nM, nN, nwg, G, c;
    __host__ __device__ void init(int M, int N, int G_, int c_) { nM = M / BM; nN = N / BM; nwg = nM * nN; G = G_; c = c_; }
    __host__ __device__ bool next(int i, Unit& u) const {
        const long L = (long)i * G + c; if (L >= nwg) return false;
        int wgid = (int)L; { const int q = nwg / NXCD, r = nwg % NXCD, xcd = wgid % NXCD, off = wgid / NXCD; wgid = (xcd < r ? xcd * (q + 1) : r * (q + 1) + (xcd - r) * q) + off; }
        const int nig = WGM * nN, gid = wgid / nig, fm = gid * WGM, gsz = (nM - fm) < WGM ? (nM - fm) : WGM;
        u.pm = fm + ((wgid % nig) % gsz); u.pn = (wgid % nig) / gsz; return true;
    }
    __device__ __forceinline__ void a_ready(const Unit&) const {}
    __device__ __forceinline__ void done(const Unit&) const {}
};

__device__ __forceinline__ unsigned cvt_pk_bf16(float lo, float hi) { unsigned r; asm volatile("v_cvt_pk_bf16_f32 %0, %1, %2" : "=v"(r) : "v"(lo), "v"(hi)); return r; }

struct EpiBf16 {
    static constexpr bool PERM = true, AFTER_DRAIN = false;
    bf16_t* O; int ldc;
    __device__ __forceinline__ void operator()(const f32x4 (&acc)[2][2][4][2], const Unit& u, int wr, int wc, int fr, int fq) const {
        const int row0 = u.pm * BM + wr * 64 + fr; const int col0 = u.pn * BM + wc * 32 + 8 * fq;
#pragma unroll
        for (int ai = 0; ai < 2; ++ai)
#pragma unroll
            for (int m = 0; m < 4; ++m) { bf16_t* rowp = O + (size_t)(row0 + ai * HALF + m * 16) * ldc + col0;
#pragma unroll
                for (int bj = 0; bj < 2; ++bj) { const f32x4 v0 = acc[ai][bj][m][0], v1 = acc[ai][bj][m][1];
                    u32x4 w; w.x = cvt_pk_bf16(v0[0], v0[1]); w.y = cvt_pk_bf16(v0[2], v0[3]); w.z = cvt_pk_bf16(v1[0], v1[1]); w.w = cvt_pk_bf16(v1[2], v1[3]);
                    *(u32x4*)(rowp + bj * HALF) = w; } }
    }
};
struct EpiResid {
    static constexpr bool PERM = true, AFTER_DRAIN = false;
    const float* base; bf16_t* out; int ldc; const float* gate; int gate_stride; int tiles_per_batch;
    __device__ __forceinline__ void operator()(const f32x4 (&acc)[2][2][4][2], const Unit& u, int wr, int wc, int fr, int fq) const {
        const int row0 = u.pm * BM + wr * 64 + fr, col0 = u.pn * BM + wc * 32 + 8 * fq;
        const float* gp = gate + (size_t)(u.pm / tiles_per_batch) * gate_stride + col0;
        f32x4 gv[2][2];
#pragma unroll
        for (int bj = 0; bj < 2; ++bj)
#pragma unroll
            for (int n = 0; n < 2; ++n) gv[bj][n] = *(const f32x4*)(gp + bj * HALF + 4 * n);
#pragma unroll
        for (int ai = 0; ai < 2; ++ai)
#pragma unroll
            for (int m = 0; m < 4; ++m) { const size_t off = (size_t)(row0 + ai * HALF + m * 16) * ldc + col0;
#pragma unroll
                for (int bj = 0; bj < 2; ++bj) { const f32x4 b0 = *(const f32x4*)(base + off + bj * HALF), b1 = *(const f32x4*)(base + off + bj * HALF + 4);
                    const f32x4 v0 = b0 + gv[bj][0] * acc[ai][bj][m][0], v1 = b1 + gv[bj][1] * acc[ai][bj][m][1];
                    u32x4 w; w.x = cvt_pk_bf16(v0[0], v0[1]); w.y = cvt_pk_bf16(v0[2], v0[3]); w.z = cvt_pk_bf16(v1[0], v1[1]); w.w = cvt_pk_bf16(v1[2], v1[3]);
                    *(u32x4*)(out + off + bj * HALF) = w; } }
    }
};

template <class Epi, class Sched, bool ALIGN_EPI = false, bool SP2 = false>
__device__ __forceinline__ void gemm_phase(PG8_LAS unsigned char* lds, const Gemm g, const Sched& S, const Epi& E) {
    const int tid = threadIdx.x, wid = __builtin_amdgcn_readfirstlane(tid >> 6), lane = tid & 63, wr = wid >> 2, wc = wid & 3, fr = lane & 15, fq = lane >> 4;
    const int K = g.K, nt = K / BK;
    unsigned voffA[2], voffB[2];
#pragma unroll
    for (int i = 0; i < 2; ++i) { int R, C; stage_rc(tid * 16 + i * 8192, R, C); const int Rb = Epi::PERM ? ((R & ~31) + perm32(R & 31)) : R;
        voffA[i] = (unsigned)(R * K + C) * 2u; voffB[i] = (unsigned)(Rb * K + C) * 2u; }
    const size_t kstep = (size_t)(BK * 2);
    const size_t hstep = (size_t)HALF * K * 2;
    const size_t tstep = 2 * hstep;
    const unsigned ldsw = (unsigned)wid * 1024u;
    const int aoff = lds_byte(wr * 64 + fr, fq * 8), boff = lds_byte(wc * 32 + fr, fq * 8);
#define PG8_SA(b, h) (((b) * 2 + (h)) * HTB)
#define PG8_SB(b, h) ((4 + (b) * 2 + (h)) * HTB)
#define PG8_STAGE(bufoff, gbase, voff) do { const unsigned long long _g = (unsigned long long)(gbase); const unsigned _lo = __builtin_amdgcn_readfirstlane((unsigned)_g), _hi = __builtin_amdgcn_readfirstlane((unsigned)(_g >> 32)); \
        const char* _gb = (const char*)(((unsigned long long)_hi << 32) | _lo); _Pragma("unroll") for (int _i = 0; _i < 2; ++_i) \
        __builtin_amdgcn_global_load_lds((const unsigned*)(_gb + (size_t)_i * (size_t)(64 * K * 2) + (voff)[0]), (PG8_LAS unsigned*)(lds + (bufoff) + ldsw + _i * 8192), 16, 0, 0); } while (0)
#define PG8_LDA(dst, b, h) do { _Pragma("unroll") for (int m = 0; m < 4; ++m) _Pragma("unroll") for (int k = 0; k < 2; ++k) dst[m][k] = *(const PG8_LAS bf16x8*)(lds + PG8_SA(b, h) + aoff + m * 2048 + k * 1024); } while (0)
#define PG8_LDB(dst, b, h) do { _Pragma("unroll") for (int n = 0; n < 2; ++n) _Pragma("unroll") for (int k = 0; k < 2; ++k) dst[n][k] = *(const PG8_LAS bf16x8*)(lds + PG8_SB(b, h) + boff + n * 2048 + k * 1024); } while (0)
#define PG8_MMA(ai, bj, At, Bt) do { __builtin_amdgcn_s_setprio(1); _Pragma("unroll") for (int m = 0; m < 4; ++m) _Pragma("unroll") for (int n = 0; n < 2; ++n) _Pragma("unroll") for (int k = 0; k < 2; ++k) \
        acc[ai][bj][m][n] = __builtin_amdgcn_mfma_f32_16x16x32_bf16(Bt[n][k], At[m][k], acc[ai][bj][m][n], 0, 0, 0); __builtin_amdgcn_s_setprio(0); } while (0)
#define PG8_WAIT_V(n) asm volatile("s_waitcnt vmcnt(" #n ")" ::: "memory")
#define PG8_WAIT_L(n) asm volatile("s_waitcnt lgkmcnt(" #n ")" ::: "memory")
#define PG8_BAR __builtin_amdgcn_s_barrier()
#define PG8_SCHED __builtin_amdgcn_sched_barrier(0)
    Unit cur, nxt; int ui = 0;
    if (!S.next(0, cur)) return;
    f32x4 acc[2][2][4][2];
#pragma unroll
    for (int a = 0; a < 2; ++a)
#pragma unroll
        for (int b = 0; b < 2; ++b)
#pragma unroll
            for (int m = 0; m < 4; ++m)
#pragma unroll
                for (int n = 0; n < 2; ++n) acc[a][b][m][n] = (f32x4){0.f, 0.f, 0.f, 0.f};
    bf16x8 At[4][2], B0[2][2], B1[2][2];
    const char* cA = (const char*)g.A + (size_t)cur.pm * tstep; const char* cB = (const char*)g.Bt + (size_t)cur.pn * tstep;
    S.a_ready(cur);
    if constexpr (SP2) {
        PG8_STAGE(PG8_SB(0, 0), cB, voffB); PG8_STAGE(PG8_SB(0, 1), cB + hstep, voffB); PG8_STAGE(PG8_SA(0, 0), cA, voffA); PG8_STAGE(PG8_SA(0, 1), cA + hstep, voffA);
        if (wr == 1) PG8_BAR;
        PG8_WAIT_V(2); PG8_BAR;
        PG8_STAGE(PG8_SB(1, 0), cB + kstep, voffB); PG8_STAGE(PG8_SA(1, 0), cA + kstep, voffA); PG8_STAGE(PG8_SB(1, 1), cB + hstep + kstep, voffB);
        PG8_WAIT_V(6); PG8_BAR;
    } else {
        PG8_STAGE(PG8_SB(0, 0), cB, voffB); PG8_STAGE(PG8_SA(0, 0), cA, voffA); PG8_STAGE(PG8_SB(0, 1), cB + hstep, voffB); PG8_STAGE(PG8_SA(0, 1), cA + hstep, voffA);
        if (wr == 1) PG8_BAR;
        PG8_WAIT_V(4); PG8_BAR;
        PG8_STAGE(PG8_SB(1, 0), cB + kstep, voffB); PG8_STAGE(PG8_SA(1, 0), cA + kstep, voffA); PG8_STAGE(PG8_SB(1, 1), cB + hstep + kstep, voffB);
        PG8_WAIT_V(6); PG8_BAR;
    }
    for (;;) {
        const bool has_next = S.next(ui + 1, nxt);
        const char* nA = has_next ? (const char*)g.A + (size_t)nxt.pm * tstep : cA; const char* nB = has_next ? (const char*)g.Bt + (size_t)nxt.pn * tstep : cB;
        for (int t = 0; t < nt; t += 2) {
            const bool last = (t == nt - 2);
            const char* a1 = cA + (size_t)(t + 1) * kstep;
            const char* a2 = last ? nA : cA + (size_t)(t + 2) * kstep; const char* b2 = last ? nB : cB + (size_t)(t + 2) * kstep;
            const char* a3 = a2 + kstep; const char* b3 = b2 + kstep;
            if (last && has_next) S.a_ready(nxt);
            if constexpr (SP2) {
            PG8_LDB(B0, 0, 0); PG8_LDB(B1, 0, 1); PG8_SCHED; PG8_LDA(At, 0, 0); PG8_STAGE(PG8_SA(1, 1), a1 + hstep, voffA);
            PG8_WAIT_V(8); PG8_WAIT_L(0); PG8_BAR; PG8_MMA(0, 0, At, B0); PG8_MMA(0, 1, At, B1); PG8_BAR; PG8_SCHED;
            PG8_LDA(At, 0, 1); PG8_STAGE(PG8_SB(0, 0), b2, voffB); PG8_STAGE(PG8_SB(0, 1), b2 + hstep, voffB); PG8_STAGE(PG8_SA(0, 0), a2, voffA);
            PG8_WAIT_V(8); PG8_WAIT_L(0); PG8_BAR; PG8_MMA(1, 0, At, B0); PG8_MMA(1, 1, At, B1); PG8_BAR; PG8_SCHED;
            PG8_LDB(B0, 1, 0); PG8_LDB(B1, 1, 1); PG8_SCHED; PG8_LDA(At, 1, 0); PG8_STAGE(PG8_SA(0, 1), a2 + hstep, voffA);
            PG8_WAIT_V(8); PG8_WAIT_L(0); PG8_BAR; PG8_MMA(0, 0, At, B0); PG8_MMA(0, 1, At, B1); PG8_BAR; PG8_SCHED;
            PG8_LDA(At, 1, 1); PG8_STAGE(PG8_SB(1, 0), b3, voffB); PG8_STAGE(PG8_SB(1, 1), b3 + hstep, voffB); PG8_STAGE(PG8_SA(1, 0), a3, voffA);
            PG8_WAIT_V(8); PG8_WAIT_L(0); PG8_BAR; PG8_MMA(1, 0, At, B0); PG8_MMA(1, 1, At, B1); PG8_BAR; PG8_SCHED;
            } else {
            PG8_LDB(B0, 0, 0); PG8_SCHED; PG8_LDA(At, 0, 0); PG8_STAGE(PG8_SA(1, 1), a1 + hstep, voffA);
            PG8_WAIT_L(8); PG8_BAR; PG8_WAIT_L(0); PG8_MMA(0, 0, At, B0); PG8_BAR; PG8_SCHED;
            PG8_LDB(B1, 0, 1); PG8_STAGE(PG8_SB(0, 0), b2, voffB);
            PG8_BAR; PG8_WAIT_L(0); PG8_MMA(0, 1, At, B1); PG8_BAR;
            PG8_LDA(At, 0, 1); PG8_STAGE(PG8_SA(0, 0), a2, voffA);
            PG8_BAR; PG8_WAIT_L(0); PG8_MMA(1, 0, At, B0); PG8_BAR; PG8_SCHED;
            PG8_STAGE(PG8_SB(0, 1), b2 + hstep, voffB);
            PG8_WAIT_V(6); PG8_BAR; PG8_MMA(1, 1, At, B1); PG8_BAR;
            PG8_LDB(B0, 1, 0); PG8_SCHED; PG8_LDA(At, 1, 0); PG8_STAGE(PG8_SA(0, 1), a2 + hstep, voffA);
            PG8_WAIT_L(8); PG8_BAR; PG8_WAIT_L(0); PG8_MMA(0, 0, At, B0); PG8_BAR; PG8_SCHED;
            PG8_LDB(B1, 1, 1); PG8_STAGE(PG8_SB(1, 0), b3, voffB);
            PG8_BAR; PG8_WAIT_L(0); PG8_MMA(0, 1, At, B1); PG8_BAR;
            PG8_LDA(At, 1, 1); PG8_STAGE(PG8_SA(1, 0), a3, voffA);
            PG8_BAR; PG8_WAIT_L(0); PG8_MMA(1, 0, At, B0); PG8_BAR; PG8_SCHED;
            PG8_STAGE(PG8_SB(1, 1), b3 + hstep, voffB);
            PG8_WAIT_V(6); PG8_BAR; PG8_MMA(1, 1, At, B1); PG8_BAR;
            }
        }
        if constexpr (ALIGN_EPI) { if (wr == 0) PG8_BAR; }
        if constexpr (!Epi::AFTER_DRAIN) { E(acc, cur, wr, wc, fr, fq); S.done(cur); }
        if (!has_next) break;
#pragma unroll
        for (int a = 0; a < 2; ++a)
#pragma unroll
            for (int b = 0; b < 2; ++b)
#pragma unroll
                for (int m = 0; m < 4; ++m)
#pragma unroll
                    for (int n = 0; n < 2; ++n) acc[a][b][m][n] = (f32x4){0.f, 0.f, 0.f, 0.f};
        cur = nxt; cA = nA; cB = nB; ++ui;
        if constexpr (ALIGN_EPI) { if (wr == 1) PG8_BAR; }
    }
    PG8_WAIT_V(0);
    if constexpr (!ALIGN_EPI) { if (wr == 0) PG8_BAR; }
    PG8_BAR;
#undef PG8_SA
#undef PG8_SB
#undef PG8_STAGE
#undef PG8_LDA
#undef PG8_LDB
#undef PG8_MMA
#undef PG8_WAIT_V
#undef PG8_WAIT_L
#undef PG8_BAR
#undef PG8_SCHED
}
}

constexpr int NWAVES = 8;
constexpr int NPHASE = 11;
constexpr int N_LAUNCHES = MK_N_LAUNCHES;
constexpr int BATCH = 4, SEQ = 2048, DM = 4096, NTOK = BATCH * SEQ;
constexpr int NMOD = 6 * DM;
constexpr int IN_WIDTH = 8720;
constexpr int NPROJ = 8960;
constexpr int C_GQ = 0, C_GK = 1024, C_GV = 2048, C_GG = 4096, C_SQ = 6144, C_SK = 8192, C_SV = 8448, C_GA = 8704;
constexpr int NEXP = 16384, PEER_N = 2048;
constexpr float EPS = 1e-6f;

constexpr size_t MiB = 1u << 20;
constexpr size_t WS_CTL = 0, CTL_ZERO_BYTES = 1 * MiB;
constexpr size_t WS_MOD = 1 * MiB;
constexpr size_t WS_ROPE = 2 * MiB;
constexpr size_t WS_BTIN = 4 * MiB;
constexpr size_t WS_BTOUT = 74 * MiB;
constexpr size_t WS_BTQ = 106 * MiB;
constexpr size_t WS_HBUF = 122 * MiB;
constexpr size_t WS_PROJ = 186 * MiB;
constexpr size_t WS_MIXIN = 326 * MiB;
constexpr size_t WS_QPEER = 390 * MiB;
constexpr size_t WS_IDX = 422 * MiB;
constexpr size_t WS_GATE = 426 * MiB;
constexpr size_t WS_DC8 = 430 * MiB;
constexpr size_t WS_UC8 = 494 * MiB;
constexpr size_t WS_YC8 = 558 * MiB;
constexpr size_t WS_ZP = 590 * MiB;
constexpr size_t WS_EIDX = 654 * MiB;
constexpr size_t WS_GATEQ = 658 * MiB;
constexpr size_t WS_HE = 662 * MiB;
constexpr size_t WS_DSC = 666 * MiB;
constexpr size_t WS_YSC = 667 * MiB;
constexpr size_t WS_EIDX16 = 668 * MiB;
constexpr size_t WS_END = 670 * MiB;
constexpr int CW_BAR = 4096;

constexpr int RING_BYTES = 131072;
constexpr int LDSCTL_OFF = RING_BYTES, MISC_OFF = LDSCTL_OFF + 320;
constexpr int LDS_BYTES = 155648;

#define LDS_WAIT() asm volatile("s_waitcnt lgkmcnt(0)" ::: "memory")
#define VM_WAIT() asm volatile("s_waitcnt vmcnt(0)" ::: "memory")
__device__ __forceinline__ unsigned f2bf(float f) { unsigned u = __builtin_bit_cast(unsigned, f); return (u + 0x7fffu + ((u >> 16) & 1u)) >> 16; }
typedef __bf16 bf16x2_t __attribute__((ext_vector_type(2)));
__device__ __forceinline__ unsigned pk2(float lo, float hi) { const bf16x2_t v = {(__bf16)lo, (__bf16)hi}; return __builtin_bit_cast(unsigned, v); }
__device__ __forceinline__ float bflo(unsigned w) { return __builtin_bit_cast(float, w << 16); }
__device__ __forceinline__ float bfhi(unsigned w) { return __builtin_bit_cast(float, w & 0xffff0000u); }
__device__ __forceinline__ float dot2_bf16(unsigned w, unsigned x, float acc) { return __builtin_amdgcn_fdot2_f32_bf16(__builtin_bit_cast(bf16x2, w), __builtin_bit_cast(bf16x2, x), acc, false); }
__device__ __forceinline__ f32x16 mfma32(bf16x8 a, bf16x8 b, f32x16 c) { return __builtin_amdgcn_mfma_f32_32x32x16_bf16(a, b, c, 0, 0, 0); }
__device__ __forceinline__ f32x4 mfma16(bf16x8 a, bf16x8 b, f32x4 c) { return __builtin_amdgcn_mfma_f32_16x16x32_bf16(a, b, c, 0, 0, 0); }
__device__ __forceinline__ bf16x8 mk8(unsigned a, unsigned b, unsigned c, unsigned d) { v4u t = {a, b, c, d}; return __builtin_bit_cast(bf16x8, t); }
__device__ __forceinline__ float silu_f(float x) { return x / (1.0f + __expf(-x)); }

#define XB_TMO      128
#define XB_XCNT(j)  (256  + 64 * (j))
#define XB_XSUB(j)  (1280 + 64 * (j))
#define XB_XGEN(j)  (2304 + 64 * (j))
#define XB_TOP      3328
#define XB_TOPGEN   3392
#define XCD_BAR_WORDS 3456
#define XB_SPIN_CAP (1u << 18)
__device__ __forceinline__ unsigned xb_ld(unsigned* p)              { return __hip_atomic_load(p, __ATOMIC_RELAXED, __HIP_MEMORY_SCOPE_AGENT); }
__device__ __forceinline__ unsigned xb_add(unsigned* p, unsigned v) { return __hip_atomic_fetch_add(p, v, __ATOMIC_RELAXED, __HIP_MEMORY_SCOPE_AGENT); }
__device__ __forceinline__ unsigned xb_xcc_id() { return (unsigned)__builtin_amdgcn_s_getreg((3 << 11) | 20) & 0xFu; }
#define XB_SPIN(cond, bar) do { unsigned _sp = 0; while (cond) { __builtin_amdgcn_s_sleep(1); \
    if ((++_sp & 255u) == 0u) { if (xb_ld(&(bar)[XB_TMO])) break; if (_sp > XB_SPIN_CAP) { atomicAdd(&(bar)[XB_TMO], 1u); break; } } } } while (0)
struct XcdBarrier { unsigned* bar; unsigned x; volatile LAS unsigned* st; };
__device__ __forceinline__ XcdBarrier xcd_barrier_post(unsigned* bar, volatile LAS unsigned* st) {
    XcdBarrier b; b.bar = bar; b.x = xb_xcc_id(); b.st = st;
    if (threadIdx.x == 0) (void)xb_add(&bar[XB_XCNT(b.x)], 1u);
    return b;
}
__device__ __forceinline__ void xcd_barrier_complete(unsigned* bar, unsigned x, unsigned& nloc, unsigned& nx) {
    const unsigned G = gridDim.x * gridDim.y * gridDim.z;
    unsigned sum, cnt, mine, sp = 0u;
    for (;;) {
        sum = 0u; cnt = 0u; mine = 0u;
#pragma unroll
        for (unsigned j = 0; j < 16; ++j) { const unsigned c = xb_ld(&bar[XB_XCNT(j)]); sum += c; cnt += (c > 0u) ? 1u : 0u; mine = (j == x) ? c : mine; }
        if (sum == G) break;
        __builtin_amdgcn_s_sleep(1);
        if ((++sp & 255u) == 0u) { if (xb_ld(&bar[XB_TMO])) break; if (sp > XB_SPIN_CAP) { atomicAdd(&bar[XB_TMO], 1u); break; } }
    }
    nloc = mine > 0u ? mine : 1u; nx = cnt > 0u ? cnt : 1u;
}
__device__ __forceinline__ void xcd_barrier(const XcdBarrier& b) {
    asm volatile("s_waitcnt vmcnt(0)" ::: "memory");
    __syncthreads();
    if (threadIdx.x == 0) {
        unsigned* bar = b.bar;
        __builtin_amdgcn_s_waitcnt(0);
        unsigned nloc = b.st[0], nx = b.st[1];
        if (nloc == 0u) { xcd_barrier_complete(bar, b.x, nloc, nx); b.st[0] = nloc; b.st[1] = nx; }
        const unsigned old = xb_add(&bar[XB_XSUB(b.x)], 1u);
        const unsigned gen = old / nloc;
        if (old + 1u == (gen + 1u) * nloc) {
            __builtin_amdgcn_fence(__ATOMIC_RELEASE, "agent");
            asm volatile("s_waitcnt vmcnt(0)" ::: "memory");
            const unsigned og = xb_add(&bar[XB_TOP], 1u);
            const unsigned tg = og / nx;
            if (og + 1u == (tg + 1u) * nx) xb_add(&bar[XB_TOPGEN], 1u);
            else XB_SPIN(xb_ld(&bar[XB_TOPGEN]) == tg, bar);
            __builtin_amdgcn_fence(__ATOMIC_ACQUIRE, "agent");
            xb_add(&bar[XB_XGEN(b.x)], 1u);
            asm volatile("s_waitcnt vmcnt(0)" ::: "memory");
        } else {
            XB_SPIN(xb_ld(&bar[XB_XGEN(b.x)]) == gen, bar);
            __builtin_amdgcn_fence(__ATOMIC_ACQUIRE, "agent");
            asm volatile("s_waitcnt vmcnt(0)" ::: "memory");
        }
    }
    __syncthreads();
}

struct Frame {
    LAS unsigned char* lds;
    volatile LAS unsigned* MISC;
    unsigned* ctl;
    int tid, lane, wave, vcu, G;
    const float *x, *c, *w_ada, *b_ada, *w_in, *w_gate_up, *b_gla_gate, *gla_out_norm, *swa_q_norm, *swa_k_norm, *swa_sinks, *swa_out_norm, *w_out, *w_peer_q, *keys1, *keys2, *edown, *eup;
    float* out;
    unsigned char* ws;
    float *MOD, *ROPE;
    bf16 *BTIN, *BTOUT, *BTQ, *HBUF, *PROJ, *MIXIN, *QPEER;
    unsigned char *DC8, *UC8, *YC8;
    int* ZP; unsigned *EIDX, *HE, *EIDX16, *TMAX; float *GATEQ, *DSC, *YSC, *USC, *HF;
    bf16 *GQT, *GST, *X1; float *GUT, *GG;
};

__device__ __forceinline__ float wave_sum(float v) {
#pragma unroll
    for (int o = 1; o < 64; o <<= 1) v += __shfl_xor(v, o);
    return v;
}
__device__ __forceinline__ float wave_max(float v) {
#pragma unroll
    for (int o = 1; o < 64; o <<= 1) v = fmaxf(v, __shfl_xor(v, o));
    return v;
}
__device__ __forceinline__ unsigned pack4i(float a, float b, float c, float d) {
    const int q0 = (int)__builtin_rintf(a), q1 = (int)__builtin_rintf(b), q2 = (int)__builtin_rintf(c), q3 = (int)__builtin_rintf(d);
    return (unsigned)(q0 & 255) | ((unsigned)(q1 & 255) << 8) | ((unsigned)(q2 & 255) << 16) | ((unsigned)q3 << 24);
}

__device__ __forceinline__ void p0_tr_item(const float* W, int ldw, int sc0, int ncols, bf16* WT, int dr0, int k0, LAS float* scr, int lane) {
    const int c4 = (lane & 7) * 4, kr = lane >> 3;
    f32x4 v[8];
#pragma unroll
    for (int i = 0; i < 8; ++i) v[i] = (c4 < ncols) ? *(const GAS f32x4*)(W + (size_t)(k0 + kr + 8 * i) * ldw + sc0 + c4) : (f32x4){0.f, 0.f, 0.f, 0.f};
#pragma unroll
    for (int i = 0; i < 8; ++i) { LAS float* d = scr + (kr + 8 * i) * 33 + c4; d[0] = v[i][0]; d[1] = v[i][1]; d[2] = v[i][2]; d[3] = v[i][3]; }
    LDS_WAIT(); asm volatile("" ::: "memory");
    const int c8 = lane & 7;
#pragma unroll
    for (int j = 0; j < 4; ++j) { const int n = (lane >> 3) + 8 * j; const LAS float* s = scr + (8 * c8) * 33 + n;
        v4u o; o.x = pk2(s[0 * 33], s[1 * 33]); o.y = pk2(s[2 * 33], s[3 * 33]); o.z = pk2(s[4 * 33], s[5 * 33]); o.w = pk2(s[6 * 33], s[7 * 33]);
        if (n < ncols) *(GAS v4u*)(WT + (size_t)(dr0 + n) * DM + k0 + 8 * c8) = o; }
    LDS_WAIT(); asm volatile("" ::: "memory");
}

__device__ __forceinline__ void p0a_ada(Frame& F) {
    const int tid = F.tid, lane = F.lane, wave = F.wave;
    {
        LAS f32x4* cact = (LAS f32x4*)F.lds;
        LAS float* red = (LAS float*)(F.lds + 65536);
        for (int k = tid; k < DM; k += 512) { f32x4 v;
#pragma unroll
            for (int b = 0; b < 4; ++b) { const float cv = F.c[b * DM + k]; v[b] = cv / (1.0f + expf(-cv)); }
            cact[k] = v; }
        __syncthreads();
        for (int slice = F.vcu; slice < 256; slice += F.G) {
            const int col0 = slice * 96, sub = lane / 24, cl = lane - sub * 24;
            f32x4 acc[4];
#pragma unroll
            for (int b = 0; b < 4; ++b) acc[b] = (f32x4){0.f, 0.f, 0.f, 0.f};
            if (lane < 48) {
                const float* wp = F.w_ada + col0 + 4 * cl;
#pragma unroll 16
                for (int k = wave * 2 + sub; k < DM; k += 16) {
                    const f32x4 w = *(const GAS f32x4*)(wp + (size_t)k * NMOD); const f32x4 cv = cact[k];
#pragma unroll
                    for (int b = 0; b < 4; ++b) acc[b] += w * cv[b];
                }
#pragma unroll
                for (int b = 0; b < 4; ++b) *(LAS f32x4*)(red + (wave * 48 + lane) * 16 + 4 * b) = acc[b];
            }
            __syncthreads();
            if (tid < 384) { const int b = tid / 96, col = tid - b * 96, cl2 = col >> 2, e = col & 3; float s = 0.f;
#pragma unroll
                for (int w = 0; w < 8; ++w) { s += red[(w * 48 + cl2) * 16 + 4 * b + e]; s += red[(w * 48 + 24 + cl2) * 16 + 4 * b + e]; }
                F.MOD[b * NMOD + col0 + col] = s + F.b_ada[col0 + col]; }
            __syncthreads();
        }
    }
}
__device__ __forceinline__ void p0b_weights(Frame& F) {
    const int tid = F.tid, lane = F.lane, wave = F.wave;
    const int gw = F.vcu * NWAVES + wave, NGW = F.G * NWAVES;
    {
        LAS float* scr = (LAS float*)(F.lds + wave * 16384);
        constexpr int NB0 = 192, NB1 = 80, NB2 = 1, NB3 = 128, NB4 = 64, NBT = NB0 + NB1 + NB2 + NB3 + NB4;
        for (int it = gw; it < NBT * 64; it += NGW) {
            int nb = it % NBT; const int k0 = (it / NBT) * 64;
            if (nb < NB0) { p0_tr_item(F.w_in, IN_WIDTH, 32 * nb, 32, F.BTIN, 32 * nb, k0, scr, lane); continue; } nb -= NB0;
            if (nb < NB1) { p0_tr_item(F.w_in, IN_WIDTH, 6160 + 32 * nb, 32, F.BTIN, 6144 + 32 * nb, k0, scr, lane); continue; } nb -= NB1;
            if (nb < NB2) { p0_tr_item(F.w_in, IN_WIDTH, 6144, 16, F.BTIN, C_GA, k0, scr, lane); continue; } nb -= NB2;
            if (nb < NB3) { p0_tr_item(F.w_out, DM, 32 * nb, 32, F.BTOUT, 32 * nb, k0, scr, lane); continue; } nb -= NB3;
            p0_tr_item(F.w_peer_q, PEER_N, 32 * nb, 32, F.BTQ, 32 * nb, k0, scr, lane);
        }
        const size_t gt = (size_t)F.vcu * 512 + tid, NT = (size_t)F.G * 512;
        GAS v4u* z = (GAS v4u*)(F.BTIN + (size_t)(C_GA + 16) * DM);
        for (size_t i = gt; i < (size_t)240 * DM / 8; i += NT) z[i] = (v4u){0u, 0u, 0u, 0u};
        for (size_t e = gt; e < (size_t)SEQ * 32; e += NT) { const int pos = (int)(e >> 5), i = (int)(e & 31);
            const float inv = exp2f(-(float)i * (13.287712379549449f / 32.0f));
            const float ang = (float)pos * inv;
            const double rev = (double)ang * 0.15915494309189535; const float fr = (float)(rev - floor(rev));
            F.ROPE[e] = __builtin_amdgcn_cosf(fr); F.ROPE[SEQ * 32 + e] = __builtin_amdgcn_sinf(fr); }
    }
}
__device__ __forceinline__ void convert_expert_groups(Frame& F, int g_lo, int g_hi, int g_step) {
    const int tid = F.tid, lane = F.lane, wave = F.wave;
    __syncthreads();
    const int ngrp = g_lo < g_hi ? (g_hi - g_lo + g_step - 1) / g_step : 0, total = 8 * ngrp;
    if (total == 0) return;
#define CV_SRC(idx) ((const GAS f32x4*)(((idx) >= 4 * ngrp ? F.eup : F.edown) + (size_t)((g_lo + (((idx) >> 2) % ngrp) * g_step) * 32 + wave * 4 + ((idx) & 3)) * DM))
#define CV_LOAD(A, B, idx) do { const GAS f32x4* src_ = CV_SRC(idx); _Pragma("unroll") for (int j = 0; j < 8; ++j) { A[j] = src_[2 * (lane + 64 * j)]; B[j] = src_[2 * (lane + 64 * j) + 1]; } } while (0)
#define CV_QUANT(A, B, idx) do { const int tb_ = (idx) >= 4 * ngrp, el_ = wave * 4 + ((idx) & 3), e_ = (g_lo + (((idx) >> 2) % ngrp) * g_step) * 32 + el_; float m = 0.f; \
        _Pragma("unroll") for (int j = 0; j < 8; ++j) _Pragma("unroll") for (int q = 0; q < 4; ++q) m = fmaxf(m, fmaxf(fabsf(A[j][q]), fabsf(B[j][q]))); \
        m = wave_max(m); const float inv = m > 0.f ? 127.0f / m : 0.f; if (lane == 0) (tb_ ? F.USC : F.DSC)[e_] = m * (1.0f / 127.0f); \
        _Pragma("unroll") for (int j = 0; j < 8; ++j) { v2u o; o.x = pack4i(A[j][0] * inv, A[j][1] * inv, A[j][2] * inv, A[j][3] * inv); o.y = pack4i(B[j][0] * inv, B[j][1] * inv, B[j][2] * inv, B[j][3] * inv); \
            *(LAS v2u*)(F.lds + el_ * 4096 + ((lane + 64 * j + el_) & 511) * 8) = o; } } while (0)
    f32x4 a0[8], b0[8], a1[8], b1[8];
    CV_LOAD(a0, b0, 0);
#pragma unroll 1
    for (int idx = 0; idx < total; idx += 2) {
        CV_LOAD(a1, b1, idx + 1);
        CV_QUANT(a0, b0, idx);
        if (idx + 2 < total) CV_LOAD(a0, b0, idx + 2);
        CV_QUANT(a1, b1, idx + 1);
        if ((idx & 3) == 2) {
            __syncthreads();
            unsigned char* dstT = (idx >= 4 * ngrp) ? F.UC8 : F.DC8; const int e0 = (g_lo + ((idx >> 2) % ngrp) * g_step) * 32, el = tid & 31;
#pragma unroll 8
            for (int it = 0; it < 32; ++it) { const int sc = it * 16 + (tid >> 5);
                const v2u o = *(const LAS v2u*)(F.lds + el * 4096 + ((sc + el) & 511) * 8);
                *(GAS v2u*)(dstT + ((size_t)sc * NEXP + e0 + el) * 8) = o; }
            __syncthreads();
        }
    }
#undef CV_SRC
#undef CV_LOAD
#undef CV_QUANT
}
constexpr int GEMM1_UNITS = (NTOK / 256) * (NPROJ / 256);
__host__ __device__ constexpr int tail_groups(int G) { return (GEMM1_UNITS % G) ? (512 - G > 0 ? 512 - G : 0) : 0; }
__device__ __forceinline__ void p0c_tables(Frame& F) {
    convert_expert_groups(F, tail_groups(F.G) + F.vcu, 512, F.G);
}
__device__ __forceinline__ void p0_prologue(Frame& F) { p0a_ada(F); p0b_weights(F); p0c_tables(F); }

__device__ __forceinline__ void modulate_rows(Frame& F, const float* src, bf16* dst, int sh_off, int sc_off) {
    const int lane = F.lane, w = F.wave, tid = F.tid;
    LAS f32x4* SC = (LAS f32x4*)F.lds;
    LAS f32x4* SH = (LAS f32x4*)(F.lds + 16384);
    for (int blk = F.vcu; blk < NTOK / 32; blk += F.G) {
        const int R0 = blk * 32, b = R0 >> 11;
        __syncthreads();
        { const GAS f32x4* shp = (const GAS f32x4*)(F.MOD + b * NMOD + sh_off); const GAS f32x4* scp = (const GAS f32x4*)(F.MOD + b * NMOD + sc_off);
          for (int i = tid; i < 1024; i += 512) { SC[i] = scp[i] + 1.0f; SH[i] = shp[i]; } }
        __syncthreads();
        const int m0 = R0 + 4 * w;
        f32x4 va[16], vb[16];
#define MR_LOAD(V, m_) do { const GAS f32x4* xr_ = (const GAS f32x4*)(src + (size_t)(m_) * DM) + lane; _Pragma("unroll") for (int j = 0; j < 16; ++j) V[j] = xr_[64 * j]; } while (0)
#define MR_ROW(V, m_) do { float s_ = 0.f; _Pragma("unroll") for (int j = 0; j < 16; ++j) s_ += (V[j].x * V[j].x + V[j].y * V[j].y) + (V[j].z * V[j].z + V[j].w * V[j].w); \
            const float rstd_ = 1.0f / sqrtf(wave_sum(s_) * (1.0f / DM) + EPS); int ln_ = lane; asm volatile("" : "+v"(ln_));     \
            GAS v2u* o8_ = (GAS v2u*)(dst + (size_t)(m_) * DM) + lane; \
            _Pragma("unroll") for (int j = 0; j < 16; ++j) { const f32x4 y_ = V[j] * rstd_ * SC[ln_ + 64 * j] + SH[ln_ + 64 * j]; v2u o_; o_.x = pk2(y_.x, y_.y); o_.y = pk2(y_.z, y_.w); o8_[64 * j] = o_; } } while (0)
        MR_LOAD(va, m0);
        MR_LOAD(vb, m0 + 1); MR_ROW(va, m0);
        MR_LOAD(va, m0 + 2); MR_ROW(vb, m0 + 1);
        MR_LOAD(vb, m0 + 3); MR_ROW(va, m0 + 2);
        MR_ROW(vb, m0 + 3);
#undef MR_LOAD
#undef MR_ROW
    }
}

__device__ __forceinline__ void p5_modulate_quant(Frame& F) {
    const int lane = F.lane, w = F.wave, tid = F.tid;
    LAS f32x4* SCA = (LAS f32x4*)F.lds;
    LAS f32x4* SCC = (LAS f32x4*)(F.lds + 8192);
    LAS f32x4* SHA = (LAS f32x4*)(F.lds + 16384);
    LAS f32x4* SHC = (LAS f32x4*)(F.lds + 24576);
    LAS unsigned char* ST = F.lds + 32768;
    for (int blk = F.vcu; blk < NTOK / 32; blk += F.G) {
        const int R0 = blk * 32, b = R0 >> 11;
        __syncthreads();
        { const GAS f32x4* shp = (const GAS f32x4*)(F.MOD + b * NMOD + 3 * DM); const GAS f32x4* scp = (const GAS f32x4*)(F.MOD + b * NMOD + 4 * DM);
          for (int i = tid; i < 1024; i += 512) { const f32x4 sc = scp[i] + 1.0f, sh = shp[i]; if (i & 1) { SCC[i >> 1] = sc; SHC[i >> 1] = sh; } else { SCA[i >> 1] = sc; SHA[i >> 1] = sh; } } }
        __syncthreads();
        v4u xw[8];
        { const GAS v4u* xr = (const GAS v4u*)(F.X1 + (size_t)(R0 + 2 * w) * DM);
#pragma unroll
          for (int j = 0; j < 8; ++j) xw[j] = xr[lane + 64 * j]; }
        for (int pass = 0; pass < 2; ++pass) {
#pragma unroll
            for (int rr = 0; rr < 2; ++rr) {
                const int rl = 2 * w + rr, m = R0 + pass * 16 + rl;
                f32x4 a[8], c[8]; float s = 0.f;
#pragma unroll
                for (int j = 0; j < 8; ++j) { const v4u x = xw[j]; a[j] = (f32x4){bflo(x.x), bfhi(x.x), bflo(x.y), bfhi(x.y)}; c[j] = (f32x4){bflo(x.z), bfhi(x.z), bflo(x.w), bfhi(x.w)};
                    s += (a[j].x * a[j].x + a[j].y * a[j].y) + (a[j].z * a[j].z + a[j].w * a[j].w) + (c[j].x * c[j].x + c[j].y * c[j].y) + (c[j].z * c[j].z + c[j].w * c[j].w); }
                {
                    const int mn = rr == 0 ? m + 1 : (pass == 0 ? R0 + 16 + 2 * w : m);
                    const GAS v4u* xr = (const GAS v4u*)(F.X1 + (size_t)mn * DM);
#pragma unroll
                    for (int j = 0; j < 8; ++j) xw[j] = xr[lane + 64 * j]; }
                const float rstd = 1.0f / sqrtf(wave_sum(s) * (1.0f / DM) + EPS);
                float mx = 0.f;
                int ln = lane; asm volatile("" : "+v"(ln));
#pragma unroll
                for (int j = 0; j < 8; ++j) { const int i = ln + 64 * j;
                    a[j] = a[j] * rstd * SCA[i] + SHA[i]; c[j] = c[j] * rstd * SCC[i] + SHC[i];
#pragma unroll
                    for (int q = 0; q < 4; ++q) mx = fmaxf(mx, fmaxf(fabsf(a[j][q]), fabsf(c[j][q])));
                    *(GAS v4u*)(F.HBUF + (size_t)m * DM + 8 * i) = (v4u){pk2(a[j].x, a[j].y), pk2(a[j].z, a[j].w), pk2(c[j].x, c[j].y), pk2(c[j].z, c[j].w)}; }
                mx = wave_max(mx);
                const float inv = mx > 0.f ? 127.0f / mx : 0.f;
                if (lane == 0) F.YSC[m] = mx * (1.0f / 127.0f);
#pragma unroll
                for (int j = 0; j < 8; ++j) { v2u o; o.x = pack4i(a[j].x * inv, a[j].y * inv, a[j].z * inv, a[j].w * inv); o.y = pack4i(c[j].x * inv, c[j].y * inv, c[j].z * inv, c[j].w * inv);
                    *(LAS v2u*)(ST + rl * 4112 + (lane + 64 * j) * 8) = o; }
            }
            __syncthreads();
            { const int q = tid & 7;
#pragma unroll
              for (int it = 0; it < 8; ++it) { const int ch = it * 64 + (tid >> 3);
                  const v2u lo = *(const LAS v2u*)(ST + (2 * q) * 4112 + ch * 8), hi = *(const LAS v2u*)(ST + (2 * q + 1) * 4112 + ch * 8);
                  *(GAS v4u*)(F.YC8 + ((size_t)ch * NTOK + R0 + pass * 16 + 2 * q) * 8) = (v4u){lo.x, lo.y, hi.x, hi.y}; } }
            __syncthreads();
        }
    }
}

__device__ __forceinline__ void swa_unit(Frame& F, int u) {
    const int b = u >> 6, kvh = (u >> 4) & 3, n = u & 15, t0 = n * 128;
    LAS unsigned char* KL = F.lds;
    LAS unsigned char* VL = F.lds + 36864;
    const float* COS = F.ROPE; const float* SIN = F.ROPE + SEQ * 32;
    {
        const int key = F.tid >> 1, p = F.tid & 1, kpos = t0 - 128 + key;
        v4u ka[2] = {{0u, 0u, 0u, 0u}, {0u, 0u, 0u, 0u}}, kb[2] = {{0u, 0u, 0u, 0u}, {0u, 0u, 0u, 0u}}, vv[4] = {{0u, 0u, 0u, 0u}, {0u, 0u, 0u, 0u}, {0u, 0u, 0u, 0u}, {0u, 0u, 0u, 0u}};
        float cs[16], sn[16];
#pragma unroll
        for (int i = 0; i < 16; ++i) { cs[i] = 1.f; sn[i] = 0.f; }
        if (kpos >= 0) {
            const bf16* pr = F.PROJ + (size_t)(b * SEQ + kpos) * NPROJ;
            const GAS v4u* kr = (const GAS v4u*)(pr + C_SK + kvh * 64);
            ka[0] = kr[2 * p]; ka[1] = kr[2 * p + 1]; kb[0] = kr[4 + 2 * p]; kb[1] = kr[4 + 2 * p + 1];
            const GAS v4u* vr = (const GAS v4u*)(pr + C_SV + kvh * 64 + 32 * p);
#pragma unroll
            for (int j = 0; j < 4; ++j) vv[j] = vr[j];
            const GAS f32x4* cp = (const GAS f32x4*)(COS + kpos * 32 + 16 * p); const GAS f32x4* sp = (const GAS f32x4*)(SIN + kpos * 32 + 16 * p);
#pragma unroll
            for (int j = 0; j < 4; ++j) { const f32x4 c4 = cp[j], s4 = sp[j];
#pragma unroll
                for (int e = 0; e < 4; ++e) { cs[4 * j + e] = c4[e]; sn[4 * j + e] = s4[e]; } }
        }
        float x1[16], x2[16]; float ss = 0.f;
#pragma unroll
        for (int j = 0; j < 2; ++j)
#pragma unroll
            for (int e = 0; e < 4; ++e) { x1[8 * j + 2 * e] = bflo(ka[j][e]); x1[8 * j + 2 * e + 1] = bfhi(ka[j][e]); x2[8 * j + 2 * e] = bflo(kb[j][e]); x2[8 * j + 2 * e + 1] = bfhi(kb[j][e]); }
#pragma unroll
        for (int i = 0; i < 16; ++i) ss += x1[i] * x1[i] + x2[i] * x2[i];
        ss += __shfl_xor(ss, 1);
        const float rstd = 1.0f / sqrtf(ss * (1.0f / 64.0f) + EPS);
        unsigned o1[8], o2[8];
#pragma unroll
        for (int i = 0; i < 8; ++i) {
            float y1[2], y2[2];
#pragma unroll
            for (int e = 0; e < 2; ++e) { const int d = 2 * i + e; const float a = x1[d] * rstd * F.swa_k_norm[16 * p + d], c = x2[d] * rstd * F.swa_k_norm[32 + 16 * p + d];
                y1[e] = a * cs[d] - c * sn[d]; y2[e] = c * cs[d] + a * sn[d]; }
            o1[i] = pk2(y1[0], y1[1]); o2[i] = pk2(y2[0], y2[1]);
        }
        LAS v4u* kd = (LAS v4u*)(KL + key * 144 + 32 * p);
        kd[0] = (v4u){o1[0], o1[1], o1[2], o1[3]}; kd[1] = (v4u){o1[4], o1[5], o1[6], o1[7]};
        LAS v4u* kd2 = (LAS v4u*)(KL + key * 144 + 64 + 32 * p);
        kd2[0] = (v4u){o2[0], o2[1], o2[2], o2[3]}; kd2[1] = (v4u){o2[4], o2[5], o2[6], o2[7]};
#pragma unroll
        for (int j = 0; j < 4; ++j)
#pragma unroll
            for (int e = 0; e < 4; ++e) { const int d = 32 * p + 8 * j + 2 * e; const unsigned w = vv[j][e];
                *(LAS unsigned short*)(VL + d * 520 + key * 2) = (unsigned short)(w & 0xffffu);
                *(LAS unsigned short*)(VL + (d + 1) * 520 + key * 2) = (unsigned short)(w >> 16); }
    }
    __syncthreads();
    {
        const int g = F.wave, hq = kvh * 8 + g, r = F.lane & 31, h = F.lane >> 5;
        const float sink = F.swa_sinks[hq];
        for (int qt = 0; qt < 4; ++qt) {
            const int qpos = t0 + 32 * qt + r;
            const size_t tok = (size_t)(b * SEQ + qpos);
            const GAS v4u* qr = (const GAS v4u*)(F.PROJ + tok * NPROJ + C_SQ + hq * 64);
            v4u qraw[4];
#pragma unroll
            for (int kk = 0; kk < 4; ++kk) qraw[kk] = qr[2 * kk + h];
            float qf[4][8]; float ss = 0.f;
#pragma unroll
            for (int kk = 0; kk < 4; ++kk)
#pragma unroll
                for (int e = 0; e < 4; ++e) { qf[kk][2 * e] = bflo(qraw[kk][e]); qf[kk][2 * e + 1] = bfhi(qraw[kk][e]); }
#pragma unroll
            for (int kk = 0; kk < 4; ++kk)
#pragma unroll
                for (int j = 0; j < 8; ++j) ss += qf[kk][j] * qf[kk][j];
            ss += __shfl_xor(ss, 32);
            const float rstd = 0.125f / sqrtf(ss * (1.0f / 64.0f) + EPS);
            bf16x8 qfrag[4];
#pragma unroll
            for (int kk = 0; kk < 2; ++kk) {
                float y1[8], y2[8];
                const GAS f32x4* cp = (const GAS f32x4*)(COS + qpos * 32 + 16 * kk + 8 * h); const GAS f32x4* sp = (const GAS f32x4*)(SIN + qpos * 32 + 16 * kk + 8 * h);
                const f32x4 c0 = cp[0], c1 = cp[1], s0 = sp[0], s1 = sp[1];
#pragma unroll
                for (int j = 0; j < 8; ++j) { const int d = 16 * kk + 8 * h + j; const float cc = j < 4 ? c0[j & 3] : c1[j & 3], sv = j < 4 ? s0[j & 3] : s1[j & 3];
                    const float a = qf[kk][j] * rstd * F.swa_q_norm[d], c = qf[kk + 2][j] * rstd * F.swa_q_norm[d + 32];
                    y1[j] = a * cc - c * sv; y2[j] = c * cc + a * sv; }
                qfrag[kk] = mk8(pk2(y1[0], y1[1]), pk2(y1[2], y1[3]), pk2(y1[4], y1[5]), pk2(y1[6], y1[7]));
                qfrag[kk + 2] = mk8(pk2(y2[0], y2[1]), pk2(y2[2], y2[3]), pk2(y2[4], y2[5]), pk2(y2[6], y2[7]));
            }
            f32x16 sacc[5];
#pragma unroll
            for (int tt = 0; tt < 5; ++tt) { f32x16 a = {0.f, 0.f, 0.f, 0.f, 0.f, 0.f, 0.f, 0.f, 0.f, 0.f, 0.f, 0.f, 0.f, 0.f, 0.f, 0.f};
#pragma unroll
                for (int kk = 0; kk < 4; ++kk) { const bf16x8 kf = *(const LAS bf16x8*)(KL + (32 * (qt + tt) + r) * 144 + (16 * kk + 8 * h) * 2); a = mfma32(kf, qfrag[kk], a); }
                sacc[tt] = a; }
            float mx = sink;
#pragma unroll
            for (int tt = 0; tt < 5; ++tt)
#pragma unroll
                for (int i = 0; i < 16; ++i) { const int koff = (i & 3) + 8 * (i >> 2) + 4 * h; const int rel = r + 128 - 32 * tt - koff; const int kidx = 32 * (qt + tt) + koff;
                    const bool valid = (rel >= 0) && (rel < 128) && (t0 - 128 + kidx >= 0);
                    const float s = valid ? sacc[tt][i] : -INFINITY; sacc[tt][i] = s; mx = fmaxf(mx, s); }
            mx = fmaxf(mx, __shfl_xor(mx, 32));
            float sum = 0.f;
#pragma unroll
            for (int tt = 0; tt < 5; ++tt)
#pragma unroll
                for (int i = 0; i < 16; ++i) { const float pv = __expf(sacc[tt][i] - mx); sacc[tt][i] = pv; sum += pv; }
            sum += __shfl_xor(sum, 32);
            const float inv = 1.0f / (sum + __expf(sink - mx));
            f32x16 oacc[2];
#pragma unroll
            for (int dt = 0; dt < 2; ++dt) oacc[dt] = (f32x16){0.f, 0.f, 0.f, 0.f, 0.f, 0.f, 0.f, 0.f, 0.f, 0.f, 0.f, 0.f, 0.f, 0.f, 0.f, 0.f};
#pragma unroll
            for (int tt = 0; tt < 5; ++tt)
#pragma unroll
                for (int s2 = 0; s2 < 2; ++s2) {
                    const bf16x8 pf = mk8(pk2(sacc[tt][8 * s2], sacc[tt][8 * s2 + 1]), pk2(sacc[tt][8 * s2 + 2], sacc[tt][8 * s2 + 3]), pk2(sacc[tt][8 * s2 + 4], sacc[tt][8 * s2 + 5]), pk2(sacc[tt][8 * s2 + 6], sacc[tt][8 * s2 + 7]));
#pragma unroll
                    for (int dt = 0; dt < 2; ++dt) { const LAS unsigned char* vp = VL + (32 * dt + r) * 520 + (32 * (qt + tt) + 16 * s2 + 4 * h) * 2;
                        const v2u lo = *(const LAS v2u*)vp, hi = *(const LAS v2u*)(vp + 16);
                        oacc[dt] = mfma32(mk8(lo.x, lo.y, hi.x, hi.y), pf, oacc[dt]); }
                }
            float so = 0.f;
#pragma unroll
            for (int dt = 0; dt < 2; ++dt)
#pragma unroll
                for (int i = 0; i < 16; ++i) { const float o = oacc[dt][i] * inv; oacc[dt][i] = o; so += o * o; }
            so += __shfl_xor(so, 32);
            const float rs2 = 1.0f / sqrtf(so * (1.0f / 64.0f) + EPS);
            bf16* orow = F.MIXIN + tok * DM + 2048 + hq * 64;
#pragma unroll
            for (int dt = 0; dt < 2; ++dt)
#pragma unroll
                for (int gq = 0; gq < 4; ++gq) { const int d0 = 32 * dt + 8 * gq + 4 * h; const f32x4 gn = *(const GAS f32x4*)(F.swa_out_norm + d0);
                    v2u o; o.x = pk2(oacc[dt][4 * gq] * rs2 * gn[0], oacc[dt][4 * gq + 1] * rs2 * gn[1]); o.y = pk2(oacc[dt][4 * gq + 2] * rs2 * gn[2], oacc[dt][4 * gq + 3] * rs2 * gn[3]);
                    *(GAS v2u*)(orow + d0) = o; }
        }
    }
    __syncthreads();
}

constexpr int GL_QT = 0, GL_KT = 9216, GL_KHT = 18432, GL_VT = 27648, GL_WG = 46336, GL_BG = 50432, GL_OB = 50688;
__device__ __forceinline__ void gla_g1_units(Frame& F, int u0, int nu) {
    const int bh = u0 >> 5, b = bh >> 4, h = bh & 15, tid = F.tid, lane = F.lane, w = F.wave;
    LAS unsigned char* QT = F.lds + GL_QT;
    LAS unsigned char* KT = F.lds + GL_KT;
    LAS unsigned char* KHT = F.lds + GL_KHT;
    LAS unsigned char* VT = F.lds + GL_VT;
    LAS float* WG = (LAS float*)(F.lds + GL_WG);
    LAS float* BG = (LAS float*)(F.lds + GL_BG);
    LAS float* OB = (LAS float*)(F.lds + GL_OB);
    __syncthreads();
    for (int i = tid; i < 1024; i += 512) WG[i] = F.w_gate_up[(i >> 6) * 1024 + h * 64 + (i & 63)];
    if (tid < 64) BG[tid] = F.b_gla_gate[h * 64 + tid];
    __syncthreads();
    const int r = lane & 15, g = lane >> 4;
    const int t2 = tid >> 3, seg = tid & 7;
    v4u qv, kv, g0, g1, vv0, vv1;
    { const size_t row0 = (size_t)b * SEQ + (u0 & 31) * 64; const bf16* pr = F.PROJ + (row0 + lane) * NPROJ;
      qv = *(const GAS v4u*)(pr + C_GQ + h * 64 + 8 * w); kv = *(const GAS v4u*)(pr + C_GK + h * 64 + 8 * w); g0 = *(const GAS v4u*)(pr + C_GA); g1 = *(const GAS v4u*)(pr + C_GA + 8);
      const GAS v4u* vr = (const GAS v4u*)(F.PROJ + (row0 + t2) * NPROJ + C_GV + h * 128 + 16 * seg); vv0 = vr[0]; vv1 = vr[1]; }
    for (int ui = 0; ui < nu; ++ui) {
        const int u = u0 + ui, chunk = u & 31;
        const size_t row0 = (size_t)b * SEQ + chunk * 64;
        v4u nqv = qv, nkv = kv, ng0 = g0, ng1 = g1, nvv0 = vv0, nvv1 = vv1;
        if (ui + 1 < nu) {
            const size_t rown = row0 + 64; const bf16* pr = F.PROJ + (rown + lane) * NPROJ;
            nqv = *(const GAS v4u*)(pr + C_GQ + h * 64 + 8 * w); nkv = *(const GAS v4u*)(pr + C_GK + h * 64 + 8 * w); ng0 = *(const GAS v4u*)(pr + C_GA); ng1 = *(const GAS v4u*)(pr + C_GA + 8);
            const GAS v4u* vr = (const GAS v4u*)(F.PROJ + (rown + t2) * NPROJ + C_GV + h * 128 + 16 * seg); nvv0 = vr[0]; nvv1 = vr[1]; }
        {
            float ga[16];
#pragma unroll
            for (int e = 0; e < 4; ++e) { ga[2 * e] = bflo(g0[e]); ga[2 * e + 1] = bfhi(g0[e]); ga[8 + 2 * e] = bflo(g1[e]); ga[8 + 2 * e + 1] = bfhi(g1[e]); }
            float z[8];
            { const f32x4 b0 = *(const LAS f32x4*)(BG + 8 * w), b1 = *(const LAS f32x4*)(BG + 8 * w + 4);
#pragma unroll
              for (int i = 0; i < 4; ++i) { z[i] = b0[i]; z[4 + i] = b1[i]; } }
#pragma unroll
            for (int j = 0; j < 16; ++j) { const f32x4 w0 = *(const LAS f32x4*)(WG + j * 64 + 8 * w), w1 = *(const LAS f32x4*)(WG + j * 64 + 8 * w + 4);
#pragma unroll
                for (int i = 0; i < 4; ++i) { z[i] += ga[j] * w0[i]; z[4 + i] += ga[j] * w1[i]; } }
            float bb[8];
#pragma unroll
            for (int i = 0; i < 8; ++i) { const float zz = z[i]; bb[i] = (fminf(zz, 0.f) - __logf(1.0f + __expf(-fabsf(zz)))) * (1.0f / 16.0f); }
#define G1_DPP_ADD(x, ctrl, rmask) x += __builtin_bit_cast(float, __builtin_amdgcn_update_dpp(0, __builtin_bit_cast(int, x), ctrl, rmask, 0xf, false))
#pragma unroll
            for (int i = 0; i < 8; ++i) { G1_DPP_ADD(bb[i], 0x111, 0xf); G1_DPP_ADD(bb[i], 0x112, 0xf); G1_DPP_ADD(bb[i], 0x114, 0xf); G1_DPP_ADD(bb[i], 0x118, 0xf);
                G1_DPP_ADD(bb[i], 0x142, 0xa); G1_DPP_ADD(bb[i], 0x143, 0xc); }
#undef G1_DPP_ADD
            float qn[8], kn[8], kh[8];
#pragma unroll
            for (int e = 0; e < 4; ++e) { qn[2 * e] = bflo(qv[e]); qn[2 * e + 1] = bfhi(qv[e]); kn[2 * e] = bflo(kv[e]); kn[2 * e + 1] = bfhi(kv[e]); }
            float ebl[8];
#pragma unroll
            for (int i = 0; i < 8; ++i) { const float eb = __expf(bb[i]);
                const float bl = __builtin_bit_cast(float, __builtin_amdgcn_readlane(__builtin_bit_cast(int, bb[i]), 63));
                ebl[i] = __builtin_bit_cast(float, __builtin_amdgcn_readlane(__builtin_bit_cast(int, eb), 63));
                qn[i] = qn[i] * 0.125f * eb; kh[i] = kn[i] * __expf(bl - bb[i]); kn[i] = kn[i] * __expf(-bb[i]); }
            if (lane == 0) { GAS f32x4* gp = (GAS f32x4*)(F.GG + (size_t)u * 64 + 8 * w); gp[0] = (f32x4){ebl[0], ebl[1], ebl[2], ebl[3]}; gp[1] = (f32x4){ebl[4], ebl[5], ebl[6], ebl[7]}; }
            const v4u qpk = {pk2(qn[0], qn[1]), pk2(qn[2], qn[3]), pk2(qn[4], qn[5]), pk2(qn[6], qn[7])};
            *(LAS v4u*)(QT + lane * 144 + 16 * w) = qpk;
            *(GAS v4u*)(F.GQT + ((size_t)u * 64 + lane) * 64 + 8 * w) = qpk;
            *(LAS v4u*)(KT + lane * 144 + 16 * w) = (v4u){pk2(kn[0], kn[1]), pk2(kn[2], kn[3]), pk2(kn[4], kn[5]), pk2(kn[6], kn[7])};
#pragma unroll
            for (int i = 0; i < 8; ++i) *(LAS unsigned short*)(KHT + (8 * w + i) * 144 + lane * 2) = (unsigned short)f2bf(kh[i]);
#pragma unroll
            for (int e = 0; e < 4; ++e) {
                *(LAS unsigned short*)(VT + (16 * seg + 2 * e) * 144 + t2 * 2) = (unsigned short)(vv0[e] & 0xffffu);
                *(LAS unsigned short*)(VT + (16 * seg + 2 * e + 1) * 144 + t2 * 2) = (unsigned short)(vv0[e] >> 16);
                *(LAS unsigned short*)(VT + (16 * seg + 8 + 2 * e) * 144 + t2 * 2) = (unsigned short)(vv1[e] & 0xffffu);
                *(LAS unsigned short*)(VT + (16 * seg + 8 + 2 * e + 1) * 144 + t2 * 2) = (unsigned short)(vv1[e] >> 16); }
        }
        __syncthreads();
        {
            unsigned dp[4][4][2];
#pragma unroll
            for (int tt = 0; tt < 4; ++tt) {
                const bf16x8 bq0 = *(const LAS bf16x8*)(QT + (16 * tt + r) * 144 + (8 * g) * 2), bq1 = *(const LAS bf16x8*)(QT + (16 * tt + r) * 144 + (32 + 8 * g) * 2);
#pragma unroll
                for (int st = 0; st < 4; ++st) {
                    if (st <= tt) {
                        const bf16x8 ak0 = *(const LAS bf16x8*)(KT + (16 * st + r) * 144 + (8 * g) * 2), ak1 = *(const LAS bf16x8*)(KT + (16 * st + r) * 144 + (32 + 8 * g) * 2);
                        f32x4 d = {0.f, 0.f, 0.f, 0.f}; d = mfma16(ak0, bq0, d); d = mfma16(ak1, bq1, d);
                        if (st == tt) {
#pragma unroll
                            for (int i = 0; i < 4; ++i) if (4 * g + i > r) d[i] = 0.f; }
                        dp[st][tt][0] = pk2(d[0], d[1]); dp[st][tt][1] = pk2(d[2], d[3]);
                    } else { dp[st][tt][0] = 0u; dp[st][tt][1] = 0u; }
                }
            }
#pragma unroll
            for (int tt = 0; tt < 4; ++tt) {
                f32x4 o = {0.f, 0.f, 0.f, 0.f};
#pragma unroll
                for (int kk = 0; kk < 2; ++kk) {
                    if (2 * kk <= tt) {
                        const LAS unsigned char* vp = VT + (16 * w + r) * 144 + (32 * kk + 4 * g) * 2;
                        const v2u lo = *(const LAS v2u*)vp, hi = *(const LAS v2u*)(vp + 32);
                        o = mfma16(mk8(dp[2 * kk][tt][0], dp[2 * kk][tt][1], dp[2 * kk + 1][tt][0], dp[2 * kk + 1][tt][1]), mk8(lo.x, lo.y, hi.x, hi.y), o);
                    }
                }
#pragma unroll
                for (int i = 0; i < 4; ++i) OB[(16 * tt + 4 * g + i) * 132 + 16 * w + r] = o[i];
            }
#pragma unroll
            for (int dt = 0; dt < 4; ++dt) {
                f32x4 uacc = {0.f, 0.f, 0.f, 0.f};
#pragma unroll
                for (int kk = 0; kk < 2; ++kk) { const bf16x8 a = *(const LAS bf16x8*)(KHT + (16 * dt + r) * 144 + (32 * kk + 8 * g) * 2), bv = *(const LAS bf16x8*)(VT + (16 * w + r) * 144 + (32 * kk + 8 * g) * 2);
                    uacc = mfma16(a, bv, uacc); }
                *(GAS f32x4*)(F.GUT + ((size_t)u * 128 + 16 * w + r) * 64 + 16 * dt + 4 * g) = uacc;
            }
        }
        __syncthreads();
        {
            unsigned ow[8];
#pragma unroll
            for (int j = 0; j < 4; ++j) { const f32x4 v = *(const LAS f32x4*)(OB + t2 * 132 + 16 * seg + 4 * j); ow[2 * j] = pk2(v[0], v[1]); ow[2 * j + 1] = pk2(v[2], v[3]); }
            GAS v4u* op = (GAS v4u*)(F.MIXIN + (row0 + t2) * DM + h * 128 + 16 * seg);
            op[0] = (v4u){ow[0], ow[1], ow[2], ow[3]}; op[1] = (v4u){ow[4], ow[5], ow[6], ow[7]};
        }
        qv = nqv; kv = nkv; g0 = ng0; g1 = ng1; vv0 = nvv0; vv1 = nvv1;
    }
}
__device__ __forceinline__ void gla_scan(Frame& F) {
    const size_t gt = (size_t)F.vcu * 512 + F.tid, NT = (size_t)F.G * 512;
    for (size_t i = gt; i < (size_t)64 * 128 * 16; i += NT) {
        const int bh = (int)(i >> 11), v = (int)((i >> 4) & 127), d4 = (int)(i & 15);
        f32x4 S = {0.f, 0.f, 0.f, 0.f};
#pragma unroll 8
        for (int c = 0; c < 32; ++c) {
            const size_t u = (size_t)bh * 32 + c;
            const f32x4 U = *(const GAS f32x4*)(F.GUT + (u * 128 + v) * 64 + 4 * d4), gg = *(const GAS f32x4*)(F.GG + u * 64 + 4 * d4);
            *(GAS v2u*)(F.GST + (u * 128 + v) * 64 + 4 * d4) = (v2u){pk2(S[0], S[1]), pk2(S[2], S[3])};
            S = gg * S + U;
        }
    }
}
struct G3Ops { v4u oi0, oi1, gg0, gg1; v2u slo[2], shi[2], qlo[4][2], qhi[4][2]; };
__device__ __forceinline__ void gla_g3_load(Frame& F, G3Ops& P, int u, int b, int h, int w, int r, int g, int t2, int seg) {
    const size_t row0 = (size_t)b * SEQ + (u & 31) * 64;
    const GAS v4u* oip = (const GAS v4u*)(F.MIXIN + (row0 + t2) * DM + h * 128 + 16 * seg); P.oi0 = oip[0]; P.oi1 = oip[1];
    const GAS v4u* gr = (const GAS v4u*)(F.PROJ + (row0 + t2) * NPROJ + C_GG + h * 128 + 16 * seg); P.gg0 = gr[0]; P.gg1 = gr[1];
#pragma unroll
    for (int kk = 0; kk < 2; ++kk) { const bf16* sp = F.GST + ((size_t)u * 128 + 16 * w + r) * 64 + 32 * kk + 4 * g; P.slo[kk] = *(const GAS v2u*)sp; P.shi[kk] = *(const GAS v2u*)(sp + 16); }
#pragma unroll
    for (int tt = 0; tt < 4; ++tt)
#pragma unroll
        for (int kk = 0; kk < 2; ++kk) { const bf16* qp = F.GQT + ((size_t)u * 64 + 16 * tt + r) * 64 + 32 * kk + 4 * g; P.qlo[tt][kk] = *(const GAS v2u*)qp; P.qhi[tt][kk] = *(const GAS v2u*)(qp + 16); }
}
__device__ __forceinline__ void gla_g3_units(Frame& F, int u0, int nu) {
    const int bh = u0 >> 5, b = bh >> 4, h = bh & 15, tid = F.tid, lane = F.lane, w = F.wave;
    LAS float* OB = (LAS float*)(F.lds + GL_OB);
    const int r = lane & 15, g = lane >> 4, t2 = tid >> 3, seg = tid & 7;
    LAS float* ON = (LAS float*)(F.lds + GL_WG);
    __syncthreads();
    if (tid < 128) ON[tid] = F.gla_out_norm[tid];
    G3Ops cur, nxt;
    gla_g3_load(F, cur, u0, b, h, w, r, g, t2, seg);
    for (int ui = 0; ui < nu; ++ui) {
        const int u = u0 + ui, chunk = u & 31;
        const size_t row0 = (size_t)b * SEQ + chunk * 64;
        if (ui + 1 < nu) gla_g3_load(F, nxt, u + 1, b, h, w, r, g, t2, seg);
        {
            bf16x8 bs[2];
#pragma unroll
            for (int kk = 0; kk < 2; ++kk) bs[kk] = mk8(cur.slo[kk].x, cur.slo[kk].y, cur.shi[kk].x, cur.shi[kk].y);
#pragma unroll
            for (int tt = 0; tt < 4; ++tt) {
                f32x4 o = {0.f, 0.f, 0.f, 0.f};
#pragma unroll
                for (int kk = 0; kk < 2; ++kk) o = mfma16(mk8(cur.qlo[tt][kk].x, cur.qlo[tt][kk].y, cur.qhi[tt][kk].x, cur.qhi[tt][kk].y), bs[kk], o);
#pragma unroll
                for (int i = 0; i < 4; ++i) OB[(16 * tt + 4 * g + i) * 132 + 16 * w + r] = o[i];
            }
        }
        __syncthreads();
        {
            float o[16]; float ss = 0.f;
#pragma unroll
            for (int j = 0; j < 4; ++j) { const f32x4 v = *(const LAS f32x4*)(OB + t2 * 132 + 16 * seg + 4 * j);
#pragma unroll
                for (int e = 0; e < 4; ++e) o[4 * j + e] = v[e]; }
#pragma unroll
            for (int e = 0; e < 4; ++e) { o[2 * e] += bflo(cur.oi0[e]); o[2 * e + 1] += bfhi(cur.oi0[e]); o[8 + 2 * e] += bflo(cur.oi1[e]); o[8 + 2 * e + 1] += bfhi(cur.oi1[e]); }
#pragma unroll
            for (int e = 0; e < 16; ++e) ss += o[e] * o[e];
            ss += __shfl_xor(ss, 1); ss += __shfl_xor(ss, 2); ss += __shfl_xor(ss, 4);
            const float rstd = 1.0f / sqrtf(ss * (1.0f / 128.0f) + EPS);
            float gg[16];
#pragma unroll
            for (int e = 0; e < 4; ++e) { gg[2 * e] = bflo(cur.gg0[e]); gg[2 * e + 1] = bfhi(cur.gg0[e]); gg[8 + 2 * e] = bflo(cur.gg1[e]); gg[8 + 2 * e + 1] = bfhi(cur.gg1[e]); }
            unsigned ow[8];
            f32x4 on[4];
#pragma unroll
            for (int j = 0; j < 4; ++j) on[j] = *(const LAS f32x4*)(ON + 16 * seg + 4 * j);
#pragma unroll
            for (int e = 0; e < 8; ++e) { const float a = o[2 * e] * rstd * on[e >> 1][(2 * e) & 3] * silu_f(gg[2 * e]), c = o[2 * e + 1] * rstd * on[e >> 1][(2 * e + 1) & 3] * silu_f(gg[2 * e + 1]);
                ow[e] = pk2(a, c); }
            GAS v4u* op = (GAS v4u*)(F.MIXIN + (row0 + t2) * DM + h * 128 + 16 * seg);
            op[0] = (v4u){ow[0], ow[1], ow[2], ow[3]}; op[1] = (v4u){ow[4], ow[5], ow[6], ow[7]};
        }
        __syncthreads();
        cur = nxt;
    }
}

__device__ __forceinline__ void p3a_mixer(Frame& F) {
    for (int u = F.vcu; u < 256; u += F.G) swa_unit(F, u);
    for (int q = F.vcu; q < 256; q += F.G) gla_g1_units(F, q * 8, 8);
}
__device__ __forceinline__ void p3c_mixer(Frame& F) {
    for (int q = F.vcu; q < 256; q += F.G) gla_g3_units(F, q * 8, 8);
}

__device__ __forceinline__ unsigned f2s(float f) { const unsigned u = __builtin_bit_cast(unsigned, f); return (u & 0x80000000u) ? ~u : (u | 0x80000000u); }
__device__ __forceinline__ float s2f(unsigned s) { const unsigned u = (s & 0x80000000u) ? (s & 0x7fffffffu) : ~s; return __builtin_bit_cast(float, u); }
#define TOPK_INSERT(list, xin) do { unsigned _x = (xin); _Pragma("unroll") for (int _p = 0; _p < 16; ++_p) { const unsigned _hi = list[_p] > _x ? list[_p] : _x; _x = list[_p] > _x ? _x : list[_p]; list[_p] = _hi; } } while (0)

__device__ __forceinline__ void cas_desc(unsigned& hi, unsigned& lo) { const unsigned a = hi > lo ? hi : lo, b = hi > lo ? lo : hi; hi = a; lo = b; }
__device__ __forceinline__ void bitonic_merge16_desc(unsigned (&a)[16]) {
#pragma unroll
    for (int j = 8; j > 0; j >>= 1)
#pragma unroll
        for (int i = 0; i < 16; ++i) { const int l = i ^ j; if (l > i) cas_desc(a[i], a[l]); }
}
__device__ __forceinline__ void sort16_desc(unsigned (&a)[16]) {
#pragma unroll
    for (int k = 2; k <= 16; k <<= 1)
#pragma unroll
        for (int j = k >> 1; j > 0; j >>= 1)
#pragma unroll
            for (int i = 0; i < 16; ++i) { const int l = i ^ j; if (l > i) { if (((i & k) == 0) || k == 16) cas_desc(a[i], a[l]); else cas_desc(a[l], a[i]); } }
}
__device__ __forceinline__ void top16_merge_desc(unsigned (&a)[16], const unsigned (&b)[16]) {
#pragma unroll
    for (int i = 0; i < 16; ++i) a[i] = a[i] > b[15 - i] ? a[i] : b[15 - i];
    bitonic_merge16_desc(a);
}
template <int MODE  > __device__ __forceinline__ void p7_topk(Frame& F) {
    const int tid = F.tid, lane = F.lane, wave = F.wave;
    LAS unsigned char* KY = F.lds;
    LAS unsigned* SC = (LAS unsigned*)(F.lds + 69632 + wave * 4096);
#pragma unroll
    for (int j = 0; j < 16; ++j) { const int i4 = j * 512 + tid, hf = i4 >> 12, key = (i4 >> 5) & 127, q4 = i4 & 31;
        const f32x4 v = *(const GAS f32x4*)((hf ? F.keys2 : F.keys1) + key * 128 + 4 * q4);
        *(LAS v2u*)(KY + hf * 34816 + key * 272 + q4 * 8) = (v2u){pk2(v[0], v[1]), pk2(v[2], v[3])}; }
    __syncthreads();
    const int gw = F.vcu * NWAVES + wave, NGW = F.G * NWAVES;
    const int r = lane & 31, h = lane >> 5;
    for (int task = gw; task < 256 * 8; task += NGW) {
        const int tile = task >> 3, hd = task & 7, tok = tile * 32 + r;
        for (int hf = 0; hf < 2; ++hf) {
            const GAS v4u* qr = (const GAS v4u*)(F.QPEER + (size_t)tok * PEER_N + hd * 256 + hf * 128);
            bf16x8 qf[8];
#pragma unroll
            for (int kk = 0; kk < 8; ++kk) qf[kk] = __builtin_bit_cast(bf16x8, qr[2 * kk + h]);
            unsigned list[16];
#pragma unroll
            for (int T = 0; T < 4; ++T) {
                f32x16 a = {0.f, 0.f, 0.f, 0.f, 0.f, 0.f, 0.f, 0.f, 0.f, 0.f, 0.f, 0.f, 0.f, 0.f, 0.f, 0.f};
#pragma unroll
                for (int kk = 0; kk < 8; ++kk) { const bf16x8 kf = *(const LAS bf16x8*)(KY + hf * 34816 + (32 * T + r) * 272 + (16 * kk + 8 * h) * 2); a = mfma32(kf, qf[kk], a); }
                unsigned tl[16];
#pragma unroll
                for (int i = 0; i < 16; ++i) { const int key = 32 * T + (i & 3) + 8 * (i >> 2) + 4 * h; tl[i] = (f2s(a[i]) & ~127u) | (unsigned)(127 - key); }
                sort16_desc(tl);
                if (T == 0) {
#pragma unroll
                    for (int i = 0; i < 16; ++i) list[i] = tl[i];
                } else top16_merge_desc(list, tl);
            }
            unsigned other[16];
#pragma unroll
            for (int p = 0; p < 16; ++p) other[p] = (unsigned)__shfl_xor((int)list[p], 32);
            top16_merge_desc(list, other);
            if (h == 0) {
#pragma unroll
                for (int p = 0; p < 16; ++p) SC[(hf * 16 + p) * 32 + r] = list[p]; }
        }
        LDS_WAIT(); asm volatile("" ::: "memory");
        float v1[16], v2[16];
#pragma unroll
        for (int p = 0; p < 16; ++p) { v1[p] = s2f(SC[p * 32 + r] & ~127u); v2[p] = s2f(SC[(16 + p) * 32 + r] & ~127u); }
#define P7_CAND(i, j) ((f2s(v1[i] + v2[j]) & ~255u) | (unsigned)(255 - ((i) * 16 + (j))))
        unsigned cl[16], cb[16], cc[16], cd[16];
#pragma unroll
        for (int j = 0; j < 16; ++j) { cl[j] = P7_CAND(0, j); cb[j] = j < 8 ? P7_CAND(1, j < 8 ? j : 0) : 0u; }
        cc[0] = P7_CAND(2, 0); cc[1] = P7_CAND(2, 1); cc[2] = P7_CAND(2, 2); cc[3] = P7_CAND(2, 3); cc[4] = P7_CAND(2, 4);
        cc[5] = P7_CAND(3, 0); cc[6] = P7_CAND(3, 1); cc[7] = P7_CAND(3, 2); cc[8] = P7_CAND(3, 3);
        cc[9] = P7_CAND(4, 0); cc[10] = P7_CAND(4, 1); cc[11] = P7_CAND(4, 2);
        cc[12] = P7_CAND(5, 0); cc[13] = P7_CAND(5, 1); cc[14] = P7_CAND(6, 0); cc[15] = P7_CAND(6, 1);
        cd[0] = P7_CAND(7, 0); cd[1] = P7_CAND(7, 1);
#pragma unroll
        for (int i = 8; i < 16; ++i) cd[i - 6] = P7_CAND(i, 0);
#pragma unroll
        for (int i = 10; i < 16; ++i) cd[i] = 0u;
#undef P7_CAND
        sort16_desc(cc); sort16_desc(cd);
        top16_merge_desc(cl, cb); top16_merge_desc(cc, cd); top16_merge_desc(cl, cc);
        float val[8]; int eidx[8]; float mx = -INFINITY;
#pragma unroll
        for (int p = 0; p < 16; ++p) { const int pos = 255 - (int)(cl[p] & 255u), i = pos >> 4, j = pos & 15;
            const unsigned a = SC[i * 32 + r], b2 = SC[(16 + j) * 32 + r];
            const float v = s2f(a & ~127u) + s2f(b2 & ~127u); mx = fmaxf(mx, v);
            if ((p >> 3) == h) { val[p & 7] = v; eidx[p & 7] = (127 - (int)(a & 127u)) * 128 + (127 - (int)(b2 & 127u)); } }
        float sum = 0.f, ex[8];
#pragma unroll
        for (int p = 0; p < 8; ++p) { ex[p] = __expf(val[p] - mx); sum += ex[p]; }
        sum += __shfl_xor(sum, 32);
        const float inv = 1.0f / sum;
        const int p4a = hd * 4 + 2 * h;
        GAS v4u* ip = (GAS v4u*)F.EIDX; GAS f32x4* gp = (GAS f32x4*)F.GATEQ;
        ip[(size_t)p4a * NTOK + tok] = (v4u){(unsigned)eidx[0], (unsigned)eidx[1], (unsigned)eidx[2], (unsigned)eidx[3]}; ip[(size_t)(p4a + 1) * NTOK + tok] = (v4u){(unsigned)eidx[4], (unsigned)eidx[5], (unsigned)eidx[6], (unsigned)eidx[7]};
        ((GAS v4u*)F.EIDX16)[(size_t)(hd * 2 + h) * NTOK + tok] = (v4u){(unsigned)eidx[0] | ((unsigned)eidx[1] << 16), (unsigned)eidx[2] | ((unsigned)eidx[3] << 16), (unsigned)eidx[4] | ((unsigned)eidx[5] << 16), (unsigned)eidx[6] | ((unsigned)eidx[7] << 16)};
        gp[(size_t)p4a * NTOK + tok] = (f32x4){ex[0] * inv, ex[1] * inv, ex[2] * inv, ex[3] * inv}; gp[(size_t)(p4a + 1) * NTOK + tok] = (f32x4){ex[4] * inv, ex[5] * inv, ex[6] * inv, ex[7] * inv};
        LDS_WAIT(); asm volatile("" ::: "memory");
    }
}

typedef int i32x4 __attribute__((ext_vector_type(4)));
__device__ __forceinline__ void lds_fill_128k(Frame& F, const unsigned char* src, int rot) {
    const unsigned long long g = (unsigned long long)src; const unsigned lo = __builtin_amdgcn_readfirstlane((unsigned)g), hi = __builtin_amdgcn_readfirstlane((unsigned)(g >> 32));
    const unsigned char* sb = (const unsigned char*)(((unsigned long long)hi << 32) | lo);
    const unsigned voff = (unsigned)F.tid * 16u; const int r8 = __builtin_amdgcn_readfirstlane(rot) & 15;
#pragma unroll
    for (int i = 0; i < 16; ++i) { const int ii = (i + r8) & 15;
        __builtin_amdgcn_global_load_lds((const unsigned*)(sb + (size_t)ii * 8192 + voff), (LAS unsigned*)(F.lds + ii * 8192 + F.wave * 1024), 16, 0, 0); }
}
constexpr int P8_YB = 132096;
constexpr int P8_DUMMY = 140288;
#define P8_WAITV0() asm volatile("s_waitcnt vmcnt(0)" ::: "memory")
#define P8_BAR() do { asm volatile("s_waitcnt lgkmcnt(0)" ::: "memory"); __builtin_amdgcn_s_barrier(); asm volatile("" ::: "memory"); } while (0)
__device__ __forceinline__ void p8a_sddmm(Frame& F) {
    const int wv = F.wave;
    for (int u = F.vcu; u < 256; u += F.G) {
        const int tg = u & 15, dr = u >> 4, t = tg * 512 + F.tid;
        unsigned id[64];
#pragma unroll
        for (int p8 = 0; p8 < 16; ++p8) { const v4u v = ((const GAS v4u*)F.EIDX16)[(size_t)p8 * NTOK + t]; id[4 * p8] = v.x; id[4 * p8 + 1] = v.y; id[4 * p8 + 2] = v.z; id[4 * p8 + 3] = v.w; }
        int acc[128];
#pragma unroll
        for (int p = 0; p < 128; ++p) acc[p] = 0;
        const unsigned char* tab = F.DC8 + (size_t)(dr * 32) * 131072;
        const unsigned char* ysrc = F.YC8 + ((size_t)(dr * 32) * NTOK + tg * 512) * 8 + (wv & 3) * 1024 + F.lane * 16;
        for (int sl = 0; sl < 32; ++sl) {
#pragma unroll
            for (int i = 0; i < 64; ++i) asm volatile("" : "+v"(id[i]));
            P8_WAITV0();
            P8_BAR();
            lds_fill_128k(F, tab + (size_t)sl * 131072, tg);
            if (wv < 4) __builtin_amdgcn_global_load_lds((const unsigned*)(ysrc + (size_t)sl * NTOK * 8), (LAS unsigned*)(F.lds + P8_YB + wv * 1024), 16, 0, 0);
            P8_WAITV0();
            P8_BAR();
            if (sl + 1 < 32) __builtin_amdgcn_global_load_lds((const unsigned*)(tab + (size_t)(sl + 1) * 131072 + (size_t)tg * 8192 + wv * 1024 + F.lane * 16), (LAS unsigned*)(F.lds + P8_DUMMY + wv * 1024), 16, 0, 0);
            const v2u yv = *(const LAS v2u*)(F.lds + P8_YB + F.tid * 8);
            v2u dA[8], dB[8];
#define P8A_OFF(p) (((p) & 1) ? ((id[(p) >> 1] >> 13) & 0x7fff8u) : ((id[(p) >> 1] << 3) & 0x7fff8u))
#define P8A_LOAD(dst, pb) do { _Pragma("unroll") for (int j_ = 0; j_ < 8; ++j_) asm volatile("ds_read_b64 %0, %1" : "=v"(dst[j_]) : "v"(P8A_OFF((pb) + j_))); } while (0)
#define P8A_DOT(src, pb) do { _Pragma("unroll") for (int j_ = 0; j_ < 8; ++j_) { acc[(pb) + j_] = __builtin_amdgcn_sdot4((int)src[j_].x, (int)yv.x, acc[(pb) + j_], false); acc[(pb) + j_] = __builtin_amdgcn_sdot4((int)src[j_].y, (int)yv.y, acc[(pb) + j_], false); } \
                _Pragma("unroll") for (int j_ = 0; j_ < 8; ++j_) asm volatile("" : "+v"(acc[(pb) + j_])); } while (0)
            asm volatile("s_waitcnt lgkmcnt(0)" ::: "memory"); __builtin_amdgcn_sched_barrier(0);
            P8A_LOAD(dA, 0);
#pragma unroll
            for (int pb = 0; pb < 128; pb += 16) {
                P8A_LOAD(dB, pb + 8);
                asm volatile("s_waitcnt lgkmcnt(8)" ::: "memory"); __builtin_amdgcn_sched_barrier(0);
                P8A_DOT(dA, pb);
                __builtin_amdgcn_sched_barrier(0);
                if (pb + 16 < 128) { P8A_LOAD(dA, pb + 16); asm volatile("s_waitcnt lgkmcnt(8)" ::: "memory"); } else asm volatile("s_waitcnt lgkmcnt(0)" ::: "memory");
                __builtin_amdgcn_sched_barrier(0);
                P8A_DOT(dB, pb + 8);
                __builtin_amdgcn_sched_barrier(0);
            }
#undef P8A_OFF
#undef P8A_LOAD
#undef P8A_DOT
        }
#pragma unroll
        for (int p4 = 0; p4 < 32; ++p4) ((GAS i32x4*)F.ZP)[((size_t)(dr * 32 + p4)) * NTOK + t] = (i32x4){acc[4 * p4], acc[4 * p4 + 1], acc[4 * p4 + 2], acc[4 * p4 + 3]};
    }
    P8_WAITV0();
    __syncthreads();
}
__device__ __forceinline__ void p8h_gate(Frame& F) {
    const size_t gt = (size_t)F.vcu * 512 + F.tid, NT = (size_t)F.G * 512;
    for (size_t i = gt; i < (size_t)32 * NTOK; i += NT) {
        const int p4 = (int)(i >> 13), t = (int)(i & (NTOK - 1));
        i32x4 z = {0, 0, 0, 0};
#pragma unroll
        for (int dr = 0; dr < 16; ++dr) z += ((const GAS i32x4*)F.ZP)[((size_t)(dr * 32 + p4)) * NTOK + t];
        const v4u e4 = ((const GAS v4u*)F.EIDX)[i]; const f32x4 g4 = ((const GAS f32x4*)F.GATEQ)[i]; const float ys = F.YSC[t];
        f32x4 hf; float mx = 0.f;
#pragma unroll
        for (int c = 0; c < 4; ++c) { const float zz = (float)z[c] * ys * F.DSC[e4[c]]; hf[c] = 0.5f * zz * (1.0f + erff(zz * 0.70710678118654752f)) * g4[c] * F.USC[e4[c]]; mx = fmaxf(mx, fabsf(hf[c])); }
        ((GAS f32x4*)F.HF)[i] = hf;
        atomicMax(F.TMAX + t, __builtin_bit_cast(unsigned, mx));
    }
}
__device__ __forceinline__ void tr4(unsigned a0, unsigned a1, unsigned a2, unsigned a3, unsigned (&T)[4]) {
    const unsigned t0 = __builtin_amdgcn_perm(a1, a0, 0x05010400u), t1 = __builtin_amdgcn_perm(a1, a0, 0x07030602u);
    const unsigned t2 = __builtin_amdgcn_perm(a3, a2, 0x05010400u), t3 = __builtin_amdgcn_perm(a3, a2, 0x07030602u);
    T[0] = __builtin_amdgcn_perm(t2, t0, 0x05040100u); T[1] = __builtin_amdgcn_perm(t2, t0, 0x07060302u);
    T[2] = __builtin_amdgcn_perm(t3, t1, 0x05040100u); T[3] = __builtin_amdgcn_perm(t3, t1, 0x07060302u);
}
template <int MODE  > __device__ __forceinline__ void p8b_spmm(Frame& F, float* dst) {
    for (int u = F.vcu; u < 256; u += F.G) {
        const int tg = u & 15, sr = u >> 4, t = tg * 512 + F.tid, b = t >> 11;
        unsigned id[64], hq[32];
#pragma unroll
        for (int p8 = 0; p8 < 16; ++p8) { const v4u v = ((const GAS v4u*)F.EIDX16)[(size_t)p8 * NTOK + t]; id[4 * p8] = v.x; id[4 * p8 + 1] = v.y; id[4 * p8 + 2] = v.z; id[4 * p8 + 3] = v.w; }
        const float smax = __builtin_bit_cast(float, F.TMAX[t]);
        const float qinv = smax > 0.f ? 127.0f / smax : 0.f, oscale = smax * (1.0f / 127.0f);
#pragma unroll
        for (int p4 = 0; p4 < 32; ++p4) { const f32x4 hv = ((const GAS f32x4*)F.HF)[(size_t)p4 * NTOK + t]; hq[p4] = pack4i(hv[0] * qinv, hv[1] * qinv, hv[2] * qinv, hv[3] * qinv); }
        const bf16* xrow = F.X1 + (size_t)t * DM; float* orow = dst + (size_t)t * DM; const float* g2 = F.MOD + b * NMOD + 5 * DM;
        LAS f32x4* G2L = (LAS f32x4*)(F.lds + P8_YB);
        P8_BAR();
        if (F.tid < 64) G2L[F.tid] = ((const GAS f32x4*)(g2 + sr * 256))[F.tid];
        v4u xw[4], xn[4];
#pragma unroll
        for (int k = 0; k < 4; ++k) xw[k] = *(const GAS v4u*)(xrow + sr * 256 + 8 * k);
#pragma unroll
        for (int k = 0; k < 4; ++k) xn[k] = xw[k];
        for (int sg = 0; sg < 8; ++sg) {
            int acc[4][8];
#pragma unroll
            for (int k = 0; k < 4; ++k) {
                const int s = sr * 32 + sg * 4 + k;
#pragma unroll
                for (int i = 0; i < 64; ++i) asm volatile("" : "+v"(id[i]));
                P8_WAITV0();
                P8_BAR();
                if (MODE != 1) lds_fill_128k(F, F.UC8 + (size_t)s * 131072, tg);
                P8_WAITV0();
                P8_BAR();
                if (MODE != 1 && (sg * 4 + k) + 1 < 32) __builtin_amdgcn_global_load_lds((const unsigned*)(F.UC8 + (size_t)(s + 1) * 131072 + (size_t)tg * 8192 + F.wave * 1024 + F.lane * 16), (LAS unsigned*)(F.lds + P8_DUMMY + F.wave * 1024), 16, 0, 0);
                if (k == 3 && sg + 1 < 8) {
#pragma unroll
                    for (int kk = 0; kk < 4; ++kk) xn[kk] = *(const GAS v4u*)(xrow + (sr * 32 + (sg + 1) * 4) * 8 + 8 * kk); }
#pragma unroll
                for (int c = 0; c < 8; ++c) acc[k][c] = 0;
                v2u wA[8], wB[8];
#define P8B_OFF(p) (((p) & 1) ? ((id[(p) >> 1] >> 13) & 0x7fff8u) : ((id[(p) >> 1] << 3) & 0x7fff8u))
#define P8B_LOAD(dst_, pb) do { _Pragma("unroll") for (int j_ = 0; j_ < 8; ++j_) asm volatile("ds_read_b64 %0, %1" : "=v"(dst_[j_]) : "v"(P8B_OFF((pb) + j_))); } while (0)
#define P8B_DOT(src, pb) do { _Pragma("unroll") for (int g_ = 0; g_ < 2; ++g_) { unsigned TL[4], TH[4]; \
                    tr4(src[4 * g_].x, src[4 * g_ + 1].x, src[4 * g_ + 2].x, src[4 * g_ + 3].x, TL); tr4(src[4 * g_].y, src[4 * g_ + 1].y, src[4 * g_ + 2].y, src[4 * g_ + 3].y, TH); \
                    const int hq_ = (int)hq[((pb) >> 2) + g_]; \
                    _Pragma("unroll") for (int c_ = 0; c_ < 4; ++c_) { acc[k][c_] = __builtin_amdgcn_sdot4((int)TL[c_], hq_, acc[k][c_], false); acc[k][4 + c_] = __builtin_amdgcn_sdot4((int)TH[c_], hq_, acc[k][4 + c_], false); } } \
                    _Pragma("unroll") for (int c_ = 0; c_ < 8; ++c_) asm volatile("" : "+v"(acc[k][c_])); } while (0)
                constexpr int NP = (MODE == 2 ? 16 : 128);
                asm volatile("s_waitcnt lgkmcnt(0)" ::: "memory"); __builtin_amdgcn_sched_barrier(0);
                P8B_LOAD(wA, 0);
#pragma unroll
                for (int pb = 0; pb < NP; pb += 16) {
                    P8B_LOAD(wB, pb + 8);
                    asm volatile("s_waitcnt lgkmcnt(8)" ::: "memory"); __builtin_amdgcn_sched_barrier(0);
                    P8B_DOT(wA, pb);
                    __builtin_amdgcn_sched_barrier(0);
                    if (pb + 16 < NP) { P8B_LOAD(wA, pb + 16); asm volatile("s_waitcnt lgkmcnt(8)" ::: "memory"); } else asm volatile("s_waitcnt lgkmcnt(0)" ::: "memory");
                    __builtin_amdgcn_sched_barrier(0);
                    P8B_DOT(wB, pb + 8);
                    __builtin_amdgcn_sched_barrier(0);
                }
#undef P8B_OFF
#undef P8B_LOAD
#undef P8B_DOT
            }
            const int c0 = (sr * 32 + sg * 4) * 8;
#pragma unroll
            for (int k = 0; k < 4; ++k) {
                const v4u xv = xw[k]; const f32x4 xa = {bflo(xv.x), bfhi(xv.x), bflo(xv.y), bfhi(xv.y)}, xb = {bflo(xv.z), bfhi(xv.z), bflo(xv.w), bfhi(xv.w)};
                const f32x4 ga = G2L[sg * 8 + 2 * k] * oscale, gb = G2L[sg * 8 + 2 * k + 1] * oscale;
                *(GAS f32x4*)(orow + c0 + 8 * k) = (f32x4){xa[0] + ga[0] * (float)acc[k][0], xa[1] + ga[1] * (float)acc[k][1], xa[2] + ga[2] * (float)acc[k][2], xa[3] + ga[3] * (float)acc[k][3]};
                *(GAS f32x4*)(orow + c0 + 8 * k + 4) = (f32x4){xb[0] + gb[0] * (float)acc[k][4], xb[1] + gb[1] * (float)acc[k][5], xb[2] + gb[2] * (float)acc[k][6], xb[3] + gb[3] * (float)acc[k][7]};
            }
#pragma unroll
            for (int k = 0; k < 4; ++k) xw[k] = xn[k];
        }
    }
    P8_WAITV0();
    __syncthreads();
}

struct Args { const float* in[18]; float* out; unsigned char* ws; int ph_lo, ph_hi; };
__global__ void __launch_bounds__(NWAVES * 64, 2) mega_fwd(Args args) {
    extern __shared__ __attribute__((aligned(16))) unsigned char lds[];
    Frame F;
    F.lds = (LAS unsigned char*)lds;
    F.MISC = (volatile LAS unsigned*)(F.lds + MISC_OFF);
    F.tid = threadIdx.x; F.lane = F.tid & 63; F.wave = __builtin_amdgcn_readfirstlane(F.tid >> 6);
    F.G = gridDim.x; { const int bx = blockIdx.x; F.vcu = (F.G % 8 == 0) ? (bx % 8) * (F.G / 8) + bx / 8 : bx; }
    unsigned char* ws = args.ws;
    F.ctl = (unsigned*)(ws + WS_CTL);
    F.x = args.in[0]; F.c = args.in[1]; F.w_ada = args.in[2]; F.b_ada = args.in[3]; F.w_in = args.in[4]; F.w_gate_up = args.in[5]; F.b_gla_gate = args.in[6]; F.gla_out_norm = args.in[7];
    F.swa_q_norm = args.in[8]; F.swa_k_norm = args.in[9]; F.swa_sinks = args.in[10]; F.swa_out_norm = args.in[11]; F.w_out = args.in[12]; F.w_peer_q = args.in[13];
    F.keys1 = args.in[14]; F.keys2 = args.in[15]; F.edown = args.in[16]; F.eup = args.in[17];
    F.out = args.out; F.ws = ws;
    F.MOD = (float*)(ws + WS_MOD); F.ROPE = (float*)(ws + WS_ROPE);
    F.BTIN = (bf16*)(ws + WS_BTIN); F.BTOUT = (bf16*)(ws + WS_BTOUT); F.BTQ = (bf16*)(ws + WS_BTQ); F.HBUF = (bf16*)(ws + WS_HBUF); F.PROJ = (bf16*)(ws + WS_PROJ);
    F.MIXIN = (bf16*)(ws + WS_MIXIN); F.QPEER = (bf16*)(ws + WS_QPEER);
    F.DC8 = ws + WS_DC8; F.UC8 = ws + WS_UC8; F.YC8 = ws + WS_YC8; F.ZP = (int*)(ws + WS_ZP); F.EIDX = (unsigned*)(ws + WS_EIDX); F.HE = (unsigned*)(ws + WS_HE);
    F.EIDX16 = (unsigned*)(ws + WS_EIDX16);
    F.GQT = (bf16*)(ws + WS_QPEER); F.GST = (bf16*)(ws + WS_YC8); F.GUT = (float*)(ws + WS_ZP); F.GG = (float*)(ws + WS_IDX); F.X1 = (bf16*)(ws + WS_PROJ);   F.GATEQ = (float*)(ws + WS_GATEQ); F.DSC = (float*)(ws + WS_DSC); F.USC = (float*)(ws + WS_DSC + 131072); F.HF = (float*)(ws + WS_HE); F.TMAX = (unsigned*)(ws + WS_CTL + 524288);     F.YSC = (float*)(ws + WS_YSC);
    for (int u = F.tid; u < (LDS_BYTES - LDSCTL_OFF) / 4; u += NWAVES * 64) ((LAS unsigned*)(F.lds + LDSCTL_OFF))[u] = 0u;
    __syncthreads();
    XcdBarrier bar; bar.bar = F.ctl + CW_BAR; bar.x = 0; bar.st = nullptr;
    if (N_LAUNCHES == 1) bar = xcd_barrier_post(F.ctl + CW_BAR, F.MISC + 8);
#define GRID_BAR() do { if (N_LAUNCHES == 1) xcd_barrier(bar); } while (0)
    const int lo = args.ph_lo, hi = args.ph_hi;
#define IN(k) (lo <= (k) && (k) < hi)
#define BOTH(k) (IN(k) && IN((k) + 1))

    if (PROBE_REP_PHASE == 20 && IN(0)) { p0a_ada(F); GRID_BAR(); }
    if (PROBE_REP_PHASE == 21 && IN(0)) { p0b_weights(F); GRID_BAR(); }
    if (PROBE_REP_PHASE == 22 && IN(0)) { p0c_tables(F); GRID_BAR(); }
    for (int rep_ = 0; rep_ < (PROBE_REP_PHASE == 0 ? 2 : 1); ++rep_) if (IN(0)) { p0_prologue(F); if (BOTH(0)) GRID_BAR(); }
    for (int rep_ = 0; rep_ < (PROBE_REP_PHASE == 1 ? 2 : 1); ++rep_) if (IN(1)) { modulate_rows(F, F.x, F.HBUF, 0, DM); if (BOTH(1)) GRID_BAR(); }
    for (int rep_ = 0; rep_ < (PROBE_REP_PHASE == 2 ? 2 : 1); ++rep_) if (IN(2)) {
        pg8::Gemm g{F.HBUF, F.BTIN, NTOK, NPROJ, DM}; pg8::StaticOrder S; S.init(NTOK, NPROJ, F.G, (int)blockIdx.x);
        pg8::EpiBf16 E{F.PROJ, NPROJ};
        pg8::gemm_phase<pg8::EpiBf16, pg8::StaticOrder, true, true>(F.lds, g, S, E);
        {
            const int G = F.G, rem = GEMM1_UNITS % G, tg = tail_groups(G), nidle = G - rem;
            if (rem != 0 && (int)blockIdx.x >= rem) convert_expert_groups(F, (int)blockIdx.x - rem, tg, nidle);
        }
        if (BOTH(2)) GRID_BAR();
    }
    for (int rep_ = 0; rep_ < (PROBE_REP_PHASE == 3 ? 2 : 1); ++rep_) if (IN(3)) { p3a_mixer(F); GRID_BAR(); gla_scan(F); GRID_BAR(); p3c_mixer(F); if (BOTH(3)) GRID_BAR(); }
    for (int rep_ = 0; rep_ < (PROBE_REP_PHASE == 4 ? 2 : 1); ++rep_) if (IN(4)) {
        pg8::Gemm g{F.MIXIN, F.BTOUT, NTOK, DM, DM}; pg8::StaticOrder S; S.init(NTOK, DM, F.G, (int)blockIdx.x);
        pg8::EpiResid E{F.x, F.X1, DM, F.MOD + 2 * DM, NMOD, SEQ / 256};
        pg8::gemm_phase<pg8::EpiResid, pg8::StaticOrder, true, true>(F.lds, g, S, E);
        if (BOTH(4)) GRID_BAR();
    }
    for (int rep_ = 0; rep_ < (PROBE_REP_PHASE == 5 ? 2 : 1); ++rep_) if (IN(5)) { p5_modulate_quant(F); if (BOTH(5)) GRID_BAR(); }
    for (int rep_ = 0; rep_ < (PROBE_REP_PHASE == 6 ? 2 : 1); ++rep_) if (IN(6)) {
        pg8::Gemm g{F.HBUF, F.BTQ, NTOK, PEER_N, DM}; pg8::StaticOrder S; S.init(NTOK, PEER_N, F.G, (int)blockIdx.x);
        pg8::EpiBf16 E{F.QPEER, PEER_N};
        pg8::gemm_phase<pg8::EpiBf16, pg8::StaticOrder, true, true>(F.lds, g, S, E);
        if (BOTH(6)) GRID_BAR();
    }
    if (PROBE_REP_PHASE == 41 && IN(7)) { p7_topk<1>(F); GRID_BAR(); }
    if (PROBE_REP_PHASE == 42 && IN(7)) { p7_topk<2>(F); GRID_BAR(); }
    for (int rep_ = 0; rep_ < (PROBE_REP_PHASE == 7 ? 2 : 1); ++rep_) if (IN(7)) { p7_topk<0>(F); if (BOTH(7)) GRID_BAR(); }
    for (int rep_ = 0; rep_ < (PROBE_REP_PHASE == 8 ? 2 : 1); ++rep_) if (IN(8)) { p8a_sddmm(F); if (BOTH(8)) GRID_BAR(); }
    for (int rep_ = 0; rep_ < (PROBE_REP_PHASE == 9 ? 2 : 1); ++rep_) if (IN(9)) { p8h_gate(F); if (BOTH(9)) GRID_BAR(); }
    if (PROBE_REP_PHASE == 10 && IN(10)) { p8b_spmm<0>(F, (float*)(F.ws + WS_BTIN)); GRID_BAR(); }
    if (PROBE_REP_PHASE == 11 && IN(10)) { p8b_spmm<1>(F, (float*)F.PROJ); GRID_BAR(); }
    if (PROBE_REP_PHASE == 12 && IN(10)) { p8b_spmm<2>(F, (float*)F.PROJ); GRID_BAR(); }
    if (IN(10)) { p8b_spmm<0>(F, F.out); }
#undef IN
#undef BOTH
}

extern "C" void kernel_launch(void* const* d_in, const int* in_sizes, int n_in, void* d_out, int out_size, void* d_ws, size_t ws_size, hipStream_t stream) {
    static int grid = 0;
    if (grid == 0) {
        if (n_in != 18 || out_size != NTOK * DM || ws_size < WS_END) { fprintf(stderr, "kernel_launch: unexpected shapes (n_in %d, out %d, ws %zu); nothing launched\n", n_in, out_size, ws_size); grid = -1; return; }
        int dev = 0, cus = 0, per_cu = 0;
        if (hipGetDevice(&dev) != hipSuccess || hipDeviceGetAttribute(&cus, hipDeviceAttributeMultiprocessorCount, dev) != hipSuccess) { grid = -1; return; }
        if (hipFuncSetAttribute((const void*)mega_fwd, hipFuncAttributeMaxDynamicSharedMemorySize, LDS_BYTES) != hipSuccess) { fprintf(stderr, "kernel_launch: hipFuncSetAttribute failed\n"); grid = -1; return; }
        if (hipOccupancyMaxActiveBlocksPerMultiprocessor(&per_cu, (const void*)mega_fwd, NWAVES * 64, LDS_BYTES) != hipSuccess || per_cu < 1)
            fprintf(stderr, "kernel_launch: note: occupancy query reports %d workgroups per CU\n", per_cu);
        (void)hipGetLastError();
        grid = cus;
    }
    if (grid < 0) return;
    (void)hipMemsetAsync((char*)d_ws + WS_CTL, 0, CTL_ZERO_BYTES, stream);
    Args a{};
    for (int i = 0; i < 18; ++i) a.in[i] = (const float*)d_in[i];
    a.out = (float*)d_out; a.ws = (unsigned char*)d_ws;
    if (N_LAUNCHES == 1) { a.ph_lo = 0; a.ph_hi = NPHASE; hipLaunchKernelGGL(mega_fwd, dim3(grid), dim3(NWAVES * 64), LDS_BYTES, stream, a); }
    else for (int p = 0; p < NPHASE; ++p) { a.ph_lo = p; a.ph_hi = p + 1; hipLaunchKernelGGL(mega_fwd, dim3(grid), dim3(NWAVES * 64), LDS_BYTES, stream, a); }
}
```

```cpp
#include <hip/hip_runtime.h>
#include <cstdio>
#include <cstdint>

#ifndef MK_N_LAUNCHES
#define MK_N_LAUNCHES 1
#endif
#ifndef PROBE_REP_PHASE
#define PROBE_REP_PHASE -1
#endif

#define GAS __attribute__((address_space(1)))
#define LAS __attribute__((address_space(3)))
typedef unsigned short bf16;
typedef unsigned v4u __attribute__((ext_vector_type(4)));
typedef unsigned v2u __attribute__((ext_vector_type(2)));
typedef float f32x4 __attribute__((ext_vector_type(4)));
typedef float f32x2 __attribute__((ext_vector_type(2)));
typedef float f32x16 __attribute__((ext_vector_type(16)));
typedef short bf16x8 __attribute__((ext_vector_type(8)));
using bf16x2 = __attribute__((ext_vector_type(2))) __bf16;

namespace pg8 {
#define PG8_LAS __attribute__((address_space(3)))
typedef unsigned short bf16_t;
typedef short bf16x8 __attribute__((ext_vector_type(8)));
typedef float f32x4 __attribute__((ext_vector_type(4)));
typedef unsigned u32x4 __attribute__((ext_vector_type(4)));
constexpr int BM = 256, BK = 64, HALF = 128, HTB = HALF * BK * 2, STAGE_BYTES = 8 * HTB, NXCD = 8, WGM = 8;

__host__ __device__ __forceinline__ int lds_byte(int r, int c) { const int st = (r >> 4) * 2 + (c >> 5), rr = r & 15, cc = c & 31, ob = rr * 64 + cc * 2; return st * 1024 + (ob ^ (((ob >> 9) & 1) << 5)); }
__host__ __device__ __forceinline__ void stage_rc(int b, int& R, int& C) { const int st = b / 1024, sb = b % 1024, swz = sb ^ (((sb >> 9) & 1) << 5); R = (st >> 1) * 16 + swz / 64; C = (st & 1) * 32 + (swz % 64) / 2; }
__host__ __device__ __forceinline__ int perm32(int rho) { const int n = rho >> 4, i = rho & 15; return 8 * (i >> 2) + 4 * n + (i & 3); }

struct Unit { int pm, pn; };
struct Gemm { const bf16_t* A; const bf16_t* Bt; int M, N, K; };

struct StaticOrder {
    int nM, nN, nwg, G, c;
    __host__ __device__ void init(int M, int N, int G_, int c_) { nM = M / BM; nN = N / BM; nwg = nM * nN; G = G_; c = c_; }
    __host__ __device__ bool next(int i, Unit& u) const {
        const long L = (long)i * G + c; if (L >= nwg) return false;
        int wgid = (int)L; { const int q = nwg / NXCD, r = nwg % NXCD, xcd = wgid % NXCD, off = wgid / NXCD; wgid = (xcd < r ? xcd * (q + 1) : r * (q + 1) + (xcd - r) * q) + off; }
        const int nig = WGM * nN, gid = wgid / nig, fm = gid * WGM, gsz = (nM - fm) < WGM ? (nM - fm) : WGM;
        u.pm = fm + ((wgid % nig) % gsz); u.pn = (wgid % nig) / gsz; return true;
    }
    __device__ __forceinline__ void a_ready(const Unit&) const {}
    __device__ __forceinline__ void done(const Unit&) const {}
};

__device__ __forceinline__ unsigned cvt_pk_bf16(float lo, float hi) { unsigned r; asm volatile("v_cvt_pk_bf16_f32 %0, %1, %2" : "=v"(r) : "v"(lo), "v"(hi)); return r; }

struct EpiBf16 {
    static constexpr bool PERM = true, AFTER_DRAIN = false;
    bf16_t* O; int ldc;
    __device__ __forceinline__ void operator()(const f32x4 (&acc)[2][2][4][2], const Unit& u, int wr, int wc, int fr, int fq) const {
        const int row0 = u.pm * BM + wr * 64 + fr; const int col0 = u.pn * BM + wc * 32 + 8 * fq;
#pragma unroll
        for (int ai = 0; ai < 2; ++ai)
#pragma unroll
            for (int m = 0; m < 4; ++m) { bf16_t* rowp = O + (size_t)(row0 + ai * HALF + m * 16) * ldc + col0;
#pragma unroll
                for (int bj = 0; bj < 2; ++bj) { const f32x4 v0 = acc[ai][bj][m][0], v1 = acc[ai][bj][m][1];
                    u32x4 w; w.x = cvt_pk_bf16(v0[0], v0[1]); w.y = cvt_pk_bf16(v0[2], v0[3]); w.z = cvt_pk_bf16(v1[0], v1[1]); w.w = cvt_pk_bf16(v1[2], v1[3]);
                    *(u32x4*)(rowp + bj * HALF) = w; } }
    }
};
struct EpiResid {
    static constexpr bool PERM = true, AFTER_DRAIN = false;
    const float* base; bf16_t* out; int ldc; const float* gate; int gate_stride; int tiles_per_batch;
    __device__ __forceinline__ void operator()(const f32x4 (&acc)[2][2][4][2], const Unit& u, int wr, int wc, int fr, int fq) const {
        const int row0 = u.pm * BM + wr * 64 + fr, col0 = u.pn * BM + wc * 32 + 8 * fq;
        const float* gp = gate + (size_t)(u.pm / tiles_per_batch) * gate_stride + col0;
        f32x4 gv[2][2];
#pragma unroll
        for (int bj = 0; bj < 2; ++bj)
#pragma unroll
            for (int n = 0; n < 2; ++n) gv[bj][n] = *(const f32x4*)(gp + bj * HALF + 4 * n);
#pragma unroll
        for (int ai = 0; ai < 2; ++ai)
#pragma unroll
            for (int m = 0; m < 4; ++m) { const size_t off = (size_t)(row0 + ai * HALF + m * 16) * ldc + col0;
#pragma unroll
                for (int bj = 0; bj < 2; ++bj) { const f32x4 b0 = *(const f32x4*)(base + off + bj * HALF), b1 = *(const f32x4*)(base + off + bj * HALF + 4);
                    const f32x4 v0 = b0 + gv[bj][0] * acc[ai][bj][m][0], v1 = b1 + gv[bj][1] * acc[ai][bj][m][1];
                    u32x4 w; w.x = cvt_pk_bf16(v0[0], v0[1]); w.y = cvt_pk_bf16(v0[2], v0[3]); w.z = cvt_pk_bf16(v1[0], v1[1]); w.w = cvt_pk_bf16(v1[2], v1[3]);
                    *(u32x4*)(out + off + bj * HALF) = w; } }
    }
};

template <class Epi, class Sched, bool ALIGN_EPI = false, bool SP2 = false>
__device__ __forceinline__ void gemm_phase(PG8_LAS unsigned char* lds, const Gemm g, const Sched& S, const Epi& E) {
    const int tid = threadIdx.x, wid = __builtin_amdgcn_readfirstlane(tid >> 6), lane = tid & 63, wr = wid >> 2, wc = wid & 3, fr = lane & 15, fq = lane >> 4;
    const int K = g.K, nt = K / BK;
    unsigned voffA[2], voffB[2];
#pragma unroll
    for (int i = 0; i < 2; ++i) { int R, C; stage_rc(tid * 16 + i * 8192, R, C); const int Rb = Epi::PERM ? ((R & ~31) + perm32(R & 31)) : R;
        voffA[i] = (unsigned)(R * K + C) * 2u; voffB[i] = (unsigned)(Rb * K + C) * 2u; }
    const size_t kstep = (size_t)(BK * 2);
    const size_t hstep = (size_t)HALF * K * 2;
    const size_t tstep = 2 * hstep;
    const unsigned ldsw = (unsigned)wid * 1024u;
    const int aoff = lds_byte(wr * 64 + fr, fq * 8), boff = lds_byte(wc * 32 + fr, fq * 8);
#define PG8_SA(b, h) (((b) * 2 + (h)) * HTB)
#define PG8_SB(b, h) ((4 + (b) * 2 + (h)) * HTB)
#define PG8_STAGE(bufoff, gbase, voff) do { const unsigned long long _g = (unsigned long long)(gbase); const unsigned _lo = __builtin_amdgcn_readfirstlane((unsigned)_g), _hi = __builtin_amdgcn_readfirstlane((unsigned)(_g >> 32)); \
        const char* _gb = (const char*)(((unsigned long long)_hi << 32) | _lo); _Pragma("unroll") for (int _i = 0; _i < 2; ++_i) \
        __builtin_amdgcn_global_load_lds((const unsigned*)(_gb + (size_t)_i * (size_t)(64 * K * 2) + (voff)[0]), (PG8_LAS unsigned*)(lds + (bufoff) + ldsw + _i * 8192), 16, 0, 0); } while (0)
#define PG8_LDA(dst, b, h) do { _Pragma("unroll") for (int m = 0; m < 4; ++m) _Pragma("unroll") for (int k = 0; k < 2; ++k) dst[m][k] = *(const PG8_LAS bf16x8*)(lds + PG8_SA(b, h) + aoff + m * 2048 + k * 1024); } while (0)
#define PG8_LDB(dst, b, h) do { _Pragma("unroll") for (int n = 0; n < 2; ++n) _Pragma("unroll") for (int k = 0; k < 2; ++k) dst[n][k] = *(const PG8_LAS bf16x8*)(lds + PG8_SB(b, h) + boff + n * 2048 + k * 1024); } while (0)
#define PG8_MMA(ai, bj, At, Bt) do { __builtin_amdgcn_s_setprio(1); _Pragma("unroll") for (int m = 0; m < 4; ++m) _Pragma("unroll") for (int n = 0; n < 2; ++n) _Pragma("unroll") for (int k = 0; k < 2; ++k) \
        acc[ai][bj][m][n] = __builtin_amdgcn_mfma_f32_16x16x32_bf16(Bt[n][k], At[m][k], acc[ai][bj][m][n], 0, 0, 0); __builtin_amdgcn_s_setprio(0); } while (0)
#define PG8_WAIT_V(n) asm volatile("s_waitcnt vmcnt(" #n ")" ::: "memory")
#define PG8_WAIT_L(n) asm volatile("s_waitcnt lgkmcnt(" #n ")" ::: "memory")
#define PG8_BAR __builtin_amdgcn_s_barrier()
#define PG8_SCHED __builtin_amdgcn_sched_barrier(0)
    Unit cur, nxt; int ui = 0;
    if (!S.next(0, cur)) return;
    f32x4 acc[2][2][4][2];
#pragma unroll
    for (int a = 0; a < 2; ++a)
#pragma unroll
        for (int b = 0; b < 2; ++b)
#pragma unroll
            for (int m = 0; m < 4; ++m)
#pragma unroll
                for (int n = 0; n < 2; ++n) acc[a][b][m][n] = (f32x4){0.f, 0.f, 0.f, 0.f};
    bf16x8 At[4][2], B0[2][2], B1[2][2];
    const char* cA = (const char*)g.A + (size_t)cur.pm * tstep; const char* cB = (const char*)g.Bt + (size_t)cur.pn * tstep;
    S.a_ready(cur);
    if constexpr (SP2) {
        PG8_STAGE(PG8_SB(0, 0), cB, voffB); PG8_STAGE(PG8_SB(0, 1), cB + hstep, voffB); PG8_STAGE(PG8_SA(0, 0), cA, voffA); PG8_STAGE(PG8_SA(0, 1), cA + hstep, voffA);
        if (wr == 1) PG8_BAR;
        PG8_WAIT_V(2); PG8_BAR;
        PG8_STAGE(PG8_SB(1, 0), cB + kstep, voffB); PG8_STAGE(PG8_SA(1, 0), cA + kstep, voffA); PG8_STAGE(PG8_SB(1, 1), cB + hstep + kstep, voffB);
        PG8_WAIT_V(6); PG8_BAR;
    } else {
        PG8_STAGE(PG8_SB(0, 0), cB, voffB); PG8_STAGE(PG8_SA(0, 0), cA, voffA); PG8_STAGE(PG8_SB(0, 1), cB + hstep, voffB); PG8_STAGE(PG8_SA(0, 1), cA + hstep, voffA);
        if (wr == 1) PG8_BAR;
        PG8_WAIT_V(4); PG8_BAR;
        PG8_STAGE(PG8_SB(1, 0), cB + kstep, voffB); PG8_STAGE(PG8_SA(1, 0), cA + kstep, voffA); PG8_STAGE(PG8_SB(1, 1), cB + hstep + kstep, voffB);
        PG8_WAIT_V(6); PG8_BAR;
    }
    for (;;) {
        const bool has_next = S.next(ui + 1, nxt);
        const char* nA = has_next ? (const char*)g.A + (size_t)nxt.pm * tstep : cA; const char* nB = has_next ? (const char*)g.Bt + (size_t)nxt.pn * tstep : cB;
        for (int t = 0; t < nt; t += 2) {
            const bool last = (t == nt - 2);
            const char* a1 = cA + (size_t)(t + 1) * kstep;
            const char* a2 = last ? nA : cA + (size_t)(t + 2) * kstep; const char* b2 = last ? nB : cB + (size_t)(t + 2) * kstep;
            const char* a3 = a2 + kstep; const char* b3 = b2 + kstep;
            if (last && has_next) S.a_ready(nxt);
            if constexpr (SP2) {
            PG8_LDB(B0, 0, 0); PG8_LDB(B1, 0, 1); PG8_SCHED; PG8_LDA(At, 0, 0); PG8_STAGE(PG8_SA(1, 1), a1 + hstep, voffA);
            PG8_WAIT_V(8); PG8_WAIT_L(0); PG8_BAR; PG8_MMA(0, 0, At, B0); PG8_MMA(0, 1, At, B1); PG8_BAR; PG8_SCHED;
            PG8_LDA(At, 0, 1); PG8_STAGE(PG8_SB(0, 0), b2, voffB); PG8_STAGE(PG8_SB(0, 1), b2 + hstep, voffB); PG8_STAGE(PG8_SA(0, 0), a2, voffA);
            PG8_WAIT_V(8); PG8_WAIT_L(0); PG8_BAR; PG8_MMA(1, 0, At, B0); PG8_MMA(1, 1, At, B1); PG8_BAR; PG8_SCHED;
            PG8_LDB(B0, 1, 0); PG8_LDB(B1, 1, 1); PG8_SCHED; PG8_LDA(At, 1, 0); PG8_STAGE(PG8_SA(0, 1), a2 + hstep, voffA);
            PG8_WAIT_V(8); PG8_WAIT_L(0); PG8_BAR; PG8_MMA(0, 0, At, B0); PG8_MMA(0, 1, At, B1); PG8_BAR; PG8_SCHED;
            PG8_LDA(At, 1, 1); PG8_STAGE(PG8_SB(1, 0), b3, voffB); PG8_STAGE(PG8_SB(1, 1), b3 + hstep, voffB); PG8_STAGE(PG8_SA(1, 0), a3, voffA);
            PG8_WAIT_V(8); PG8_WAIT_L(0); PG8_BAR; PG8_MMA(1, 0, At, B0); PG8_MMA(1, 1, At, B1); PG8_BAR; PG8_SCHED;
            } else {
            PG8_LDB(B0, 0, 0); PG8_SCHED; PG8_LDA(At, 0, 0); PG8_STAGE(PG8_SA(1, 1), a1 + hstep, voffA);
            PG8_WAIT_L(8); PG8_BAR; PG8_WAIT_L(0); PG8_MMA(0, 0, At, B0); PG8_BAR; PG8_SCHED;
            PG8_LDB(B1, 0, 1); PG8_STAGE(PG8_SB(0, 0), b2, voffB);
            PG8_BAR; PG8_WAIT_L(0); PG8_MMA(0, 1, At, B1); PG8_BAR;
            PG8_LDA(At, 0, 1); PG8_STAGE(PG8_SA(0, 0), a2, voffA);
            PG8_BAR; PG8_WAIT_L(0); PG8_MMA(1, 0, At, B0); PG8_BAR; PG8_SCHED;
            PG8_STAGE(PG8_SB(0, 1), b2 + hstep, voffB);
            PG8_WAIT_V(6); PG8_BAR; PG8_MMA(1, 1, At, B1); PG8_BAR;
            PG8_LDB(B0, 1, 0); PG8_SCHED; PG8_LDA(At, 1, 0); PG8_STAGE(PG8_SA(0, 1), a2 + hstep, voffA);
            PG8_WAIT_L(8); PG8_BAR; PG8_WAIT_L(0); PG8_MMA(0, 0, At, B0); PG8_BAR; PG8_SCHED;
            PG8_LDB(B1, 1, 1); PG8_STAGE(PG8_SB(1, 0), b3, voffB);
            PG8_BAR; PG8_WAIT_L(0); PG8_MMA(0, 1, At, B1); PG8_BAR;
            PG8_LDA(At, 1, 1); PG8_STAGE(PG8_SA(1, 0), a3, voffA);
            PG8_BAR; PG8_WAIT_L(0); PG8_MMA(1, 0, At, B0); PG8_BAR; PG8_SCHED;
            PG8_STAGE(PG8_SB(1, 1), b3 + hstep, voffB);
            PG8_WAIT_V(6); PG8_BAR; PG8_MMA(1, 1, At, B1); PG8_BAR;
            }
        }
        if constexpr (ALIGN_EPI) { if (wr == 0) PG8_BAR; }
        if constexpr (!Epi::AFTER_DRAIN) { E(acc, cur, wr, wc, fr, fq); S.done(cur); }
        if (!has_next) break;
#pragma unroll
        for (int a = 0; a < 2; ++a)
#pragma unroll
            for (int b = 0; b < 2; ++b)
#pragma unroll
                for (int m = 0; m < 4; ++m)
#pragma unroll
                    for (int n = 0; n < 2; ++n) acc[a][b][m][n] = (f32x4){0.f, 0.f, 0.f, 0.f};
        cur = nxt; cA = nA; cB = nB; ++ui;
        if constexpr (ALIGN_EPI) { if (wr == 1) PG8_BAR; }
    }
    PG8_WAIT_V(0);
    if constexpr (!ALIGN_EPI) { if (wr == 0) PG8_BAR; }
    PG8_BAR;
#undef PG8_SA
#undef PG8_SB
#undef PG8_STAGE
#undef PG8_LDA
#undef PG8_LDB
#undef PG8_MMA
#undef PG8_WAIT_V
#undef PG8_WAIT_L
#undef PG8_BAR
#undef PG8_SCHED
}
}

constexpr int NWAVES = 8;
constexpr int NPHASE = 11;
constexpr int N_LAUNCHES = MK_N_LAUNCHES;
constexpr int BATCH = 4, SEQ = 2048, DM = 4096, NTOK = BATCH * SEQ;
constexpr int NMOD = 6 * DM;
constexpr int IN_WIDTH = 8720;
constexpr int NPROJ = 8960;
constexpr int C_GQ = 0, C_GK = 1024, C_GV = 2048, C_GG = 4096, C_SQ = 6144, C_SK = 8192, C_SV = 8448, C_GA = 8704;
constexpr int NEXP = 16384, PEER_N = 2048;
constexpr float EPS = 1e-6f;

constexpr size_t MiB = 1u << 20;
constexpr size_t WS_CTL = 0, CTL_ZERO_BYTES = 1 * MiB;
constexpr size_t WS_MOD = 1 * MiB;
constexpr size_t WS_ROPE = 2 * MiB;
constexpr size_t WS_GA = 3 * MiB;
constexpr size_t WS_BTIN = 4 * MiB;
constexpr size_t WS_BTOUT = 74 * MiB;
constexpr size_t WS_BTQ = 106 * MiB;
constexpr size_t WS_HBUF = 122 * MiB;
constexpr size_t WS_PROJ = 186 * MiB;
constexpr size_t WS_MIXIN = 326 * MiB;
constexpr size_t WS_QPEER = 390 * MiB;
constexpr size_t WS_IDX = 422 * MiB;
constexpr size_t WS_GATE = 426 * MiB;
constexpr size_t WS_DC8 = 430 * MiB;
constexpr size_t WS_UC8 = 494 * MiB;
constexpr size_t WS_YC8 = 558 * MiB;
constexpr size_t WS_ZP = 590 * MiB;
constexpr size_t WS_EIDX = 654 * MiB;
constexpr size_t WS_GATEQ = 658 * MiB;
constexpr size_t WS_HE = 662 * MiB;
constexpr size_t WS_DSC = 666 * MiB;
constexpr size_t WS_YSC = 667 * MiB;
constexpr size_t WS_EIDX16 = 668 * MiB;
constexpr size_t WS_END = 670 * MiB;
constexpr int CW_BAR = 4096;

constexpr int RING_BYTES = 131072;
constexpr int LDSCTL_OFF = RING_BYTES, MISC_OFF = LDSCTL_OFF + 320;
constexpr int LDS_BYTES = 155648;

#define LDS_WAIT() asm volatile("s_waitcnt lgkmcnt(0)" ::: "memory")
#define VM_WAIT() asm volatile("s_waitcnt vmcnt(0)" ::: "memory")
__device__ __forceinline__ unsigned f2bf(float f) { unsigned u = __builtin_bit_cast(unsigned, f); return (u + 0x7fffu + ((u >> 16) & 1u)) >> 16; }
typedef __bf16 bf16x2_t __attribute__((ext_vector_type(2)));
__device__ __forceinline__ unsigned pk2(float lo, float hi) { const bf16x2_t v = {(__bf16)lo, (__bf16)hi}; return __builtin_bit_cast(unsigned, v); }
__device__ __forceinline__ float bflo(unsigned w) { return __builtin_bit_cast(float, w << 16); }
__device__ __forceinline__ float bfhi(unsigned w) { return __builtin_bit_cast(float, w & 0xffff0000u); }
__device__ __forceinline__ float dot2_bf16(unsigned w, unsigned x, float acc) { return __builtin_amdgcn_fdot2_f32_bf16(__builtin_bit_cast(bf16x2, w), __builtin_bit_cast(bf16x2, x), acc, false); }
__device__ __forceinline__ f32x16 mfma32(bf16x8 a, bf16x8 b, f32x16 c) { return __builtin_amdgcn_mfma_f32_32x32x16_bf16(a, b, c, 0, 0, 0); }
__device__ __forceinline__ f32x4 mfma16(bf16x8 a, bf16x8 b, f32x4 c) { return __builtin_amdgcn_mfma_f32_16x16x32_bf16(a, b, c, 0, 0, 0); }
__device__ __forceinline__ bf16x8 mk8(unsigned a, unsigned b, unsigned c, unsigned d) { v4u t = {a, b, c, d}; return __builtin_bit_cast(bf16x8, t); }
__device__ __forceinline__ float silu_f(float x) { return x / (1.0f + __expf(-x)); }

#define XB_TMO      128
#define XB_XCNT(j)  (256  + 64 * (j))
#define XB_XSUB(j)  (1280 + 64 * (j))
#define XB_XGEN(j)  (2304 + 64 * (j))
#define XB_TOP      3328
#define XB_TOPGEN   3392
#define XCD_BAR_WORDS 3456
#define XB_SPIN_CAP (1u << 18)
__device__ __forceinline__ unsigned xb_ld(unsigned* p)              { return __hip_atomic_load(p, __ATOMIC_RELAXED, __HIP_MEMORY_SCOPE_AGENT); }
__device__ __forceinline__ unsigned xb_add(unsigned* p, unsigned v) { return __hip_atomic_fetch_add(p, v, __ATOMIC_RELAXED, __HIP_MEMORY_SCOPE_AGENT); }
__device__ __forceinline__ unsigned xb_xcc_id() { return (unsigned)__builtin_amdgcn_s_getreg((3 << 11) | 20) & 0xFu; }
#define XB_SPIN(cond, bar) do { unsigned _sp = 0; while (cond) { __builtin_amdgcn_s_sleep(1); \
    if ((++_sp & 255u) == 0u) { if (xb_ld(&(bar)[XB_TMO])) break; if (_sp > XB_SPIN_CAP) { atomicAdd(&(bar)[XB_TMO], 1u); break; } } } } while (0)
struct XcdBarrier { unsigned* bar; unsigned x; volatile LAS unsigned* st; };
__device__ __forceinline__ XcdBarrier xcd_barrier_post(unsigned* bar, volatile LAS unsigned* st) {
    XcdBarrier b; b.bar = bar; b.x = xb_xcc_id(); b.st = st;
    if (threadIdx.x == 0) (void)xb_add(&bar[XB_XCNT(b.x)], 1u);
    return b;
}
__device__ __forceinline__ void xcd_barrier_complete(unsigned* bar, unsigned x, unsigned& nloc, unsigned& nx) {
    const unsigned G = gridDim.x * gridDim.y * gridDim.z;
    unsigned sum, cnt, mine, sp = 0u;
    for (;;) {
        sum = 0u; cnt = 0u; mine = 0u;
        unsigned cj[16]; const unsigned* p0 = &bar[XB_XCNT(0)];
        asm volatile("global_load_dword %0, %16, off sc1\n\tglobal_load_dword %1, %16, off offset:256 sc1\n\tglobal_load_dword %2, %16, off offset:512 sc1\n\tglobal_load_dword %3, %16, off offset:768 sc1\n\t"
                     "global_load_dword %4, %16, off offset:1024 sc1\n\tglobal_load_dword %5, %16, off offset:1280 sc1\n\tglobal_load_dword %6, %16, off offset:1536 sc1\n\tglobal_load_dword %7, %16, off offset:1792 sc1\n\t"
                     "global_load_dword %8, %16, off offset:2048 sc1\n\tglobal_load_dword %9, %16, off offset:2304 sc1\n\tglobal_load_dword %10, %16, off offset:2560 sc1\n\tglobal_load_dword %11, %16, off offset:2816 sc1\n\t"
                     "global_load_dword %12, %16, off offset:3072 sc1\n\tglobal_load_dword %13, %16, off offset:3328 sc1\n\tglobal_load_dword %14, %16, off offset:3584 sc1\n\tglobal_load_dword %15, %16, off offset:3840 sc1\n\ts_waitcnt vmcnt(0)"
                     : "=&v"(cj[0]), "=&v"(cj[1]), "=&v"(cj[2]), "=&v"(cj[3]), "=&v"(cj[4]), "=&v"(cj[5]), "=&v"(cj[6]), "=&v"(cj[7]), "=&v"(cj[8]), "=&v"(cj[9]), "=&v"(cj[10]), "=&v"(cj[11]), "=&v"(cj[12]), "=&v"(cj[13]), "=&v"(cj[14]), "=&v"(cj[15])
                     : "v"(p0) : "memory");
#pragma unroll
        for (unsigned j = 0; j < 16; ++j) { const unsigned c = cj[j]; sum += c; cnt += (c > 0u) ? 1u : 0u; mine = (j == x) ? c : mine; }
        if (sum == G) break;
        __builtin_amdgcn_s_sleep(1);
        if ((++sp & 255u) == 0u) { if (xb_ld(&bar[XB_TMO])) break; if (sp > XB_SPIN_CAP) { atomicAdd(&bar[XB_TMO], 1u); break; } }
    }
    nloc = mine > 0u ? mine : 1u; nx = cnt > 0u ? cnt : 1u;
}
__device__ __forceinline__ void xcd_barrier(const XcdBarrier& b) {
    asm volatile("s_waitcnt vmcnt(0)" ::: "memory");
    __syncthreads();
    if (threadIdx.x == 0) {
        unsigned* bar = b.bar;
        __builtin_amdgcn_s_waitcnt(0);
        unsigned nloc = b.st[0], nx = b.st[1];
        if (nloc == 0u) { xcd_barrier_complete(bar, b.x, nloc, nx); b.st[0] = nloc; b.st[1] = nx; }
        const unsigned old = xb_add(&bar[XB_XSUB(b.x)], 1u);
        const unsigned gen = old / nloc;
        if (old + 1u == (gen + 1u) * nloc) {
            __builtin_amdgcn_fence(__ATOMIC_RELEASE, "agent");
            asm volatile("s_waitcnt vmcnt(0)" ::: "memory");
            const unsigned og = xb_add(&bar[XB_TOP], 1u);
            const unsigned tg = og / nx;
            if (og + 1u == (tg + 1u) * nx) xb_add(&bar[XB_TOPGEN], 1u);
            else XB_SPIN(xb_ld(&bar[XB_TOPGEN]) == tg, bar);
            __builtin_amdgcn_fence(__ATOMIC_ACQUIRE, "agent");
            xb_add(&bar[XB_XGEN(b.x)], 1u);
            asm volatile("s_waitcnt vmcnt(0)" ::: "memory");
        } else {
            XB_SPIN(xb_ld(&bar[XB_XGEN(b.x)]) == gen, bar);
            __builtin_amdgcn_fence(__ATOMIC_ACQUIRE, "agent");
            asm volatile("s_waitcnt vmcnt(0)" ::: "memory");
        }
    }
    __syncthreads();
}

struct Frame {
    LAS unsigned char* lds;
    volatile LAS unsigned* MISC;
    unsigned* ctl;
    int tid, lane, wave, vcu, G;
    const float *x, *c, *w_ada, *b_ada, *w_in, *w_gate_up, *b_gla_gate, *gla_out_norm, *swa_q_norm, *swa_k_norm, *swa_sinks, *swa_out_norm, *w_out, *w_peer_q, *keys1, *keys2, *edown, *eup;
    float* out;
    unsigned char* ws;
    float *MOD, *ROPE;
    bf16 *BTIN, *BTOUT, *BTQ, *HBUF, *PROJ, *MIXIN, *QPEER;
    unsigned char *DC8, *UC8, *YC8;
    int* ZP; unsigned *EIDX, *HE, *EIDX16, *TMAX; float *GATEQ, *DSC, *YSC, *USC, *HF;
    bf16 *GQT, *GST, *X1, *GA; float *GUT, *GG;
};

__device__ __forceinline__ float wave_sum(float v) {
#pragma unroll
    for (int o = 1; o < 64; o <<= 1) v += __shfl_xor(v, o);
    return v;
}
__device__ __forceinline__ float wave_max(float v) {
#pragma unroll
    for (int o = 1; o < 64; o <<= 1) v = fmaxf(v, __shfl_xor(v, o));
    return v;
}
__device__ __forceinline__ unsigned pack4i(float a, float b, float c, float d) {
    const int q0 = (int)__builtin_rintf(a), q1 = (int)__builtin_rintf(b), q2 = (int)__builtin_rintf(c), q3 = (int)__builtin_rintf(d);
    return (unsigned)(q0 & 255) | ((unsigned)(q1 & 255) << 8) | ((unsigned)(q2 & 255) << 16) | ((unsigned)q3 << 24);
}

__device__ __forceinline__ void p0_tr_item(const float* W, int ldw, int sc0, int ncols, bf16* WT, int dr0, int k0, LAS float* scr, int lane) {
    const int c4 = (lane & 7) * 4, kr = lane >> 3;
    f32x4 v[8];
#pragma unroll
    for (int i = 0; i < 8; ++i) v[i] = (c4 < ncols) ? __builtin_nontemporal_load((const GAS f32x4*)(W + (size_t)(k0 + kr + 8 * i) * ldw + sc0 + c4)) : (f32x4){0.f, 0.f, 0.f, 0.f};
#pragma unroll
    for (int i = 0; i < 8; ++i) { LAS float* d = scr + (kr + 8 * i) * 33 + c4; d[0] = v[i][0]; d[1] = v[i][1]; d[2] = v[i][2]; d[3] = v[i][3]; }
    LDS_WAIT(); asm volatile("" ::: "memory");
    const int c8 = lane & 7;
#pragma unroll
    for (int j = 0; j < 4; ++j) { const int n = (lane >> 3) + 8 * j; const LAS float* s = scr + (8 * c8) * 33 + n;
        v4u o; o.x = pk2(s[0 * 33], s[1 * 33]); o.y = pk2(s[2 * 33], s[3 * 33]); o.z = pk2(s[4 * 33], s[5 * 33]); o.w = pk2(s[6 * 33], s[7 * 33]);
        if (n < ncols) *(GAS v4u*)(WT + (size_t)(dr0 + n) * DM + k0 + 8 * c8) = o; }
    LDS_WAIT(); asm volatile("" ::: "memory");
}

__device__ __forceinline__ void p0a_ada(Frame& F) {
    const int tid = F.tid, lane = F.lane, wave = F.wave;
    {
        LAS f32x4* cact = (LAS f32x4*)F.lds;
        LAS float* red = (LAS float*)(F.lds + 65536);
        for (int k = tid; k < DM; k += 512) { f32x4 v;
#pragma unroll
            for (int b = 0; b < 4; ++b) { const float cv = F.c[b * DM + k]; v[b] = cv / (1.0f + expf(-cv)); }
            cact[k] = v; }
        __syncthreads();
        for (int slice = F.vcu; slice < 256; slice += F.G) {
            const int col0 = slice * 96, sub = lane / 24, cl = lane - sub * 24;
            f32x4 acc[4];
#pragma unroll
            for (int b = 0; b < 4; ++b) acc[b] = (f32x4){0.f, 0.f, 0.f, 0.f};
            if (lane < 48) {
                const unsigned voff = (unsigned)(((size_t)sub * NMOD + col0 + 4 * cl) * 4);
                const char* sb = (const char*)(F.w_ada + (size_t)(wave * 2) * NMOD);
                const LAS f32x4* cb = cact + wave * 2 + sub;
                f32x4 wb[16];
#define GV_LD(j, i) asm volatile("global_load_dwordx4 %0, %1, %2 nt" : "=v"(wb[j]) : "v"(voff), "s"(sb + (size_t)(i) * (16 * NMOD * 4)) : "memory")
#define GV_USE(j, i, N) do { asm volatile("s_waitcnt vmcnt(" #N ")" : "+v"(wb[j]) :: "memory"); const f32x4 cv = cb[16 * (i)]; _Pragma("unroll") for (int b = 0; b < 4; ++b) acc[b] += wb[j] * cv[b]; } while (0)
#define GV_STEP(j) do { GV_USE(j, i0 + j, 15); GV_LD(j, i0 + 16 + j); } while (0)
                GV_LD(0, 0); GV_LD(1, 1); GV_LD(2, 2); GV_LD(3, 3); GV_LD(4, 4); GV_LD(5, 5); GV_LD(6, 6); GV_LD(7, 7);
                GV_LD(8, 8); GV_LD(9, 9); GV_LD(10, 10); GV_LD(11, 11); GV_LD(12, 12); GV_LD(13, 13); GV_LD(14, 14); GV_LD(15, 15);
#pragma unroll 1
                for (int i0 = 0; i0 < 240; i0 += 16) {
                    GV_STEP(0); GV_STEP(1); GV_STEP(2); GV_STEP(3); GV_STEP(4); GV_STEP(5); GV_STEP(6); GV_STEP(7);
                    GV_STEP(8); GV_STEP(9); GV_STEP(10); GV_STEP(11); GV_STEP(12); GV_STEP(13); GV_STEP(14); GV_STEP(15);
                }
                GV_USE(0, 240, 15); GV_USE(1, 241, 14); GV_USE(2, 242, 13); GV_USE(3, 243, 12); GV_USE(4, 244, 11); GV_USE(5, 245, 10); GV_USE(6, 246, 9); GV_USE(7, 247, 8);
                GV_USE(8, 248, 7); GV_USE(9, 249, 6); GV_USE(10, 250, 5); GV_USE(11, 251, 4); GV_USE(12, 252, 3); GV_USE(13, 253, 2); GV_USE(14, 254, 1); GV_USE(15, 255, 0);
#undef GV_LD
#undef GV_USE
#undef GV_STEP
#pragma unroll
                for (int b = 0; b < 4; ++b) *(LAS f32x4*)(red + (wave * 48 + lane) * 16 + 4 * b) = acc[b];
            }
            __syncthreads();
            if (tid < 384) { const int b = tid / 96, col = tid - b * 96, cl2 = col >> 2, e = col & 3; float s = 0.f;
#pragma unroll
                for (int w = 0; w < 8; ++w) { s += red[(w * 48 + cl2) * 16 + 4 * b + e]; s += red[(w * 48 + 24 + cl2) * 16 + 4 * b + e]; }
                F.MOD[b * NMOD + col0 + col] = s + F.b_ada[col0 + col]; }
            __syncthreads();
        }
    }
}
__device__ __forceinline__ void p0b_weights(Frame& F) {
    const int tid = F.tid, lane = F.lane, wave = F.wave;
    const int gw = F.vcu * NWAVES + wave, NGW = F.G * NWAVES;
    {
        LAS float* scr = (LAS float*)(F.lds + wave * 16384);
        constexpr int NB0 = 192, NB1 = 80, NB2 = 1, NB3 = 128, NB4 = 64, NBT = NB0 + NB1 + NB2 + NB3 + NB4;
        for (int it = gw; it < NBT * 64; it += NGW) {
            int nb = it % NBT; const int k0 = (it / NBT) * 64;
            if (nb < NB0) { p0_tr_item(F.w_in, IN_WIDTH, 32 * nb, 32, F.BTIN, 32 * nb, k0, scr, lane); continue; } nb -= NB0;
            if (nb < NB1) { p0_tr_item(F.w_in, IN_WIDTH, 6160 + 32 * nb, 32, F.BTIN, 6144 + 32 * nb, k0, scr, lane); continue; } nb -= NB1;
            if (nb < NB2) { p0_tr_item(F.w_in, IN_WIDTH, 6144, 16, F.BTIN, C_GA, k0, scr, lane); continue; } nb -= NB2;
            if (nb < NB3) { p0_tr_item(F.w_out, DM, 32 * nb, 32, F.BTOUT, 32 * nb, k0, scr, lane); continue; } nb -= NB3;
            p0_tr_item(F.w_peer_q, PEER_N, 32 * nb, 32, F.BTQ, 32 * nb, k0, scr, lane);
        }
        const size_t gt = (size_t)F.vcu * 512 + tid, NT = (size_t)F.G * 512;
        GAS v4u* z = (GAS v4u*)(F.BTIN + (size_t)(C_GA + 16) * DM);
        for (size_t i = gt; i < (size_t)240 * DM / 8; i += NT) z[i] = (v4u){0u, 0u, 0u, 0u};
        for (size_t e = gt; e < (size_t)SEQ * 32; e += NT) { const int pos = (int)(e >> 5), i = (int)(e & 31);
            const float inv = exp2f(-(float)i * (13.287712379549449f / 32.0f));
            const float ang = (float)pos * inv;
            const double rev = (double)ang * 0.15915494309189535; const float fr = (float)(rev - floor(rev));
            F.ROPE[e] = __builtin_amdgcn_cosf(fr); F.ROPE[SEQ * 32 + e] = __builtin_amdgcn_sinf(fr); }
    }
}
__device__ __forceinline__ void convert_expert_groups(Frame& F, int g_lo, int g_hi, int g_step, const int tb_lo = 0, const int ntb = 2) {
    const int tid = F.tid, lane = F.lane, wave = F.wave;
    __syncthreads();
    const int ngrp = g_lo < g_hi ? (g_hi - g_lo + g_step - 1) / g_step : 0, total = 4 * ngrp * ntb;
    if (total == 0) return;
#define CV_SRC(idx) ((const GAS f32x4*)(((tb_lo + ((idx) >= 4 * ngrp ? 1 : 0)) ? F.eup : F.edown) + (size_t)((g_lo + (((idx) >> 2) % ngrp) * g_step) * 32 + wave * 4 + ((idx) & 3)) * DM))
#define CV_LOAD(A, B, idx) do { const GAS f32x4* src_ = CV_SRC(idx); _Pragma("unroll") for (int j = 0; j < 8; ++j) { A[j] = __builtin_nontemporal_load(src_ + 2 * (lane + 64 * j)); B[j] = __builtin_nontemporal_load(src_ + 2 * (lane + 64 * j) + 1); } } while (0)
#define CV_QUANT(A, B, idx) do { const int tb_ = tb_lo + ((idx) >= 4 * ngrp ? 1 : 0), el_ = wave * 4 + ((idx) & 3), e_ = (g_lo + (((idx) >> 2) % ngrp) * g_step) * 32 + el_; float m = 0.f; \
        _Pragma("unroll") for (int j = 0; j < 8; ++j) _Pragma("unroll") for (int q = 0; q < 4; ++q) m = fmaxf(m, fmaxf(fabsf(A[j][q]), fabsf(B[j][q]))); \
        m = wave_max(m); const float inv = m > 0.f ? 127.0f / m : 0.f; if (lane == 0) (tb_ ? F.USC : F.DSC)[e_] = m * (1.0f / 127.0f); \
        _Pragma("unroll") for (int j = 0; j < 8; ++j) { v2u o; o.x = pack4i(A[j][0] * inv, A[j][1] * inv, A[j][2] * inv, A[j][3] * inv); o.y = pack4i(B[j][0] * inv, B[j][1] * inv, B[j][2] * inv, B[j][3] * inv); \
            *(LAS v2u*)(F.lds + el_ * 4096 + ((lane + 64 * j + el_) & 511) * 8) = o; } } while (0)
    f32x4 a0[8], b0[8], a1[8], b1[8];
    CV_LOAD(a0, b0, 0);
#pragma unroll 1
    for (int idx = 0; idx < total; idx += 2) {
        CV_LOAD(a1, b1, idx + 1);
        CV_QUANT(a0, b0, idx);
        if (idx + 2 < total) CV_LOAD(a0, b0, idx + 2);
        CV_QUANT(a1, b1, idx + 1);
        if ((idx & 3) == 2) {
            __syncthreads();
            unsigned char* dstT = (tb_lo + (idx >= 4 * ngrp ? 1 : 0)) ? F.UC8 : F.DC8; const int e0 = (g_lo + ((idx >> 2) % ngrp) * g_step) * 32, el = tid & 31;
#pragma unroll 8
            for (int it = 0; it < 32; ++it) { const int sc = it * 16 + (tid >> 5);
                const v2u o = *(const LAS v2u*)(F.lds + el * 4096 + ((sc + el) & 511) * 8);
                *(GAS v2u*)(dstT + ((size_t)sc * NEXP + e0 + el) * 8) = o; }
            __syncthreads();
        }
    }
#undef CV_SRC
#undef CV_LOAD
#undef CV_QUANT
}
constexpr int GEMM1_N = 8704;
constexpr int GEMM1_UNITS = (NTOK / 256) * (GEMM1_N / 256);
__host__ __device__ constexpr int tail_groups(int G) { return (GEMM1_UNITS % G) ? (512 - G / 2 > 0 ? 512 - G / 2 : 0) : 0; }
__device__ __forceinline__ void p0c_tables(Frame& F) {
    for (int U = F.vcu; U < 2 * (512 - tail_groups(F.G)); U += F.G) { const int grp = tail_groups(F.G) + (U >> 1); convert_expert_groups(F, grp, grp + 1, 1, U & 1, 1); }
}
__device__ __forceinline__ void p0_prologue(Frame& F) { p0a_ada(F); p0b_weights(F); p0c_tables(F); }

__device__ __forceinline__ void modulate_rows(Frame& F, const float* src, bf16* dst, int sh_off, int sc_off) {
    const int lane = F.lane, w = F.wave, tid = F.tid;
    LAS f32x4* SC = (LAS f32x4*)F.lds;
    LAS f32x4* SH = (LAS f32x4*)(F.lds + 16384);
    for (int blk = F.vcu; blk < NTOK / 32; blk += F.G) {
        const int R0 = blk * 32, b = R0 >> 11;
        __syncthreads();
        { const GAS f32x4* shp = (const GAS f32x4*)(F.MOD + b * NMOD + sh_off); const GAS f32x4* scp = (const GAS f32x4*)(F.MOD + b * NMOD + sc_off);
          for (int i = tid; i < 1024; i += 512) { SC[i] = scp[i] + 1.0f; SH[i] = shp[i]; } }
        __syncthreads();
        const int m0 = R0 + 4 * w;
        f32x4 va[16], vb[16];
#define MR_LOAD(V, m_) do { const GAS f32x4* xr_ = (const GAS f32x4*)(src + (size_t)(m_) * DM) + lane; _Pragma("unroll") for (int j = 0; j < 16; ++j) V[j] = __builtin_nontemporal_load(xr_ + 64 * j); } while (0)
#define MR_ROW(V, m_) do { float s_ = 0.f; _Pragma("unroll") for (int j = 0; j < 16; ++j) s_ += (V[j].x * V[j].x + V[j].y * V[j].y) + (V[j].z * V[j].z + V[j].w * V[j].w); \
            const float rstd_ = 1.0f / sqrtf(wave_sum(s_) * (1.0f / DM) + EPS); int ln_ = lane; asm volatile("" : "+v"(ln_));     \
            GAS v2u* o8_ = (GAS v2u*)(dst + (size_t)(m_) * DM) + lane; \
            _Pragma("unroll") for (int j = 0; j < 16; ++j) { const f32x4 y_ = V[j] * rstd_ * SC[ln_ + 64 * j] + SH[ln_ + 64 * j]; v2u o_; o_.x = pk2(y_.x, y_.y); o_.y = pk2(y_.z, y_.w); o8_[64 * j] = o_; } } while (0)
        MR_LOAD(va, m0);
        MR_LOAD(vb, m0 + 1); MR_ROW(va, m0);
        MR_LOAD(va, m0 + 2); MR_ROW(vb, m0 + 1);
        MR_LOAD(vb, m0 + 3); MR_ROW(va, m0 + 2);
        MR_ROW(vb, m0 + 3);
#undef MR_LOAD
#undef MR_ROW
    }
}

__device__ __forceinline__ void p1b_ga(Frame& F) {
    const int lane = F.lane, w = F.wave, tid = F.tid, r = lane & 15, g = lane >> 4;
    LAS float* RED = (LAS float*)(F.lds + 32768);
    for (int blk = F.vcu; blk < NTOK / 32; blk += F.G) {
        const int R0 = blk * 32;
        asm volatile("s_waitcnt vmcnt(0)" ::: "memory");
        __syncthreads();
        f32x4 d0 = {0.f, 0.f, 0.f, 0.f}, d1 = {0.f, 0.f, 0.f, 0.f};
        const bf16* xa = F.HBUF + (size_t)(R0 + r) * DM + 512 * w + 8 * g;
        const bf16* wb = F.BTIN + (size_t)(C_GA + r) * DM + 512 * w + 8 * g;
#define GA_LD8(F8, P, B) asm volatile("global_load_dwordx4 %0, %8, off offset:" #B "+0\n\tglobal_load_dwordx4 %1, %8, off offset:" #B "+64\n\tglobal_load_dwordx4 %2, %8, off offset:" #B "+128\n\tglobal_load_dwordx4 %3, %8, off offset:" #B "+192\n\t" \
            "global_load_dwordx4 %4, %8, off offset:" #B "+256\n\tglobal_load_dwordx4 %5, %8, off offset:" #B "+320\n\tglobal_load_dwordx4 %6, %8, off offset:" #B "+384\n\tglobal_load_dwordx4 %7, %8, off offset:" #B "+448" \
            : "=&v"(F8[0]), "=&v"(F8[1]), "=&v"(F8[2]), "=&v"(F8[3]), "=&v"(F8[4]), "=&v"(F8[5]), "=&v"(F8[6]), "=&v"(F8[7]) : "v"(P) : "memory")
#define GA_PIN8(F8) asm volatile("s_waitcnt vmcnt(0)" : "+v"(F8[0]), "+v"(F8[1]), "+v"(F8[2]), "+v"(F8[3]), "+v"(F8[4]), "+v"(F8[5]), "+v"(F8[6]), "+v"(F8[7]) :: "memory")
#define GA_BATCH(B) do { bf16x8 fa0[8], fa1[8], fbw[8]; const bf16* xa1 = xa + (size_t)16 * DM; \
            GA_LD8(fa0, xa, B); GA_LD8(fa1, xa1, B); GA_LD8(fbw, wb, B); GA_PIN8(fa0); GA_PIN8(fa1); GA_PIN8(fbw); \
            _Pragma("unroll") for (int ks = 0; ks < 8; ++ks) { d0 = mfma16(fa0[ks], fbw[ks], d0); d1 = mfma16(fa1[ks], fbw[ks], d1); } } while (0)
        GA_BATCH(0); GA_BATCH(512);
#undef GA_LD8
#undef GA_PIN8
#undef GA_BATCH
        *(LAS f32x4*)(RED + ((w * 2 + 0) * 64 + lane) * 4) = d0; *(LAS f32x4*)(RED + ((w * 2 + 1) * 64 + lane) * 4) = d1;
        __syncthreads();
        if (tid < 128) { const int m = tid >> 6, l = tid & 63; f32x4 sacc = {0.f, 0.f, 0.f, 0.f};
#pragma unroll
            for (int w2 = 0; w2 < 8; ++w2) sacc += *(const LAS f32x4*)(RED + ((w2 * 2 + m) * 64 + l) * 4);
#pragma unroll
            for (int i = 0; i < 4; ++i) *(GAS unsigned short*)(F.GA + (size_t)(R0 + 16 * m + 4 * (l >> 4) + i) * 16 + (l & 15)) = (unsigned short)f2bf(sacc[i]); }
        __syncthreads();
    }
}

__device__ __forceinline__ void p5_modulate_quant(Frame& F) {
    const int lane = F.lane, w = F.wave, tid = F.tid;
    LAS f32x4* SCA = (LAS f32x4*)F.lds;
    LAS f32x4* SCC = (LAS f32x4*)(F.lds + 8192);
    LAS f32x4* SHA = (LAS f32x4*)(F.lds + 16384);
    LAS f32x4* SHC = (LAS f32x4*)(F.lds + 24576);
    LAS unsigned char* ST = F.lds + 32768;
    for (int blk = F.vcu; blk < NTOK / 32; blk += F.G) {
        const int R0 = blk * 32, b = R0 >> 11;
        __syncthreads();
        { const GAS f32x4* shp = (const GAS f32x4*)(F.MOD + b * NMOD + 3 * DM); const GAS f32x4* scp = (const GAS f32x4*)(F.MOD + b * NMOD + 4 * DM);
          for (int i = tid; i < 1024; i += 512) { const f32x4 sc = scp[i] + 1.0f, sh = shp[i]; if (i & 1) { SCC[i >> 1] = sc; SHC[i >> 1] = sh; } else { SCA[i >> 1] = sc; SHA[i >> 1] = sh; } } }
        __syncthreads();
        v4u xw[8];
        { const GAS v4u* xr = (const GAS v4u*)(F.X1 + (size_t)(R0 + 2 * w) * DM);
#pragma unroll
          for (int j = 0; j < 8; ++j) xw[j] = xr[lane + 64 * j]; }
        for (int pass = 0; pass < 2; ++pass) {
#pragma unroll
            for (int rr = 0; rr < 2; ++rr) {
                const int rl = 2 * w + rr, m = R0 + pass * 16 + rl;
                f32x4 a[8], c[8]; float s = 0.f;
#pragma unroll
                for (int j = 0; j < 8; ++j) { const v4u x = xw[j]; a[j] = (f32x4){bflo(x.x), bfhi(x.x), bflo(x.y), bfhi(x.y)}; c[j] = (f32x4){bflo(x.z), bfhi(x.z), bflo(x.w), bfhi(x.w)};
                    s += (a[j].x * a[j].x + a[j].y * a[j].y) + (a[j].z * a[j].z + a[j].w * a[j].w) + (c[j].x * c[j].x + c[j].y * c[j].y) + (c[j].z * c[j].z + c[j].w * c[j].w); }
                {
                    const int mn = rr == 0 ? m + 1 : (pass == 0 ? R0 + 16 + 2 * w : m);
                    const GAS v4u* xr = (const GAS v4u*)(F.X1 + (size_t)mn * DM);
#pragma unroll
                    for (int j = 0; j < 8; ++j) xw[j] = xr[lane + 64 * j]; }
                const float rstd = 1.0f / sqrtf(wave_sum(s) * (1.0f / DM) + EPS);
                float mx = 0.f;
                int ln = lane; asm volatile("" : "+v"(ln));
#pragma unroll
                for (int j = 0; j < 8; ++j) { const int i = ln + 64 * j;
                    a[j] = a[j] * rstd * SCA[i] + SHA[i]; c[j] = c[j] * rstd * SCC[i] + SHC[i];
#pragma unroll
                    for (int q = 0; q < 4; ++q) mx = fmaxf(mx, fmaxf(fabsf(a[j][q]), fabsf(c[j][q])));
                    *(GAS v4u*)(F.HBUF + (size_t)m * DM + 8 * i) = (v4u){pk2(a[j].x, a[j].y), pk2(a[j].z, a[j].w), pk2(c[j].x, c[j].y), pk2(c[j].z, c[j].w)}; }
                mx = wave_max(mx);
                const float inv = mx > 0.f ? 127.0f / mx : 0.f;
                if (lane == 0) F.YSC[m] = mx * (1.0f / 127.0f);
#pragma unroll
                for (int j = 0; j < 8; ++j) { v2u o; o.x = pack4i(a[j].x * inv, a[j].y * inv, a[j].z * inv, a[j].w * inv); o.y = pack4i(c[j].x * inv, c[j].y * inv, c[j].z * inv, c[j].w * inv);
                    *(LAS v2u*)(ST + rl * 4112 + (lane + 64 * j) * 8) = o; }
            }
            __syncthreads();
            { const int q = tid & 7;
#pragma unroll
              for (int it = 0; it < 8; ++it) { const int ch = it * 64 + (tid >> 3);
                  const v2u lo = *(const LAS v2u*)(ST + (2 * q) * 4112 + ch * 8), hi = *(const LAS v2u*)(ST + (2 * q + 1) * 4112 + ch * 8);
                  *(GAS v4u*)(F.YC8 + ((size_t)ch * NTOK + R0 + pass * 16 + 2 * q) * 8) = (v4u){lo.x, lo.y, hi.x, hi.y}; } }
            __syncthreads();
        }
    }
}

__device__ __forceinline__ void swa_unit(Frame& F, int u) {
    const int b = u >> 6, kvh = (u >> 4) & 3, n = u & 15, t0 = n * 128;
    LAS unsigned char* KL = F.lds;
    LAS unsigned char* VL = F.lds + 36864;
    const float* COS = F.ROPE; const float* SIN = F.ROPE + SEQ * 32;
    {
        const int key = F.tid >> 1, p = F.tid & 1, kpos = t0 - 128 + key;
        v4u ka[2] = {{0u, 0u, 0u, 0u}, {0u, 0u, 0u, 0u}}, kb[2] = {{0u, 0u, 0u, 0u}, {0u, 0u, 0u, 0u}}, vv[4] = {{0u, 0u, 0u, 0u}, {0u, 0u, 0u, 0u}, {0u, 0u, 0u, 0u}, {0u, 0u, 0u, 0u}};
        float cs[16], sn[16];
#pragma unroll
        for (int i = 0; i < 16; ++i) { cs[i] = 1.f; sn[i] = 0.f; }
        if (kpos >= 0) {
            const bf16* pr = F.PROJ + (size_t)(b * SEQ + kpos) * NPROJ;
            const GAS v4u* kr = (const GAS v4u*)(pr + C_SK + kvh * 64);
            ka[0] = kr[2 * p]; ka[1] = kr[2 * p + 1]; kb[0] = kr[4 + 2 * p]; kb[1] = kr[4 + 2 * p + 1];
            const GAS v4u* vr = (const GAS v4u*)(pr + C_SV + kvh * 64 + 32 * p);
#pragma unroll
            for (int j = 0; j < 4; ++j) vv[j] = vr[j];
            const GAS f32x4* cp = (const GAS f32x4*)(COS + kpos * 32 + 16 * p); const GAS f32x4* sp = (const GAS f32x4*)(SIN + kpos * 32 + 16 * p);
#pragma unroll
            for (int j = 0; j < 4; ++j) { const f32x4 c4 = cp[j], s4 = sp[j];
#pragma unroll
                for (int e = 0; e < 4; ++e) { cs[4 * j + e] = c4[e]; sn[4 * j + e] = s4[e]; } }
        }
        float x1[16], x2[16]; float ss = 0.f;
#pragma unroll
        for (int j = 0; j < 2; ++j)
#pragma unroll
            for (int e = 0; e < 4; ++e) { x1[8 * j + 2 * e] = bflo(ka[j][e]); x1[8 * j + 2 * e + 1] = bfhi(ka[j][e]); x2[8 * j + 2 * e] = bflo(kb[j][e]); x2[8 * j + 2 * e + 1] = bfhi(kb[j][e]); }
#pragma unroll
        for (int i = 0; i < 16; ++i) ss += x1[i] * x1[i] + x2[i] * x2[i];
        ss += __shfl_xor(ss, 1);
        const float rstd = 1.0f / sqrtf(ss * (1.0f / 64.0f) + EPS);
        unsigned o1[8], o2[8];
#pragma unroll
        for (int i = 0; i < 8; ++i) {
            float y1[2], y2[2];
#pragma unroll
            for (int e = 0; e < 2; ++e) { const int d = 2 * i + e; const float a = x1[d] * rstd * F.swa_k_norm[16 * p + d], c = x2[d] * rstd * F.swa_k_norm[32 + 16 * p + d];
                y1[e] = a * cs[d] - c * sn[d]; y2[e] = c * cs[d] + a * sn[d]; }
            o1[i] = pk2(y1[0], y1[1]); o2[i] = pk2(y2[0], y2[1]);
        }
        LAS v4u* kd = (LAS v4u*)(KL + key * 144 + 32 * p);
        kd[0] = (v4u){o1[0], o1[1], o1[2], o1[3]}; kd[1] = (v4u){o1[4], o1[5], o1[6], o1[7]};
        LAS v4u* kd2 = (LAS v4u*)(KL + key * 144 + 64 + 32 * p);
        kd2[0] = (v4u){o2[0], o2[1], o2[2], o2[3]}; kd2[1] = (v4u){o2[4], o2[5], o2[6], o2[7]};
#pragma unroll
        for (int j = 0; j < 4; ++j)
#pragma unroll
            for (int e = 0; e < 4; ++e) { const int d = 32 * p + 8 * j + 2 * e; const unsigned w = vv[j][e];
                *(LAS unsigned short*)(VL + d * 520 + key * 2) = (unsigned short)(w & 0xffffu);
                *(LAS unsigned short*)(VL + (d + 1) * 520 + key * 2) = (unsigned short)(w >> 16); }
    }
    __syncthreads();
    {
        const int g = F.wave, hq = kvh * 8 + g, r = F.lane & 31, h = F.lane >> 5;
        const float sink = F.swa_sinks[hq] * 1.4426950408889634f;
        for (int qt = 0; qt < 4; ++qt) {
            const int qpos = t0 + 32 * qt + r;
            const size_t tok = (size_t)(b * SEQ + qpos);
            const GAS v4u* qr = (const GAS v4u*)(F.PROJ + tok * NPROJ + C_SQ + hq * 64);
            v4u qraw[4];
#pragma unroll
            for (int kk = 0; kk < 4; ++kk) qraw[kk] = qr[2 * kk + h];
            float qf[4][8]; float ss = 0.f;
#pragma unroll
            for (int kk = 0; kk < 4; ++kk)
#pragma unroll
                for (int e = 0; e < 4; ++e) { qf[kk][2 * e] = bflo(qraw[kk][e]); qf[kk][2 * e + 1] = bfhi(qraw[kk][e]); }
#pragma unroll
            for (int kk = 0; kk < 4; ++kk)
#pragma unroll
                for (int j = 0; j < 8; ++j) ss += qf[kk][j] * qf[kk][j];
            ss += __shfl_xor(ss, 32);
            const float rstd = (0.125f * 1.4426950408889634f) / sqrtf(ss * (1.0f / 64.0f) + EPS);
            bf16x8 qfrag[4];
#pragma unroll
            for (int kk = 0; kk < 2; ++kk) {
                float y1[8], y2[8];
                const GAS f32x4* cp = (const GAS f32x4*)(COS + qpos * 32 + 16 * kk + 8 * h); const GAS f32x4* sp = (const GAS f32x4*)(SIN + qpos * 32 + 16 * kk + 8 * h);
                const f32x4 c0 = cp[0], c1 = cp[1], s0 = sp[0], s1 = sp[1];
#pragma unroll
                for (int j = 0; j < 8; ++j) { const int d = 16 * kk + 8 * h + j; const float cc = j < 4 ? c0[j & 3] : c1[j & 3], sv = j < 4 ? s0[j & 3] : s1[j & 3];
                    const float a = qf[kk][j] * rstd * F.swa_q_norm[d], c = qf[kk + 2][j] * rstd * F.swa_q_norm[d + 32];
                    y1[j] = a * cc - c * sv; y2[j] = c * cc + a * sv; }
                qfrag[kk] = mk8(pk2(y1[0], y1[1]), pk2(y1[2], y1[3]), pk2(y1[4], y1[5]), pk2(y1[6], y1[7]));
                qfrag[kk + 2] = mk8(pk2(y2[0], y2[1]), pk2(y2[2], y2[3]), pk2(y2[4], y2[5]), pk2(y2[6], y2[7]));
            }
            f32x16 sacc[5];
#pragma unroll
            for (int tt = 0; tt < 5; ++tt) { f32x16 a = {0.f, 0.f, 0.f, 0.f, 0.f, 0.f, 0.f, 0.f, 0.f, 0.f, 0.f, 0.f, 0.f, 0.f, 0.f, 0.f};
#pragma unroll
                for (int kk = 0; kk < 4; ++kk) { const bf16x8 kf = *(const LAS bf16x8*)(KL + (32 * (qt + tt) + r) * 144 + (16 * kk + 8 * h) * 2); a = mfma32(kf, qfrag[kk], a); }
                sacc[tt] = a; }
            float mx = sink;
#pragma unroll
            for (int tt = 0; tt < 5; ++tt)
#pragma unroll
                for (int i = 0; i < 16; ++i) { const int koff = (i & 3) + 8 * (i >> 2) + 4 * h; const int rel = r + 128 - 32 * tt - koff; const int kidx = 32 * (qt + tt) + koff;
                    const bool valid = (rel >= 0) && (rel < 128) && (t0 - 128 + kidx >= 0);
                    const float s = valid ? sacc[tt][i] : -INFINITY; sacc[tt][i] = s; mx = fmaxf(mx, s); }
            mx = fmaxf(mx, __shfl_xor(mx, 32));
            float sum = 0.f;
#pragma unroll
            for (int tt = 0; tt < 5; ++tt)
#pragma unroll
                for (int i = 0; i < 16; ++i) { const float pv = __builtin_amdgcn_exp2f(sacc[tt][i] - mx); sacc[tt][i] = pv; sum += pv; }
            sum += __shfl_xor(sum, 32);
            const float inv = 1.0f / (sum + __builtin_amdgcn_exp2f(sink - mx));
            f32x16 oacc[2];
#pragma unroll
            for (int dt = 0; dt < 2; ++dt) oacc[dt] = (f32x16){0.f, 0.f, 0.f, 0.f, 0.f, 0.f, 0.f, 0.f, 0.f, 0.f, 0.f, 0.f, 0.f, 0.f, 0.f, 0.f};
#pragma unroll
            for (int tt = 0; tt < 5; ++tt)
#pragma unroll
                for (int s2 = 0; s2 < 2; ++s2) {
                    const bf16x8 pf = mk8(pk2(sacc[tt][8 * s2], sacc[tt][8 * s2 + 1]), pk2(sacc[tt][8 * s2 + 2], sacc[tt][8 * s2 + 3]), pk2(sacc[tt][8 * s2 + 4], sacc[tt][8 * s2 + 5]), pk2(sacc[tt][8 * s2 + 6], sacc[tt][8 * s2 + 7]));
#pragma unroll
                    for (int dt = 0; dt < 2; ++dt) { const LAS unsigned char* vp = VL + (32 * dt + r) * 520 + (32 * (qt + tt) + 16 * s2 + 4 * h) * 2;
                        const v2u lo = *(const LAS v2u*)vp, hi = *(const LAS v2u*)(vp + 16);
                        oacc[dt] = mfma32(mk8(lo.x, lo.y, hi.x, hi.y), pf, oacc[dt]); }
                }
            float so = 0.f;
#pragma unroll
            for (int dt = 0; dt < 2; ++dt)
#pragma unroll
                for (int i = 0; i < 16; ++i) { const float o = oacc[dt][i] * inv; oacc[dt][i] = o; so += o * o; }
            so += __shfl_xor(so, 32);
            const float rs2 = 1.0f / sqrtf(so * (1.0f / 64.0f) + EPS);
            bf16* orow = F.MIXIN + tok * DM + 2048 + hq * 64;
#pragma unroll
            for (int dt = 0; dt < 2; ++dt)
#pragma unroll
                for (int gq = 0; gq < 4; ++gq) { const int d0 = 32 * dt + 8 * gq + 4 * h; const f32x4 gn = *(const GAS f32x4*)(F.swa_out_norm + d0);
                    v2u o; o.x = pk2(oacc[dt][4 * gq] * rs2 * gn[0], oacc[dt][4 * gq + 1] * rs2 * gn[1]); o.y = pk2(oacc[dt][4 * gq + 2] * rs2 * gn[2], oacc[dt][4 * gq + 3] * rs2 * gn[3]);
                    *(GAS v2u*)(orow + d0) = o; }
        }
    }
    __syncthreads();
}

constexpr int GL_QT = 0, GL_KT = 9216, GL_KHT = 18432, GL_VT = 27648, GL_WG = 46336, GL_BG = 50432, GL_OB = 50688;
__device__ __forceinline__ void gla_g1_units(Frame& F, int u0, int nu) {
    const int bh = u0 >> 5, b = bh >> 4, h = bh & 15, tid = F.tid, lane = F.lane, w = F.wave;
    LAS unsigned char* QT = F.lds + GL_QT;
    LAS unsigned char* KT = F.lds + GL_KT;
    LAS unsigned char* KHT = F.lds + GL_KHT;
    LAS unsigned char* VT = F.lds + GL_VT;
    LAS float* WG = (LAS float*)(F.lds + GL_WG);
    LAS float* BG = (LAS float*)(F.lds + GL_BG);
    LAS float* OB = (LAS float*)(F.lds + GL_OB);
    __syncthreads();
    for (int i = tid; i < 1024; i += 512) WG[i] = F.w_gate_up[(i >> 6) * 1024 + h * 64 + (i & 63)];
    if (tid < 64) BG[tid] = F.b_gla_gate[h * 64 + tid];
    __syncthreads();
    const int r = lane & 15, g = lane >> 4;
    const int t2 = tid >> 3, seg = tid & 7;
    v4u qv, kv, g0, g1, vv0, vv1;
    { const size_t row0 = (size_t)b * SEQ + (u0 & 31) * 64; const bf16* pr = F.PROJ + (row0 + lane) * NPROJ;
      qv = *(const GAS v4u*)(pr + C_GQ + h * 64 + 8 * w); kv = *(const GAS v4u*)(pr + C_GK + h * 64 + 8 * w); g0 = *(const GAS v4u*)(F.GA + (row0 + lane) * 16); g1 = *(const GAS v4u*)(F.GA + (row0 + lane) * 16 + 8);
      const GAS v4u* vr = (const GAS v4u*)(F.PROJ + (row0 + t2) * NPROJ + C_GV + h * 128 + 16 * seg); vv0 = vr[0]; vv1 = vr[1]; }
    for (int ui = 0; ui < nu; ++ui) {
        const int u = u0 + ui, chunk = u & 31;
        const size_t row0 = (size_t)b * SEQ + chunk * 64;
        v4u nqv = qv, nkv = kv, ng0 = g0, ng1 = g1, nvv0 = vv0, nvv1 = vv1;
        if (ui + 1 < nu) {
            const size_t rown = row0 + 64; const bf16* pr = F.PROJ + (rown + lane) * NPROJ;
            nqv = *(const GAS v4u*)(pr + C_GQ + h * 64 + 8 * w); nkv = *(const GAS v4u*)(pr + C_GK + h * 64 + 8 * w); ng0 = *(const GAS v4u*)(F.GA + (rown + lane) * 16); ng1 = *(const GAS v4u*)(F.GA + (rown + lane) * 16 + 8);
            const GAS v4u* vr = (const GAS v4u*)(F.PROJ + (rown + t2) * NPROJ + C_GV + h * 128 + 16 * seg); nvv0 = vr[0]; nvv1 = vr[1]; }
        {
            float ga[16];
#pragma unroll
            for (int e = 0; e < 4; ++e) { ga[2 * e] = bflo(g0[e]); ga[2 * e + 1] = bfhi(g0[e]); ga[8 + 2 * e] = bflo(g1[e]); ga[8 + 2 * e + 1] = bfhi(g1[e]); }
            float z[8];
            { const f32x4 b0 = *(const LAS f32x4*)(BG + 8 * w), b1 = *(const LAS f32x4*)(BG + 8 * w + 4);
#pragma unroll
              for (int i = 0; i < 4; ++i) { z[i] = b0[i]; z[4 + i] = b1[i]; } }
#pragma unroll
            for (int j = 0; j < 16; ++j) { const f32x4 w0 = *(const LAS f32x4*)(WG + j * 64 + 8 * w), w1 = *(const LAS f32x4*)(WG + j * 64 + 8 * w + 4);
#pragma unroll
                for (int i = 0; i < 4; ++i) { z[i] += ga[j] * w0[i]; z[4 + i] += ga[j] * w1[i]; } }
            float bb[8];
#pragma unroll
            for (int i = 0; i < 8; ++i) { const float zz = z[i]; bb[i] = (fminf(zz, 0.f) - __logf(1.0f + __expf(-fabsf(zz)))) * (1.0f / 16.0f); }
#define G1_DPP_ADD(x, ctrl, rmask) x += __builtin_bit_cast(float, __builtin_amdgcn_update_dpp(0, __builtin_bit_cast(int, x), ctrl, rmask, 0xf, false))
#pragma unroll
            for (int i = 0; i < 8; ++i) { G1_DPP_ADD(bb[i], 0x111, 0xf); G1_DPP_ADD(bb[i], 0x112, 0xf); G1_DPP_ADD(bb[i], 0x114, 0xf); G1_DPP_ADD(bb[i], 0x118, 0xf);
                G1_DPP_ADD(bb[i], 0x142, 0xa); G1_DPP_ADD(bb[i], 0x143, 0xc); }
#undef G1_DPP_ADD
            float qn[8], kn[8], kh[8];
#pragma unroll
            for (int e = 0; e < 4; ++e) { qn[2 * e] = bflo(qv[e]); qn[2 * e + 1] = bfhi(qv[e]); kn[2 * e] = bflo(kv[e]); kn[2 * e + 1] = bfhi(kv[e]); }
            float ebl[8];
#pragma unroll
            for (int i = 0; i < 8; ++i) { const float eb = __expf(bb[i]);
                const float bl = __builtin_bit_cast(float, __builtin_amdgcn_readlane(__builtin_bit_cast(int, bb[i]), 63));
                ebl[i] = __builtin_bit_cast(float, __builtin_amdgcn_readlane(__builtin_bit_cast(int, eb), 63));
                qn[i] = qn[i] * 0.125f * eb; kh[i] = kn[i] * __expf(bl - bb[i]); kn[i] = kn[i] * __expf(-bb[i]); }
            if (lane == 0) { GAS f32x4* gp = (GAS f32x4*)(F.GG + (size_t)u * 64 + 8 * w); gp[0] = (f32x4){ebl[0], ebl[1], ebl[2], ebl[3]}; gp[1] = (f32x4){ebl[4], ebl[5], ebl[6], ebl[7]}; }
            const v4u qpk = {pk2(qn[0], qn[1]), pk2(qn[2], qn[3]), pk2(qn[4], qn[5]), pk2(qn[6], qn[7])};
            *(LAS v4u*)(QT + lane * 144 + 16 * w) = qpk;
            *(GAS v4u*)(F.GQT + ((size_t)u * 64 + lane) * 64 + 8 * w) = qpk;
            *(LAS v4u*)(KT + lane * 144 + 16 * w) = (v4u){pk2(kn[0], kn[1]), pk2(kn[2], kn[3]), pk2(kn[4], kn[5]), pk2(kn[6], kn[7])};
#pragma unroll
            for (int i = 0; i < 8; ++i) *(LAS unsigned short*)(KHT + (8 * w + i) * 144 + lane * 2) = (unsigned short)f2bf(kh[i]);
#pragma unroll
            for (int e = 0; e < 4; ++e) {
                *(LAS unsigned short*)(VT + (16 * seg + 2 * e) * 144 + t2 * 2) = (unsigned short)(vv0[e] & 0xffffu);
                *(LAS unsigned short*)(VT + (16 * seg + 2 * e + 1) * 144 + t2 * 2) = (unsigned short)(vv0[e] >> 16);
                *(LAS unsigned short*)(VT + (16 * seg + 8 + 2 * e) * 144 + t2 * 2) = (unsigned short)(vv1[e] & 0xffffu);
                *(LAS unsigned short*)(VT + (16 * seg + 8 + 2 * e + 1) * 144 + t2 * 2) = (unsigned short)(vv1[e] >> 16); }
        }
        __syncthreads();
        {
            unsigned dp[4][4][2];
#pragma unroll
            for (int tt = 0; tt < 4; ++tt) {
                const bf16x8 bq0 = *(const LAS bf16x8*)(QT + (16 * tt + r) * 144 + (8 * g) * 2), bq1 = *(const LAS bf16x8*)(QT + (16 * tt + r) * 144 + (32 + 8 * g) * 2);
#pragma unroll
                for (int st = 0; st < 4; ++st) {
                    if (st <= tt) {
                        const bf16x8 ak0 = *(const LAS bf16x8*)(KT + (16 * st + r) * 144 + (8 * g) * 2), ak1 = *(const LAS bf16x8*)(KT + (16 * st + r) * 144 + (32 + 8 * g) * 2);
                        f32x4 d = {0.f, 0.f, 0.f, 0.f}; d = mfma16(ak0, bq0, d); d = mfma16(ak1, bq1, d);
                        if (st == tt) {
#pragma unroll
                            for (int i = 0; i < 4; ++i) if (4 * g + i > r) d[i] = 0.f; }
                        dp[st][tt][0] = pk2(d[0], d[1]); dp[st][tt][1] = pk2(d[2], d[3]);
                    } else { dp[st][tt][0] = 0u; dp[st][tt][1] = 0u; }
                }
            }
#pragma unroll
            for (int tt = 0; tt < 4; ++tt) {
                f32x4 o = {0.f, 0.f, 0.f, 0.f};
#pragma unroll
                for (int kk = 0; kk < 2; ++kk) {
                    if (2 * kk <= tt) {
                        const LAS unsigned char* vp = VT + (16 * w + r) * 144 + (32 * kk + 4 * g) * 2;
                        const v2u lo = *(const LAS v2u*)vp, hi = *(const LAS v2u*)(vp + 32);
                        o = mfma16(mk8(dp[2 * kk][tt][0], dp[2 * kk][tt][1], dp[2 * kk + 1][tt][0], dp[2 * kk + 1][tt][1]), mk8(lo.x, lo.y, hi.x, hi.y), o);
                    }
                }
#pragma unroll
                for (int i = 0; i < 4; ++i) OB[(16 * tt + 4 * g + i) * 132 + 16 * w + r] = o[i];
            }
#pragma unroll
            for (int dt = 0; dt < 4; ++dt) {
                f32x4 uacc = {0.f, 0.f, 0.f, 0.f};
#pragma unroll
                for (int kk = 0; kk < 2; ++kk) { const bf16x8 a = *(const LAS bf16x8*)(KHT + (16 * dt + r) * 144 + (32 * kk + 8 * g) * 2), bv = *(const LAS bf16x8*)(VT + (16 * w + r) * 144 + (32 * kk + 8 * g) * 2);
                    uacc = mfma16(a, bv, uacc); }
                *(GAS f32x4*)(F.GUT + ((size_t)u * 128 + 16 * w + r) * 64 + 16 * dt + 4 * g) = uacc;
            }
        }
        __syncthreads();
        {
            unsigned ow[8];
#pragma unroll
            for (int j = 0; j < 4; ++j) { const f32x4 v = *(const LAS f32x4*)(OB + t2 * 132 + 16 * seg + 4 * j); ow[2 * j] = pk2(v[0], v[1]); ow[2 * j + 1] = pk2(v[2], v[3]); }
            GAS v4u* op = (GAS v4u*)(F.MIXIN + (row0 + t2) * DM + h * 128 + 16 * seg);
            op[0] = (v4u){ow[0], ow[1], ow[2], ow[3]}; op[1] = (v4u){ow[4], ow[5], ow[6], ow[7]};
        }
        qv = nqv; kv = nkv; g0 = ng0; g1 = ng1; vv0 = nvv0; vv1 = nvv1;
    }
}
__device__ __forceinline__ void gla_scan(Frame& F) {
    const size_t gt = (size_t)F.vcu * 512 + F.tid, NT = (size_t)F.G * 512;
    for (size_t i = gt; i < (size_t)64 * 128 * 16; i += NT) {
        const int bh = (int)(i >> 11), v = (int)((i >> 4) & 127), d4 = (int)(i & 15);
        f32x4 S = {0.f, 0.f, 0.f, 0.f};
#pragma unroll 8
        for (int c = 0; c < 32; ++c) {
            const size_t u = (size_t)bh * 32 + c;
            const f32x4 U = *(const GAS f32x4*)(F.GUT + (u * 128 + v) * 64 + 4 * d4), gg = *(const GAS f32x4*)(F.GG + u * 64 + 4 * d4);
            *(GAS v2u*)(F.GST + (u * 128 + v) * 64 + 4 * d4) = (v2u){pk2(S[0], S[1]), pk2(S[2], S[3])};
            S = gg * S + U;
        }
    }
}
struct G3Ops { v4u oi0, oi1, gg0, gg1; v2u slo[2], shi[2], qlo[4][2], qhi[4][2]; };
__device__ __forceinline__ void gla_g3_load(Frame& F, G3Ops& P, int u, int b, int h, int w, int r, int g, int t2, int seg) {
    const size_t row0 = (size_t)b * SEQ + (u & 31) * 64;
    const GAS v4u* oip = (const GAS v4u*)(F.MIXIN + (row0 + t2) * DM + h * 128 + 16 * seg); P.oi0 = oip[0]; P.oi1 = oip[1];
    const GAS v4u* gr = (const GAS v4u*)(F.PROJ + (row0 + t2) * NPROJ + C_GG + h * 128 + 16 * seg); P.gg0 = gr[0]; P.gg1 = gr[1];
#pragma unroll
    for (int kk = 0; kk < 2; ++kk) { const bf16* sp = F.GST + ((size_t)u * 128 + 16 * w + r) * 64 + 32 * kk + 4 * g; P.slo[kk] = *(const GAS v2u*)sp; P.shi[kk] = *(const GAS v2u*)(sp + 16); }
#pragma unroll
    for (int tt = 0; tt < 4; ++tt)
#pragma unroll
        for (int kk = 0; kk < 2; ++kk) { const bf16* qp = F.GQT + ((size_t)u * 64 + 16 * tt + r) * 64 + 32 * kk + 4 * g; P.qlo[tt][kk] = *(const GAS v2u*)qp; P.qhi[tt][kk] = *(const GAS v2u*)(qp + 16); }
}
__device__ __forceinline__ void gla_g3_units(Frame& F, int u0, int nu) {
    const int bh = u0 >> 5, b = bh >> 4, h = bh & 15, tid = F.tid, lane = F.lane, w = F.wave;
    LAS float* OB = (LAS float*)(F.lds + GL_OB);
    const int r = lane & 15, g = lane >> 4, t2 = tid >> 3, seg = tid & 7;
    LAS float* ON = (LAS float*)(F.lds + GL_WG);
    __syncthreads();
    if (tid < 128) ON[tid] = F.gla_out_norm[tid];
    G3Ops cur, nxt;
    gla_g3_load(F, cur, u0, b, h, w, r, g, t2, seg);
    for (int ui = 0; ui < nu; ++ui) {
        const int u = u0 + ui, chunk = u & 31;
        const size_t row0 = (size_t)b * SEQ + chunk * 64;
        if (ui + 1 < nu) gla_g3_load(F, nxt, u + 1, b, h, w, r, g, t2, seg);
        {
            bf16x8 bs[2];
#pragma unroll
            for (int kk = 0; kk < 2; ++kk) bs[kk] = mk8(cur.slo[kk].x, cur.slo[kk].y, cur.shi[kk].x, cur.shi[kk].y);
#pragma unroll
            for (int tt = 0; tt < 4; ++tt) {
                f32x4 o = {0.f, 0.f, 0.f, 0.f};
#pragma unroll
                for (int kk = 0; kk < 2; ++kk) o = mfma16(mk8(cur.qlo[tt][kk].x, cur.qlo[tt][kk].y, cur.qhi[tt][kk].x, cur.qhi[tt][kk].y), bs[kk], o);
#pragma unroll
                for (int i = 0; i < 4; ++i) OB[(16 * tt + 4 * g + i) * 132 + 16 * w + r] = o[i];
            }
        }
        __syncthreads();
        {
            float o[16]; float ss = 0.f;
#pragma unroll
            for (int j = 0; j < 4; ++j) { const f32x4 v = *(const LAS f32x4*)(OB + t2 * 132 + 16 * seg + 4 * j);
#pragma unroll
                for (int e = 0; e < 4; ++e) o[4 * j + e] = v[e]; }
#pragma unroll
            for (int e = 0; e < 4; ++e) { o[2 * e] += bflo(cur.oi0[e]); o[2 * e + 1] += bfhi(cur.oi0[e]); o[8 + 2 * e] += bflo(cur.oi1[e]); o[8 + 2 * e + 1] += bfhi(cur.oi1[e]); }
#pragma unroll
            for (int e = 0; e < 16; ++e) ss += o[e] * o[e];
            ss += __shfl_xor(ss, 1); ss += __shfl_xor(ss, 2); ss += __shfl_xor(ss, 4);
            const float rstd = 1.0f / sqrtf(ss * (1.0f / 128.0f) + EPS);
            float gg[16];
#pragma unroll
            for (int e = 0; e < 4; ++e) { gg[2 * e] = bflo(cur.gg0[e]); gg[2 * e + 1] = bfhi(cur.gg0[e]); gg[8 + 2 * e] = bflo(cur.gg1[e]); gg[8 + 2 * e + 1] = bfhi(cur.gg1[e]); }
            unsigned ow[8];
            f32x4 on[4];
#pragma unroll
            for (int j = 0; j < 4; ++j) on[j] = *(const LAS f32x4*)(ON + 16 * seg + 4 * j);
#pragma unroll
            for (int e = 0; e < 8; ++e) { const float a = o[2 * e] * rstd * on[e >> 1][(2 * e) & 3] * silu_f(gg[2 * e]), c = o[2 * e + 1] * rstd * on[e >> 1][(2 * e + 1) & 3] * silu_f(gg[2 * e + 1]);
                ow[e] = pk2(a, c); }
            GAS v4u* op = (GAS v4u*)(F.MIXIN + (row0 + t2) * DM + h * 128 + 16 * seg);
            op[0] = (v4u){ow[0], ow[1], ow[2], ow[3]}; op[1] = (v4u){ow[4], ow[5], ow[6], ow[7]};
        }
        __syncthreads();
        cur = nxt;
    }
}

__device__ __forceinline__ void p3a_mixer(Frame& F) {
    for (int u = F.vcu; u < 256; u += F.G) swa_unit(F, u);
    for (int q = F.vcu; q < 256; q += F.G) gla_g1_units(F, q * 8, 8);
}
__device__ __forceinline__ void p3c_mixer(Frame& F) {
    for (int q = F.vcu; q < 256; q += F.G) gla_g3_units(F, q * 8, 8);
}

__device__ __forceinline__ unsigned f2s(float f) { const unsigned u = __builtin_bit_cast(unsigned, f); return (u & 0x80000000u) ? ~u : (u | 0x80000000u); }
__device__ __forceinline__ float s2f(unsigned s) { const unsigned u = (s & 0x80000000u) ? (s & 0x7fffffffu) : ~s; return __builtin_bit_cast(float, u); }
#define TOPK_INSERT(list, xin) do { unsigned _x = (xin); _Pragma("unroll") for (int _p = 0; _p < 16; ++_p) { const unsigned _hi = list[_p] > _x ? list[_p] : _x; _x = list[_p] > _x ? _x : list[_p]; list[_p] = _hi; } } while (0)

__device__ __forceinline__ void cas_desc(unsigned& hi, unsigned& lo) { const unsigned a = hi > lo ? hi : lo, b = hi > lo ? lo : hi; hi = a; lo = b; }
__device__ __forceinline__ void bitonic_merge16_desc(unsigned (&a)[16]) {
#pragma unroll
    for (int j = 8; j > 0; j >>= 1)
#pragma unroll
        for (int i = 0; i < 16; ++i) { const int l = i ^ j; if (l > i) cas_desc(a[i], a[l]); }
}
__device__ __forceinline__ void sort16_desc(unsigned (&a)[16]) {
#pragma unroll
    for (int k = 2; k <= 16; k <<= 1)
#pragma unroll
        for (int j = k >> 1; j > 0; j >>= 1)
#pragma unroll
            for (int i = 0; i < 16; ++i) { const int l = i ^ j; if (l > i) { if (((i & k) == 0) || k == 16) cas_desc(a[i], a[l]); else cas_desc(a[l], a[i]); } }
}
__device__ __forceinline__ void top16_merge_desc(unsigned (&a)[16], const unsigned (&b)[16]) {
#pragma unroll
    for (int i = 0; i < 16; ++i) a[i] = a[i] > b[15 - i] ? a[i] : b[15 - i];
    bitonic_merge16_desc(a);
}
template <int MODE  > __device__ __forceinline__ void p7_topk(Frame& F) {
    const int tid = F.tid, lane = F.lane, wave = F.wave;
    LAS unsigned char* KY = F.lds;
    LAS unsigned* SC = (LAS unsigned*)(F.lds + 69632 + wave * 4096);
#pragma unroll
    for (int j = 0; j < 16; ++j) { const int i4 = j * 512 + tid, hf = i4 >> 12, key = (i4 >> 5) & 127, q4 = i4 & 31;
        const f32x4 v = *(const GAS f32x4*)((hf ? F.keys2 : F.keys1) + key * 128 + 4 * q4);
        *(LAS v2u*)(KY + hf * 34816 + key * 272 + q4 * 8) = (v2u){pk2(v[0], v[1]), pk2(v[2], v[3])}; }
    __syncthreads();
    const int gw = F.vcu * NWAVES + wave, NGW = F.G * NWAVES;
    const int r = lane & 31, h = lane >> 5;
    for (int task = gw; task < 256 * 8; task += NGW) {
        const int tile = task >> 3, hd = task & 7, tok = tile * 32 + r;
        for (int hf = 0; hf < 2; ++hf) {
            const GAS v4u* qr = (const GAS v4u*)(F.QPEER + (size_t)tok * PEER_N + hd * 256 + hf * 128);
            bf16x8 qf[8];
#pragma unroll
            for (int kk = 0; kk < 8; ++kk) qf[kk] = __builtin_bit_cast(bf16x8, qr[2 * kk + h]);
            unsigned list[16];
#pragma unroll
            for (int T = 0; T < 4; ++T) {
                f32x16 a = {0.f, 0.f, 0.f, 0.f, 0.f, 0.f, 0.f, 0.f, 0.f, 0.f, 0.f, 0.f, 0.f, 0.f, 0.f, 0.f};
#pragma unroll
                for (int kk = 0; kk < 8; ++kk) { const bf16x8 kf = *(const LAS bf16x8*)(KY + hf * 34816 + (32 * T + r) * 272 + (16 * kk + 8 * h) * 2); a = mfma32(kf, qf[kk], a); }
                unsigned tl[16];
#pragma unroll
                for (int i = 0; i < 16; ++i) { const int key = 32 * T + (i & 3) + 8 * (i >> 2) + 4 * h; tl[i] = (f2s(a[i]) & ~127u) | (unsigned)(127 - key); }
                sort16_desc(tl);
                if (T == 0) {
#pragma unroll
                    for (int i = 0; i < 16; ++i) list[i] = tl[i];
                } else top16_merge_desc(list, tl);
            }
            unsigned other[16];
#pragma unroll
            for (int p = 0; p < 16; ++p) other[p] = (unsigned)__shfl_xor((int)list[p], 32);
            top16_merge_desc(list, other);
            if (h == 0) {
#pragma unroll
                for (int p = 0; p < 16; ++p) SC[(hf * 16 + p) * 32 + r] = list[p]; }
        }
        LDS_WAIT(); asm volatile("" ::: "memory");
        float v1[16], v2[16];
#pragma unroll
        for (int p = 0; p < 16; ++p) { v1[p] = s2f(SC[p * 32 + r] & ~127u); v2[p] = s2f(SC[(16 + p) * 32 + r] & ~127u); }
#define P7_CAND(i, j) ((f2s(v1[i] + v2[j]) & ~255u) | (unsigned)(255 - ((i) * 16 + (j))))
        unsigned cl[16], cb[16], cc[16], cd[16];
#pragma unroll
        for (int j = 0; j < 16; ++j) { cl[j] = P7_CAND(0, j); cb[j] = j < 8 ? P7_CAND(1, j < 8 ? j : 0) : 0u; }
        cc[0] = P7_CAND(2, 0); cc[1] = P7_CAND(2, 1); cc[2] = P7_CAND(2, 2); cc[3] = P7_CAND(2, 3); cc[4] = P7_CAND(2, 4);
        cc[5] = P7_CAND(3, 0); cc[6] = P7_CAND(3, 1); cc[7] = P7_CAND(3, 2); cc[8] = P7_CAND(3, 3);
        cc[9] = P7_CAND(4, 0); cc[10] = P7_CAND(4, 1); cc[11] = P7_CAND(4, 2);
        cc[12] = P7_CAND(5, 0); cc[13] = P7_CAND(5, 1); cc[14] = P7_CAND(6, 0); cc[15] = P7_CAND(6, 1);
        cd[0] = P7_CAND(7, 0); cd[1] = P7_CAND(7, 1);
#pragma unroll
        for (int i = 8; i < 16; ++i) cd[i - 6] = P7_CAND(i, 0);
#pragma unroll
        for (int i = 10; i < 16; ++i) cd[i] = 0u;
#undef P7_CAND
        sort16_desc(cc); sort16_desc(cd);
        top16_merge_desc(cl, cb); top16_merge_desc(cc, cd); top16_merge_desc(cl, cc);
        float val[8]; int eidx[8]; float mx = -INFINITY;
#pragma unroll
        for (int p = 0; p < 16; ++p) { const int pos = 255 - (int)(cl[p] & 255u), i = pos >> 4, j = pos & 15;
            const unsigned a = SC[i * 32 + r], b2 = SC[(16 + j) * 32 + r];
            const float v = s2f(a & ~127u) + s2f(b2 & ~127u); mx = fmaxf(mx, v);
            if ((p >> 3) == h) { val[p & 7] = v; eidx[p & 7] = (127 - (int)(a & 127u)) * 128 + (127 - (int)(b2 & 127u)); } }
        float sum = 0.f, ex[8];
#pragma unroll
        for (int p = 0; p < 8; ++p) { ex[p] = __expf(val[p] - mx); sum += ex[p]; }
        sum += __shfl_xor(sum, 32);
        const float inv = 1.0f / sum;
        const int p4a = hd * 4 + 2 * h;
        GAS v4u* ip = (GAS v4u*)F.EIDX; GAS f32x4* gp = (GAS f32x4*)F.GATEQ;
        ip[(size_t)p4a * NTOK + tok] = (v4u){(unsigned)eidx[0], (unsigned)eidx[1], (unsigned)eidx[2], (unsigned)eidx[3]}; ip[(size_t)(p4a + 1) * NTOK + tok] = (v4u){(unsigned)eidx[4], (unsigned)eidx[5], (unsigned)eidx[6], (unsigned)eidx[7]};
        ((GAS v4u*)F.EIDX16)[(size_t)(hd * 2 + h) * NTOK + tok] = (v4u){(unsigned)eidx[0] | ((unsigned)eidx[1] << 16), (unsigned)eidx[2] | ((unsigned)eidx[3] << 16), (unsigned)eidx[4] | ((unsigned)eidx[5] << 16), (unsigned)eidx[6] | ((unsigned)eidx[7] << 16)};
        gp[(size_t)p4a * NTOK + tok] = (f32x4){ex[0] * inv, ex[1] * inv, ex[2] * inv, ex[3] * inv}; gp[(size_t)(p4a + 1) * NTOK + tok] = (f32x4){ex[4] * inv, ex[5] * inv, ex[6] * inv, ex[7] * inv};
        LDS_WAIT(); asm volatile("" ::: "memory");
    }
}

typedef int i32x4 __attribute__((ext_vector_type(4)));
__device__ __forceinline__ void lds_fill_128k(Frame& F, const unsigned char* src, int rot) {
    const unsigned long long g = (unsigned long long)src; const unsigned lo = __builtin_amdgcn_readfirstlane((unsigned)g), hi = __builtin_amdgcn_readfirstlane((unsigned)(g >> 32));
    const unsigned char* sb = (const unsigned char*)(((unsigned long long)hi << 32) | lo);
    const unsigned voff = (unsigned)F.tid * 16u; const int r8 = __builtin_amdgcn_readfirstlane(rot) & 15;
#pragma unroll
    for (int i = 0; i < 16; ++i) { const int ii = (i + r8) & 15;
        __builtin_amdgcn_global_load_lds((const unsigned*)(sb + (size_t)ii * 8192 + voff), (LAS unsigned*)(F.lds + ii * 8192 + F.wave * 1024), 16, 0, 0); }
}
__device__ __forceinline__ unsigned p8_off_lo(unsigned idr, unsigned three) { unsigned r; asm("v_lshlrev_b32_sdwa %0, %1, %2 dst_sel:DWORD dst_unused:UNUSED_PAD src0_sel:DWORD src1_sel:WORD_0" : "=v"(r) : "v"(three), "v"(idr)); return r; }
__device__ __forceinline__ unsigned p8_off_hi(unsigned idr, unsigned three) { unsigned r; asm("v_lshlrev_b32_sdwa %0, %1, %2 dst_sel:DWORD dst_unused:UNUSED_PAD src0_sel:DWORD src1_sel:WORD_1" : "=v"(r) : "v"(three), "v"(idr)); return r; }
#define P8_GATHER8(D, I0, I1, I2, I3) do { unsigned t0_, t1_, t2_, t3_; asm volatile( \
            "v_lshlrev_b32_sdwa %8, %12, %13 dst_sel:DWORD dst_unused:UNUSED_PAD src0_sel:DWORD src1_sel:WORD_0\n\t" \
            "v_lshlrev_b32_sdwa %9, %12, %13 dst_sel:DWORD dst_unused:UNUSED_PAD src0_sel:DWORD src1_sel:WORD_1\n\t" \
            "v_lshlrev_b32_sdwa %10, %12, %14 dst_sel:DWORD dst_unused:UNUSED_PAD src0_sel:DWORD src1_sel:WORD_0\n\t" \
            "v_lshlrev_b32_sdwa %11, %12, %14 dst_sel:DWORD dst_unused:UNUSED_PAD src0_sel:DWORD src1_sel:WORD_1\n\t" \
            "ds_read_b64 %0, %8\n\t" \
            "ds_read_b64 %1, %9\n\t" \
            "ds_read_b64 %2, %10\n\t" \
            "ds_read_b64 %3, %11\n\t" \
            "v_lshlrev_b32_sdwa %8, %12, %15 dst_sel:DWORD dst_unused:UNUSED_PAD src0_sel:DWORD src1_sel:WORD_0\n\t" \
            "v_lshlrev_b32_sdwa %9, %12, %15 dst_sel:DWORD dst_unused:UNUSED_PAD src0_sel:DWORD src1_sel:WORD_1\n\t" \
            "v_lshlrev_b32_sdwa %10, %12, %16 dst_sel:DWORD dst_unused:UNUSED_PAD src0_sel:DWORD src1_sel:WORD_0\n\t" \
            "v_lshlrev_b32_sdwa %11, %12, %16 dst_sel:DWORD dst_unused:UNUSED_PAD src0_sel:DWORD src1_sel:WORD_1\n\t" \
            "ds_read_b64 %4, %8\n\t" \
            "ds_read_b64 %5, %9\n\t" \
            "ds_read_b64 %6, %10\n\t" \
            "ds_read_b64 %7, %11" \
            : "=&v"(D[0]), "=&v"(D[1]), "=&v"(D[2]), "=&v"(D[3]), "=&v"(D[4]), "=&v"(D[5]), "=&v"(D[6]), "=&v"(D[7]), "=&v"(t0_), "=&v"(t1_), "=&v"(t2_), "=&v"(t3_) : "v"(three), "v"(I0), "v"(I1), "v"(I2), "v"(I3)); } while (0)
constexpr int P8_YB = 132096;
constexpr int P8_DUMMY = 140288;
#define P8_WAITV0() asm volatile("s_waitcnt vmcnt(0)" ::: "memory")
#define P8_BAR() do { asm volatile("s_waitcnt lgkmcnt(0)" ::: "memory"); __builtin_amdgcn_s_barrier(); asm volatile("" ::: "memory"); } while (0)
__device__ __forceinline__ void p8a_sddmm(Frame& F) {
    const int wv = F.wave;
    unsigned three = 3u; asm volatile("" : "+v"(three));
    for (int u = F.vcu; u < 256; u += F.G) {
        const int tg = u & 15, dr = u >> 4, t = tg * 512 + F.tid;
        unsigned id[64];
#pragma unroll
        for (int p8 = 0; p8 < 16; ++p8) { const v4u v = ((const GAS v4u*)F.EIDX16)[(size_t)p8 * NTOK + t]; id[4 * p8] = v.x; id[4 * p8 + 1] = v.y; id[4 * p8 + 2] = v.z; id[4 * p8 + 3] = v.w; }
        int acc[128];
#pragma unroll
        for (int p = 0; p < 128; ++p) acc[p] = 0;
        const unsigned char* tab = F.DC8 + (size_t)(dr * 32) * 131072;
        const unsigned char* ysrc = F.YC8 + ((size_t)(dr * 32) * NTOK + tg * 512) * 8 + (wv & 3) * 1024 + F.lane * 16;
        for (int sl = 0; sl < 32; ++sl) {
#pragma unroll
            for (int i = 0; i < 64; ++i) asm volatile("" : "+v"(id[i]));
            P8_WAITV0();
            P8_BAR();
            lds_fill_128k(F, tab + (size_t)sl * 131072, tg);
            if (wv < 4) __builtin_amdgcn_global_load_lds((const unsigned*)(ysrc + (size_t)sl * NTOK * 8), (LAS unsigned*)(F.lds + P8_YB + wv * 1024), 16, 0, 0);
            P8_WAITV0();
            P8_BAR();
            if (sl + 1 < 32) __builtin_amdgcn_global_load_lds((const unsigned*)(tab + (size_t)(sl + 1) * 131072 + (size_t)tg * 8192 + wv * 1024 + F.lane * 16), (LAS unsigned*)(F.lds + P8_DUMMY + wv * 1024), 16, 0, 0);
            const v2u yv = *(const LAS v2u*)(F.lds + P8_YB + F.tid * 8);
            v2u dA[8], dB[8];
#define P8A_OFF(p) (((p) & 1) ? p8_off_hi(id[(p) >> 1], three) : p8_off_lo(id[(p) >> 1], three))
#define P8A_LOAD(dst, pb) P8_GATHER8(dst, id[(pb) >> 1], id[((pb) >> 1) + 1], id[((pb) >> 1) + 2], id[((pb) >> 1) + 3])
#define P8A_DOT(src, pb) do { _Pragma("unroll") for (int j_ = 0; j_ < 8; ++j_) { acc[(pb) + j_] = __builtin_amdgcn_sdot4((int)src[j_].x, (int)yv.x, acc[(pb) + j_], false); acc[(pb) + j_] = __builtin_amdgcn_sdot4((int)src[j_].y, (int)yv.y, acc[(pb) + j_], false); } \
                _Pragma("unroll") for (int j_ = 0; j_ < 8; ++j_) asm volatile("" : "+v"(acc[(pb) + j_])); } while (0)
            asm volatile("s_waitcnt lgkmcnt(0)" ::: "memory"); __builtin_amdgcn_sched_barrier(0);
            P8A_LOAD(dA, 0);
#pragma unroll
            for (int pb = 0; pb < 128; pb += 16) {
                P8A_LOAD(dB, pb + 8);
                asm volatile("s_waitcnt lgkmcnt(8)" ::: "memory"); __builtin_amdgcn_sched_barrier(0);
                P8A_DOT(dA, pb);
                __builtin_amdgcn_sched_barrier(0);
                if (pb + 16 < 128) { P8A_LOAD(dA, pb + 16); asm volatile("s_waitcnt lgkmcnt(8)" ::: "memory"); } else asm volatile("s_waitcnt lgkmcnt(0)" ::: "memory");
                __builtin_amdgcn_sched_barrier(0);
                P8A_DOT(dB, pb + 8);
                __builtin_amdgcn_sched_barrier(0);
            }
#undef P8A_OFF
#undef P8A_LOAD
#undef P8A_DOT
        }
#pragma unroll
        for (int p4 = 0; p4 < 32; ++p4) ((GAS i32x4*)F.ZP)[((size_t)(dr * 32 + p4)) * NTOK + t] = (i32x4){acc[4 * p4], acc[4 * p4 + 1], acc[4 * p4 + 2], acc[4 * p4 + 3]};
    }
    P8_WAITV0();
    __syncthreads();
}
__device__ __forceinline__ void p8h_gate(Frame& F) {
    const size_t gt = (size_t)F.vcu * 512 + F.tid, NT = (size_t)F.G * 512;
    for (size_t i = gt; i < (size_t)32 * NTOK; i += NT) {
        const int p4 = (int)(i >> 13), t = (int)(i & (NTOK - 1));
        i32x4 z = {0, 0, 0, 0};
#pragma unroll
        for (int dr = 0; dr < 16; ++dr) z += ((const GAS i32x4*)F.ZP)[((size_t)(dr * 32 + p4)) * NTOK + t];
        const v4u e4 = ((const GAS v4u*)F.EIDX)[i]; const f32x4 g4 = ((const GAS f32x4*)F.GATEQ)[i]; const float ys = F.YSC[t];
        f32x4 hf; float mx = 0.f;
#pragma unroll
        for (int c = 0; c < 4; ++c) { const float zz = (float)z[c] * ys * F.DSC[e4[c]]; hf[c] = 0.5f * zz * (1.0f + erff(zz * 0.70710678118654752f)) * g4[c] * F.USC[e4[c]]; mx = fmaxf(mx, fabsf(hf[c])); }
        ((GAS f32x4*)F.HF)[i] = hf;
        atomicMax(F.TMAX + t, __builtin_bit_cast(unsigned, mx));
    }
}
__device__ __forceinline__ void tr4(unsigned a0, unsigned a1, unsigned a2, unsigned a3, unsigned (&T)[4]) {
    const unsigned t0 = __builtin_amdgcn_perm(a1, a0, 0x05010400u), t1 = __builtin_amdgcn_perm(a1, a0, 0x07030602u);
    const unsigned t2 = __builtin_amdgcn_perm(a3, a2, 0x05010400u), t3 = __builtin_amdgcn_perm(a3, a2, 0x07030602u);
    T[0] = __builtin_amdgcn_perm(t2, t0, 0x05040100u); T[1] = __builtin_amdgcn_perm(t2, t0, 0x07060302u);
    T[2] = __builtin_amdgcn_perm(t3, t1, 0x05040100u); T[3] = __builtin_amdgcn_perm(t3, t1, 0x07060302u);
}
template <int MODE  > __device__ __forceinline__ void p8b_spmm(Frame& F, float* dst) {
    unsigned three = 3u; asm volatile("" : "+v"(three));
    for (int u = F.vcu; u < 256; u += F.G) {
        const int tg = u & 15, sr = u >> 4, t = tg * 512 + F.tid, b = t >> 11;
        unsigned id[64], hq[32];
#pragma unroll
        for (int p8 = 0; p8 < 16; ++p8) { const v4u v = ((const GAS v4u*)F.EIDX16)[(size_t)p8 * NTOK + t]; id[4 * p8] = v.x; id[4 * p8 + 1] = v.y; id[4 * p8 + 2] = v.z; id[4 * p8 + 3] = v.w; }
        const float smax = __builtin_bit_cast(float, F.TMAX[t]);
        const float qinv = smax > 0.f ? 127.0f / smax : 0.f, oscale = smax * (1.0f / 127.0f);
#pragma unroll
        for (int p4 = 0; p4 < 32; ++p4) { const f32x4 hv = ((const GAS f32x4*)F.HF)[(size_t)p4 * NTOK + t]; hq[p4] = pack4i(hv[0] * qinv, hv[1] * qinv, hv[2] * qinv, hv[3] * qinv); }
        const bf16* xrow = F.X1 + (size_t)t * DM; float* orow = dst + (size_t)t * DM; const float* g2 = F.MOD + b * NMOD + 5 * DM;
        LAS f32x4* G2L = (LAS f32x4*)(F.lds + P8_YB);
        P8_BAR();
        if (F.tid < 64) G2L[F.tid] = ((const GAS f32x4*)(g2 + sr * 256))[F.tid];
        v4u xw[4], xn[4];
#pragma unroll
        for (int k = 0; k < 4; ++k) xw[k] = *(const GAS v4u*)(xrow + sr * 256 + 8 * k);
#pragma unroll
        for (int k = 0; k < 4; ++k) xn[k] = xw[k];
        for (int sg = 0; sg < 8; ++sg) {
            int acc[4][8];
#pragma unroll
            for (int k = 0; k < 4; ++k) {
                const int s = sr * 32 + sg * 4 + k;
#pragma unroll
                for (int i = 0; i < 64; ++i) asm volatile("" : "+v"(id[i]));
                P8_WAITV0();
                P8_BAR();
                if (MODE != 1) lds_fill_128k(F, F.UC8 + (size_t)s * 131072, tg);
                P8_WAITV0();
                P8_BAR();
                if (MODE != 1 && (sg * 4 + k) + 1 < 32) __builtin_amdgcn_global_load_lds((const unsigned*)(F.UC8 + (size_t)(s + 1) * 131072 + (size_t)tg * 8192 + F.wave * 1024 + F.lane * 16), (LAS unsigned*)(F.lds + P8_DUMMY + F.wave * 1024), 16, 0, 0);
                if (k == 3 && sg + 1 < 8) {
#pragma unroll
                    for (int kk = 0; kk < 4; ++kk) xn[kk] = *(const GAS v4u*)(xrow + (sr * 32 + (sg + 1) * 4) * 8 + 8 * kk); }
#pragma unroll
                for (int c = 0; c < 8; ++c) acc[k][c] = 0;
                v2u wA[8], wB[8];
#define P8B_OFF(p) (((p) & 1) ? p8_off_hi(id[(p) >> 1], three) : p8_off_lo(id[(p) >> 1], three))
#define P8B_LOAD(dst_, pb) P8_GATHER8(dst_, id[(pb) >> 1], id[((pb) >> 1) + 1], id[((pb) >> 1) + 2], id[((pb) >> 1) + 3])
#define P8B_DOT(src, pb) do { _Pragma("unroll") for (int g_ = 0; g_ < 2; ++g_) { unsigned TL[4], TH[4]; \
                    tr4(src[4 * g_].x, src[4 * g_ + 1].x, src[4 * g_ + 2].x, src[4 * g_ + 3].x, TL); tr4(src[4 * g_].y, src[4 * g_ + 1].y, src[4 * g_ + 2].y, src[4 * g_ + 3].y, TH); \
                    const int hq_ = (int)hq[((pb) >> 2) + g_]; \
                    _Pragma("unroll") for (int c_ = 0; c_ < 4; ++c_) { acc[k][c_] = __builtin_amdgcn_sdot4((int)TL[c_], hq_, acc[k][c_], false); acc[k][4 + c_] = __builtin_amdgcn_sdot4((int)TH[c_], hq_, acc[k][4 + c_], false); } } \
                    _Pragma("unroll") for (int c_ = 0; c_ < 8; ++c_) asm volatile("" : "+v"(acc[k][c_])); } while (0)
                constexpr int NP = (MODE == 2 ? 16 : 128);
                asm volatile("s_waitcnt lgkmcnt(0)" ::: "memory"); __builtin_amdgcn_sched_barrier(0);
                P8B_LOAD(wA, 0);
#pragma unroll
                for (int pb = 0; pb < NP; pb += 16) {
                    P8B_LOAD(wB, pb + 8);
                    asm volatile("s_waitcnt lgkmcnt(8)" ::: "memory"); __builtin_amdgcn_sched_barrier(0);
                    P8B_DOT(wA, pb);
                    __builtin_amdgcn_sched_barrier(0);
                    if (pb + 16 < NP) { P8B_LOAD(wA, pb + 16); asm volatile("s_waitcnt lgkmcnt(8)" ::: "memory"); } else asm volatile("s_waitcnt lgkmcnt(0)" ::: "memory");
                    __builtin_amdgcn_sched_barrier(0);
                    P8B_DOT(wB, pb + 8);
                    __builtin_amdgcn_sched_barrier(0);
                }
#undef P8B_OFF
#undef P8B_LOAD
#undef P8B_DOT
            }
            const int c0 = (sr * 32 + sg * 4) * 8;
            f32x4 ov[8];
#pragma unroll
            for (int k = 0; k < 4; ++k) {
                const v4u xv = xw[k]; const f32x4 xa = {bflo(xv.x), bfhi(xv.x), bflo(xv.y), bfhi(xv.y)}, xb = {bflo(xv.z), bfhi(xv.z), bflo(xv.w), bfhi(xv.w)};
                const f32x4 ga = G2L[sg * 8 + 2 * k] * oscale, gb = G2L[sg * 8 + 2 * k + 1] * oscale;
                ov[2 * k] = (f32x4){xa[0] + ga[0] * (float)acc[k][0], xa[1] + ga[1] * (float)acc[k][1], xa[2] + ga[2] * (float)acc[k][2], xa[3] + ga[3] * (float)acc[k][3]};
                ov[2 * k + 1] = (f32x4){xb[0] + gb[0] * (float)acc[k][4], xb[1] + gb[1] * (float)acc[k][5], xb[2] + gb[2] * (float)acc[k][6], xb[3] + gb[3] * (float)acc[k][7]};
            }
            {
                LAS unsigned char* scr = F.lds + (F.wave < 4 ? 136192 + F.wave * 1024 : 148480 + (F.wave - 4) * 1024);
                const int lt = F.lane >> 3, lp = F.lane & 7;
                float* obase = dst + ((size_t)(tg * 512 + F.wave * 64 + lt)) * DM + c0 + 4 * lp;
#pragma unroll
                for (int o = 0; o < 8; ++o) {
                    if (lt == o) {
#pragma unroll
                        for (int j = 0; j < 8; ++j) *(LAS f32x4*)(scr + lp * 128 + ((j ^ lp) * 16)) = ov[j]; }
                    asm volatile("s_waitcnt lgkmcnt(0)" ::: "memory");
                    const f32x4 piece = *(const LAS f32x4*)(scr + lt * 128 + ((lp ^ lt) * 16));
                    asm volatile("s_waitcnt lgkmcnt(0)" ::: "memory");
                    *(GAS f32x4*)(obase + (size_t)(8 * o) * DM) = piece;
                }
            }
#pragma unroll
            for (int k = 0; k < 4; ++k) xw[k] = xn[k];
        }
    }
    P8_WAITV0();
    __syncthreads();
}

struct Args { const float* in[18]; float* out; unsigned char* ws; int ph_lo, ph_hi; };
__global__ void __launch_bounds__(NWAVES * 64, 2) mega_fwd(Args args) {
    extern __shared__ __attribute__((aligned(16))) unsigned char lds[];
    Frame F;
    F.lds = (LAS unsigned char*)lds;
    F.MISC = (volatile LAS unsigned*)(F.lds + MISC_OFF);
    F.tid = threadIdx.x; F.lane = F.tid & 63; F.wave = __builtin_amdgcn_readfirstlane(F.tid >> 6);
    F.G = gridDim.x; { const int bx = blockIdx.x; F.vcu = (F.G % 8 == 0) ? (bx % 8) * (F.G / 8) + bx / 8 : bx; }
    unsigned char* ws = args.ws;
    F.ctl = (unsigned*)(ws + WS_CTL);
    F.x = args.in[0]; F.c = args.in[1]; F.w_ada = args.in[2]; F.b_ada = args.in[3]; F.w_in = args.in[4]; F.w_gate_up = args.in[5]; F.b_gla_gate = args.in[6]; F.gla_out_norm = args.in[7];
    F.swa_q_norm = args.in[8]; F.swa_k_norm = args.in[9]; F.swa_sinks = args.in[10]; F.swa_out_norm = args.in[11]; F.w_out = args.in[12]; F.w_peer_q = args.in[13];
    F.keys1 = args.in[14]; F.keys2 = args.in[15]; F.edown = args.in[16]; F.eup = args.in[17];
    F.out = args.out; F.ws = ws;
    F.MOD = (float*)(ws + WS_MOD); F.ROPE = (float*)(ws + WS_ROPE);
    F.BTIN = (bf16*)(ws + WS_BTIN); F.BTOUT = (bf16*)(ws + WS_BTOUT); F.BTQ = (bf16*)(ws + WS_BTQ); F.HBUF = (bf16*)(ws + WS_HBUF); F.PROJ = (bf16*)(ws + WS_PROJ);
    F.MIXIN = (bf16*)(ws + WS_MIXIN); F.QPEER = (bf16*)(ws + WS_QPEER);
    F.DC8 = ws + WS_DC8; F.UC8 = ws + WS_UC8; F.YC8 = ws + WS_YC8; F.ZP = (int*)(ws + WS_ZP); F.EIDX = (unsigned*)(ws + WS_EIDX); F.HE = (unsigned*)(ws + WS_HE);
    F.EIDX16 = (unsigned*)(ws + WS_EIDX16);
    F.GQT = (bf16*)(ws + WS_QPEER); F.GST = (bf16*)(ws + WS_YC8); F.GUT = (float*)(ws + WS_ZP); F.GG = (float*)(ws + WS_IDX); F.X1 = (bf16*)(ws + WS_PROJ); F.GA = (bf16*)(ws + WS_GA);   F.GATEQ = (float*)(ws + WS_GATEQ); F.DSC = (float*)(ws + WS_DSC); F.USC = (float*)(ws + WS_DSC + 131072); F.HF = (float*)(ws + WS_HE); F.TMAX = (unsigned*)(ws + WS_CTL + 524288);     F.YSC = (float*)(ws + WS_YSC);
    for (int u = F.tid; u < (LDS_BYTES - LDSCTL_OFF) / 4; u += NWAVES * 64) ((LAS unsigned*)(F.lds + LDSCTL_OFF))[u] = 0u;
    __syncthreads();
    XcdBarrier bar; bar.bar = F.ctl + CW_BAR; bar.x = 0; bar.st = nullptr;
    if (N_LAUNCHES == 1) bar = xcd_barrier_post(F.ctl + CW_BAR, F.MISC + 8);
#define GRID_BAR() do { if (N_LAUNCHES == 1) xcd_barrier(bar); } while (0)
    const int lo = args.ph_lo, hi = args.ph_hi;
#define IN(k) (lo <= (k) && (k) < hi)
#define BOTH(k) (IN(k) && IN((k) + 1))

    if (PROBE_REP_PHASE == 20 && IN(0)) { p0a_ada(F); GRID_BAR(); }
    if (PROBE_REP_PHASE == 21 && IN(0)) { p0b_weights(F); GRID_BAR(); }
    if (PROBE_REP_PHASE == 22 && IN(0)) { p0c_tables(F); GRID_BAR(); }
    for (int rep_ = 0; rep_ < (PROBE_REP_PHASE == 0 ? 2 : 1); ++rep_) if (IN(0)) { p0_prologue(F); if (BOTH(0)) GRID_BAR(); }
    for (int rep_ = 0; rep_ < (PROBE_REP_PHASE == 1 ? 2 : 1); ++rep_) if (IN(1)) { modulate_rows(F, F.x, F.HBUF, 0, DM); p1b_ga(F); if (BOTH(1)) GRID_BAR(); }
    for (int rep_ = 0; rep_ < (PROBE_REP_PHASE == 2 ? 2 : 1); ++rep_) if (IN(2)) {
        pg8::Gemm g{F.HBUF, F.BTIN, NTOK, GEMM1_N, DM}; pg8::StaticOrder S; S.init(NTOK, GEMM1_N, F.G, (int)blockIdx.x);
        pg8::EpiBf16 E{F.PROJ, NPROJ};
        pg8::gemm_phase<pg8::EpiBf16, pg8::StaticOrder, true, true>(F.lds, g, S, E);
        {
            const int G = F.G, rem = GEMM1_UNITS % G, tg = tail_groups(G), nidle = G - rem;
            if (rem != 0 && (int)blockIdx.x >= rem) convert_expert_groups(F, (int)blockIdx.x - rem, tg, nidle);
        }
        if (BOTH(2)) GRID_BAR();
    }
    for (int rep_ = 0; rep_ < (PROBE_REP_PHASE == 3 ? 2 : 1); ++rep_) if (IN(3)) { p3a_mixer(F); GRID_BAR(); gla_scan(F); GRID_BAR(); p3c_mixer(F); if (BOTH(3)) GRID_BAR(); }
    for (int rep_ = 0; rep_ < (PROBE_REP_PHASE == 4 ? 2 : 1); ++rep_) if (IN(4)) {
        pg8::Gemm g{F.MIXIN, F.BTOUT, NTOK, DM, DM}; pg8::StaticOrder S; S.init(NTOK, DM, F.G, (int)blockIdx.x);
        pg8::EpiResid E{F.x, F.X1, DM, F.MOD + 2 * DM, NMOD, SEQ / 256};
        pg8::gemm_phase<pg8::EpiResid, pg8::StaticOrder, true, true>(F.lds, g, S, E);
        if (BOTH(4)) GRID_BAR();
    }
    for (int rep_ = 0; rep_ < (PROBE_REP_PHASE == 5 ? 2 : 1); ++rep_) if (IN(5)) { p5_modulate_quant(F); if (BOTH(5)) GRID_BAR(); }
    for (int rep_ = 0; rep_ < (PROBE_REP_PHASE == 6 ? 2 : 1); ++rep_) if (IN(6)) {
        pg8::Gemm g{F.HBUF, F.BTQ, NTOK, PEER_N, DM}; pg8::StaticOrder S; S.init(NTOK, PEER_N, F.G, (int)blockIdx.x);
        pg8::EpiBf16 E{F.QPEER, PEER_N};
        pg8::gemm_phase<pg8::EpiBf16, pg8::StaticOrder, true, true>(F.lds, g, S, E);
        if (BOTH(6)) GRID_BAR();
    }
    if (PROBE_REP_PHASE == 41 && IN(7)) { p7_topk<1>(F); GRID_BAR(); }
    if (PROBE_REP_PHASE == 42 && IN(7)) { p7_topk<2>(F); GRID_BAR(); }
    for (int rep_ = 0; rep_ < (PROBE_REP_PHASE == 7 ? 2 : 1); ++rep_) if (IN(7)) { p7_topk<0>(F); if (BOTH(7)) GRID_BAR(); }
    for (int rep_ = 0; rep_ < (PROBE_REP_PHASE == 8 ? 2 : 1); ++rep_) if (IN(8)) { p8a_sddmm(F); if (BOTH(8)) GRID_BAR(); }
    for (int rep_ = 0; rep_ < (PROBE_REP_PHASE == 9 ? 2 : 1); ++rep_) if (IN(9)) { p8h_gate(F); if (BOTH(9)) GRID_BAR(); }
    if (PROBE_REP_PHASE == 10 && IN(10)) { p8b_spmm<0>(F, (float*)(F.ws + WS_BTIN)); GRID_BAR(); }
    if (PROBE_REP_PHASE == 11 && IN(10)) { p8b_spmm<1>(F, (float*)F.PROJ); GRID_BAR(); }
    if (PROBE_REP_PHASE == 12 && IN(10)) { p8b_spmm<2>(F, (float*)F.PROJ); GRID_BAR(); }
    if (IN(10)) { p8b_spmm<0>(F, F.out); }
#undef IN
#undef BOTH
}

extern "C" void kernel_launch(void* const* d_in, const int* in_sizes, int n_in, void* d_out, int out_size, void* d_ws, size_t ws_size, hipStream_t stream) {
    static int grid = 0;
    if (grid == 0) {
        if (n_in != 18 || out_size != NTOK * DM || ws_size < WS_END) { fprintf(stderr, "kernel_launch: unexpected shapes (n_in %d, out %d, ws %zu); nothing launched\n", n_in, out_size, ws_size); grid = -1; return; }
        int dev = 0, cus = 0, per_cu = 0;
        if (hipGetDevice(&dev) != hipSuccess || hipDeviceGetAttribute(&cus, hipDeviceAttributeMultiprocessorCount, dev) != hipSuccess) { grid = -1; return; }
        if (hipFuncSetAttribute((const void*)mega_fwd, hipFuncAttributeMaxDynamicSharedMemorySize, LDS_BYTES) != hipSuccess) { fprintf(stderr, "kernel_launch: hipFuncSetAttribute failed\n"); grid = -1; return; }
        if (hipOccupancyMaxActiveBlocksPerMultiprocessor(&per_cu, (const void*)mega_fwd, NWAVES * 64, LDS_BYTES) != hipSuccess || per_cu < 1)
            fprintf(stderr, "kernel_launch: note: occupancy query reports %d workgroups per CU\n", per_cu);
        (void)hipGetLastError();
        grid = cus;
    }
    if (grid < 0) return;
    (void)hipMemsetAsync((char*)d_ws + WS_CTL, 0, CTL_ZERO_BYTES, stream);
    Args a{};
    for (int i = 0; i < 18; ++i) a.in[i] = (const float*)d_in[i];
    a.out = (float*)d_out; a.ws = (unsigned char*)d_ws;
    if (N_LAUNCHES == 1) { a.ph_lo = 0; a.ph_hi = NPHASE; hipLaunchKernelGGL(mega_fwd, dim3(grid), dim3(NWAVES * 64), LDS_BYTES, stream, a); }
    else for (int p = 0; p < NPHASE; ++p) { a.ph_lo = p; a.ph_hi = p + 1; hipLaunchKernelGGL(mega_fwd, dim3(grid), dim3(NWAVES * 64), LDS_BYTES, stream, a); }
}
```
